# Optimizing an MI355X kernel written in HIP

```python
import jax, jax.numpy as jnp
from jax import lax
import numpy as np


D_MODEL = 1024
BATCH = 16
SEQ = 4096
DEPTH = 1

GRID_W = 64
CTX_LEN = 256
N_HEADS = 8
N_KV_HEADS = 2
HEAD_DIM = 64
WINDOW = 128
BLOCK = 128
ROPE_BASE = 10000.0
M_HEADS = 4
M_DIM = 128
CHUNK = 128
CONV_W = 3
ATT_WIDTH = N_HEADS * HEAD_DIM
KV_WIDTH = N_KV_HEADS * HEAD_DIM
M_WIDTH = M_HEADS * M_DIM
MIX_WIDTH = ATT_WIDTH + M_WIDTH
IN_SPLITS = (ATT_WIDTH, KV_WIDTH, KV_WIDTH, M_WIDTH, M_WIDTH, M_WIDTH, M_WIDTH, 4 * M_HEADS)
IN_COLS = sum(IN_SPLITS)
N_EXPERTS = 16
EXPERT_FF = 512
CAPACITY = 2
EPS = 1e-6
NEG = -1e30

kernel_name = 'hybrid_swa_mlstm_ecmoe_dit_block'

f32 = jnp.float32


def rmsnorm(x, w):
    xf = x.astype(f32)
    y = xf * lax.rsqrt(jnp.mean(xf * xf, -1, keepdims=True) + EPS)
    return (y * w.astype(f32)).astype(x.dtype)


def modulate(h, shift, scale):
    return h * (1 + scale) + shift


def axial_rope_tables(n):
    rows = n // GRID_W
    row, col = jnp.meshgrid(jnp.arange(rows), jnp.arange(GRID_W), indexing='ij')
    n_freq = HEAD_DIM // 4
    freqs = ROPE_BASE ** (-jnp.arange(n_freq, dtype=f32) / n_freq)
    ang = jnp.concatenate([row.reshape(-1, 1).astype(f32) * freqs,
                           col.reshape(-1, 1).astype(f32) * freqs], -1)
    return jnp.cos(ang), jnp.sin(ang)


def apply_rope(x, cos, sin):
    shape = (1, cos.shape[0]) + (1,) * (x.ndim - 3) + (cos.shape[1],)
    cos = cos.reshape(shape)
    sin = sin.reshape(shape)
    x1, x2 = jnp.split(x.astype(f32), 2, -1)
    return jnp.concatenate([x1 * cos - x2 * sin, x2 * cos + x1 * sin], -1).astype(x.dtype)


def short_conv(u, w):
    n = u.shape[1]
    r = CONV_W // 2
    up = jnp.pad(u, ((0, 0), (r, r), (0, 0)))
    out = up[:, 0:n] * w[0]
    for j in range(1, CONV_W):
        out = out + up[:, j:j + n] * w[j]
    return out


def mixer_inputs(h, w_in, b_gates, conv_qk, q_norm_w, k_norm_w):
    B, N, _ = h.shape
    offs = np.cumsum(IN_SPLITS)[:-1].tolist()
    aq, ak, av, mq, mk, mv, mo, gates = jnp.split(h @ w_in, offs, -1)
    aq = rmsnorm(aq.reshape(B, N, N_KV_HEADS, N_HEADS // N_KV_HEADS, HEAD_DIM), q_norm_w)
    ak = rmsnorm(ak.reshape(B, N, N_KV_HEADS, HEAD_DIM), k_norm_w)
    av = av.reshape(B, N, N_KV_HEADS, HEAD_DIM)
    mqk = jax.nn.silu(short_conv(jnp.concatenate([mq, mk], -1), conv_qk))
    mq, mk = jnp.split(mqk, 2, -1)

    def heads(a):
        return a.reshape(B, N, M_HEADS, M_DIM).transpose(0, 2, 1, 3).astype(f32)

    g = (gates + b_gates).astype(f32).reshape(B, N, 4, M_HEADS).transpose(2, 0, 3, 1)
    li_f, f_f, li_b, f_b = g[0], g[1], g[2], g[3]
    return (aq, ak, av, heads(mq) * (M_DIM ** -0.5), heads(mk), heads(mv), mo,
            li_f, jax.nn.log_sigmoid(f_f), li_b, jax.nn.log_sigmoid(f_b))


def latent_attention(q, k, v, k_ctx, v_ctx, sink):
    B, N = q.shape[:2]
    L = k_ctx.shape[1]
    nb = N // BLOCK
    span = BLOCK + 2 * WINDOW
    pad = ((0, 0), (WINDOW, WINDOW), (0, 0), (0, 0))
    idx = jnp.arange(nb)[:, None] * BLOCK + jnp.arange(span)[None]
    k_blk = jnp.moveaxis(jnp.pad(k, pad)[:, idx], 1, 0)
    v_blk = jnp.moveaxis(jnp.pad(v, pad)[:, idx], 1, 0)
    q_blk = jnp.moveaxis(q.reshape((B, nb, BLOCK) + q.shape[2:]), 1, 0)
    scale = HEAD_DIM ** -0.5
    sink_f = sink.astype(f32)

    def one_block(args):
        qb, kb, vb, n = args
        qpos = n * BLOCK + jnp.arange(BLOCK)
        kpos = n * BLOCK - WINDOW + jnp.arange(span)
        ok = (kpos[None] >= 0) & (kpos[None] < N) & (jnp.abs(qpos[:, None] - kpos[None]) <= WINDOW)
        s_loc = jnp.einsum('bqkgd,bskd->bkgqs', qb, kb, preferred_element_type=f32) * scale
        s_loc = jnp.where(ok, s_loc, NEG)
        s_ctx = jnp.einsum('bqkgd,bckd->bkgqc', qb, k_ctx, preferred_element_type=f32) * scale
        s_sink = jnp.broadcast_to(sink_f[None, :, :, None, None], s_loc.shape[:-1] + (1,))
        p = jax.nn.softmax(jnp.concatenate([s_loc, s_ctx, s_sink], -1), -1)
        p_loc = p[..., :span].astype(vb.dtype)
        p_ctx = p[..., span:span + L].astype(vb.dtype)
        return (jnp.einsum('bkgqs,bskd->bqkgd', p_loc, vb)
                + jnp.einsum('bkgqc,bckd->bqkgd', p_ctx, v_ctx))

    o = lax.map(one_block, (q_blk, k_blk, v_blk, jnp.arange(nb)))
    return jnp.moveaxis(o, 0, 1).reshape(B, N, ATT_WIDTH)


def context_attention(q, k, v, sink):
    B, L = q.shape[:2]
    s = jnp.einsum('bqkgd,bckd->bkgqc', q, k, preferred_element_type=f32) * (HEAD_DIM ** -0.5)
    s_sink = jnp.broadcast_to(sink.astype(f32)[None, :, :, None, None], s.shape[:-1] + (1,))
    p = jax.nn.softmax(jnp.concatenate([s, s_sink], -1), -1)[..., :L].astype(v.dtype)
    return jnp.einsum('bkgqc,bckd->bqkgd', p, v).reshape(B, L, ATT_WIDTH)


def zero_state(batch):
    return (jnp.zeros((batch, M_HEADS, M_DIM, M_DIM), f32),
            jnp.zeros((batch, M_HEADS, M_DIM), f32),
            jnp.zeros((batch, M_HEADS), f32))


def mlstm_state_update(state, k, v, li, lf):
    C, n, m = state
    b = jnp.cumsum(lf, -1)
    b_last = b[..., -1]
    w = b_last[..., None] - b + li
    m_new = jnp.maximum(b_last + m, w.max(-1))
    a = jnp.exp(b_last + m - m_new)
    ws = jnp.exp(w - m_new[..., None])
    C_new = a[..., None, None] * C + jnp.einsum('bhs,bhsd,bhsv->bhdv', ws, k, v)
    n_new = a[..., None] * n + jnp.einsum('bhs,bhsd->bhd', ws, k)
    return (C_new, n_new, m_new)


def mlstm_chunk(state, xs):
    q, k, v, li, lf = xs
    C, n, m = state
    b = jnp.cumsum(lf, -1)
    within = jnp.tril(jnp.ones((CHUNK, CHUNK), bool))
    d = jnp.where(within, b[..., :, None] - b[..., None, :] + li[..., None, :], -jnp.inf)
    inter = b + m[..., None]
    m_t = jnp.maximum(inter, d.max(-1))
    wts = jnp.exp(d - m_t[..., None]) * jnp.einsum('bhtd,bhsd->bhts', q, k)
    decay = jnp.exp(inter - m_t)
    num = jnp.einsum('bhts,bhsv->bhtv', wts, v) + decay[..., None] * jnp.einsum('bhtd,bhdv->bhtv', q, C)
    den = wts.sum(-1) + decay * jnp.einsum('bhtd,bhd->bht', q, n)
    h = num / jnp.maximum(jnp.abs(den), jnp.exp(-m_t))[..., None]
    return mlstm_state_update(state, k, v, li, lf), h


def mlstm_scan(q, k, v, li, lf, state):
    B, H, N, _ = q.shape
    nc = N // CHUNK

    def chunks(a):
        return jnp.moveaxis(a.reshape((B, H, nc, CHUNK) + a.shape[3:]), 2, 0)

    state, h = lax.scan(mlstm_chunk, state, (chunks(q), chunks(k), chunks(v), chunks(li), chunks(lf)))
    return jnp.moveaxis(h, 0, 2).reshape(B, H, N, M_DIM), state


def flip(a):
    return jnp.flip(a, 2)


def bidir_mlstm(mq, mk, mv, li_f, lf_f, li_b, lf_b, st_f, st_b):
    h_f, end_f = mlstm_scan(mq, mk, mv, li_f, lf_f, st_f)
    h_b, end_b = mlstm_scan(flip(mq), flip(mk), flip(mv), flip(li_b), flip(lf_b), st_b)
    return h_f + flip(h_b), end_f, end_b


def mlstm_out(h_sum, mo, norm_w):
    B, H, N, _ = h_sum.shape
    h = jnp.moveaxis(h_sum, 1, 2)
    h = h * lax.rsqrt(jnp.mean(h * h, -1, keepdims=True) + EPS) * norm_w.astype(f32).reshape(M_HEADS, M_DIM)
    return (h.reshape(B, N, M_WIDTH) * jax.nn.sigmoid(mo.astype(f32))).astype(mo.dtype)


def expert_choice_ffn(h, w_router, w_gate, w_up, w_down):
    B, N, _ = h.shape
    cap = CAPACITY * N // N_EXPERTS
    aff = jax.nn.softmax((h @ w_router).astype(f32), -1)
    gate, idx = lax.top_k(jnp.swapaxes(aff, 1, 2), cap)
    bidx = jnp.arange(B)[:, None, None]
    xg = h[bidx, idx]
    g = jnp.einsum('becd,edf->becf', xg, w_gate)
    u = jnp.einsum('becd,edf->becf', xg, w_up)
    y = jnp.einsum('becf,efd->becd', jax.nn.silu(g) * u, w_down) * gate[..., None].astype(h.dtype)
    return jnp.zeros_like(h).at[bidx, idx].add(y)


def layer(x, ctx, mod_x, mod_c, norm1_w, norm2_w, w_in, b_gates, conv_qk, q_norm_w, k_norm_w,
          sink, mlstm_norm_w, w_out, w_router, w_gate, w_up, w_down, update_ctx):
    B = x.shape[0]
    sh1, sc1, g1, sh2, sc2, g2 = jnp.split(mod_x[:, None, :], 6, -1)
    csh1, csc1, cg1, csh2, csc2, cg2 = jnp.split(mod_c, 6, -1)
    sink_r = sink.reshape(N_KV_HEADS, N_HEADS // N_KV_HEADS)

    hx = modulate(rmsnorm(x, norm1_w), sh1, sc1)
    hc = modulate(rmsnorm(ctx, norm1_w), csh1, csc1)
    aq, ak, av, mq, mk, mv, mo, li_f, lf_f, li_b, lf_b = mixer_inputs(hx, w_in, b_gates, conv_qk, q_norm_w, k_norm_w)
    caq, cak, cav, cmq, cmk, cmv, cmo, cli_f, clf_f, cli_b, clf_b = mixer_inputs(hc, w_in, b_gates, conv_qk, q_norm_w, k_norm_w)

    cos, sin = axial_rope_tables(x.shape[1])
    att = latent_attention(apply_rope(aq, cos, sin), apply_rope(ak, cos, sin), av, cak, cav, sink_r)

    if update_ctx:
        hc_sum, st_f, st_b = bidir_mlstm(cmq, cmk, cmv, cli_f, clf_f, cli_b, clf_b, zero_state(B), zero_state(B))
        c_mix = jnp.concatenate([context_attention(caq, cak, cav, sink_r), mlstm_out(hc_sum, cmo, mlstm_norm_w)], -1)
        ctx_new = ctx + cg1 * (c_mix @ w_out)
        hc2 = modulate(rmsnorm(ctx_new, norm2_w), csh2, csc2)
        ctx_new = ctx_new + cg2 * expert_choice_ffn(hc2, w_router, w_gate, w_up, w_down)
    else:
        st_f = mlstm_state_update(zero_state(B), cmk, cmv, cli_f, clf_f)
        st_b = mlstm_state_update(zero_state(B), flip(cmk), flip(cmv), flip(cli_b), flip(clf_b))
        ctx_new = ctx

    h_sum, _, _ = bidir_mlstm(mq, mk, mv, li_f, lf_f, li_b, lf_b, st_f, st_b)
    mix = jnp.concatenate([att, mlstm_out(h_sum, mo, mlstm_norm_w)], -1)
    x = x + g1 * (mix @ w_out)

    hx2 = modulate(rmsnorm(x, norm2_w), sh2, sc2)
    x = x + g2 * expert_choice_ffn(hx2, w_router, w_gate, w_up, w_down)
    return x, ctx_new


def setup_inputs(seed: int = 0) -> dict:
    key = jax.random.key(seed)
    ks = jax.random.split(key, 24)
    D = D_MODEL

    def nrm(k, shape, scale):
        return jax.random.normal(k, shape, f32) * scale

    f_bias = 3.0 + 0.5 * jax.random.normal(ks[20], (DEPTH, 2, M_HEADS), f32)
    i_bias = 0.1 * jax.random.normal(ks[21], (DEPTH, 2, M_HEADS), f32)
    b_gates = jnp.stack([i_bias[:, 0], f_bias[:, 0], i_bias[:, 1], f_bias[:, 1]], 1).reshape(DEPTH, 4 * M_HEADS)
    return {
        'x': nrm(ks[0], (BATCH, SEQ, D), 1.0),
        'c': nrm(ks[1], (BATCH, D), 1.0),
        'ctx': nrm(ks[2], (BATCH, CTX_LEN, D), 1.0),
        'c_ctx': nrm(ks[3], (D,), 1.0),
        'w_mod': nrm(ks[4], (DEPTH, D, 6 * D), 0.5 * D ** -0.5),
        'b_mod': nrm(ks[5], (DEPTH, 6 * D), 0.02),
        'norm1_w': 1.0 + nrm(ks[6], (DEPTH, D), 0.02),
        'norm2_w': 1.0 + nrm(ks[7], (DEPTH, D), 0.02),
        'w_in': nrm(ks[8], (DEPTH, D, IN_COLS), D ** -0.5),
        'b_gates': b_gates,
        'conv_qk': nrm(ks[9], (DEPTH, CONV_W, 2 * M_WIDTH), CONV_W ** -0.5),
        'q_norm_w': 1.0 + nrm(ks[10], (DEPTH, HEAD_DIM), 0.02),
        'k_norm_w': 1.0 + nrm(ks[11], (DEPTH, HEAD_DIM), 0.02),
        'sink': nrm(ks[12], (DEPTH, N_HEADS), 0.5),
        'mlstm_norm_w': 1.0 + nrm(ks[13], (DEPTH, M_WIDTH), 0.02),
        'w_out': nrm(ks[14], (DEPTH, MIX_WIDTH, D), MIX_WIDTH ** -0.5),
        'w_router': nrm(ks[15], (DEPTH, D, N_EXPERTS), D ** -0.5),
        'w_gate': nrm(ks[16], (DEPTH, N_EXPERTS, D, EXPERT_FF), D ** -0.5),
        'w_up': nrm(ks[17], (DEPTH, N_EXPERTS, D, EXPERT_FF), D ** -0.5),
        'w_down': nrm(ks[18], (DEPTH, N_EXPERTS, EXPERT_FF, D), EXPERT_FF ** -0.5),
    }


def reference(x, c, ctx, c_ctx, w_mod, b_mod, norm1_w, norm2_w, w_in, b_gates, conv_qk, q_norm_w,
              k_norm_w, sink, mlstm_norm_w, w_out, w_router, w_gate, w_up, w_down):
    for l in range(DEPTH):
        mod_x = jax.nn.silu(c) @ w_mod[l] + b_mod[l]
        mod_c = jax.nn.silu(c_ctx) @ w_mod[l] + b_mod[l]
        x, ctx = layer(x, ctx, mod_x, mod_c, norm1_w[l], norm2_w[l], w_in[l], b_gates[l], conv_qk[l],
                       q_norm_w[l], k_norm_w[l], sink[l], mlstm_norm_w[l], w_out[l], w_router[l],
                       w_gate[l], w_up[l], w_down[l], l < DEPTH - 1)
    return x
```

```cpp
#include <hip/hip_runtime.h>
#include <cstdio>
#include <cstdint>

namespace nv {
constexpr int D = 1024, B = 16, N = 4096, L = 256;
constexpr int MT = B * N;
constexpr int MC = B * L;
constexpr int MA = MT + MC;
constexpr int INC = 2832;
constexpr int E = 16, FF = 512, CAP = 512;
constexpr float EPS = 1e-6f;

__device__ __forceinline__ float wave_sum(float v) {
#pragma unroll
    for (int o = 1; o < 64; o <<= 1) v += __shfl_xor(v, o);
    return v;
}
__device__ __forceinline__ float silu(float x) { return x / (1.f + expf(-x)); }
__device__ __forceinline__ float sigmoidf(float x) { return 1.f / (1.f + expf(-x)); }
__device__ __forceinline__ float logsig(float x) { return fminf(x, 0.f) - log1pf(expf(-fabsf(x))); }

__device__ __forceinline__ const float* in_row(const float* x, const float* ctx, int m) { return m < MT ? x + (size_t)m * D : ctx + (size_t)(m - MT) * D; }
__device__ __forceinline__ int mod_row(int m) { return m < MT ? m / N : 16; }

__global__ void k_mod(const float* c, const float* c_ctx, const float* w_mod, const float* b_mod, float* mod) {
    const int col = blockIdx.x * 256 + threadIdx.x, r = blockIdx.y;
    const float* src = r < 16 ? c + r * D : c_ctx;
    float acc = b_mod[col];
    for (int k = 0; k < D; ++k) acc += silu(src[k]) * w_mod[(size_t)k * 6144 + col];
    mod[r * 6144 + col] = acc;
}
__global__ void k_rinv(const float* x, const float* ctx, float* rinv) {
    const int m = blockIdx.x * 4 + (threadIdx.x >> 6), lane = threadIdx.x & 63;
    const float* r = in_row(x, ctx, m);
    float s = 0.f;
    for (int k = lane; k < D; k += 64) s += r[k] * r[k];
    s = wave_sum(s);
    if (lane == 0) rinv[m] = rsqrtf(s / D + EPS);
}

struct AProj { const float* x; const float* ctx; const float* rinv; const float* mod; const float* n1w;
    __device__ __forceinline__ float operator()(int z, int m, int k) const { const int r = mod_row(m); const float* mr = mod + r * 6144;
        return in_row(x, ctx, m)[k] * rinv[m] * n1w[k] * (1.f + mr[D + k]) + mr[k]; } };
struct APlain { const float* A; int lda;
    __device__ __forceinline__ float operator()(int z, int m, int k) const { return A[(size_t)m * lda + k]; } };
struct AGather { const float* hx2; const int* idx;
    __device__ __forceinline__ float operator()(int z, int m, int k) const { const int b = z >> 4; return hx2[((size_t)b * N + idx[z * CAP + m]) * D + k]; } };

struct EProj { float* Pa; float* Pm; float* G; const float* b_gates;
    __device__ __forceinline__ void operator()(int z, int m, int n, float v, float v2) const {
        if (n < 768) Pa[(size_t)m * 768 + n] = v; else if (n < 2816) Pm[(size_t)m * 2048 + (n - 768)] = v; else G[(size_t)m * 16 + (n - 2816)] = v + b_gates[n - 2816]; } };
struct EOut { const float* x; const float* mod; float* x1;
    __device__ __forceinline__ void operator()(int z, int m, int n, float v, float v2) const { const int b = m / N; x1[(size_t)m * D + n] = x[(size_t)m * D + n] + mod[b * 6144 + 2 * D + n] * v; } };
struct EAct { float* act;
    __device__ __forceinline__ void operator()(int z, int m, int n, float v, float v2) const { act[((size_t)z * CAP + m) * FF + n] = silu(v) * v2; } };

template <class AL, class EP, bool DUAL>
__global__ void __launch_bounds__(256) k_gemm(AL al, EP ep, const float* W, const float* W2, size_t wz_stride, int wz_mod, int M, int Nn, int K) {
    __shared__ float As[16][68], Bs[16][68], Bs2[DUAL ? 16 : 1][68];
    const int tid = threadIdx.x, tx = tid & 15, ty = tid >> 4, z = blockIdx.z;
    const int m0 = blockIdx.y * 64, n0 = blockIdx.x * 64;
    const float* Wz = W + (size_t)(z % wz_mod) * wz_stride; const float* Wz2 = DUAL ? W2 + (size_t)(z % wz_mod) * wz_stride : nullptr;
    float acc[4][4], acc2[4][4];
#pragma unroll
    for (int i = 0; i < 4; ++i)
#pragma unroll
        for (int j = 0; j < 4; ++j) { acc[i][j] = 0.f; acc2[i][j] = 0.f; }
    for (int k0 = 0; k0 < K; k0 += 16) {
#pragma unroll
        for (int i = 0; i < 4; ++i) { const int e = tid + i * 256, kk = e & 15, mm = e >> 4; As[kk][mm] = al(z, m0 + mm, k0 + kk); }
#pragma unroll
        for (int i = 0; i < 4; ++i) { const int e = tid + i * 256, nn = e & 63, kk = e >> 6; const int n = n0 + nn;
            Bs[kk][nn] = n < Nn ? Wz[(size_t)(k0 + kk) * Nn + n] : 0.f; if (DUAL) Bs2[kk][nn] = n < Nn ? Wz2[(size_t)(k0 + kk) * Nn + n] : 0.f; }
        __syncthreads();
#pragma unroll
        for (int kk = 0; kk < 16; ++kk) {
            float a[4], b[4], b2[4];
#pragma unroll
            for (int i = 0; i < 4; ++i) { a[i] = As[kk][ty * 4 + i]; b[i] = Bs[kk][tx * 4 + i]; if (DUAL) b2[i] = Bs2[kk][tx * 4 + i]; }
#pragma unroll
            for (int i = 0; i < 4; ++i)
#pragma unroll
                for (int j = 0; j < 4; ++j) { acc[i][j] += a[i] * b[j]; if (DUAL) acc2[i][j] += a[i] * b2[j]; }
        }
        __syncthreads();
    }
#pragma unroll
    for (int i = 0; i < 4; ++i)
#pragma unroll
        for (int j = 0; j < 4; ++j) { const int m = m0 + ty * 4 + i, n = n0 + tx * 4 + j; if (n < Nn) ep(z, m, n, acc[i][j], acc2[i][j]); }
}

__global__ void k_qkpost(float* Pa, const float* qw, const float* kw) {
    const int gw = blockIdx.x * 4 + (threadIdx.x >> 6), lane = threadIdx.x & 63;
    const int m = gw / 10, slot = gw % 10;
    if (m >= MA) return;
    if (m >= MT && slot < 8) return;
    float* p = Pa + (size_t)m * 768 + slot * 64;
    const float v = p[lane];
    const float ss = wave_sum(v * v);
    float y = v * rsqrtf(ss / 64.f + EPS) * (slot < 8 ? qw[lane] : kw[lane]);
    if (m < MT) {
        const int n = m % N, i = lane & 31, fi = i & 15;
        const float pos = (float)(i < 16 ? n / 64 : n % 64);
        const float freq = powf(10000.f, -(float)fi / 16.f);
        const float ang = pos * freq, cs = cosf(ang), sn = sinf(ang);
        const float other = __shfl_xor(y, 32);
        y = lane < 32 ? y * cs - other * sn : y * cs + other * sn;
    }
    p[lane] = y;
}

__global__ void __launch_bounds__(256) k_attn(const float* Pa, const float* sink, float* mix) {
    __shared__ float sc[4][640];
    const int w = threadIdx.x >> 6, lane = threadIdx.x & 63;
    const int gw = blockIdx.x * 4 + w, m = gw >> 3, h = gw & 7, kv = h >> 2;
    const int b = m / N, n = m % N;
    const float q = Pa[(size_t)m * 768 + h * 64 + lane];
    const int j0 = max(0, n - 128), j1 = min(N - 1, n + 128), nl = j1 - j0 + 1;
    float mx = sink[h];
    for (int j = 0; j < nl + L; ++j) {
        const int row = j < nl ? b * N + j0 + j : MT + b * L + (j - nl);
        const float s = wave_sum(q * Pa[(size_t)row * 768 + 512 + kv * 64 + lane]) * 0.125f;
        if (lane == 0) sc[w][j] = s;
        mx = fmaxf(mx, s);
    }
    __syncthreads();
    float l = expf(sink[h] - mx), o = 0.f;
    for (int j = 0; j < nl + L; ++j) {
        const int row = j < nl ? b * N + j0 + j : MT + b * L + (j - nl);
        const float p = expf(sc[w][j] - mx);
        l += p; o += p * Pa[(size_t)row * 768 + 640 + kv * 64 + lane];
    }
    mix[(size_t)m * D + h * 64 + lane] = o / l;
}

__global__ void __launch_bounds__(1024) k_mlstm(const float* Pm, const float* G, const float* conv, float* Hf, float* Hb) {
    __shared__ float qs[128], ks[128], vs[128], part[8][128], dpart[128], gl[2];
    const int tid = threadIdx.x, id = blockIdx.x, dir = id & 1, h = (id >> 1) & 3, b = id >> 3;
    const int v = tid & 127, dg = tid >> 7;
    float Cst[16]; float nst = 0.f;
#pragma unroll
    for (int i = 0; i < 16; ++i) Cst[i] = 0.f;
    for (int step = 0; step < L + N; ++step) {
        int seqbase, len, pos;
        if (step < L) { seqbase = MT + b * L; len = L; pos = dir ? L - 1 - step : step; }
        else { seqbase = b * N; len = N; pos = dir ? N - 1 - (step - L) : step - L; }
        const int row = seqbase + pos;
        if (tid < 256) {
            const int ch = (tid < 128 ? 0 : 512) + h * 128 + (tid & 127);
            const float* base = Pm + (size_t)row * 2048 + ch;
            float u = base[0] * conv[1 * 1024 + ch];
            if (pos > 0) u += base[-2048] * conv[0 * 1024 + ch];
            if (pos < len - 1) u += base[2048] * conv[2 * 1024 + ch];
            u = silu(u);
            if (tid < 128) qs[tid] = u * 0.08838834764831845f; else ks[tid - 128] = u;
        } else if (tid < 384) {
            vs[tid - 256] = Pm[(size_t)row * 2048 + 1024 + h * 128 + (tid - 256)];
        } else if (tid == 384) {
            const float* g = G + (size_t)row * 16;
            gl[0] = expf(g[(dir ? 8 : 0) + h]);
            gl[1] = expf(logsig(g[(dir ? 12 : 4) + h]));
        }
        __syncthreads();
        const float ig = gl[0], fg = gl[1], vv = vs[v];
        float pn = 0.f;
#pragma unroll
        for (int i = 0; i < 16; ++i) { const int d = dg * 16 + i; Cst[i] = fg * Cst[i] + ig * ks[d] * vv; pn += qs[d] * Cst[i]; }
        part[dg][v] = pn;
        if (tid < 128) { nst = fg * nst + ig * ks[tid]; dpart[tid] = qs[tid] * nst; }
        __syncthreads();
        if (step >= L && tid < 128) {
            float num = 0.f, den = 0.f;
#pragma unroll
            for (int i = 0; i < 8; ++i) num += part[i][tid];
            for (int i = 0; i < 128; ++i) den += dpart[i];
            (dir ? Hb : Hf)[(size_t)row * 512 + h * 128 + tid] = num / fmaxf(fabsf(den), 1.f);
        }
        __syncthreads();
    }
}
__global__ void k_mlstm_out(const float* Hf, const float* Hb, const float* Pm, const float* nw, float* mix) {
    const int gw = blockIdx.x * 4 + (threadIdx.x >> 6), lane = threadIdx.x & 63, m = gw >> 2, h = gw & 3;
    const size_t o = (size_t)m * 512 + h * 128;
    const float a0 = Hf[o + lane] + Hb[o + lane], a1 = Hf[o + 64 + lane] + Hb[o + 64 + lane];
    const float r = rsqrtf(wave_sum(a0 * a0 + a1 * a1) / 128.f + EPS);
    const float* mo = Pm + (size_t)m * 2048 + 1536 + h * 128;
    mix[(size_t)m * D + 512 + h * 128 + lane] = a0 * r * nw[h * 128 + lane] * sigmoidf(mo[lane]);
    mix[(size_t)m * D + 512 + h * 128 + 64 + lane] = a1 * r * nw[h * 128 + 64 + lane] * sigmoidf(mo[64 + lane]);
}
__global__ void __launch_bounds__(256) k_hx2(const float* x1, const float* mod, const float* n2w, const float* wr, float* hx2, float* aff) {
    __shared__ float red[4], hrow[D], lg[16];
    const int m = blockIdx.x, tid = threadIdx.x, b = m / N, n = m % N;
    const float* r = x1 + (size_t)m * D;
    float v[4], s = 0.f;
#pragma unroll
    for (int i = 0; i < 4; ++i) { v[i] = r[tid + 256 * i]; s += v[i] * v[i]; }
    s = wave_sum(s); if ((tid & 63) == 0) red[tid >> 6] = s;
    __syncthreads();
    const float rinv = rsqrtf((red[0] + red[1] + red[2] + red[3]) / D + EPS);
    const float* mr = mod + b * 6144;
#pragma unroll
    for (int i = 0; i < 4; ++i) { const int k = tid + 256 * i; const float hv = v[i] * rinv * n2w[k] * (1.f + mr[4 * D + k]) + mr[3 * D + k]; hrow[k] = hv; hx2[(size_t)m * D + k] = hv; }
    __syncthreads();
    { const int e = tid >> 4, part = tid & 15; float a = 0.f; for (int k = part; k < D; k += 16) a += hrow[k] * wr[k * 16 + e];
      a += __shfl_xor(a, 1); a += __shfl_xor(a, 2); a += __shfl_xor(a, 4); a += __shfl_xor(a, 8); if (part == 0) lg[e] = a; }
    __syncthreads();
    if (tid < 16) { float mx = lg[0]; for (int e = 1; e < 16; ++e) mx = fmaxf(mx, lg[e]); float sum = 0.f; for (int e = 0; e < 16; ++e) sum += expf(lg[e] - mx);
        aff[((size_t)b * 16 + tid) * N + n] = expf(lg[tid] - mx) / sum; }
}
__global__ void __launch_bounds__(1024) k_topk(const float* aff, int* idx, float* gate, int* slotmap) {
    __shared__ float a[N];
    const int z = blockIdx.x, tid = threadIdx.x;
    for (int i = tid; i < N; i += 1024) a[i] = aff[(size_t)z * N + i];
    __syncthreads();
    for (int i = tid; i < N; i += 1024) { const float ai = a[i]; int rank = 0;
        for (int j = 0; j < N; ++j) { const float aj = a[j]; rank += (aj > ai || (aj == ai && j < i)) ? 1 : 0; }
        if (rank < CAP) { idx[z * CAP + rank] = i; gate[z * CAP + rank] = ai; slotmap[(size_t)z * N + i] = rank; } else slotmap[(size_t)z * N + i] = -1; }
}
__global__ void __launch_bounds__(256) k_final(const float* x1, const float* mod, const float* act, const float* gate, const int* slotmap, const float* wd, float* out) {
    const int m = blockIdx.x, b = m / N, n = m % N;
    for (int col = threadIdx.x; col < D; col += 256) {
        float acc = 0.f;
        for (int e = 0; e < 16; ++e) { const int z = b * 16 + e, slot = slotmap[(size_t)z * N + n]; if (slot < 0) continue;
            const float* ar = act + ((size_t)z * CAP + slot) * FF; const float* w = wd + (size_t)e * FF * D + col; float a = 0.f;
            for (int f = 0; f < FF; ++f) a += ar[f] * w[(size_t)f * D];
            acc += a * gate[z * CAP + slot]; }
        out[(size_t)m * D + col] = x1[(size_t)m * D + col] + mod[b * 6144 + 5 * D + col] * acc;
    }
}
}

extern "C" void kernel_launch(void* const* d_in, const int* in_sizes, int n_in, void* d_out, int out_size, void* d_ws, size_t ws_size, hipStream_t stream) {
    using namespace nv;
    const float* x = (const float*)d_in[0]; const float* c = (const float*)d_in[1]; const float* ctx = (const float*)d_in[2]; const float* c_ctx = (const float*)d_in[3];
    const float* w_mod = (const float*)d_in[4]; const float* b_mod = (const float*)d_in[5]; const float* n1w = (const float*)d_in[6]; const float* n2w = (const float*)d_in[7];
    const float* w_in = (const float*)d_in[8]; const float* b_gates = (const float*)d_in[9]; const float* conv = (const float*)d_in[10]; const float* qw = (const float*)d_in[11];
    const float* kw = (const float*)d_in[12]; const float* sink = (const float*)d_in[13]; const float* mnw = (const float*)d_in[14]; const float* w_out = (const float*)d_in[15];
    const float* w_router = (const float*)d_in[16]; const float* w_gate = (const float*)d_in[17]; const float* w_up = (const float*)d_in[18]; const float* w_down = (const float*)d_in[19];
    float* out = (float*)d_out;
    char* ws = (char*)d_ws; size_t off = 0;
    auto carve = [&](size_t bytes) { char* p = ws + off; off += (bytes + 255) & ~(size_t)255; return p; };
    float* mod = (float*)carve(17 * 6144 * 4); float* rinv = (float*)carve((size_t)MA * 4); float* G = (float*)carve((size_t)MA * 16 * 4);
    float* aff = (float*)carve((size_t)B * E * N * 4); int* idx = (int*)carve(256 * CAP * 4); float* gate = (float*)carve(256 * CAP * 4); int* slotmap = (int*)carve((size_t)256 * N * 4);
    float* Pa = (float*)carve((size_t)MA * 768 * 4);
    float* Pm = (float*)carve((size_t)MA * 2048 * 4);
    float* Hf = (float*)carve((size_t)MT * 512 * 4); float* Hb = (float*)carve((size_t)MT * 512 * 4);
    float* mix = out;
    float* x1 = Pm; float* hx2 = Pm + (size_t)MT * D;
    float* act = Hf;
    if (off > ws_size) { fprintf(stderr, "ws too small: need %zu have %zu\n", off, ws_size); return; }

    k_mod<<<dim3(24, 17), 256, 0, stream>>>(c, c_ctx, w_mod, b_mod, mod);
    k_rinv<<<MA / 4, 256, 0, stream>>>(x, ctx, rinv);
    k_gemm<AProj, EProj, false><<<dim3((INC + 63) / 64, MA / 64, 1), 256, 0, stream>>>(AProj{x, ctx, rinv, mod, n1w}, EProj{Pa, Pm, G, b_gates}, w_in, nullptr, 0, 1, MA, INC, D);
    k_qkpost<<<(MA * 10 + 3) / 4, 256, 0, stream>>>(Pa, qw, kw);
    k_attn<<<MT * 8 / 4, 256, 0, stream>>>(Pa, sink, mix);
    k_mlstm<<<128, 1024, 0, stream>>>(Pm, G, conv, Hf, Hb);
    k_mlstm_out<<<MT * 4 / 4, 256, 0, stream>>>(Hf, Hb, Pm, mnw, mix);
    k_gemm<APlain, EOut, false><<<dim3(D / 64, MT / 64, 1), 256, 0, stream>>>(APlain{mix, D}, EOut{x, mod, x1}, w_out, nullptr, 0, 1, MT, D, D);
    k_hx2<<<MT, 256, 0, stream>>>(x1, mod, n2w, w_router, hx2, aff);
    k_topk<<<256, 1024, 0, stream>>>(aff, idx, gate, slotmap);
    k_gemm<AGather, EAct, true><<<dim3(FF / 64, CAP / 64, 256), 256, 0, stream>>>(AGather{hx2, idx}, EAct{act}, w_gate, w_up, (size_t)D * FF, 16, CAP, FF, D);
    k_final<<<MT, 256, 0, stream>>>(x1, mod, act, gate, slotmap, w_down, out);
}
```

```cpp
#include <hip/hip_runtime.h>
#include <hip/hip_cooperative_groups.h>
#include <cstdio>
#include <cstdint>
namespace cg = cooperative_groups;
namespace pg8 {
#define PG8_LAS __attribute__((address_space(3)))
typedef unsigned short bf16_t;
typedef short bf16x8 __attribute__((ext_vector_type(8)));
typedef float f32x4 __attribute__((ext_vector_type(4)));
typedef unsigned u32x4 __attribute__((ext_vector_type(4)));
constexpr int BM = 256, BK = 64, HALF = 128, HTB = HALF * BK * 2  , STAGE_BYTES = 8 * HTB, NXCD = 8, WGM = 8;

__host__ __device__ __forceinline__ int lds_byte(int r, int c) { const int st = (r >> 4) * 2 + (c >> 5), rr = r & 15, cc = c & 31, ob = rr * 64 + cc * 2; return st * 1024 + (ob ^ (((ob >> 9) & 1) << 5)); }
__host__ __device__ __forceinline__ void stage_rc(int b, int& R, int& C) { const int st = b / 1024, sb = b % 1024, swz = sb ^ (((sb >> 9) & 1) << 5); R = (st >> 1) * 16 + swz / 64; C = (st & 1) * 32 + (swz % 64) / 2; }
__host__ __device__ __forceinline__ int perm32(int rho) { const int n = rho >> 4, i = rho & 15; return 8 * (i >> 2) + 4 * n + (i & 3); }

struct Unit { int pm, pn; };
struct Gemm { const bf16_t* A; const bf16_t* Bt; int M, N, K; };

struct StaticOrder {
    int nM, nN, nwg, G, c;
    __host__ __device__ void init(int M, int N, int G_, int c_) { nM = M / BM; nN = N / BM; nwg = nM * nN; G = G_; c = c_; }
    __host__ __device__ bool next(int i, Unit& u) const {
        const long L = (long)i * G + c; if (L >= nwg) return false;
        int wgid = (int)L; { const int q = nwg / NXCD, r = nwg % NXCD, xcd = wgid % NXCD, off = wgid / NXCD; wgid = (xcd < r ? xcd * (q + 1) : r * (q + 1) + (xcd - r) * q) + off; }
        const int nig = WGM * nN, gid = wgid / nig, fm = gid * WGM, gsz = (nM - fm) < WGM ? (nM - fm) : WGM;
        u.pm = fm + ((wgid % nig) % gsz); u.pn = (wgid % nig) / gsz; return true;
    }
    __device__ __forceinline__ void a_ready(const Unit&) const {}
    __device__ __forceinline__ void done(const Unit&) const {}
};
__device__ __forceinline__ unsigned cvt_pk_bf16(float lo, float hi) { unsigned r; asm volatile("v_cvt_pk_bf16_f32 %0, %1, %2" : "=v"(r) : "v"(lo), "v"(hi)); return r; }
typedef float f32x2 __attribute__((ext_vector_type(2)));
template <class Epi, class Sched, bool ALIGN_EPI = false, bool SP2 = false>
__device__ __forceinline__ void gemm_phase(PG8_LAS unsigned char* lds, const Gemm g, const Sched& S, const Epi& E) {
    const int tid = threadIdx.x, wid = __builtin_amdgcn_readfirstlane(tid >> 6), lane = tid & 63, wr = wid >> 2, wc = wid & 3, fr = lane & 15, fq = lane >> 4;
    const int K = g.K, nt = K / BK;
    unsigned voffA[2], voffB[2];
#pragma unroll
    for (int i = 0; i < 2; ++i) { int R, C; stage_rc(tid * 16 + i * 8192, R, C); const int Rb = Epi::PERM ? ((R & ~31) + perm32(R & 31)) : R;
        voffA[i] = (unsigned)(R * K + C) * 2u; voffB[i] = (unsigned)(Rb * K + C) * 2u; }
    const size_t kstep = (size_t)(BK * 2);
    const size_t hstep = (size_t)HALF * K * 2;
    const size_t tstep = 2 * hstep;
    const unsigned ldsw = (unsigned)wid * 1024u;
    const int aoff = lds_byte(wr * 64 + fr, fq * 8), boff = lds_byte(wc * 32 + fr, fq * 8);
#define PG8_SA(b, h) (((b) * 2 + (h)) * HTB)
#define PG8_SB(b, h) ((4 + (b) * 2 + (h)) * HTB)
#define PG8_STAGE(bufoff, gbase, voff) do { _Pragma("unroll") for (int _i = 0; _i < 2; ++_i) \
        __builtin_amdgcn_global_load_lds((const unsigned*)((const char*)(gbase) + (voff)[_i]), (PG8_LAS unsigned*)(lds + (bufoff) + ldsw + _i * 8192), 16, 0, 0); } while (0)
#define PG8_LDA(dst, b, h) do { _Pragma("unroll") for (int m = 0; m < 4; ++m) _Pragma("unroll") for (int k = 0; k < 2; ++k) dst[m][k] = *(const PG8_LAS bf16x8*)(lds + PG8_SA(b, h) + aoff + m * 2048 + k * 1024); } while (0)
#define PG8_LDB(dst, b, h) do { _Pragma("unroll") for (int n = 0; n < 2; ++n) _Pragma("unroll") for (int k = 0; k < 2; ++k) dst[n][k] = *(const PG8_LAS bf16x8*)(lds + PG8_SB(b, h) + boff + n * 2048 + k * 1024); } while (0)
#define PG8_MMA(ai, bj, At, Bt) do { __builtin_amdgcn_s_setprio(1); _Pragma("unroll") for (int m = 0; m < 4; ++m) _Pragma("unroll") for (int n = 0; n < 2; ++n) _Pragma("unroll") for (int k = 0; k < 2; ++k) \
        acc[ai][bj][m][n] = __builtin_amdgcn_mfma_f32_16x16x32_bf16(Bt[n][k], At[m][k], acc[ai][bj][m][n], 0, 0, 0); __builtin_amdgcn_s_setprio(0); } while (0)
#define PG8_WAIT_V(n) asm volatile("s_waitcnt vmcnt(" #n ")" ::: "memory")
#define PG8_WAIT_L(n) asm volatile("s_waitcnt lgkmcnt(" #n ")" ::: "memory")
#define PG8_BAR __builtin_amdgcn_s_barrier()
#define PG8_SCHED __builtin_amdgcn_sched_barrier(0)
    Unit cur, nxt; int ui = 0;
    if (!S.next(0, cur)) return;
    f32x4 acc[2][2][4][2];
#pragma unroll
    for (int a = 0; a < 2; ++a)
#pragma unroll
        for (int b = 0; b < 2; ++b)
#pragma unroll
            for (int m = 0; m < 4; ++m)
#pragma unroll
                for (int n = 0; n < 2; ++n) acc[a][b][m][n] = (f32x4){0.f, 0.f, 0.f, 0.f};
    bf16x8 At[4][2], B0[2][2], B1[2][2];
    const char* cA = (const char*)g.A + (size_t)cur.pm * tstep; const char* cB = (const char*)g.Bt + (size_t)cur.pn * tstep;
    S.a_ready(cur);
    if constexpr (SP2) {
        PG8_STAGE(PG8_SB(0, 0), cB, voffB); PG8_STAGE(PG8_SB(0, 1), cB + hstep, voffB); PG8_STAGE(PG8_SA(0, 0), cA, voffA); PG8_STAGE(PG8_SA(0, 1), cA + hstep, voffA);
        if (wr == 1) PG8_BAR;
        PG8_WAIT_V(2); PG8_BAR;
        PG8_STAGE(PG8_SB(1, 0), cB + kstep, voffB); PG8_STAGE(PG8_SA(1, 0), cA + kstep, voffA); PG8_STAGE(PG8_SB(1, 1), cB + hstep + kstep, voffB);
        PG8_WAIT_V(6); PG8_BAR;
    } else {
        PG8_STAGE(PG8_SB(0, 0), cB, voffB); PG8_STAGE(PG8_SA(0, 0), cA, voffA); PG8_STAGE(PG8_SB(0, 1), cB + hstep, voffB); PG8_STAGE(PG8_SA(0, 1), cA + hstep, voffA);
        if (wr == 1) PG8_BAR;
        PG8_WAIT_V(4); PG8_BAR;
        PG8_STAGE(PG8_SB(1, 0), cB + kstep, voffB); PG8_STAGE(PG8_SA(1, 0), cA + kstep, voffA); PG8_STAGE(PG8_SB(1, 1), cB + hstep + kstep, voffB);
        PG8_WAIT_V(6); PG8_BAR;
    }
    for (;;) {
        const bool has_next = S.next(ui + 1, nxt);
        const char* nA = has_next ? (const char*)g.A + (size_t)nxt.pm * tstep : cA; const char* nB = has_next ? (const char*)g.Bt + (size_t)nxt.pn * tstep : cB;
        for (int t = 0; t < nt; t += 2) {
            const bool last = (t == nt - 2);
            const char* a1 = cA + (size_t)(t + 1) * kstep;
            const char* a2 = last ? nA : cA + (size_t)(t + 2) * kstep; const char* b2 = last ? nB : cB + (size_t)(t + 2) * kstep;
            const char* a3 = a2 + kstep; const char* b3 = b2 + kstep;
            if (last && has_next) S.a_ready(nxt);
            if constexpr (SP2) {
            PG8_LDB(B0, 0, 0); PG8_LDB(B1, 0, 1); PG8_SCHED; PG8_LDA(At, 0, 0); PG8_STAGE(PG8_SA(1, 1), a1 + hstep, voffA);
            PG8_WAIT_V(8); PG8_WAIT_L(0); PG8_BAR; PG8_MMA(0, 0, At, B0); PG8_MMA(0, 1, At, B1); PG8_BAR; PG8_SCHED;
            PG8_LDA(At, 0, 1); PG8_STAGE(PG8_SB(0, 0), b2, voffB); PG8_STAGE(PG8_SB(0, 1), b2 + hstep, voffB); PG8_STAGE(PG8_SA(0, 0), a2, voffA);
            PG8_WAIT_V(8); PG8_WAIT_L(0); PG8_BAR; PG8_MMA(1, 0, At, B0); PG8_MMA(1, 1, At, B1); PG8_BAR; PG8_SCHED;
            PG8_LDB(B0, 1, 0); PG8_LDB(B1, 1, 1); PG8_SCHED; PG8_LDA(At, 1, 0); PG8_STAGE(PG8_SA(0, 1), a2 + hstep, voffA);
            PG8_WAIT_V(8); PG8_WAIT_L(0); PG8_BAR; PG8_MMA(0, 0, At, B0); PG8_MMA(0, 1, At, B1); PG8_BAR; PG8_SCHED;
            PG8_LDA(At, 1, 1); PG8_STAGE(PG8_SB(1, 0), b3, voffB); PG8_STAGE(PG8_SB(1, 1), b3 + hstep, voffB); PG8_STAGE(PG8_SA(1, 0), a3, voffA);
            PG8_WAIT_V(8); PG8_WAIT_L(0); PG8_BAR; PG8_MMA(1, 0, At, B0); PG8_MMA(1, 1, At, B1); PG8_BAR; PG8_SCHED;
            } else {
            PG8_LDB(B0, 0, 0); PG8_SCHED; PG8_LDA(At, 0, 0); PG8_STAGE(PG8_SA(1, 1), a1 + hstep, voffA);
            PG8_WAIT_L(8); PG8_BAR; PG8_WAIT_L(0); PG8_MMA(0, 0, At, B0); PG8_BAR; PG8_SCHED;
            PG8_LDB(B1, 0, 1); PG8_STAGE(PG8_SB(0, 0), b2, voffB);
            PG8_BAR; PG8_WAIT_L(0); PG8_MMA(0, 1, At, B1); PG8_BAR;
            PG8_LDA(At, 0, 1); PG8_STAGE(PG8_SA(0, 0), a2, voffA);
            PG8_BAR; PG8_WAIT_L(0); PG8_MMA(1, 0, At, B0); PG8_BAR; PG8_SCHED;
            PG8_STAGE(PG8_SB(0, 1), b2 + hstep, voffB);
            PG8_WAIT_V(6); PG8_BAR; PG8_MMA(1, 1, At, B1); PG8_BAR;
            PG8_LDB(B0, 1, 0); PG8_SCHED; PG8_LDA(At, 1, 0); PG8_STAGE(PG8_SA(0, 1), a2 + hstep, voffA);
            PG8_WAIT_L(8); PG8_BAR; PG8_WAIT_L(0); PG8_MMA(0, 0, At, B0); PG8_BAR; PG8_SCHED;
            PG8_LDB(B1, 1, 1); PG8_STAGE(PG8_SB(1, 0), b3, voffB);
            PG8_BAR; PG8_WAIT_L(0); PG8_MMA(0, 1, At, B1); PG8_BAR;
            PG8_LDA(At, 1, 1); PG8_STAGE(PG8_SA(1, 0), a3, voffA);
            PG8_BAR; PG8_WAIT_L(0); PG8_MMA(1, 0, At, B0); PG8_BAR; PG8_SCHED;
            PG8_STAGE(PG8_SB(1, 1), b3 + hstep, voffB);
            PG8_WAIT_V(6); PG8_BAR; PG8_MMA(1, 1, At, B1); PG8_BAR;
            }
        }
        if constexpr (ALIGN_EPI) { if (wr == 0) PG8_BAR; }
        if constexpr (!Epi::AFTER_DRAIN) { E(acc, cur, wr, wc, fr, fq); S.done(cur); }
        if (!has_next) break;
#pragma unroll
        for (int a = 0; a < 2; ++a)
#pragma unroll
            for (int b = 0; b < 2; ++b)
#pragma unroll
                for (int m = 0; m < 4; ++m)
#pragma unroll
                    for (int n = 0; n < 2; ++n) acc[a][b][m][n] = (f32x4){0.f, 0.f, 0.f, 0.f};
        cur = nxt; cA = nA; cB = nB; ++ui;
        if constexpr (ALIGN_EPI) { if (wr == 1) PG8_BAR; }
    }
    PG8_WAIT_V(0);
    if constexpr (!ALIGN_EPI) { if (wr == 0) PG8_BAR; }
    PG8_BAR;
    if constexpr (Epi::AFTER_DRAIN) { E.fused(acc, cur, wr, wc, fr, fq, lds, wid, lane); S.done(cur); }
#undef PG8_SA
#undef PG8_SB
#undef PG8_STAGE
#undef PG8_LDA
#undef PG8_LDB
#undef PG8_MMA
#undef PG8_WAIT_V
#undef PG8_WAIT_L
#undef PG8_BAR
#undef PG8_SCHED
}
}
namespace mk {
using pg8::bf16_t; using pg8::bf16x8; using pg8::f32x4; using pg8::u32x4; using pg8::Unit; using pg8::Gemm;
#define LAS __attribute__((address_space(3)))
typedef short v4i16 __attribute__((ext_vector_type(4)));
typedef unsigned u32x2 __attribute__((ext_vector_type(2)));

constexpr int D = 1024, NB = 16, NT = 4096, NL = 256;
constexpr int MT = NB * NT, MC = NB * NL, MA = MT + MC;
constexpr int NPROJ = 2816, INC = 2832;
constexpr int NE = 16, FF = 512, CAP = 512;
constexpr float EPS = 1e-6f, LOG2E = 1.4426950408889634f;
constexpr int NWAVES = 8, NTHREADS = 512;
constexpr int LDS_BYTES = 144 * 1024;

constexpr size_t al256(size_t x) { return (x + 255) & ~(size_t)255; }
constexpr size_t WS_MOD = 0;
constexpr size_t WS_ROPE = WS_MOD + al256(17 * 6144 * 4);
constexpr size_t WS_MISC = WS_ROPE + al256(2 * 1024 * 4);
constexpr size_t WS_GATES = WS_MISC + 256;
constexpr size_t WS_AFF = WS_GATES + al256((size_t)MA * 16 * 4);
constexpr size_t WS_IDX = WS_AFF + al256((size_t)NB * NE * NT * 4);
constexpr size_t WS_GATE = WS_IDX + al256(256 * CAP * 4);
constexpr size_t WS_SLOT = WS_GATE + al256(256 * CAP * 4);
constexpr size_t WS_WIN = WS_SLOT + al256((size_t)256 * NT * 4);
constexpr size_t WS_WOUT = WS_WIN + al256((size_t)NPROJ * D * 2);
constexpr size_t WS_WGU = WS_WOUT + al256((size_t)D * D * 2);
constexpr size_t WS_WD = WS_WGU + al256((size_t)NE * 1024 * D * 2);
constexpr size_t WS_HX = WS_WD + al256((size_t)NE * D * FF * 2);
constexpr size_t WS_Q = WS_HX + al256((size_t)MA * D * 2);
constexpr size_t WS_KK = WS_Q + al256((size_t)MT * 512 * 2);
constexpr size_t WS_VV = WS_KK + al256((size_t)MA * 128 * 2);
constexpr size_t WS_M4 = WS_VV + al256((size_t)MA * 128 * 2);
constexpr size_t WS_MIX = WS_M4 + al256((size_t)4 * MA * 512 * 2);
constexpr size_t WS_HF = WS_MIX + (size_t)MT * D * 2;
constexpr size_t WS_HB = WS_HF + (size_t)MT * 512 * 2;
constexpr size_t WS_ACT = WS_HB + (size_t)MT * 512 * 2;
constexpr size_t WS_END = WS_ACT + al256((size_t)256 * CAP * FF * 2);
static_assert(WS_END <= ((size_t)1 << 30), "workspace map exceeds 1 GiB");
static_assert((size_t)256 * CAP * D * 2 <= (size_t)4 * MA * 512 * 2, "XG overlay fits");

struct Args { const float* in[20]; float* out; unsigned char* ws; int ph_lo, ph_hi; };

__device__ __forceinline__ float wave_sum(float v) {
#pragma unroll
    for (int o = 1; o < 64; o <<= 1) v += __shfl_xor(v, o);
    return v;
}
__device__ __forceinline__ float bflo(unsigned w) { return __builtin_bit_cast(float, w << 16); }
__device__ __forceinline__ float bfhi(unsigned w) { return __builtin_bit_cast(float, w & 0xffff0000u); }
__device__ __forceinline__ unsigned pkbf(float lo, float hi) { return pg8::cvt_pk_bf16(lo, hi); }
__device__ __forceinline__ float silu_f(float x) { return x / (1.f + __expf(-x)); }
__device__ __forceinline__ float logsig_f(float x) { return fminf(x, 0.f) - log1pf(expf(-fabsf(x))); }
__device__ __forceinline__ f32x4 mfma16(bf16x8 a, bf16x8 b, f32x4 c) { return __builtin_amdgcn_mfma_f32_16x16x32_bf16(a, b, c, 0, 0, 0); }
__device__ __forceinline__ bf16x8 tr2(const LAS bf16_t* p0, const LAS bf16_t* p1) {
    const v4i16 a = __builtin_amdgcn_ds_read_tr16_b64_v4i16((LAS v4i16*)p0), b = __builtin_amdgcn_ds_read_tr16_b64_v4i16((LAS v4i16*)p1);
    return (bf16x8){a[0], a[1], a[2], a[3], b[0], b[1], b[2], b[3]};
}
__device__ __forceinline__ bf16x8 pack8(const f32x4 a, const f32x4 b) {
    u32x4 w; w.x = pkbf(a[0], a[1]); w.y = pkbf(a[2], a[3]); w.z = pkbf(b[0], b[1]); w.w = pkbf(b[2], b[3]); return __builtin_bit_cast(bf16x8, w);
}
__host__ __device__ __forceinline__ int win_dst_row(int n) {
    if (n >= 768) return n;
    const int pn = n >> 8, r = n & 255, wc = r >> 6, bj = (r >> 5) & 1, p = r & 31;
    return 256 * pn + 128 * bj + 32 * wc + p;
}

__device__ __forceinline__ void transpose_item(const float* W, int N, int k0, int n0, bf16_t* WT, int K, int drow0, LAS float* scr, int lane) {
#pragma unroll 8
    for (int i = 0; i < 32; ++i) { const int kk = 2 * i + (lane >> 5); scr[kk * 33 + (lane & 31)] = W[(size_t)(k0 + kk) * N + n0 + (lane & 31)]; }
    asm volatile("s_waitcnt lgkmcnt(0)" ::: "memory");
    const int c = lane & 7;
#pragma unroll
    for (int j = 0; j < 4; ++j) { const int n = (lane >> 3) + 8 * j; const LAS float* s = scr + (8 * c) * 33 + n;
        u32x4 o; o.x = pkbf(s[0 * 33], s[1 * 33]); o.y = pkbf(s[2 * 33], s[3 * 33]); o.z = pkbf(s[4 * 33], s[5 * 33]); o.w = pkbf(s[6 * 33], s[7 * 33]);
        *(u32x4*)(WT + (size_t)(drow0 + n) * K + k0 + 8 * c) = o; }
    asm volatile("s_waitcnt lgkmcnt(0)" ::: "memory");
}
__device__ __forceinline__ void phase0(const Args& a, LAS unsigned char* lds) {
    const int tid = threadIdx.x, lane = tid & 63, wave = tid >> 6, wg = blockIdx.x, G = gridDim.x;
    unsigned char* ws = a.ws;
    {
        LAS float* sc = (LAS float*)lds;
        LAS float* part = sc + 17 * 1024;
        const float* c = a.in[1]; const float* cctx = a.in[3]; const float* w_mod = a.in[4]; const float* b_mod = a.in[5];
        float* mod = (float*)(ws + WS_MOD);
        for (int i = tid; i < 17 * 1024; i += NTHREADS) { const int r = i >> 10, k = i & 1023; const float v = r < 16 ? c[r * 1024 + k] : cctx[k]; sc[i] = v / (1.f + expf(-v)); }
        __syncthreads();
        for (int it = wg; it < 256; it += G) {
            const int col0 = it * 24;
            if (tid < 504) {
                const int j = tid % 24, kg = tid / 24; float acc[17];
#pragma unroll
                for (int r = 0; r < 17; ++r) acc[r] = 0.f;
                for (int k = kg; k < 1024; k += 21) { const float w = w_mod[(size_t)k * 6144 + col0 + j];
#pragma unroll
                    for (int r = 0; r < 17; ++r) acc[r] += sc[r * 1024 + k] * w; }
#pragma unroll
                for (int r = 0; r < 17; ++r) part[(kg * 17 + r) * 24 + j] = acc[r];
            }
            __syncthreads();
            if (tid < 408) { const int r = tid / 24, j = tid % 24; float s = b_mod[col0 + j]; for (int kg = 0; kg < 21; ++kg) s += part[(kg * 17 + r) * 24 + j]; mod[r * 6144 + col0 + j] = s; }
            __syncthreads();
        }
    }
    if (wg == 0) {
        float* rope = (float*)(ws + WS_ROPE);
        for (int i = tid; i < 1024; i += NTHREADS) { const int pos = i >> 4, f = i & 15; const float ang = (float)pos * powf(10000.f, -(float)f / 16.f); rope[i] = cosf(ang); rope[1024 + i] = sinf(ang); }
        if (tid == 0) { float mq = 0.f, mkk = 0.f; for (int i = 0; i < 64; ++i) { mq = fmaxf(mq, fabsf(a.in[11][i])); mkk = fmaxf(mkk, fabsf(a.in[12][i])); }
            ((float*)(ws + WS_MISC))[0] = fmaxf(0.f, 8.f * mq * mkk * LOG2E - 16.f); }
    }
    {
        LAS float* scr = (LAS float*)lds + wave * (64 * 33);
        const int gw = wg * NWAVES + wave, NGW = G * NWAVES;
        constexpr int I_IN = 16 * 88, I_OUT = 16 * 32, I_G = 16 * 16, I_D = 8 * 32;
        constexpr int NITEMS = I_IN + I_OUT + NE * (2 * I_G + I_D);
        bf16_t* WIN = (bf16_t*)(ws + WS_WIN); bf16_t* WOUT = (bf16_t*)(ws + WS_WOUT); bf16_t* WGU = (bf16_t*)(ws + WS_WGU); bf16_t* WDT = (bf16_t*)(ws + WS_WD);
        for (int it = gw; it < NITEMS; it += NGW) {
            int r = it;
            if (r < I_IN) { const int kb = r / 88, nb = r % 88; transpose_item(a.in[8], INC, 64 * kb, 32 * nb, WIN, D, win_dst_row(32 * nb), scr, lane); continue; } r -= I_IN;
            if (r < I_OUT) { const int kb = r / 32, nb = r % 32; transpose_item(a.in[15], D, 64 * kb, 32 * nb, WOUT, D, 32 * nb, scr, lane); continue; } r -= I_OUT;
            const int e = r / (2 * I_G + I_D); r -= e * (2 * I_G + I_D);
            if (r < 2 * I_G) { const int up = r / I_G, rr = r % I_G, kb = rr / 16, nb = rr % 16, n0 = 32 * nb;
                transpose_item((up ? a.in[18] : a.in[17]) + (size_t)e * D * FF, FF, 64 * kb, n0, WGU + (size_t)e * 1024 * D, D, 256 * (n0 >> 7) + (n0 & 127) + 128 * up, scr, lane); continue; }
            r -= 2 * I_G;
            { const int kb = r / 32, nb = r % 32; transpose_item(a.in[19] + (size_t)e * FF * D, D, 64 * kb, 32 * nb, WDT + (size_t)e * D * FF, FF, 32 * nb, scr, lane); }
        }
    }
}

__device__ __forceinline__ void fill_w16(LAS float* W16, const float* src, int pitch, int tid) {
    for (int idx = tid; idx < 1024 * 16; idx += NTHREADS) { const int k = idx >> 4, t = idx & 15; const int ln = (k & 255) >> 2, i = k & 3, j = k >> 8;
        W16[((j * 4 + i) * 64 + ln) * 20 + t] = src[(size_t)k * pitch + t]; }
}
__device__ __forceinline__ void row_norm_dots(f32x4 (&v)[4], const f32x4 (&sc)[4], const f32x4 (&sh)[4], const LAS float* W16, int lane, float (&g)[16]) {
    float s = 0.f;
#pragma unroll
    for (int j = 0; j < 4; ++j) s += (v[j][0] * v[j][0] + v[j][1] * v[j][1]) + (v[j][2] * v[j][2] + v[j][3] * v[j][3]);
    const float rinv = rsqrtf(wave_sum(s) * (1.f / D) + EPS);
#pragma unroll
    for (int t = 0; t < 16; ++t) g[t] = 0.f;
#pragma unroll
    for (int j = 0; j < 4; ++j) {
        v[j] = v[j] * rinv * sc[j] + sh[j];
#pragma unroll
        for (int i = 0; i < 4; ++i) { const LAS f32x4* wp = (const LAS f32x4*)(W16 + ((j * 4 + i) * 64 + lane) * 20); const float hv = v[j][i];
#pragma unroll
            for (int q = 0; q < 4; ++q) { const f32x4 w = wp[q]; g[4 * q + 0] += hv * w[0]; g[4 * q + 1] += hv * w[1]; g[4 * q + 2] += hv * w[2]; g[4 * q + 3] += hv * w[3]; } }
    }
#pragma unroll
    for (int t = 0; t < 16; ++t) g[t] = wave_sum(g[t]);
}
__device__ __forceinline__ void store_row_bf16(bf16_t* orow, const f32x4 (&v)[4], int lane) {
#pragma unroll
    for (int j = 0; j < 4; ++j) { u32x2 o; o.x = pkbf(v[j][0], v[j][1]); o.y = pkbf(v[j][2], v[j][3]); *(u32x2*)(orow + 4 * lane + 256 * j) = o; }
}
__device__ __forceinline__ void phase1(const Args& a, LAS unsigned char* lds) {
    const int tid = threadIdx.x, lane = tid & 63, wave = tid >> 6;
    LAS float* W16 = (LAS float*)lds;
    fill_w16(W16, a.in[8] + NPROJ, INC, tid);
    __syncthreads();
    const float* mod = (const float*)(a.ws + WS_MOD); const float* n1w = a.in[6]; const float* bg = a.in[9];
    bf16_t* HX = (bf16_t*)(a.ws + WS_HX); float* GATES = (float*)(a.ws + WS_GATES);
    const int gw = blockIdx.x * NWAVES + wave, NGW = gridDim.x * NWAVES;
    const int per = (MA + NGW - 1) / NGW; const int r0 = gw * per, r1 = min(MA, r0 + per);
    int curb = -1; f32x4 sc[4], sh[4];
    for (int m = r0; m < r1; ++m) {
        const int b = m < MT ? m >> 12 : 16;
        if (b != curb) { curb = b; const float* mr = mod + b * 6144;
#pragma unroll
            for (int j = 0; j < 4; ++j) { const int k = 4 * lane + 256 * j; const f32x4 w = *(const f32x4*)(n1w + k), s1 = *(const f32x4*)(mr + D + k); sc[j] = w * (1.f + s1); sh[j] = *(const f32x4*)(mr + k); } }
        const float* xr = m < MT ? a.in[0] + (size_t)m * D : a.in[2] + (size_t)(m - MT) * D;
        f32x4 v[4];
#pragma unroll
        for (int j = 0; j < 4; ++j) v[j] = *(const f32x4*)(xr + 4 * lane + 256 * j);
        float g[16];
        row_norm_dots(v, sc, sh, W16, lane, g);
        store_row_bf16(HX + (size_t)m * D, v, lane);
        float gv = 0.f;
#pragma unroll
        for (int t = 0; t < 16; ++t) gv = (lane == t) ? g[t] : gv;
        if (lane < 16) { gv += bg[lane]; if ((lane >> 2) & 1) gv = logsig_f(gv); GATES[(size_t)m * 16 + lane] = gv; }
    }
}

struct SeqOrder {
    int pm0, nN, n;
    __device__ __forceinline__ bool next(int i, Unit& u) const { if (i >= n) return false; u.pm = pm0 + i / nN; u.pn = i % nN; return true; }
    __device__ __forceinline__ void a_ready(const Unit&) const {}
    __device__ __forceinline__ void done(const Unit&) const {}
};
struct EpiProj {
    static constexpr bool PERM = true, AFTER_DRAIN = false;
    bf16_t *Q, *KK, *VV, *M4; const float *qw, *kw, *rope; float qscale;
    __device__ __forceinline__ void operator()(const f32x4 (&acc)[2][2][4][2], const Unit& u, int wr, int wc, int fr, int fq) const {
        const int pn = u.pn, row0 = u.pm * 256 + wr * 64 + fr;
        if (pn >= 3) {
            bf16_t* base = M4 + (size_t)((pn - 3) >> 1) * MA * 512 + ((pn - 3) & 1) * 256 + wc * 32 + 8 * fq;
#pragma unroll
            for (int ai = 0; ai < 2; ++ai)
#pragma unroll
                for (int m = 0; m < 4; ++m) { bf16_t* rowp = base + (size_t)(row0 + ai * 128 + m * 16) * 512;
#pragma unroll
                    for (int bj = 0; bj < 2; ++bj) { const f32x4 v0 = acc[ai][bj][m][0], v1 = acc[ai][bj][m][1]; u32x4 w; w.x = pkbf(v0[0], v0[1]); w.y = pkbf(v0[2], v0[3]); w.z = pkbf(v1[0], v1[1]); w.w = pkbf(v1[2], v1[3]);
                        *(u32x4*)(rowp + bj * 128) = w; } }
            return;
        }
        const bool latent = u.pm < 256;
        if (pn < 2 && !latent) return;
        const bool isv = (pn == 2) && (wc >= 2);
        bf16_t* dst; int ld; const float* nw; float osc = 1.f;
        if (pn < 2) { dst = Q + (4 * pn + wc) * 64; ld = 512; nw = qw; osc = qscale; }
        else if (!isv) { dst = KK + wc * 64; ld = 128; nw = kw; }
        else { dst = VV + (wc - 2) * 64; ld = 128; nw = kw; }
        f32x4 w4[2][2];
#pragma unroll
        for (int bj = 0; bj < 2; ++bj)
#pragma unroll
            for (int n = 0; n < 2; ++n) w4[bj][n] = *(const f32x4*)(nw + 32 * bj + 8 * fq + 4 * n);
#pragma unroll
        for (int ai = 0; ai < 2; ++ai)
#pragma unroll
            for (int m = 0; m < 4; ++m) {
                const int row = row0 + ai * 128 + m * 16;
                f32x4 y[2][2];
#pragma unroll
                for (int bj = 0; bj < 2; ++bj)
#pragma unroll
                    for (int n = 0; n < 2; ++n) y[bj][n] = acc[ai][bj][m][n];
                if (!isv) {
                    float ss = 0.f;
#pragma unroll
                    for (int bj = 0; bj < 2; ++bj)
#pragma unroll
                        for (int n = 0; n < 2; ++n) ss += (y[bj][n][0] * y[bj][n][0] + y[bj][n][1] * y[bj][n][1]) + (y[bj][n][2] * y[bj][n][2] + y[bj][n][3] * y[bj][n][3]);
                    ss += __shfl_xor(ss, 16); ss += __shfl_xor(ss, 32);
                    const float rinv = rsqrtf(ss * (1.f / 64.f) + EPS);
#pragma unroll
                    for (int bj = 0; bj < 2; ++bj)
#pragma unroll
                        for (int n = 0; n < 2; ++n) y[bj][n] = y[bj][n] * rinv * w4[bj][n];
                    if (latent) {
                        const int ntok = row & (NT - 1); const int pos = (fq < 2) ? (ntok >> 6) : (ntok & 63);
                        const float* rp = rope + pos * 16 + 8 * (fq & 1);
#pragma unroll
                        for (int n = 0; n < 2; ++n) { const f32x4 cs = *(const f32x4*)(rp + 4 * n), sn = *(const f32x4*)(rp + 1024 + 4 * n);
                            const f32x4 x1 = y[0][n], x2 = y[1][n]; y[0][n] = x1 * cs - x2 * sn; y[1][n] = x2 * cs + x1 * sn; }
                    }
                }
                bf16_t* rowp = dst + (size_t)row * ld + 8 * fq;
#pragma unroll
                for (int bj = 0; bj < 2; ++bj) { const f32x4 v0 = y[bj][0] * osc, v1 = y[bj][1] * osc; u32x4 w; w.x = pkbf(v0[0], v0[1]); w.y = pkbf(v0[2], v0[3]); w.z = pkbf(v1[0], v1[1]); w.w = pkbf(v1[2], v1[3]);
                    *(u32x4*)(rowp + 32 * bj) = w; }
            }
    }
};
struct EpiOut {
    static constexpr bool PERM = false, AFTER_DRAIN = false;
    const float* x; const float* mod; float* out;
    __device__ __forceinline__ void operator()(const f32x4 (&acc)[2][2][4][2], const Unit& u, int wr, int wc, int fr, int fq) const {
        const int row0 = u.pm * 256 + wr * 64 + fr, col0 = u.pn * 256 + wc * 32 + 4 * fq;
        const float* g1 = mod + (u.pm >> 4) * 6144 + 2 * D;
        f32x4 gv[2][2];
#pragma unroll
        for (int bj = 0; bj < 2; ++bj)
#pragma unroll
            for (int n = 0; n < 2; ++n) gv[bj][n] = *(const f32x4*)(g1 + col0 + bj * 128 + n * 16);
#pragma unroll
        for (int ai = 0; ai < 2; ++ai)
#pragma unroll
            for (int m = 0; m < 4; ++m) { const size_t off = (size_t)(row0 + ai * 128 + m * 16) * D + col0;
#pragma unroll
                for (int bj = 0; bj < 2; ++bj)
#pragma unroll
                    for (int n = 0; n < 2; ++n) { const f32x4 xv = *(const f32x4*)(x + off + bj * 128 + n * 16); *(f32x4*)(out + off + bj * 128 + n * 16) = xv + gv[bj][n] * acc[ai][bj][m][n]; }
                asm volatile("" ::: "memory"); }
    }
};
struct EpiAct {
    static constexpr bool PERM = true, AFTER_DRAIN = false;
    bf16_t* ACT;
    __device__ __forceinline__ void operator()(const f32x4 (&acc)[2][2][4][2], const Unit& u, int wr, int wc, int fr, int fq) const {
        const int row0 = u.pm * 256 + wr * 64 + fr, col0 = u.pn * 128 + wc * 32 + 8 * fq;
#pragma unroll
        for (int ai = 0; ai < 2; ++ai)
#pragma unroll
            for (int m = 0; m < 4; ++m) { f32x4 o[2];
#pragma unroll
                for (int n = 0; n < 2; ++n) { const f32x4 gt = acc[ai][0][m][n], up = acc[ai][1][m][n];
#pragma unroll
                    for (int j = 0; j < 4; ++j) o[n][j] = silu_f(gt[j]) * up[j]; }
                u32x4 w; w.x = pkbf(o[0][0], o[0][1]); w.y = pkbf(o[0][2], o[0][3]); w.z = pkbf(o[1][0], o[1][1]); w.w = pkbf(o[1][2], o[1][3]);
                *(u32x4*)(ACT + (size_t)(row0 + ai * 128 + m * 16) * FF + col0) = w; asm volatile("" ::: "memory"); }
    }
};
struct EpiDown {
    static constexpr bool PERM = true, AFTER_DRAIN = false;
    bf16_t* Y; const float* gate;
    __device__ __forceinline__ void operator()(const f32x4 (&acc)[2][2][4][2], const Unit& u, int wr, int wc, int fr, int fq) const {
        const int row0 = u.pm * 256 + wr * 64 + fr, col0 = u.pn * 256 + wc * 32 + 8 * fq;
#pragma unroll
        for (int ai = 0; ai < 2; ++ai)
#pragma unroll
            for (int m = 0; m < 4; ++m) { const int row = row0 + ai * 128 + m * 16; const float gt = gate[row];
#pragma unroll
                for (int bj = 0; bj < 2; ++bj) { const f32x4 v0 = acc[ai][bj][m][0] * gt, v1 = acc[ai][bj][m][1] * gt; u32x4 w; w.x = pkbf(v0[0], v0[1]); w.y = pkbf(v0[2], v0[3]); w.z = pkbf(v1[0], v1[1]); w.w = pkbf(v1[2], v1[3]);
                    *(u32x4*)(Y + (size_t)row * D + col0 + bj * 128) = w; } asm volatile("" ::: "memory"); }
    }
};

constexpr int AT_STRIDE = 72;
constexpr int AT_K = 0, AT_V = 384 * AT_STRIDE * 2;
__device__ __forceinline__ void attn_tile(const LAS bf16_t* AK, const LAS bf16_t* AV, int kb, bool masked, int kpos_base  , int qpos0  ,
                                          const bf16x8 (&Qf)[4][2], f32x4 (&O)[4][4], float (&ls)[4], float cshift, int fr, int fq) {
    const int q4 = fr >> 2, p4 = fr & 3;
    f32x4 S[4][4];
#pragma unroll
    for (int ks = 0; ks < 4; ++ks) {
        const LAS bf16_t* kp = AK + (kb + 16 * ks + fr) * AT_STRIDE + 8 * fq;
        const bf16x8 A0 = *(const LAS bf16x8*)kp, A1 = *(const LAS bf16x8*)(kp + 32);
#pragma unroll
        for (int qt = 0; qt < 4; ++qt) { f32x4 z = {0.f, 0.f, 0.f, 0.f}; z = mfma16(A0, Qf[qt][0], z); S[ks][qt] = mfma16(A1, Qf[qt][1], z); }
    }
#pragma unroll
    for (int ks = 0; ks < 4; ++ks)
#pragma unroll
        for (int qt = 0; qt < 4; ++qt)
#pragma unroll
            for (int r = 0; r < 4; ++r) {
                float p = exp2f(S[ks][qt][r] - cshift);
                if (masked) { const int kpos = kpos_base + kb + 16 * ks + 4 * fq + r, qpos = qpos0 + 16 * qt + fr; const int dd = kpos - qpos;
                    if (kpos < 0 || kpos >= NT || dd > 128 || dd < -128) p = 0.f; }
                ls[qt] += p; S[ks][qt][r] = p;
            }
#pragma unroll
    for (int kk2 = 0; kk2 < 2; ++kk2) {
        bf16x8 Bp[4];
#pragma unroll
        for (int qt = 0; qt < 4; ++qt) Bp[qt] = pack8(S[2 * kk2][qt], S[2 * kk2 + 1][qt]);
#pragma unroll
        for (int dt = 0; dt < 4; ++dt) {
            const LAS bf16_t* vp = AV + (kb + 32 * kk2 + 4 * fq + q4) * AT_STRIDE + 16 * dt + 4 * p4;
            const bf16x8 A = tr2(vp, vp + 16 * AT_STRIDE);
#pragma unroll
            for (int qt = 0; qt < 4; ++qt) O[dt][qt] = mfma16(A, Bp[qt], O[dt][qt]);
        }
    }
}
__device__ __forceinline__ void attn_item(const Args& a, LAS unsigned char* lds, int item) {
    const int tid = threadIdx.x, lane = tid & 63, w = __builtin_amdgcn_readfirstlane(tid >> 6), fr = lane & 15, fq = lane >> 4;
    const int qblk = item & 31, kvh = (item >> 5) & 1, b = item >> 6;
    const int g = w >> 1, qh = w & 1, head = 4 * kvh + g;
    const bf16_t* Q = (const bf16_t*)(a.ws + WS_Q); const bf16_t* KK = (const bf16_t*)(a.ws + WS_KK); const bf16_t* VV = (const bf16_t*)(a.ws + WS_VV);
    bf16_t* MIX = (bf16_t*)(a.ws + WS_MIX);
    LAS bf16_t* AK = (LAS bf16_t*)(lds + AT_K); LAS bf16_t* AV = (LAS bf16_t*)(lds + AT_V);
    const float cshift = ((const float*)(a.ws + WS_MISC))[0];
    const int qpos0 = 128 * qblk + 64 * qh;
    bf16x8 Qf[4][2];
#pragma unroll
    for (int qt = 0; qt < 4; ++qt) { const bf16_t* qp = Q + (size_t)(b * NT + qpos0 + 16 * qt + fr) * 512 + head * 64 + 8 * fq; Qf[qt][0] = *(const bf16x8*)qp; Qf[qt][1] = *(const bf16x8*)(qp + 32); }
    f32x4 O[4][4]; float ls[4];
#pragma unroll
    for (int dt = 0; dt < 4; ++dt)
#pragma unroll
        for (int qt = 0; qt < 4; ++qt) O[dt][qt] = (f32x4){0.f, 0.f, 0.f, 0.f};
#pragma unroll
    for (int qt = 0; qt < 4; ++qt) ls[qt] = 0.f;
    const int kpos_base = 128 * qblk - 128;
    for (int i = tid; i < 384 * 8; i += NTHREADS) { const int r = i >> 3, c = i & 7; int kp = kpos_base + r; kp = kp < 0 ? 0 : (kp > NT - 1 ? NT - 1 : kp);
        const size_t src = (size_t)(b * NT + kp) * 128 + kvh * 64 + 8 * c;
        *(LAS u32x4*)(AK + r * AT_STRIDE + 8 * c) = *(const u32x4*)(KK + src); *(LAS u32x4*)(AV + r * AT_STRIDE + 8 * c) = *(const u32x4*)(VV + src); }
    __syncthreads();
    for (int jt = 0; jt < 5; ++jt) attn_tile(AK, AV, 64 * qh + 64 * jt, true, kpos_base, qpos0, Qf, O, ls, cshift, fr, fq);
    __syncthreads();
    for (int i = tid; i < 256 * 8; i += NTHREADS) { const int r = i >> 3, c = i & 7; const size_t src = (size_t)(MT + b * NL + r) * 128 + kvh * 64 + 8 * c;
        *(LAS u32x4*)(AK + r * AT_STRIDE + 8 * c) = *(const u32x4*)(KK + src); *(LAS u32x4*)(AV + r * AT_STRIDE + 8 * c) = *(const u32x4*)(VV + src); }
    __syncthreads();
    for (int jt = 0; jt < 4; ++jt) attn_tile(AK, AV, 64 * jt, false, 0, qpos0, Qf, O, ls, cshift, fr, fq);
    __syncthreads();
    const float psink = exp2f(a.in[13][head] * LOG2E - cshift);
#pragma unroll
    for (int qt = 0; qt < 4; ++qt) {
        float l = ls[qt]; l += __shfl_xor(l, 16); l += __shfl_xor(l, 32); const float inv = 1.f / (l + psink);
        bf16_t* op = MIX + (size_t)(b * NT + qpos0 + 16 * qt + fr) * D + head * 64 + 4 * fq;
#pragma unroll
        for (int dt = 0; dt < 4; ++dt) { const f32x4 o = O[dt][qt] * inv; u32x2 wv; wv.x = pkbf(o[0], o[1]); wv.y = pkbf(o[2], o[3]); *(u32x2*)(op + 16 * dt) = wv; }
    }
}

constexpr int KS_ST = 136, VS_ST = 88;
constexpr int ML_KS = 0, ML_VN = ML_KS + 128 * KS_ST * 2, ML_VW = ML_VN + 128 * VS_ST * 2, ML_CN = ML_VW + 128 * VS_ST * 2, ML_F = ML_CN + 128 * VS_ST * 2, ML_CW = ML_F + 1024 * 4, ML_END = ML_CW + 768 * 4;
static_assert(ML_END <= LDS_BYTES, "mLSTM LDS map");
__device__ __forceinline__ void mlstm_item(const Args& a, LAS unsigned char* lds, int item) {
    const int tid = threadIdx.x, lane = tid & 63, w = __builtin_amdgcn_readfirstlane(tid >> 6), fr = lane & 15, fq = lane >> 4, q4 = fr >> 2, p4 = fr & 3;
    const int vh = item & 1, dir = (item >> 1) & 1, h = (item >> 2) & 3, b = item >> 4;
    LAS bf16_t* Ks = (LAS bf16_t*)(lds + ML_KS); LAS bf16_t* Vn = (LAS bf16_t*)(lds + ML_VN); LAS bf16_t* Vw = (LAS bf16_t*)(lds + ML_VW); LAS bf16_t* Cn = (LAS bf16_t*)(lds + ML_CN);
    LAS float* F = (LAS float*)(lds + ML_F); LAS float* gA = F, *MA_ = F + 128, *ebA = F + 256, *decA = F + 384, *wsA = F + 512, *scal = F + 640; LAS float* cw = (LAS float*)(lds + ML_CW);
    const bf16_t* MQ = (const bf16_t*)(a.ws + WS_M4); const bf16_t* MK = MQ + (size_t)MA * 512; const bf16_t* MV = MK + (size_t)MA * 512;
    const float* GATES = (const float*)(a.ws + WS_GATES);
    bf16_t* H = (bf16_t*)(a.ws + (dir ? WS_HB : WS_HF));
    const float* conv = a.in[10];
    for (int i = tid; i < 768; i += NTHREADS) { const int j = i >> 8, c = i & 255; cw[i] = conv[j * 1024 + (c < 128 ? h * 128 + c : 512 + h * 128 + (c - 128))]; }
    for (int i = tid; i < 128 * VS_ST / 2; i += NTHREADS) ((LAS unsigned*)Cn)[i] = 0u;
    for (int i = tid; i < 128 * 12; i += NTHREADS) { const int s = i / 12, c = i % 12; ((LAS unsigned*)(Vn + s * VS_ST + 64))[c] = (c == 0) ? 0x00003f80u : 0u; ((LAS unsigned*)(Vw + s * VS_ST + 64))[c] = 0u; }
    f32x4 accC[5];
#pragma unroll
    for (int vt = 0; vt < 5; ++vt) accC[vt] = (f32x4){0.f, 0.f, 0.f, 0.f};
    float m_state = 0.f;
    __syncthreads();
    for (int ci = 0; ci < 34; ++ci) {
        const bool isctx = ci < 2;
        int seq0, seqlen, nbase;
        if (isctx) { seq0 = MT + b * NL; seqlen = NL; nbase = dir ? 128 * (1 - ci) : 128 * ci; }
        else { const int k = ci - 2; seq0 = b * NT; seqlen = NT; nbase = dir ? 128 * (31 - k) : 128 * k; }
#define ML_POS(s) (dir ? nbase + 127 - (s) : nbase + (s))
        if (w == 0) {
            const int s0 = 2 * lane, s1 = s0 + 1;
            const float* G0 = GATES + (size_t)(seq0 + ML_POS(s0)) * 16 + h; const float* G1 = GATES + (size_t)(seq0 + ML_POS(s1)) * 16 + h;
            const float li0 = G0[dir ? 8 : 0], lf0 = G0[dir ? 12 : 4], li1 = G1[dir ? 8 : 0], lf1 = G1[dir ? 12 : 4];
            float cs = lf0 + lf1;
#pragma unroll
            for (int o = 1; o < 64; o <<= 1) { const float y = __shfl_up(cs, o); if (lane >= o) cs += y; }
            const float b1 = cs, b0 = cs - lf1;
            const float g0 = li0 - b0, g1 = li1 - b1;
            float mx = fmaxf(g0, g1);
#pragma unroll
            for (int o = 1; o < 64; o <<= 1) { const float y = __shfl_up(mx, o); if (lane >= o) mx = fmaxf(mx, y); }
            float ex = __shfl_up(mx, 1); if (lane == 0) ex = -INFINITY;
            const float pm0 = fmaxf(ex, g0), pm1 = mx;
            const float M0 = fmaxf(m_state, pm0), M1 = fmaxf(m_state, pm1);
            const float b_last = __shfl(b1, 63), M_last = __shfl(M1, 63);
            gA[s0] = g0; gA[s1] = g1; MA_[s0] = M0; MA_[s1] = M1;
            ebA[s0] = expf(-b0 - M0); ebA[s1] = expf(-b1 - M1);
            decA[s0] = expf(m_state - M0); decA[s1] = expf(m_state - M1);
            wsA[s0] = expf(g0 - M_last); wsA[s1] = expf(g1 - M_last);
            if (lane == 0) scal[0] = expf(m_state - M_last);
            m_state = b_last + M_last;
        }
#pragma unroll
        for (int ps = 0; ps < 4; ++ps) {
            const int s = (tid >> 4) + 32 * ps, dc = tid & 15, pos = ML_POS(s);
            const bf16_t* kp = MK + (size_t)(seq0 + pos) * 512 + h * 128 + 8 * dc;
            const u32x4 r1 = *(const u32x4*)kp; u32x4 r0 = {0u, 0u, 0u, 0u}, r2 = {0u, 0u, 0u, 0u};
            if (pos > 0) r0 = *(const u32x4*)(kp - 512);
            if (pos < seqlen - 1) r2 = *(const u32x4*)(kp + 512);
            const LAS float* c0 = cw + 128 + 8 * dc; float u[8];
#pragma unroll
            for (int e = 0; e < 4; ++e) {
                const float a0 = bflo(r0[e]), a1 = bflo(r1[e]), a2 = bflo(r2[e]), b0 = bfhi(r0[e]), b1 = bfhi(r1[e]), b2 = bfhi(r2[e]);
                u[2 * e] = silu_f(a0 * c0[2 * e] + a1 * c0[256 + 2 * e] + a2 * c0[512 + 2 * e]);
                u[2 * e + 1] = silu_f(b0 * c0[2 * e + 1] + b1 * c0[256 + 2 * e + 1] + b2 * c0[512 + 2 * e + 1]);
            }
            u32x4 o; o.x = pkbf(u[0], u[1]); o.y = pkbf(u[2], u[3]); o.z = pkbf(u[4], u[5]); o.w = pkbf(u[6], u[7]);
            *(LAS u32x4*)(Ks + s * KS_ST + 8 * dc) = o;
        }
        u32x4 vreg[2];
#pragma unroll
        for (int ps = 0; ps < 2; ++ps) {
            const int s = (tid >> 3) + 64 * ps, vc = tid & 7, pos = ML_POS(s);
            vreg[ps] = *(const u32x4*)(MV + (size_t)(seq0 + pos) * 512 + h * 128 + vh * 64 + 8 * vc);
            *(LAS u32x4*)(Vn + s * VS_ST + 8 * vc) = vreg[ps];
        }
        bf16x8 Bq[4];
        if (!isctx) {
            const int t = 16 * w + fr, pos = ML_POS(t);
            const bf16_t* qp = MQ + (size_t)(seq0 + pos) * 512 + h * 128 + 8 * fq;
#pragma unroll
            for (int kk = 0; kk < 4; ++kk) {
                const u32x4 r1 = *(const u32x4*)(qp + 32 * kk); u32x4 r0 = {0u, 0u, 0u, 0u}, r2 = {0u, 0u, 0u, 0u};
                if (pos > 0) r0 = *(const u32x4*)(qp + 32 * kk - 512);
                if (pos < seqlen - 1) r2 = *(const u32x4*)(qp + 32 * kk + 512);
                const LAS float* c0 = cw + 32 * kk + 8 * fq; float u[8];
#pragma unroll
                for (int e = 0; e < 4; ++e) {
                    const float a0 = bflo(r0[e]), a1 = bflo(r1[e]), a2 = bflo(r2[e]), b0 = bfhi(r0[e]), b1 = bfhi(r1[e]), b2 = bfhi(r2[e]);
                    u[2 * e] = silu_f(a0 * c0[2 * e] + a1 * c0[256 + 2 * e] + a2 * c0[512 + 2 * e]) * 0.08838834764831845f;
                    u[2 * e + 1] = silu_f(b0 * c0[2 * e + 1] + b1 * c0[256 + 2 * e + 1] + b2 * c0[512 + 2 * e + 1]) * 0.08838834764831845f;
                }
                u32x4 o; o.x = pkbf(u[0], u[1]); o.y = pkbf(u[2], u[3]); o.z = pkbf(u[4], u[5]); o.w = pkbf(u[6], u[7]);
                Bq[kk] = __builtin_bit_cast(bf16x8, o);
            }
        } else {
#pragma unroll
            for (int kk = 0; kk < 4; ++kk) Bq[kk] = (bf16x8){0, 0, 0, 0, 0, 0, 0, 0};
        }
        __syncthreads();
#pragma unroll
        for (int ps = 0; ps < 2; ++ps) {
            const int s = (tid >> 3) + 64 * ps, vc = tid & 7; const float wv = wsA[s]; u32x4 o;
#pragma unroll
            for (int e = 0; e < 4; ++e) o[e] = pkbf(bflo(vreg[ps][e]) * wv, bfhi(vreg[ps][e]) * wv);
            *(LAS u32x4*)(Vw + s * VS_ST + 8 * vc) = o;
        }
        if (tid < 128) ((LAS unsigned*)(Vw + tid * VS_ST + 64))[0] = pkbf(wsA[tid], 0.f);
        __syncthreads();
        if (!isctx) {
            const int t = 16 * w + fr; const float Mt = MA_[t];
            f32x4 P[8];
#pragma unroll
            for (int i = 0; i < 8; ++i) {
                P[i] = (f32x4){0.f, 0.f, 0.f, 0.f};
                if (i <= w) {
#pragma unroll
                    for (int kk = 0; kk < 4; ++kk) { const bf16x8 Ak = *(const LAS bf16x8*)(Ks + (16 * i + fr) * KS_ST + 32 * kk + 8 * fq); P[i] = mfma16(Ak, Bq[kk], P[i]); }
                    const f32x4 gs = *(const LAS f32x4*)(gA + 16 * i + 4 * fq);
#pragma unroll
                    for (int r = 0; r < 4; ++r) { const int s = 16 * i + 4 * fq + r; const float wgt = (s <= t) ? exp2f((gs[r] - Mt) * LOG2E) : 0.f; P[i][r] *= wgt; }
                }
            }
            f32x4 num[5], itr[5];
#pragma unroll
            for (int vt = 0; vt < 5; ++vt) { num[vt] = (f32x4){0.f, 0.f, 0.f, 0.f}; itr[vt] = (f32x4){0.f, 0.f, 0.f, 0.f}; }
#pragma unroll
            for (int kk2 = 0; kk2 < 4; ++kk2) {
                if (2 * kk2 <= w) {
                    const bf16x8 Bw = pack8(P[2 * kk2], P[2 * kk2 + 1]);
#pragma unroll
                    for (int vt = 0; vt < 5; ++vt) { const LAS bf16_t* vp = Vn + (32 * kk2 + 4 * fq + q4) * VS_ST + 16 * vt + 4 * p4; num[vt] = mfma16(tr2(vp, vp + 16 * VS_ST), Bw, num[vt]); }
                }
            }
#pragma unroll
            for (int kk = 0; kk < 4; ++kk)
#pragma unroll
                for (int vt = 0; vt < 5; ++vt) { const LAS bf16_t* cp = Cn + (32 * kk + 8 * fq + q4) * VS_ST + 16 * vt + 4 * p4; itr[vt] = mfma16(tr2(cp, cp + 4 * VS_ST), Bq[kk], itr[vt]); }
            const float dect = decA[t], ebt = ebA[t];
#pragma unroll
            for (int vt = 0; vt < 5; ++vt) num[vt] = num[vt] + itr[vt] * dect;
            const float den = __shfl(num[4][0], fr);
            const float inv = 1.f / fmaxf(fabsf(den), ebt);
            bf16_t* hp = H + (size_t)(seq0 + ML_POS(t)) * 512 + h * 128 + vh * 64 + 4 * fq;
#pragma unroll
            for (int vt = 0; vt < 4; ++vt) { const f32x4 o = num[vt] * inv; u32x2 wv; wv.x = pkbf(o[0], o[1]); wv.y = pkbf(o[2], o[3]); *(u32x2*)(hp + 16 * vt) = wv; }
        }
        {
            const float av = scal[0];
#pragma unroll
            for (int vt = 0; vt < 5; ++vt) accC[vt] = accC[vt] * av;
#pragma unroll
            for (int kk2 = 0; kk2 < 4; ++kk2) {
                const LAS bf16_t* kp = Ks + (32 * kk2 + 8 * fq + q4) * KS_ST + 16 * w + 4 * p4; const bf16x8 Bk = tr2(kp, kp + 4 * KS_ST);
#pragma unroll
                for (int vt = 0; vt < 5; ++vt) { const LAS bf16_t* vp = Vw + (32 * kk2 + 8 * fq + q4) * VS_ST + 16 * vt + 4 * p4; accC[vt] = mfma16(tr2(vp, vp + 4 * VS_ST), Bk, accC[vt]); }
            }
        }
        __syncthreads();
#pragma unroll
        for (int vt = 0; vt < 5; ++vt) { u32x2 wv; wv.x = pkbf(accC[vt][0], accC[vt][1]); wv.y = pkbf(accC[vt][2], accC[vt][3]); *(LAS u32x2*)(Cn + (16 * w + fr) * VS_ST + 16 * vt + 4 * fq) = wv; }
#undef ML_POS
    }
    __syncthreads();
}

__device__ __forceinline__ void mlstm_out_rows(const Args& a, int row_lo, int nrows) {
    const int tid = threadIdx.x, lane = tid & 63, wave = tid >> 6;
    const unsigned* HF = (const unsigned*)(a.ws + WS_HF); const unsigned* HB = (const unsigned*)(a.ws + WS_HB);
    const unsigned* MO = (const unsigned*)((const bf16_t*)(a.ws + WS_M4) + (size_t)3 * MA * 512);
    unsigned* MIX = (unsigned*)(a.ws + WS_MIX); const float* nw = a.in[14];
    for (int i = wave; i < nrows * 4; i += NWAVES) {
        const int row = row_lo + (i >> 2), hh = i & 3; const size_t o = ((size_t)row * 512 + hh * 128) / 2 + lane;
        const unsigned f = HF[o], bb = HB[o], mo = MO[o];
        const float s0 = bflo(f) + bflo(bb), s1 = bfhi(f) + bfhi(bb);
        const float r = rsqrtf(wave_sum(s0 * s0 + s1 * s1) * (1.f / 128.f) + EPS);
        const float o0 = s0 * r * nw[hh * 128 + 2 * lane] / (1.f + __expf(-bflo(mo))), o1 = s1 * r * nw[hh * 128 + 2 * lane + 1] / (1.f + __expf(-bfhi(mo)));
        MIX[((size_t)row * D + 512 + hh * 128) / 2 + lane] = pkbf(o0, o1);
    }
}
__device__ __forceinline__ void post_rows(const Args& a, LAS unsigned char* lds, int row_lo, int nrows) {
    const int tid = threadIdx.x, lane = tid & 63, wave = tid >> 6;
    LAS float* W16 = (LAS float*)lds;
    fill_w16(W16, a.in[16], 16, tid);
    __syncthreads();
    const float* mod = (const float*)(a.ws + WS_MOD); const float* n2w = a.in[7];
    bf16_t* HX2 = (bf16_t*)(a.ws + WS_HX); float* AFF = (float*)(a.ws + WS_AFF);
    const int b = row_lo >> 12; const float* mr = mod + b * 6144;
    f32x4 sc[4], sh[4];
#pragma unroll
    for (int j = 0; j < 4; ++j) { const int k = 4 * lane + 256 * j; const f32x4 wv = *(const f32x4*)(n2w + k), s2 = *(const f32x4*)(mr + 4 * D + k); sc[j] = wv * (1.f + s2); sh[j] = *(const f32x4*)(mr + 3 * D + k); }
    for (int i = wave; i < nrows; i += NWAVES) {
        const int m = row_lo + i; const float* xr = a.out + (size_t)m * D;
        f32x4 v[4];
#pragma unroll
        for (int j = 0; j < 4; ++j) v[j] = *(const f32x4*)(xr + 4 * lane + 256 * j);
        float g[16];
        row_norm_dots(v, sc, sh, W16, lane, g);
        store_row_bf16(HX2 + (size_t)m * D, v, lane);
        float mx = g[0];
#pragma unroll
        for (int t = 1; t < 16; ++t) mx = fmaxf(mx, g[t]);
        float sum = 0.f, mine = 0.f;
#pragma unroll
        for (int t = 0; t < 16; ++t) { const float e = expf(g[t] - mx); sum += e; mine = (lane == t) ? e : mine; }
        if (lane < 16) AFF[((size_t)b * NE + lane) * NT + (m & (NT - 1))] = mine / sum;
    }
    __syncthreads();
}

__device__ __forceinline__ void topk_select(const Args& a, LAS unsigned char* lds, int z) {
    const int tid = threadIdx.x, lane = tid & 63, wave = tid >> 6;
    LAS unsigned* hist = (LAS unsigned*)lds; LAS unsigned* sc = hist + 256; LAS unsigned* wsum = hist + 272;
    const float* aff = (const float*)(a.ws + WS_AFF) + (size_t)z * NT;
    int* idx = (int*)(a.ws + WS_IDX) + z * CAP; float* gate = (float*)(a.ws + WS_GATE) + z * CAP; int* slot = (int*)(a.ws + WS_SLOT) + (size_t)z * NT;
    unsigned key[8];
    { const u32x4 k0 = *(const u32x4*)(aff + 8 * tid), k1 = *(const u32x4*)(aff + 8 * tid + 4); key[0] = k0.x; key[1] = k0.y; key[2] = k0.z; key[3] = k0.w; key[4] = k1.x; key[5] = k1.y; key[6] = k1.z; key[7] = k1.w; }
    unsigned prefix = 0u, need = CAP;
#pragma unroll 1
    for (int pass = 0; pass < 4; ++pass) {
        const int shift = 24 - 8 * pass;
        if (tid < 256) hist[tid] = 0u;
        __syncthreads();
#pragma unroll
        for (int i = 0; i < 8; ++i) { const bool match = (pass == 0) || ((key[i] >> (shift + 8)) == prefix); if (match) __hip_atomic_fetch_add(&hist[(key[i] >> shift) & 255u], 1u, __ATOMIC_RELAXED, __HIP_MEMORY_SCOPE_WORKGROUP); }
        __syncthreads();
        if (wave == 0) {
            unsigned c[4]; unsigned s = 0u;
#pragma unroll
            for (int j = 0; j < 4; ++j) { c[j] = hist[255 - (4 * lane + j)]; s += c[j]; }
            unsigned incl = s;
#pragma unroll
            for (int o = 1; o < 64; o <<= 1) { const unsigned y = __shfl_up(incl, o); if (lane >= o) incl += y; }
            unsigned cb = incl - s;
#pragma unroll
            for (int j = 0; j < 4; ++j) { if (cb < need && need <= cb + c[j]) { sc[0] = (prefix << 8) | (unsigned)(255 - (4 * lane + j)); sc[1] = need - cb; } cb += c[j]; }
        }
        __syncthreads();
        prefix = sc[0]; need = sc[1];
        __syncthreads();
    }
    const unsigned T = prefix;
    unsigned cg = 0u, ce = 0u;
#pragma unroll
    for (int i = 0; i < 8; ++i) { cg += key[i] > T ? 1u : 0u; ce += key[i] == T ? 1u : 0u; }
    const unsigned mine = cg | (ce << 16);
    unsigned incl = mine;
#pragma unroll
    for (int o = 1; o < 64; o <<= 1) { const unsigned y = __shfl_up(incl, o); if (lane >= o) incl += y; }
    if (lane == 63) wsum[wave] = incl;
    __syncthreads();
    unsigned base = 0u;
    for (int q = 0; q < wave; ++q) base += wsum[q];
    const unsigned excl = base + incl - mine;
    unsigned pg = excl & 0xffffu, pe = excl >> 16;
    const unsigned total_gt = CAP - need;
#pragma unroll
    for (int i = 0; i < 8; ++i) {
        const int tok = 8 * tid + i; int sl = -1;
        if (key[i] > T) { sl = (int)pg; ++pg; }
        else if (key[i] == T) { if (pe < need) sl = (int)(total_gt + pe); ++pe; }
        if (sl >= 0) { idx[sl] = tok; gate[sl] = __builtin_bit_cast(float, key[i]); }
        slot[tok] = sl;
    }
    __syncthreads();
}

__global__ void __launch_bounds__(NTHREADS, 2) mk_fwd(Args a) {
    extern __shared__ __attribute__((aligned(16))) unsigned char lds_raw[];
    LAS unsigned char* lds = (LAS unsigned char*)lds_raw;
    cg::grid_group grid = cg::this_grid();
    const int lo = a.ph_lo, hi = a.ph_hi;
    const int c = blockIdx.x, G = gridDim.x, tid = threadIdx.x, lane = tid & 63, wave = tid >> 6;
#ifndef MK_PHASE_MASK
#define MK_PHASE_MASK 0x7f
#endif
#define IN(k) ((((MK_PHASE_MASK) >> (k)) & 1) && lo <= (k) && (k) < hi)
#define SEAM(k) do { if (IN(k) && IN((k) + 1)) grid.sync(); } while (0)
    unsigned char* ws = a.ws;

    if (IN(0)) phase0(a, lds);
    SEAM(0);
    if (IN(1)) phase1(a, lds);
    SEAM(1);
    if (IN(2)) {
        Gemm g{(const bf16_t*)(ws + WS_HX), (const bf16_t*)(ws + WS_WIN), MA, NPROJ, D};
        pg8::StaticOrder S; S.init(MA, NPROJ, G, c);
        EpiProj E{(bf16_t*)(ws + WS_Q), (bf16_t*)(ws + WS_KK), (bf16_t*)(ws + WS_VV), (bf16_t*)(ws + WS_M4), a.in[11], a.in[12], (const float*)(ws + WS_ROPE), 0.125f * LOG2E};
        pg8::gemm_phase<EpiProj, pg8::StaticOrder, true, true>(lds, g, S, E);
        __syncthreads();
    }
    SEAM(2);
    if (IN(3)) {
        for (int it = c; it < 256; it += G) mlstm_item(a, lds, it);
        for (int it = c; it < 1024; it += G) attn_item(a, lds, it);
    }
    SEAM(3);
    if (IN(4)) {
        if (c < 256) { const int pm = c;
            mlstm_out_rows(a, pm * 256, 256);
            __syncthreads();
            Gemm g{(const bf16_t*)(ws + WS_MIX), (const bf16_t*)(ws + WS_WOUT), MT, D, D};
            SeqOrder S{pm, 4, 4};
            EpiOut E{a.in[0], (const float*)(ws + WS_MOD), a.out};
            pg8::gemm_phase<EpiOut, SeqOrder, true, true>(lds, g, S, E);
            __syncthreads();
            post_rows(a, lds, pm * 256, 256);
        }
    }
    SEAM(4);
    if (IN(5)) {
        if (c < 256) { const int z = c;
            const int b = z >> 4, e = z & 15;
            topk_select(a, lds, z);
            bf16_t* XG = (bf16_t*)(ws + WS_M4) + (size_t)z * CAP * D; const bf16_t* HX2 = (const bf16_t*)(ws + WS_HX); const int* idx = (const int*)(ws + WS_IDX) + z * CAP;
            for (int r = wave; r < CAP; r += NWAVES) { const u32x4* src = (const u32x4*)(HX2 + ((size_t)b * NT + idx[r]) * D); u32x4* dst = (u32x4*)(XG + (size_t)r * D);
                const u32x4 v0 = src[lane], v1 = src[lane + 64]; dst[lane] = v0; dst[lane + 64] = v1; }
            __syncthreads();
            bf16_t* ACT = (bf16_t*)(ws + WS_ACT) + (size_t)z * CAP * FF;
            { Gemm g{XG, (const bf16_t*)(ws + WS_WGU) + (size_t)e * 1024 * D, CAP, 1024, D}; SeqOrder S{0, 4, 8}; EpiAct E{ACT};
              pg8::gemm_phase<EpiAct, SeqOrder, true, true>(lds, g, S, E); }
            __syncthreads();
            { Gemm g{ACT, (const bf16_t*)(ws + WS_WD) + (size_t)e * D * FF, CAP, D, FF}; SeqOrder S{0, 4, 8}; EpiDown E{(bf16_t*)(ws + WS_MIX) + (size_t)z * CAP * D, (const float*)(ws + WS_GATE) + z * CAP};
              pg8::gemm_phase<EpiDown, SeqOrder, true, true>(lds, g, S, E); }
            __syncthreads();
        }
    }
    SEAM(5);
    if (IN(6)) {
        const int gw = c * NWAVES + wave, NGW = G * NWAVES;
        const int* SL = (const int*)(ws + WS_SLOT); const bf16_t* Y = (const bf16_t*)(ws + WS_MIX); const float* mod = (const float*)(ws + WS_MOD);
        for (int m = gw; m < MT; m += NGW) {
            const int b = m >> 12, n = m & (NT - 1);
            const int sv = lane < 16 ? SL[((size_t)b * NE + lane) * NT + n] : -1;
            if (__ballot(sv >= 0) == 0ull) continue;
            float acc[16];
#pragma unroll
            for (int i = 0; i < 16; ++i) acc[i] = 0.f;
            for (int e = 0; e < 16; ++e) { const int s = __shfl(sv, e); if (s < 0) continue;
                const bf16_t* yr = Y + ((size_t)(b * NE + e) * CAP + s) * D;
#pragma unroll
                for (int j = 0; j < 2; ++j) { const u32x4 y = *(const u32x4*)(yr + 8 * lane + 512 * j);
#pragma unroll
                    for (int q = 0; q < 4; ++q) { acc[8 * j + 2 * q] += bflo(y[q]); acc[8 * j + 2 * q + 1] += bfhi(y[q]); } } }
            const float* g2 = mod + b * 6144 + 5 * D; float* orow = a.out + (size_t)m * D;
#pragma unroll
            for (int j = 0; j < 2; ++j)
#pragma unroll
                for (int q = 0; q < 2; ++q) { const int col = 8 * lane + 512 * j + 4 * q; const f32x4 xv = *(const f32x4*)(orow + col), gv = *(const f32x4*)(g2 + col);
                    f32x4 o; o[0] = xv[0] + gv[0] * acc[8 * j + 4 * q]; o[1] = xv[1] + gv[1] * acc[8 * j + 4 * q + 1]; o[2] = xv[2] + gv[2] * acc[8 * j + 4 * q + 2]; o[3] = xv[3] + gv[3] * acc[8 * j + 4 * q + 3];
                    *(f32x4*)(orow + col) = o; }
        }
    }
#undef IN
#undef SEAM
}
}

#ifndef MK_N_LAUNCHES
#define MK_N_LAUNCHES 7
#endif
extern "C" void kernel_launch(void* const* d_in, const int* in_sizes, int n_in, void* d_out, int out_size, void* d_ws, size_t ws_size, hipStream_t stream) {
    using namespace mk;
    static int grid = 0;
    if (grid == 0) {
        if (n_in != 20 || out_size != MT * D || ws_size < WS_END) { fprintf(stderr, "kernel_launch: unexpected problem (n_in %d out %d ws %zu need %zu)\n", n_in, out_size, ws_size, (size_t)WS_END); grid = -1; return; }
        int dev = 0, cus = 0, per_cu = 0;
        hipGetDevice(&dev); hipDeviceGetAttribute(&cus, hipDeviceAttributeMultiprocessorCount, dev);
        if (hipFuncSetAttribute((const void*)mk_fwd, hipFuncAttributeMaxDynamicSharedMemorySize, LDS_BYTES) != hipSuccess) { fprintf(stderr, "kernel_launch: hipFuncSetAttribute failed\n"); grid = -1; return; }
        hipOccupancyMaxActiveBlocksPerMultiprocessor(&per_cu, (const void*)mk_fwd, NTHREADS, LDS_BYTES);
        (void)hipGetLastError();
        if (per_cu < 1) { fprintf(stderr, "kernel_launch: occupancy query says %d blocks per CU\n", per_cu); per_cu = 1; }
        grid = cus;
        if (grid > 256) grid = 256;
    }
    if (grid < 0) return;
    Args a{};
    for (int i = 0; i < 20; ++i) a.in[i] = (const float*)d_in[i];
    a.out = (float*)d_out; a.ws = (unsigned char*)d_ws;
#if MK_N_LAUNCHES == 1
    a.ph_lo = 0; a.ph_hi = 7;
    void* args[] = {&a};
    hipError_t e = hipLaunchCooperativeKernel((const void*)mk_fwd, dim3(grid), dim3(NTHREADS), args, LDS_BYTES, stream);
    if (e != hipSuccess) fprintf(stderr, "cooperative launch failed: %s (grid %d)\n", hipGetErrorString(e), grid);
#else
    for (int p = 0; p < 7; ++p) { a.ph_lo = p; a.ph_hi = p + 1; hipLaunchKernelGGL(mk_fwd, dim3(grid), dim3(NTHREADS), LDS_BYTES, stream, a); }
#endif
}
```

```cpp
#include <hip/hip_runtime.h>
#include <hip/hip_cooperative_groups.h>
#include <cstdio>
#include <cstdint>
namespace cg = cooperative_groups;
namespace pg8 {
#define PG8_LAS __attribute__((address_space(3)))
typedef unsigned short bf16_t;
typedef short bf16x8 __attribute__((ext_vector_type(8)));
typedef float f32x4 __attribute__((ext_vector_type(4)));
typedef unsigned u32x4 __attribute__((ext_vector_type(4)));
constexpr int BM = 256, BK = 64, HALF = 128, HTB = HALF * BK * 2  , STAGE_BYTES = 8 * HTB, NXCD = 8, WGM = 8;

__host__ __device__ __forceinline__ int lds_byte(int r, int c) { const int st = (r >> 4) * 2 + (c >> 5), rr = r & 15, cc = c & 31, ob = rr * 64 + cc * 2; return st * 1024 + (ob ^ (((ob >> 9) & 1) << 5)); }
__host__ __device__ __forceinline__ void stage_rc(int b, int& R, int& C) { const int st = b / 1024, sb = b % 1024, swz = sb ^ (((sb >> 9) & 1) << 5); R = (st >> 1) * 16 + swz / 64; C = (st & 1) * 32 + (swz % 64) / 2; }
__host__ __device__ __forceinline__ int perm32(int rho) { const int n = rho >> 4, i = rho & 15; return 8 * (i >> 2) + 4 * n + (i & 3); }

struct Unit { int pm, pn; };
struct Gemm { const bf16_t* A; const bf16_t* Bt; int M, N, K; };

struct StaticOrder {
    int nM, nN, nwg, G, c;
    __host__ __device__ void init(int M, int N, int G_, int c_) { nM = M / BM; nN = N / BM; nwg = nM * nN; G = G_; c = c_; }
    __host__ __device__ bool next(int i, Unit& u) const {
        const long L = (long)i * G + c; if (L >= nwg) return false;
        int wgid = (int)L; { const int q = nwg / NXCD, r = nwg % NXCD, xcd = wgid % NXCD, off = wgid / NXCD; wgid = (xcd < r ? xcd * (q + 1) : r * (q + 1) + (xcd - r) * q) + off; }
        const int nig = WGM * nN, gid = wgid / nig, fm = gid * WGM, gsz = (nM - fm) < WGM ? (nM - fm) : WGM;
        u.pm = fm + ((wgid % nig) % gsz); u.pn = (wgid % nig) / gsz; return true;
    }
    __device__ __forceinline__ void a_ready(const Unit&) const {}
    __device__ __forceinline__ void done(const Unit&) const {}
};
__device__ __forceinline__ unsigned cvt_pk_bf16(float lo, float hi) { unsigned r; asm volatile("v_cvt_pk_bf16_f32 %0, %1, %2" : "=v"(r) : "v"(lo), "v"(hi)); return r; }
typedef float f32x2 __attribute__((ext_vector_type(2)));
template <class Epi, class Sched, bool ALIGN_EPI = false, bool SP2 = false>
__device__ __forceinline__ void gemm_phase(PG8_LAS unsigned char* lds, const Gemm g, const Sched& S, const Epi& E) {
    const int tid = threadIdx.x, wid = __builtin_amdgcn_readfirstlane(tid >> 6), lane = tid & 63, wr = wid >> 2, wc = wid & 3, fr = lane & 15, fq = lane >> 4;
    const int K = g.K, nt = K / BK;
    unsigned voffA[2], voffB[2];
#pragma unroll
    for (int i = 0; i < 2; ++i) { int R, C; stage_rc(tid * 16 + i * 8192, R, C); const int Rb = Epi::PERM ? ((R & ~31) + perm32(R & 31)) : R;
        voffA[i] = (unsigned)(R * K + C) * 2u; voffB[i] = (unsigned)(Rb * K + C) * 2u; }
    const size_t kstep = (size_t)(BK * 2);
    const size_t hstep = (size_t)HALF * K * 2;
    const size_t tstep = 2 * hstep;
    const unsigned ldsw = (unsigned)wid * 1024u;
    const int aoff = lds_byte(wr * 64 + fr, fq * 8), boff = lds_byte(wc * 32 + fr, fq * 8);
#define PG8_SA(b, h) (((b) * 2 + (h)) * HTB)
#define PG8_SB(b, h) ((4 + (b) * 2 + (h)) * HTB)
#define PG8_STAGE(bufoff, gbase, voff) do { _Pragma("unroll") for (int _i = 0; _i < 2; ++_i) \
        __builtin_amdgcn_global_load_lds((const unsigned*)((const char*)(gbase) + (voff)[_i]), (PG8_LAS unsigned*)(lds + (bufoff) + ldsw + _i * 8192), 16, 0, 0); } while (0)
#define PG8_LDA(dst, b, h) do { _Pragma("unroll") for (int m = 0; m < 4; ++m) _Pragma("unroll") for (int k = 0; k < 2; ++k) dst[m][k] = *(const PG8_LAS bf16x8*)(lds + PG8_SA(b, h) + aoff + m * 2048 + k * 1024); } while (0)
#define PG8_LDB(dst, b, h) do { _Pragma("unroll") for (int n = 0; n < 2; ++n) _Pragma("unroll") for (int k = 0; k < 2; ++k) dst[n][k] = *(const PG8_LAS bf16x8*)(lds + PG8_SB(b, h) + boff + n * 2048 + k * 1024); } while (0)
#define PG8_MMA(ai, bj, At, Bt) do { __builtin_amdgcn_s_setprio(1); _Pragma("unroll") for (int m = 0; m < 4; ++m) _Pragma("unroll") for (int n = 0; n < 2; ++n) _Pragma("unroll") for (int k = 0; k < 2; ++k) \
        acc[ai][bj][m][n] = __builtin_amdgcn_mfma_f32_16x16x32_bf16(Bt[n][k], At[m][k], acc[ai][bj][m][n], 0, 0, 0); __builtin_amdgcn_s_setprio(0); } while (0)
#define PG8_WAIT_V(n) asm volatile("s_waitcnt vmcnt(" #n ")" ::: "memory")
#define PG8_WAIT_L(n) asm volatile("s_waitcnt lgkmcnt(" #n ")" ::: "memory")
#define PG8_BAR __builtin_amdgcn_s_barrier()
#define PG8_SCHED __builtin_amdgcn_sched_barrier(0)
    Unit cur, nxt; int ui = 0;
    if (!S.next(0, cur)) return;
    f32x4 acc[2][2][4][2];
#pragma unroll
    for (int a = 0; a < 2; ++a)
#pragma unroll
        for (int b = 0; b < 2; ++b)
#pragma unroll
            for (int m = 0; m < 4; ++m)
#pragma unroll
                for (int n = 0; n < 2; ++n) acc[a][b][m][n] = (f32x4){0.f, 0.f, 0.f, 0.f};
    bf16x8 At[4][2], B0[2][2], B1[2][2];
    const char* cA = (const char*)g.A + (size_t)cur.pm * tstep; const char* cB = (const char*)g.Bt + (size_t)cur.pn * tstep;
    S.a_ready(cur);
    if constexpr (SP2) {
        PG8_STAGE(PG8_SB(0, 0), cB, voffB); PG8_STAGE(PG8_SB(0, 1), cB + hstep, voffB); PG8_STAGE(PG8_SA(0, 0), cA, voffA); PG8_STAGE(PG8_SA(0, 1), cA + hstep, voffA);
        if (wr == 1) PG8_BAR;
        PG8_WAIT_V(2); PG8_BAR;
        PG8_STAGE(PG8_SB(1, 0), cB + kstep, voffB); PG8_STAGE(PG8_SA(1, 0), cA + kstep, voffA); PG8_STAGE(PG8_SB(1, 1), cB + hstep + kstep, voffB);
        PG8_WAIT_V(6); PG8_BAR;
    } else {
        PG8_STAGE(PG8_SB(0, 0), cB, voffB); PG8_STAGE(PG8_SA(0, 0), cA, voffA); PG8_STAGE(PG8_SB(0, 1), cB + hstep, voffB); PG8_STAGE(PG8_SA(0, 1), cA + hstep, voffA);
        if (wr == 1) PG8_BAR;
        PG8_WAIT_V(4); PG8_BAR;
        PG8_STAGE(PG8_SB(1, 0), cB + kstep, voffB); PG8_STAGE(PG8_SA(1, 0), cA + kstep, voffA); PG8_STAGE(PG8_SB(1, 1), cB + hstep + kstep, voffB);
        PG8_WAIT_V(6); PG8_BAR;
    }
    for (;;) {
        const bool has_next = S.next(ui + 1, nxt);
        const char* nA = has_next ? (const char*)g.A + (size_t)nxt.pm * tstep : cA; const char* nB = has_next ? (const char*)g.Bt + (size_t)nxt.pn * tstep : cB;
        for (int t = 0; t < nt; t += 2) {
            const bool last = (t == nt - 2);
            const char* a1 = cA + (size_t)(t + 1) * kstep;
            const char* a2 = last ? nA : cA + (size_t)(t + 2) * kstep; const char* b2 = last ? nB : cB + (size_t)(t + 2) * kstep;
            const char* a3 = a2 + kstep; const char* b3 = b2 + kstep;
            if (last && has_next) S.a_ready(nxt);
            if constexpr (SP2) {
            PG8_LDB(B0, 0, 0); PG8_LDB(B1, 0, 1); PG8_SCHED; PG8_LDA(At, 0, 0); PG8_STAGE(PG8_SA(1, 1), a1 + hstep, voffA);
            PG8_WAIT_V(8); PG8_WAIT_L(0); PG8_BAR; PG8_MMA(0, 0, At, B0); PG8_MMA(0, 1, At, B1); PG8_BAR; PG8_SCHED;
            PG8_LDA(At, 0, 1); PG8_STAGE(PG8_SB(0, 0), b2, voffB); PG8_STAGE(PG8_SB(0, 1), b2 + hstep, voffB); PG8_STAGE(PG8_SA(0, 0), a2, voffA);
            PG8_WAIT_V(8); PG8_WAIT_L(0); PG8_BAR; PG8_MMA(1, 0, At, B0); PG8_MMA(1, 1, At, B1); PG8_BAR; PG8_SCHED;
            PG8_LDB(B0, 1, 0); PG8_LDB(B1, 1, 1); PG8_SCHED; PG8_LDA(At, 1, 0); PG8_STAGE(PG8_SA(0, 1), a2 + hstep, voffA);
            PG8_WAIT_V(8); PG8_WAIT_L(0); PG8_BAR; PG8_MMA(0, 0, At, B0); PG8_MMA(0, 1, At, B1); PG8_BAR; PG8_SCHED;
            PG8_LDA(At, 1, 1); PG8_STAGE(PG8_SB(1, 0), b3, voffB); PG8_STAGE(PG8_SB(1, 1), b3 + hstep, voffB); PG8_STAGE(PG8_SA(1, 0), a3, voffA);
            PG8_WAIT_V(8); PG8_WAIT_L(0); PG8_BAR; PG8_MMA(1, 0, At, B0); PG8_MMA(1, 1, At, B1); PG8_BAR; PG8_SCHED;
            } else {
            PG8_LDB(B0, 0, 0); PG8_SCHED; PG8_LDA(At, 0, 0); PG8_STAGE(PG8_SA(1, 1), a1 + hstep, voffA);
            PG8_WAIT_L(8); PG8_BAR; PG8_WAIT_L(0); PG8_MMA(0, 0, At, B0); PG8_BAR; PG8_SCHED;
            PG8_LDB(B1, 0, 1); PG8_STAGE(PG8_SB(0, 0), b2, voffB);
            PG8_BAR; PG8_WAIT_L(0); PG8_MMA(0, 1, At, B1); PG8_BAR;
            PG8_LDA(At, 0, 1); PG8_STAGE(PG8_SA(0, 0), a2, voffA);
            PG8_BAR; PG8_WAIT_L(0); PG8_MMA(1, 0, At, B0); PG8_BAR; PG8_SCHED;
            PG8_STAGE(PG8_SB(0, 1), b2 + hstep, voffB);
            PG8_WAIT_V(6); PG8_BAR; PG8_MMA(1, 1, At, B1); PG8_BAR;
            PG8_LDB(B0, 1, 0); PG8_SCHED; PG8_LDA(At, 1, 0); PG8_STAGE(PG8_SA(0, 1), a2 + hstep, voffA);
            PG8_WAIT_L(8); PG8_BAR; PG8_WAIT_L(0); PG8_MMA(0, 0, At, B0); PG8_BAR; PG8_SCHED;
            PG8_LDB(B1, 1, 1); PG8_STAGE(PG8_SB(1, 0), b3, voffB);
            PG8_BAR; PG8_WAIT_L(0); PG8_MMA(0, 1, At, B1); PG8_BAR;
            PG8_LDA(At, 1, 1); PG8_STAGE(PG8_SA(1, 0), a3, voffA);
            PG8_BAR; PG8_WAIT_L(0); PG8_MMA(1, 0, At, B0); PG8_BAR; PG8_SCHED;
            PG8_STAGE(PG8_SB(1, 1), b3 + hstep, voffB);
            PG8_WAIT_V(6); PG8_BAR; PG8_MMA(1, 1, At, B1); PG8_BAR;
            }
        }
        if constexpr (ALIGN_EPI) { if (wr == 0) PG8_BAR; }
        if constexpr (!Epi::AFTER_DRAIN) { E(acc, cur, wr, wc, fr, fq); S.done(cur); }
        if (!has_next) break;
#pragma unroll
        for (int a = 0; a < 2; ++a)
#pragma unroll
            for (int b = 0; b < 2; ++b)
#pragma unroll
                for (int m = 0; m < 4; ++m)
#pragma unroll
                    for (int n = 0; n < 2; ++n) acc[a][b][m][n] = (f32x4){0.f, 0.f, 0.f, 0.f};
        cur = nxt; cA = nA; cB = nB; ++ui;
        if constexpr (ALIGN_EPI) { if (wr == 1) PG8_BAR; }
    }
    PG8_WAIT_V(0);
    if constexpr (!ALIGN_EPI) { if (wr == 0) PG8_BAR; }
    PG8_BAR;
    if constexpr (Epi::AFTER_DRAIN) { E.fused(acc, cur, wr, wc, fr, fq, lds, wid, lane); S.done(cur); }
#undef PG8_SA
#undef PG8_SB
#undef PG8_STAGE
#undef PG8_LDA
#undef PG8_LDB
#undef PG8_MMA
#undef PG8_WAIT_V
#undef PG8_WAIT_L
#undef PG8_BAR
#undef PG8_SCHED
}
}
namespace mk {
using pg8::bf16_t; using pg8::bf16x8; using pg8::f32x4; using pg8::u32x4; using pg8::Unit; using pg8::Gemm;
#define LAS __attribute__((address_space(3)))
typedef short v4i16 __attribute__((ext_vector_type(4)));
typedef unsigned u32x2 __attribute__((ext_vector_type(2)));

constexpr int D = 1024, NB = 16, NT = 4096, NL = 256;
constexpr int MT = NB * NT, MC = NB * NL, MA = MT + MC;
constexpr int NPROJ = 2816, INC = 2832;
constexpr int NE = 16, FF = 512, CAP = 512;
constexpr float EPS = 1e-6f, LOG2E = 1.4426950408889634f;
constexpr int NWAVES = 8, NTHREADS = 512;
constexpr int LDS_BYTES = 144 * 1024;

constexpr size_t al256(size_t x) { return (x + 255) & ~(size_t)255; }
constexpr size_t WS_MOD = 0;
constexpr size_t WS_ROPE = WS_MOD + al256(17 * 6144 * 4);
constexpr size_t WS_MISC = WS_ROPE + al256(2 * 1024 * 4);
constexpr size_t WS_GATES = WS_MISC + 256;
constexpr size_t WS_AFF = WS_GATES + al256((size_t)MA * 16 * 4);
constexpr size_t WS_IDX = WS_AFF + al256((size_t)NB * NE * NT * 4);
constexpr size_t WS_GATE = WS_IDX + al256(256 * CAP * 4);
constexpr size_t WS_SLOT = WS_GATE + al256(256 * CAP * 4);
constexpr size_t WS_WIN = WS_SLOT + al256((size_t)256 * NT * 4);
constexpr size_t WS_WOUT = WS_WIN + al256((size_t)NPROJ * D * 2);
constexpr size_t WS_WGU = WS_WOUT + al256((size_t)D * D * 2);
constexpr size_t WS_WD = WS_WGU + al256((size_t)NE * 1024 * D * 2);
constexpr size_t WS_HX = WS_WD + al256((size_t)NE * D * FF * 2);
constexpr size_t WS_Q = WS_HX + al256((size_t)MA * D * 2);
constexpr size_t WS_KK = WS_Q + al256((size_t)MT * 512 * 2);
constexpr size_t WS_VV = WS_KK + al256((size_t)MA * 128 * 2);
constexpr size_t WS_M4 = WS_VV + al256((size_t)MA * 128 * 2);
constexpr size_t WS_MIX = WS_M4 + al256((size_t)4 * MA * 512 * 2);
constexpr size_t WS_HF = WS_MIX + (size_t)MT * D * 2;
constexpr size_t WS_HB = WS_HF + (size_t)MT * 512 * 2;
constexpr size_t WS_ACT = WS_HB + (size_t)MT * 512 * 2;
constexpr size_t WS_END = WS_ACT + al256((size_t)256 * CAP * FF * 2);
static_assert(WS_END <= ((size_t)1 << 30), "workspace map exceeds 1 GiB");
static_assert((size_t)256 * CAP * D * 2 <= (size_t)4 * MA * 512 * 2, "XG overlay fits");

struct Args { const float* in[20]; float* out; unsigned char* ws; int ph_lo, ph_hi; };

__device__ __forceinline__ float wave_sum(float v) {
#pragma unroll
    for (int o = 1; o < 64; o <<= 1) v += __shfl_xor(v, o);
    return v;
}
__device__ __forceinline__ float bflo(unsigned w) { return __builtin_bit_cast(float, w << 16); }
__device__ __forceinline__ float bfhi(unsigned w) { return __builtin_bit_cast(float, w & 0xffff0000u); }
__device__ __forceinline__ unsigned pkbf(float lo, float hi) { return pg8::cvt_pk_bf16(lo, hi); }
__device__ __forceinline__ float silu_f(float x) { return x / (1.f + __expf(-x)); }
__device__ __forceinline__ float logsig_f(float x) { return fminf(x, 0.f) - log1pf(expf(-fabsf(x))); }
__device__ __forceinline__ f32x4 mfma16(bf16x8 a, bf16x8 b, f32x4 c) { return __builtin_amdgcn_mfma_f32_16x16x32_bf16(a, b, c, 0, 0, 0); }
__device__ __forceinline__ bf16x8 tr2(const LAS bf16_t* p0, const LAS bf16_t* p1) {
    const v4i16 a = __builtin_amdgcn_ds_read_tr16_b64_v4i16((LAS v4i16*)p0), b = __builtin_amdgcn_ds_read_tr16_b64_v4i16((LAS v4i16*)p1);
    return (bf16x8){a[0], a[1], a[2], a[3], b[0], b[1], b[2], b[3]};
}
__device__ __forceinline__ bf16x8 pack8(const f32x4 a, const f32x4 b) {
    u32x4 w; w.x = pkbf(a[0], a[1]); w.y = pkbf(a[2], a[3]); w.z = pkbf(b[0], b[1]); w.w = pkbf(b[2], b[3]); return __builtin_bit_cast(bf16x8, w);
}
__host__ __device__ __forceinline__ int win_dst_row(int n) {
    if (n >= 768) return n;
    const int pn = n >> 8, r = n & 255, wc = r >> 6, bj = (r >> 5) & 1, p = r & 31;
    return 256 * pn + 128 * bj + 32 * wc + p;
}

__device__ __forceinline__ void transpose_item(const float* W, int N, int k0, int n0, bf16_t* WT, int K, int drow0, LAS float* scr, int lane) {
#pragma unroll 8
    for (int i = 0; i < 32; ++i) { const int kk = 2 * i + (lane >> 5); scr[kk * 33 + (lane & 31)] = W[(size_t)(k0 + kk) * N + n0 + (lane & 31)]; }
    asm volatile("s_waitcnt lgkmcnt(0)" ::: "memory");
    const int c = lane & 7;
#pragma unroll
    for (int j = 0; j < 4; ++j) { const int n = (lane >> 3) + 8 * j; const LAS float* s = scr + (8 * c) * 33 + n;
        u32x4 o; o.x = pkbf(s[0 * 33], s[1 * 33]); o.y = pkbf(s[2 * 33], s[3 * 33]); o.z = pkbf(s[4 * 33], s[5 * 33]); o.w = pkbf(s[6 * 33], s[7 * 33]);
        *(u32x4*)(WT + (size_t)(drow0 + n) * K + k0 + 8 * c) = o; }
    asm volatile("s_waitcnt lgkmcnt(0)" ::: "memory");
}
__device__ __forceinline__ void phase0(const Args& a, LAS unsigned char* lds) {
    const int tid = threadIdx.x, lane = tid & 63, wave = tid >> 6, wg = blockIdx.x, G = gridDim.x;
    unsigned char* ws = a.ws;
    {
        LAS float* sc = (LAS float*)lds;
        LAS float* part = sc + 17 * 1024;
        const float* c = a.in[1]; const float* cctx = a.in[3]; const float* w_mod = a.in[4]; const float* b_mod = a.in[5];
        float* mod = (float*)(ws + WS_MOD);
        for (int i = tid; i < 17 * 1024; i += NTHREADS) { const int r = i >> 10, k = i & 1023; const float v = r < 16 ? c[r * 1024 + k] : cctx[k]; sc[i] = v / (1.f + expf(-v)); }
        __syncthreads();
        for (int it = wg; it < 256; it += G) {
            const int col0 = it * 24;
            if (tid < 504) {
                const int j = tid % 24, kg = tid / 24; float acc[17];
#pragma unroll
                for (int r = 0; r < 17; ++r) acc[r] = 0.f;
                for (int k = kg; k < 1024; k += 21) { const float w = w_mod[(size_t)k * 6144 + col0 + j];
#pragma unroll
                    for (int r = 0; r < 17; ++r) acc[r] += sc[r * 1024 + k] * w; }
#pragma unroll
                for (int r = 0; r < 17; ++r) part[(kg * 17 + r) * 24 + j] = acc[r];
            }
            __syncthreads();
            if (tid < 408) { const int r = tid / 24, j = tid % 24; float s = b_mod[col0 + j]; for (int kg = 0; kg < 21; ++kg) s += part[(kg * 17 + r) * 24 + j]; mod[r * 6144 + col0 + j] = s; }
            __syncthreads();
        }
    }
    if (wg == 0) {
        float* rope = (float*)(ws + WS_ROPE);
        for (int i = tid; i < 1024; i += NTHREADS) { const int pos = i >> 4, f = i & 15; const float ang = (float)pos * powf(10000.f, -(float)f / 16.f); rope[i] = cosf(ang); rope[1024 + i] = sinf(ang); }
        if (tid == 0) { float mq = 0.f, mkk = 0.f; for (int i = 0; i < 64; ++i) { mq = fmaxf(mq, fabsf(a.in[11][i])); mkk = fmaxf(mkk, fabsf(a.in[12][i])); }
            ((float*)(ws + WS_MISC))[0] = fmaxf(0.f, 8.f * mq * mkk * LOG2E - 16.f); }
    }
    {
        LAS float* scr = (LAS float*)lds + wave * (64 * 33);
        const int gw = wg * NWAVES + wave, NGW = G * NWAVES;
        constexpr int I_IN = 16 * 88, I_OUT = 16 * 32, I_G = 16 * 16, I_D = 8 * 32;
        constexpr int NITEMS = I_IN + I_OUT + NE * (2 * I_G + I_D);
        bf16_t* WIN = (bf16_t*)(ws + WS_WIN); bf16_t* WOUT = (bf16_t*)(ws + WS_WOUT); bf16_t* WGU = (bf16_t*)(ws + WS_WGU); bf16_t* WDT = (bf16_t*)(ws + WS_WD);
        for (int it = gw; it < NITEMS; it += NGW) {
            int r = it;
            if (r < I_IN) { const int kb = r / 88, nb = r % 88; transpose_item(a.in[8], INC, 64 * kb, 32 * nb, WIN, D, win_dst_row(32 * nb), scr, lane); continue; } r -= I_IN;
            if (r < I_OUT) { const int kb = r / 32, nb = r % 32; transpose_item(a.in[15], D, 64 * kb, 32 * nb, WOUT, D, 32 * nb, scr, lane); continue; } r -= I_OUT;
            const int e = r / (2 * I_G + I_D); r -= e * (2 * I_G + I_D);
            if (r < 2 * I_G) { const int up = r / I_G, rr = r % I_G, kb = rr / 16, nb = rr % 16, n0 = 32 * nb;
                transpose_item((up ? a.in[18] : a.in[17]) + (size_t)e * D * FF, FF, 64 * kb, n0, WGU + (size_t)e * 1024 * D, D, 256 * (n0 >> 7) + (n0 & 127) + 128 * up, scr, lane); continue; }
            r -= 2 * I_G;
            { const int kb = r / 32, nb = r % 32; transpose_item(a.in[19] + (size_t)e * FF * D, D, 64 * kb, 32 * nb, WDT + (size_t)e * D * FF, FF, 32 * nb, scr, lane); }
        }
    }
}

__device__ __forceinline__ void fill_w16(LAS float* W16, const float* src, int pitch, int tid) {
    for (int idx = tid; idx < 1024 * 16; idx += NTHREADS) { const int k = idx >> 4, t = idx & 15; const int ln = (k & 255) >> 2, i = k & 3, j = k >> 8;
        W16[((j * 4 + i) * 64 + ln) * 20 + t] = src[(size_t)k * pitch + t]; }
}
__device__ __forceinline__ void row_norm_dots(f32x4 (&v)[4], const f32x4 (&sc)[4], const f32x4 (&sh)[4], const LAS float* W16, int lane, float (&g)[16]) {
    float s = 0.f;
#pragma unroll
    for (int j = 0; j < 4; ++j) s += (v[j][0] * v[j][0] + v[j][1] * v[j][1]) + (v[j][2] * v[j][2] + v[j][3] * v[j][3]);
    const float rinv = rsqrtf(wave_sum(s) * (1.f / D) + EPS);
#pragma unroll
    for (int t = 0; t < 16; ++t) g[t] = 0.f;
#pragma unroll
    for (int j = 0; j < 4; ++j) {
        v[j] = v[j] * rinv * sc[j] + sh[j];
#pragma unroll
        for (int i = 0; i < 4; ++i) { const LAS f32x4* wp = (const LAS f32x4*)(W16 + ((j * 4 + i) * 64 + lane) * 20); const float hv = v[j][i];
#pragma unroll
            for (int q = 0; q < 4; ++q) { const f32x4 w = wp[q]; g[4 * q + 0] += hv * w[0]; g[4 * q + 1] += hv * w[1]; g[4 * q + 2] += hv * w[2]; g[4 * q + 3] += hv * w[3]; } }
    }
#pragma unroll
    for (int t = 0; t < 16; ++t) g[t] = wave_sum(g[t]);
}
__device__ __forceinline__ void store_row_bf16(bf16_t* orow, const f32x4 (&v)[4], int lane) {
#pragma unroll
    for (int j = 0; j < 4; ++j) { u32x2 o; o.x = pkbf(v[j][0], v[j][1]); o.y = pkbf(v[j][2], v[j][3]); *(u32x2*)(orow + 4 * lane + 256 * j) = o; }
}
__device__ __forceinline__ void phase1(const Args& a, LAS unsigned char* lds) {
    const int tid = threadIdx.x, lane = tid & 63, wave = tid >> 6;
    LAS float* W16 = (LAS float*)lds;
    fill_w16(W16, a.in[8] + NPROJ, INC, tid);
    __syncthreads();
    const float* mod = (const float*)(a.ws + WS_MOD); const float* n1w = a.in[6]; const float* bg = a.in[9];
    bf16_t* HX = (bf16_t*)(a.ws + WS_HX); float* GATES = (float*)(a.ws + WS_GATES);
    const int gw = blockIdx.x * NWAVES + wave, NGW = gridDim.x * NWAVES;
    const int per = (MA + NGW - 1) / NGW; const int r0 = gw * per, r1 = min(MA, r0 + per);
    int curb = -1; f32x4 sc[4], sh[4];
    for (int m = r0; m < r1; ++m) {
        const int b = m < MT ? m >> 12 : 16;
        if (b != curb) { curb = b; const float* mr = mod + b * 6144;
#pragma unroll
            for (int j = 0; j < 4; ++j) { const int k = 4 * lane + 256 * j; const f32x4 w = *(const f32x4*)(n1w + k), s1 = *(const f32x4*)(mr + D + k); sc[j] = w * (1.f + s1); sh[j] = *(const f32x4*)(mr + k); } }
        const float* xr = m < MT ? a.in[0] + (size_t)m * D : a.in[2] + (size_t)(m - MT) * D;
        f32x4 v[4];
#pragma unroll
        for (int j = 0; j < 4; ++j) v[j] = *(const f32x4*)(xr + 4 * lane + 256 * j);
        float g[16];
        row_norm_dots(v, sc, sh, W16, lane, g);
        store_row_bf16(HX + (size_t)m * D, v, lane);
        float gv = 0.f;
#pragma unroll
        for (int t = 0; t < 16; ++t) gv = (lane == t) ? g[t] : gv;
        if (lane < 16) { gv += bg[lane]; if ((lane >> 2) & 1) gv = logsig_f(gv); GATES[(size_t)m * 16 + lane] = gv; }
    }
}

struct SeqOrder {
    int pm0, nN, n;
    __device__ __forceinline__ bool next(int i, Unit& u) const { if (i >= n) return false; u.pm = pm0 + i / nN; u.pn = i % nN; return true; }
    __device__ __forceinline__ void a_ready(const Unit&) const {}
    __device__ __forceinline__ void done(const Unit&) const {}
};
struct EpiProj {
    static constexpr bool PERM = true, AFTER_DRAIN = false;
    bf16_t *Q, *KK, *VV, *M4; const float *qw, *kw, *rope; float qscale;
    __device__ __forceinline__ void operator()(const f32x4 (&acc)[2][2][4][2], const Unit& u, int wr, int wc, int fr, int fq) const {
        const int pn = u.pn, row0 = u.pm * 256 + wr * 64 + fr;
        if (pn >= 3) {
            bf16_t* base = M4 + (size_t)((pn - 3) >> 1) * MA * 512 + ((pn - 3) & 1) * 256 + wc * 32 + 8 * fq;
#pragma unroll
            for (int ai = 0; ai < 2; ++ai)
#pragma unroll
                for (int m = 0; m < 4; ++m) { bf16_t* rowp = base + (size_t)(row0 + ai * 128 + m * 16) * 512;
#pragma unroll
                    for (int bj = 0; bj < 2; ++bj) { const f32x4 v0 = acc[ai][bj][m][0], v1 = acc[ai][bj][m][1]; u32x4 w; w.x = pkbf(v0[0], v0[1]); w.y = pkbf(v0[2], v0[3]); w.z = pkbf(v1[0], v1[1]); w.w = pkbf(v1[2], v1[3]);
                        *(u32x4*)(rowp + bj * 128) = w; } }
            return;
        }
        const bool latent = u.pm < 256;
        if (pn < 2 && !latent) return;
        const bool isv = (pn == 2) && (wc >= 2);
        bf16_t* dst; int ld; const float* nw; float osc = 1.f;
        if (pn < 2) { dst = Q + (4 * pn + wc) * 64; ld = 512; nw = qw; osc = qscale; }
        else if (!isv) { dst = KK + wc * 64; ld = 128; nw = kw; }
        else { dst = VV + (wc - 2) * 64; ld = 128; nw = kw; }
        f32x4 w4[2][2];
#pragma unroll
        for (int bj = 0; bj < 2; ++bj)
#pragma unroll
            for (int n = 0; n < 2; ++n) w4[bj][n] = *(const f32x4*)(nw + 32 * bj + 8 * fq + 4 * n);
#pragma unroll
        for (int ai = 0; ai < 2; ++ai)
#pragma unroll
            for (int m = 0; m < 4; ++m) {
                const int row = row0 + ai * 128 + m * 16;
                f32x4 y[2][2];
#pragma unroll
                for (int bj = 0; bj < 2; ++bj)
#pragma unroll
                    for (int n = 0; n < 2; ++n) y[bj][n] = acc[ai][bj][m][n];
                if (!isv) {
                    float ss = 0.f;
#pragma unroll
                    for (int bj = 0; bj < 2; ++bj)
#pragma unroll
                        for (int n = 0; n < 2; ++n) ss += (y[bj][n][0] * y[bj][n][0] + y[bj][n][1] * y[bj][n][1]) + (y[bj][n][2] * y[bj][n][2] + y[bj][n][3] * y[bj][n][3]);
                    ss += __shfl_xor(ss, 16); ss += __shfl_xor(ss, 32);
                    const float rinv = rsqrtf(ss * (1.f / 64.f) + EPS);
#pragma unroll
                    for (int bj = 0; bj < 2; ++bj)
#pragma unroll
                        for (int n = 0; n < 2; ++n) y[bj][n] = y[bj][n] * rinv * w4[bj][n];
                    if (latent) {
                        const int ntok = row & (NT - 1); const int pos = (fq < 2) ? (ntok >> 6) : (ntok & 63);
                        const float* rp = rope + pos * 16 + 8 * (fq & 1);
#pragma unroll
                        for (int n = 0; n < 2; ++n) { const f32x4 cs = *(const f32x4*)(rp + 4 * n), sn = *(const f32x4*)(rp + 1024 + 4 * n);
                            const f32x4 x1 = y[0][n], x2 = y[1][n]; y[0][n] = x1 * cs - x2 * sn; y[1][n] = x2 * cs + x1 * sn; }
                    }
                }
                bf16_t* rowp = dst + (size_t)row * ld + 8 * fq;
#pragma unroll
                for (int bj = 0; bj < 2; ++bj) { const f32x4 v0 = y[bj][0] * osc, v1 = y[bj][1] * osc; u32x4 w; w.x = pkbf(v0[0], v0[1]); w.y = pkbf(v0[2], v0[3]); w.z = pkbf(v1[0], v1[1]); w.w = pkbf(v1[2], v1[3]);
                    *(u32x4*)(rowp + 32 * bj) = w; }
            }
    }
};
struct EpiOut {
    static constexpr bool PERM = false, AFTER_DRAIN = false;
    const float* x; const float* mod; float* out;
    __device__ __forceinline__ void operator()(const f32x4 (&acc)[2][2][4][2], const Unit& u, int wr, int wc, int fr, int fq) const {
        const int row0 = u.pm * 256 + wr * 64 + fr, col0 = u.pn * 256 + wc * 32 + 4 * fq;
        const float* g1 = mod + (u.pm >> 4) * 6144 + 2 * D;
        f32x4 gv[2][2];
#pragma unroll
        for (int bj = 0; bj < 2; ++bj)
#pragma unroll
            for (int n = 0; n < 2; ++n) gv[bj][n] = *(const f32x4*)(g1 + col0 + bj * 128 + n * 16);
#pragma unroll
        for (int ai = 0; ai < 2; ++ai)
#pragma unroll
            for (int m = 0; m < 4; ++m) { const size_t off = (size_t)(row0 + ai * 128 + m * 16) * D + col0;
#pragma unroll
                for (int bj = 0; bj < 2; ++bj)
#pragma unroll
                    for (int n = 0; n < 2; ++n) { const f32x4 xv = *(const f32x4*)(x + off + bj * 128 + n * 16); *(f32x4*)(out + off + bj * 128 + n * 16) = xv + gv[bj][n] * acc[ai][bj][m][n]; }
                asm volatile("" ::: "memory"); }
    }
};
struct EpiAct {
    static constexpr bool PERM = true, AFTER_DRAIN = false;
    bf16_t* ACT;
    __device__ __forceinline__ void operator()(const f32x4 (&acc)[2][2][4][2], const Unit& u, int wr, int wc, int fr, int fq) const {
        const int row0 = u.pm * 256 + wr * 64 + fr, col0 = u.pn * 128 + wc * 32 + 8 * fq;
#pragma unroll
        for (int ai = 0; ai < 2; ++ai)
#pragma unroll
            for (int m = 0; m < 4; ++m) { f32x4 o[2];
#pragma unroll
                for (int n = 0; n < 2; ++n) { const f32x4 gt = acc[ai][0][m][n], up = acc[ai][1][m][n];
#pragma unroll
                    for (int j = 0; j < 4; ++j) o[n][j] = silu_f(gt[j]) * up[j]; }
                u32x4 w; w.x = pkbf(o[0][0], o[0][1]); w.y = pkbf(o[0][2], o[0][3]); w.z = pkbf(o[1][0], o[1][1]); w.w = pkbf(o[1][2], o[1][3]);
                *(u32x4*)(ACT + (size_t)(row0 + ai * 128 + m * 16) * FF + col0) = w; asm volatile("" ::: "memory"); }
    }
};
struct EpiDown {
    static constexpr bool PERM = true, AFTER_DRAIN = false;
    bf16_t* Y; const float* gate;
    __device__ __forceinline__ void operator()(const f32x4 (&acc)[2][2][4][2], const Unit& u, int wr, int wc, int fr, int fq) const {
        const int row0 = u.pm * 256 + wr * 64 + fr, col0 = u.pn * 256 + wc * 32 + 8 * fq;
#pragma unroll
        for (int ai = 0; ai < 2; ++ai)
#pragma unroll
            for (int m = 0; m < 4; ++m) { const int row = row0 + ai * 128 + m * 16; const float gt = gate[row];
#pragma unroll
                for (int bj = 0; bj < 2; ++bj) { const f32x4 v0 = acc[ai][bj][m][0] * gt, v1 = acc[ai][bj][m][1] * gt; u32x4 w; w.x = pkbf(v0[0], v0[1]); w.y = pkbf(v0[2], v0[3]); w.z = pkbf(v1[0], v1[1]); w.w = pkbf(v1[2], v1[3]);
                    *(u32x4*)(Y + (size_t)row * D + col0 + bj * 128) = w; } asm volatile("" ::: "memory"); }
    }
};

constexpr int AT_STRIDE = 72;
constexpr int AT_K = 0, AT_V = 384 * AT_STRIDE * 2;
__device__ __forceinline__ void attn_tile(const LAS bf16_t* AK, const LAS bf16_t* AV, int kb, bool masked, int kpos_base  , int qpos0  ,
                                          const bf16x8 (&Qf)[4][2], f32x4 (&O)[4][4], float (&ls)[4], float cshift, int fr, int fq) {
    const int q4 = fr >> 2, p4 = fr & 3;
    f32x4 S[4][4];
#pragma unroll
    for (int ks = 0; ks < 4; ++ks) {
        const LAS bf16_t* kp = AK + (kb + 16 * ks + fr) * AT_STRIDE + 8 * fq;
        const bf16x8 A0 = *(const LAS bf16x8*)kp, A1 = *(const LAS bf16x8*)(kp + 32);
#pragma unroll
        for (int qt = 0; qt < 4; ++qt) { f32x4 z = {0.f, 0.f, 0.f, 0.f}; z = mfma16(A0, Qf[qt][0], z); S[ks][qt] = mfma16(A1, Qf[qt][1], z); }
    }
#pragma unroll
    for (int ks = 0; ks < 4; ++ks)
#pragma unroll
        for (int qt = 0; qt < 4; ++qt)
#pragma unroll
            for (int r = 0; r < 4; ++r) {
                float p = exp2f(S[ks][qt][r] - cshift);
                if (masked) { const int kpos = kpos_base + kb + 16 * ks + 4 * fq + r, qpos = qpos0 + 16 * qt + fr; const int dd = kpos - qpos;
                    if (kpos < 0 || kpos >= NT || dd > 128 || dd < -128) p = 0.f; }
                ls[qt] += p; S[ks][qt][r] = p;
            }
#pragma unroll
    for (int kk2 = 0; kk2 < 2; ++kk2) {
        bf16x8 Bp[4];
#pragma unroll
        for (int qt = 0; qt < 4; ++qt) Bp[qt] = pack8(S[2 * kk2][qt], S[2 * kk2 + 1][qt]);
#pragma unroll
        for (int dt = 0; dt < 4; ++dt) {
            const LAS bf16_t* vp = AV + (kb + 32 * kk2 + 4 * fq + q4) * AT_STRIDE + 16 * dt + 4 * p4;
            const bf16x8 A = tr2(vp, vp + 16 * AT_STRIDE);
#pragma unroll
            for (int qt = 0; qt < 4; ++qt) O[dt][qt] = mfma16(A, Bp[qt], O[dt][qt]);
        }
    }
}
__device__ __forceinline__ void attn_item(const Args& a, LAS unsigned char* lds, int item) {
    const int tid = threadIdx.x, lane = tid & 63, w = __builtin_amdgcn_readfirstlane(tid >> 6), fr = lane & 15, fq = lane >> 4;
    const int qblk = item & 31, kvh = (item >> 5) & 1, b = item >> 6;
    const int g = w >> 1, qh = w & 1, head = 4 * kvh + g;
    const bf16_t* Q = (const bf16_t*)(a.ws + WS_Q); const bf16_t* KK = (const bf16_t*)(a.ws + WS_KK); const bf16_t* VV = (const bf16_t*)(a.ws + WS_VV);
    bf16_t* MIX = (bf16_t*)(a.ws + WS_MIX);
    LAS bf16_t* AK = (LAS bf16_t*)(lds + AT_K); LAS bf16_t* AV = (LAS bf16_t*)(lds + AT_V);
    const float cshift = ((const float*)(a.ws + WS_MISC))[0];
    const int qpos0 = 128 * qblk + 64 * qh;
    bf16x8 Qf[4][2];
#pragma unroll
    for (int qt = 0; qt < 4; ++qt) { const bf16_t* qp = Q + (size_t)(b * NT + qpos0 + 16 * qt + fr) * 512 + head * 64 + 8 * fq; Qf[qt][0] = *(const bf16x8*)qp; Qf[qt][1] = *(const bf16x8*)(qp + 32); }
    f32x4 O[4][4]; float ls[4];
#pragma unroll
    for (int dt = 0; dt < 4; ++dt)
#pragma unroll
        for (int qt = 0; qt < 4; ++qt) O[dt][qt] = (f32x4){0.f, 0.f, 0.f, 0.f};
#pragma unroll
    for (int qt = 0; qt < 4; ++qt) ls[qt] = 0.f;
    const int kpos_base = 128 * qblk - 128;
    for (int i = tid; i < 384 * 8; i += NTHREADS) { const int r = i >> 3, c = i & 7; int kp = kpos_base + r; kp = kp < 0 ? 0 : (kp > NT - 1 ? NT - 1 : kp);
        const size_t src = (size_t)(b * NT + kp) * 128 + kvh * 64 + 8 * c;
        *(LAS u32x4*)(AK + r * AT_STRIDE + 8 * c) = *(const u32x4*)(KK + src); *(LAS u32x4*)(AV + r * AT_STRIDE + 8 * c) = *(const u32x4*)(VV + src); }
    __syncthreads();
    for (int jt = 0; jt < 5; ++jt) attn_tile(AK, AV, 64 * qh + 64 * jt, true, kpos_base, qpos0, Qf, O, ls, cshift, fr, fq);
    __syncthreads();
    for (int i = tid; i < 256 * 8; i += NTHREADS) { const int r = i >> 3, c = i & 7; const size_t src = (size_t)(MT + b * NL + r) * 128 + kvh * 64 + 8 * c;
        *(LAS u32x4*)(AK + r * AT_STRIDE + 8 * c) = *(const u32x4*)(KK + src); *(LAS u32x4*)(AV + r * AT_STRIDE + 8 * c) = *(const u32x4*)(VV + src); }
    __syncthreads();
    for (int jt = 0; jt < 4; ++jt) attn_tile(AK, AV, 64 * jt, false, 0, qpos0, Qf, O, ls, cshift, fr, fq);
    __syncthreads();
    const float psink = exp2f(a.in[13][head] * LOG2E - cshift);
#pragma unroll
    for (int qt = 0; qt < 4; ++qt) {
        float l = ls[qt]; l += __shfl_xor(l, 16); l += __shfl_xor(l, 32); const float inv = 1.f / (l + psink);
        bf16_t* op = MIX + (size_t)(b * NT + qpos0 + 16 * qt + fr) * D + head * 64 + 4 * fq;
#pragma unroll
        for (int dt = 0; dt < 4; ++dt) { const f32x4 o = O[dt][qt] * inv; u32x2 wv; wv.x = pkbf(o[0], o[1]); wv.y = pkbf(o[2], o[3]); *(u32x2*)(op + 16 * dt) = wv; }
    }
}

constexpr int KS_ST = 136, VS_ST = 88;
constexpr int ML_KS = 0, ML_VN = ML_KS + 128 * KS_ST * 2, ML_VW = ML_VN + 128 * VS_ST * 2, ML_CN = ML_VW + 128 * VS_ST * 2, ML_F = ML_CN + 128 * VS_ST * 2, ML_CW = ML_F + 1024 * 4, ML_END = ML_CW + 768 * 4;
static_assert(ML_END <= LDS_BYTES, "mLSTM LDS map");
__device__ __forceinline__ void mlstm_item(const Args& a, LAS unsigned char* lds, int item) {
    const int tid = threadIdx.x, lane = tid & 63, w = __builtin_amdgcn_readfirstlane(tid >> 6), fr = lane & 15, fq = lane >> 4, q4 = fr >> 2, p4 = fr & 3;
    const int vh = item & 1, dir = (item >> 1) & 1, h = (item >> 2) & 3, b = item >> 4;
    LAS bf16_t* Ks = (LAS bf16_t*)(lds + ML_KS); LAS bf16_t* Vn = (LAS bf16_t*)(lds + ML_VN); LAS bf16_t* Vw = (LAS bf16_t*)(lds + ML_VW); LAS bf16_t* Cn = (LAS bf16_t*)(lds + ML_CN);
    LAS float* F = (LAS float*)(lds + ML_F); LAS float* gA = F, *MA_ = F + 128, *ebA = F + 256, *decA = F + 384, *wsA = F + 512, *scal = F + 640; LAS float* cw = (LAS float*)(lds + ML_CW);
    const bf16_t* MQ = (const bf16_t*)(a.ws + WS_M4); const bf16_t* MK = MQ + (size_t)MA * 512; const bf16_t* MV = MK + (size_t)MA * 512;
    const float* GATES = (const float*)(a.ws + WS_GATES);
    bf16_t* H = (bf16_t*)(a.ws + (dir ? WS_HB : WS_HF));
    const float* conv = a.in[10];
    for (int i = tid; i < 768; i += NTHREADS) { const int j = i >> 8, c = i & 255; cw[i] = conv[j * 1024 + (c < 128 ? h * 128 + c : 512 + h * 128 + (c - 128))]; }
    for (int i = tid; i < 128 * VS_ST / 2; i += NTHREADS) ((LAS unsigned*)Cn)[i] = 0u;
    for (int i = tid; i < 128 * 12; i += NTHREADS) { const int s = i / 12, c = i % 12; ((LAS unsigned*)(Vn + s * VS_ST + 64))[c] = (c == 0) ? 0x00003f80u : 0u; ((LAS unsigned*)(Vw + s * VS_ST + 64))[c] = 0u; }
    f32x4 accC[5];
#pragma unroll
    for (int vt = 0; vt < 5; ++vt) accC[vt] = (f32x4){0.f, 0.f, 0.f, 0.f};
    float m_state = 0.f;
    __syncthreads();
    for (int ci = 0; ci < 34; ++ci) {
        const bool isctx = ci < 2;
        int seq0, seqlen, nbase;
        if (isctx) { seq0 = MT + b * NL; seqlen = NL; nbase = dir ? 128 * (1 - ci) : 128 * ci; }
        else { const int k = ci - 2; seq0 = b * NT; seqlen = NT; nbase = dir ? 128 * (31 - k) : 128 * k; }
#define ML_POS(s) (dir ? nbase + 127 - (s) : nbase + (s))
        if (w == 0) {
            const int s0 = 2 * lane, s1 = s0 + 1;
            const float* G0 = GATES + (size_t)(seq0 + ML_POS(s0)) * 16 + h; const float* G1 = GATES + (size_t)(seq0 + ML_POS(s1)) * 16 + h;
            const float li0 = G0[dir ? 8 : 0], lf0 = G0[dir ? 12 : 4], li1 = G1[dir ? 8 : 0], lf1 = G1[dir ? 12 : 4];
            float cs = lf0 + lf1;
#pragma unroll
            for (int o = 1; o < 64; o <<= 1) { const float y = __shfl_up(cs, o); if (lane >= o) cs += y; }
            const float b1 = cs, b0 = cs - lf1;
            const float g0 = li0 - b0, g1 = li1 - b1;
            float mx = fmaxf(g0, g1);
#pragma unroll
            for (int o = 1; o < 64; o <<= 1) { const float y = __shfl_up(mx, o); if (lane >= o) mx = fmaxf(mx, y); }
            float ex = __shfl_up(mx, 1); if (lane == 0) ex = -INFINITY;
            const float pm0 = fmaxf(ex, g0), pm1 = mx;
            const float M0 = fmaxf(m_state, pm0), M1 = fmaxf(m_state, pm1);
            const float b_last = __shfl(b1, 63), M_last = __shfl(M1, 63);
            gA[s0] = g0; gA[s1] = g1; MA_[s0] = M0; MA_[s1] = M1;
            ebA[s0] = expf(-b0 - M0); ebA[s1] = expf(-b1 - M1);
            decA[s0] = expf(m_state - M0); decA[s1] = expf(m_state - M1);
            wsA[s0] = expf(g0 - M_last); wsA[s1] = expf(g1 - M_last);
            if (lane == 0) scal[0] = expf(m_state - M_last);
            m_state = b_last + M_last;
        }
#pragma unroll
        for (int ps = 0; ps < 4; ++ps) {
            const int s = (tid >> 4) + 32 * ps, dc = tid & 15, pos = ML_POS(s);
            const bf16_t* kp = MK + (size_t)(seq0 + pos) * 512 + h * 128 + 8 * dc;
            const u32x4 r1 = *(const u32x4*)kp; u32x4 r0 = {0u, 0u, 0u, 0u}, r2 = {0u, 0u, 0u, 0u};
            if (pos > 0) r0 = *(const u32x4*)(kp - 512);
            if (pos < seqlen - 1) r2 = *(const u32x4*)(kp + 512);
            const LAS float* c0 = cw + 128 + 8 * dc; float u[8];
#pragma unroll
            for (int e = 0; e < 4; ++e) {
                const float a0 = bflo(r0[e]), a1 = bflo(r1[e]), a2 = bflo(r2[e]), b0 = bfhi(r0[e]), b1 = bfhi(r1[e]), b2 = bfhi(r2[e]);
                u[2 * e] = silu_f(a0 * c0[2 * e] + a1 * c0[256 + 2 * e] + a2 * c0[512 + 2 * e]);
                u[2 * e + 1] = silu_f(b0 * c0[2 * e + 1] + b1 * c0[256 + 2 * e + 1] + b2 * c0[512 + 2 * e + 1]);
            }
            u32x4 o; o.x = pkbf(u[0], u[1]); o.y = pkbf(u[2], u[3]); o.z = pkbf(u[4], u[5]); o.w = pkbf(u[6], u[7]);
            *(LAS u32x4*)(Ks + s * KS_ST + 8 * dc) = o;
        }
        u32x4 vreg[2];
#pragma unroll
        for (int ps = 0; ps < 2; ++ps) {
            const int s = (tid >> 3) + 64 * ps, vc = tid & 7, pos = ML_POS(s);
            vreg[ps] = *(const u32x4*)(MV + (size_t)(seq0 + pos) * 512 + h * 128 + vh * 64 + 8 * vc);
            *(LAS u32x4*)(Vn + s * VS_ST + 8 * vc) = vreg[ps];
        }
        bf16x8 Bq[4];
        if (!isctx) {
            const int t = 16 * w + fr, pos = ML_POS(t);
            const bf16_t* qp = MQ + (size_t)(seq0 + pos) * 512 + h * 128 + 8 * fq;
#pragma unroll
            for (int kk = 0; kk < 4; ++kk) {
                const u32x4 r1 = *(const u32x4*)(qp + 32 * kk); u32x4 r0 = {0u, 0u, 0u, 0u}, r2 = {0u, 0u, 0u, 0u};
                if (pos > 0) r0 = *(const u32x4*)(qp + 32 * kk - 512);
                if (pos < seqlen - 1) r2 = *(const u32x4*)(qp + 32 * kk + 512);
                const LAS float* c0 = cw + 32 * kk + 8 * fq; float u[8];
#pragma unroll
                for (int e = 0; e < 4; ++e) {
                    const float a0 = bflo(r0[e]), a1 = bflo(r1[e]), a2 = bflo(r2[e]), b0 = bfhi(r0[e]), b1 = bfhi(r1[e]), b2 = bfhi(r2[e]);
                    u[2 * e] = silu_f(a0 * c0[2 * e] + a1 * c0[256 + 2 * e] + a2 * c0[512 + 2 * e]) * 0.08838834764831845f;
                    u[2 * e + 1] = silu_f(b0 * c0[2 * e + 1] + b1 * c0[256 + 2 * e + 1] + b2 * c0[512 + 2 * e + 1]) * 0.08838834764831845f;
                }
                u32x4 o; o.x = pkbf(u[0], u[1]); o.y = pkbf(u[2], u[3]); o.z = pkbf(u[4], u[5]); o.w = pkbf(u[6], u[7]);
                Bq[kk] = __builtin_bit_cast(bf16x8, o);
            }
        } else {
#pragma unroll
            for (int kk = 0; kk < 4; ++kk) Bq[kk] = (bf16x8){0, 0, 0, 0, 0, 0, 0, 0};
        }
        __syncthreads();
#pragma unroll
        for (int ps = 0; ps < 2; ++ps) {
            const int s = (tid >> 3) + 64 * ps, vc = tid & 7; const float wv = wsA[s]; u32x4 o;
#pragma unroll
            for (int e = 0; e < 4; ++e) o[e] = pkbf(bflo(vreg[ps][e]) * wv, bfhi(vreg[ps][e]) * wv);
            *(LAS u32x4*)(Vw + s * VS_ST + 8 * vc) = o;
        }
        if (tid < 128) ((LAS unsigned*)(Vw + tid * VS_ST + 64))[0] = pkbf(wsA[tid], 0.f);
        __syncthreads();
        if (!isctx) {
            const int t = 16 * w + fr; const float Mt = MA_[t];
            f32x4 P[8];
#pragma unroll
            for (int i = 0; i < 8; ++i) {
                P[i] = (f32x4){0.f, 0.f, 0.f, 0.f};
                if (i <= w) {
#pragma unroll
                    for (int kk = 0; kk < 4; ++kk) { const bf16x8 Ak = *(const LAS bf16x8*)(Ks + (16 * i + fr) * KS_ST + 32 * kk + 8 * fq); P[i] = mfma16(Ak, Bq[kk], P[i]); }
                    const f32x4 gs = *(const LAS f32x4*)(gA + 16 * i + 4 * fq);
#pragma unroll
                    for (int r = 0; r < 4; ++r) { const int s = 16 * i + 4 * fq + r; const float wgt = (s <= t) ? exp2f((gs[r] - Mt) * LOG2E) : 0.f; P[i][r] *= wgt; }
                }
            }
            f32x4 num[5], itr[5];
#pragma unroll
            for (int vt = 0; vt < 5; ++vt) { num[vt] = (f32x4){0.f, 0.f, 0.f, 0.f}; itr[vt] = (f32x4){0.f, 0.f, 0.f, 0.f}; }
#pragma unroll
            for (int kk2 = 0; kk2 < 4; ++kk2) {
                if (2 * kk2 <= w) {
                    const bf16x8 Bw = pack8(P[2 * kk2], P[2 * kk2 + 1]);
#pragma unroll
                    for (int vt = 0; vt < 5; ++vt) { const LAS bf16_t* vp = Vn + (32 * kk2 + 4 * fq + q4) * VS_ST + 16 * vt + 4 * p4; num[vt] = mfma16(tr2(vp, vp + 16 * VS_ST), Bw, num[vt]); }
                }
            }
#pragma unroll
            for (int kk = 0; kk < 4; ++kk)
#pragma unroll
                for (int vt = 0; vt < 5; ++vt) { const LAS bf16_t* cp = Cn + (32 * kk + 8 * fq + q4) * VS_ST + 16 * vt + 4 * p4; itr[vt] = mfma16(tr2(cp, cp + 4 * VS_ST), Bq[kk], itr[vt]); }
            const float dect = decA[t], ebt = ebA[t];
#pragma unroll
            for (int vt = 0; vt < 5; ++vt) num[vt] = num[vt] + itr[vt] * dect;
            const float den = __shfl(num[4][0], fr);
            const float inv = 1.f / fmaxf(fabsf(den), ebt);
            bf16_t* hp = H + (size_t)(seq0 + ML_POS(t)) * 512 + h * 128 + vh * 64 + 4 * fq;
#pragma unroll
            for (int vt = 0; vt < 4; ++vt) { const f32x4 o = num[vt] * inv; u32x2 wv; wv.x = pkbf(o[0], o[1]); wv.y = pkbf(o[2], o[3]); *(u32x2*)(hp + 16 * vt) = wv; }
        }
        {
            const float av = scal[0];
#pragma unroll
            for (int vt = 0; vt < 5; ++vt) accC[vt] = accC[vt] * av;
#pragma unroll
            for (int kk2 = 0; kk2 < 4; ++kk2) {
                const LAS bf16_t* kp = Ks + (32 * kk2 + 8 * fq + q4) * KS_ST + 16 * w + 4 * p4; const bf16x8 Bk = tr2(kp, kp + 4 * KS_ST);
#pragma unroll
                for (int vt = 0; vt < 5; ++vt) { const LAS bf16_t* vp = Vw + (32 * kk2 + 8 * fq + q4) * VS_ST + 16 * vt + 4 * p4; accC[vt] = mfma16(tr2(vp, vp + 4 * VS_ST), Bk, accC[vt]); }
            }
        }
        __syncthreads();
#pragma unroll
        for (int vt = 0; vt < 5; ++vt) { u32x2 wv; wv.x = pkbf(accC[vt][0], accC[vt][1]); wv.y = pkbf(accC[vt][2], accC[vt][3]); *(LAS u32x2*)(Cn + (16 * w + fr) * VS_ST + 16 * vt + 4 * fq) = wv; }
#undef ML_POS
    }
    __syncthreads();
}

__device__ __forceinline__ void mlstm_out_rows(const Args& a, int row_lo, int nrows) {
    const int tid = threadIdx.x, lane = tid & 63, wave = tid >> 6;
    const unsigned* HF = (const unsigned*)(a.ws + WS_HF); const unsigned* HB = (const unsigned*)(a.ws + WS_HB);
    const unsigned* MO = (const unsigned*)((const bf16_t*)(a.ws + WS_M4) + (size_t)3 * MA * 512);
    unsigned* MIX = (unsigned*)(a.ws + WS_MIX); const float* nw = a.in[14];
    for (int i = wave; i < nrows * 4; i += NWAVES) {
        const int row = row_lo + (i >> 2), hh = i & 3; const size_t o = ((size_t)row * 512 + hh * 128) / 2 + lane;
        const unsigned f = HF[o], bb = HB[o], mo = MO[o];
        const float s0 = bflo(f) + bflo(bb), s1 = bfhi(f) + bfhi(bb);
        const float r = rsqrtf(wave_sum(s0 * s0 + s1 * s1) * (1.f / 128.f) + EPS);
        const float o0 = s0 * r * nw[hh * 128 + 2 * lane] / (1.f + __expf(-bflo(mo))), o1 = s1 * r * nw[hh * 128 + 2 * lane + 1] / (1.f + __expf(-bfhi(mo)));
        MIX[((size_t)row * D + 512 + hh * 128) / 2 + lane] = pkbf(o0, o1);
    }
}
__device__ __forceinline__ void post_rows(const Args& a, LAS unsigned char* lds, int row_lo, int nrows) {
    const int tid = threadIdx.x, lane = tid & 63, wave = tid >> 6;
    LAS float* W16 = (LAS float*)lds;
    fill_w16(W16, a.in[16], 16, tid);
    __syncthreads();
    const float* mod = (const float*)(a.ws + WS_MOD); const float* n2w = a.in[7];
    bf16_t* HX2 = (bf16_t*)(a.ws + WS_HX); float* AFF = (float*)(a.ws + WS_AFF);
    const int b = row_lo >> 12; const float* mr = mod + b * 6144;
    f32x4 sc[4], sh[4];
#pragma unroll
    for (int j = 0; j < 4; ++j) { const int k = 4 * lane + 256 * j; const f32x4 wv = *(const f32x4*)(n2w + k), s2 = *(const f32x4*)(mr + 4 * D + k); sc[j] = wv * (1.f + s2); sh[j] = *(const f32x4*)(mr + 3 * D + k); }
    for (int i = wave; i < nrows; i += NWAVES) {
        const int m = row_lo + i; const float* xr = a.out + (size_t)m * D;
        f32x4 v[4];
#pragma unroll
        for (int j = 0; j < 4; ++j) v[j] = *(const f32x4*)(xr + 4 * lane + 256 * j);
        float g[16];
        row_norm_dots(v, sc, sh, W16, lane, g);
        store_row_bf16(HX2 + (size_t)m * D, v, lane);
        float mx = g[0];
#pragma unroll
        for (int t = 1; t < 16; ++t) mx = fmaxf(mx, g[t]);
        float sum = 0.f, mine = 0.f;
#pragma unroll
        for (int t = 0; t < 16; ++t) { const float e = expf(g[t] - mx); sum += e; mine = (lane == t) ? e : mine; }
        if (lane < 16) AFF[((size_t)b * NE + lane) * NT + (m & (NT - 1))] = mine / sum;
    }
    __syncthreads();
}

__device__ __forceinline__ void topk_select(const Args& a, LAS unsigned char* lds, int z) {
    const int tid = threadIdx.x, lane = tid & 63, wave = tid >> 6;
    LAS unsigned* hist = (LAS unsigned*)lds; LAS unsigned* sc = hist + 256; LAS unsigned* wsum = hist + 272;
    const float* aff = (const float*)(a.ws + WS_AFF) + (size_t)z * NT;
    int* idx = (int*)(a.ws + WS_IDX) + z * CAP; float* gate = (float*)(a.ws + WS_GATE) + z * CAP; int* slot = (int*)(a.ws + WS_SLOT) + (size_t)z * NT;
    unsigned key[8];
    { const u32x4 k0 = *(const u32x4*)(aff + 8 * tid), k1 = *(const u32x4*)(aff + 8 * tid + 4); key[0] = k0.x; key[1] = k0.y; key[2] = k0.z; key[3] = k0.w; key[4] = k1.x; key[5] = k1.y; key[6] = k1.z; key[7] = k1.w; }
    unsigned prefix = 0u, need = CAP;
#pragma unroll 1
    for (int pass = 0; pass < 4; ++pass) {
        const int shift = 24 - 8 * pass;
        if (tid < 256) hist[tid] = 0u;
        __syncthreads();
#pragma unroll
        for (int i = 0; i < 8; ++i) { const bool match = (pass == 0) || ((key[i] >> (shift + 8)) == prefix); if (match) __hip_atomic_fetch_add(&hist[(key[i] >> shift) & 255u], 1u, __ATOMIC_RELAXED, __HIP_MEMORY_SCOPE_WORKGROUP); }
        __syncthreads();
        if (wave == 0) {
            unsigned c[4]; unsigned s = 0u;
#pragma unroll
            for (int j = 0; j < 4; ++j) { c[j] = hist[255 - (4 * lane + j)]; s += c[j]; }
            unsigned incl = s;
#pragma unroll
            for (int o = 1; o < 64; o <<= 1) { const unsigned y = __shfl_up(incl, o); if (lane >= o) incl += y; }
            unsigned cb = incl - s;
#pragma unroll
            for (int j = 0; j < 4; ++j) { if (cb < need && need <= cb + c[j]) { sc[0] = (prefix << 8) | (unsigned)(255 - (4 * lane + j)); sc[1] = need - cb; } cb += c[j]; }
        }
        __syncthreads();
        prefix = sc[0]; need = sc[1];
        __syncthreads();
    }
    const unsigned T = prefix;
    unsigned cg = 0u, ce = 0u;
#pragma unroll
    for (int i = 0; i < 8; ++i) { cg += key[i] > T ? 1u : 0u; ce += key[i] == T ? 1u : 0u; }
    const unsigned mine = cg | (ce << 16);
    unsigned incl = mine;
#pragma unroll
    for (int o = 1; o < 64; o <<= 1) { const unsigned y = __shfl_up(incl, o); if (lane >= o) incl += y; }
    if (lane == 63) wsum[wave] = incl;
    __syncthreads();
    unsigned base = 0u;
    for (int q = 0; q < wave; ++q) base += wsum[q];
    const unsigned excl = base + incl - mine;
    unsigned pg = excl & 0xffffu, pe = excl >> 16;
    const unsigned total_gt = CAP - need;
#pragma unroll
    for (int i = 0; i < 8; ++i) {
        const int tok = 8 * tid + i; int sl = -1;
        if (key[i] > T) { sl = (int)pg; ++pg; }
        else if (key[i] == T) { if (pe < need) sl = (int)(total_gt + pe); ++pe; }
        if (sl >= 0) { idx[sl] = tok; gate[sl] = __builtin_bit_cast(float, key[i]); }
        slot[tok] = sl;
    }
    __syncthreads();
}

__global__ void __launch_bounds__(NTHREADS, 2) mk_fwd(Args a) {
    extern __shared__ __attribute__((aligned(16))) unsigned char lds_raw[];
    LAS unsigned char* lds = (LAS unsigned char*)lds_raw;
    cg::grid_group grid = cg::this_grid();
    const int lo = a.ph_lo, hi = a.ph_hi;
    const int c = blockIdx.x, G = gridDim.x, tid = threadIdx.x, lane = tid & 63, wave = tid >> 6;
#ifndef MK_PHASE_MASK
#define MK_PHASE_MASK 0x7f
#endif
#define IN(k) ((((MK_PHASE_MASK) >> (k)) & 1) && lo <= (k) && (k) < hi)
#define SEAM(k) do { if (IN(k) && IN((k) + 1)) grid.sync(); } while (0)
    unsigned char* ws = a.ws;

    if (IN(0)) phase0(a, lds);
    SEAM(0);
    if (IN(1)) phase1(a, lds);
    SEAM(1);
    if (IN(2)) {
        Gemm g{(const bf16_t*)(ws + WS_HX), (const bf16_t*)(ws + WS_WIN), MA, NPROJ, D};
        pg8::StaticOrder S; S.init(MA, NPROJ, G, c);
        EpiProj E{(bf16_t*)(ws + WS_Q), (bf16_t*)(ws + WS_KK), (bf16_t*)(ws + WS_VV), (bf16_t*)(ws + WS_M4), a.in[11], a.in[12], (const float*)(ws + WS_ROPE), 0.125f * LOG2E};
        pg8::gemm_phase<EpiProj, pg8::StaticOrder, true, true>(lds, g, S, E);
        __syncthreads();
    }
    SEAM(2);
    if (IN(3)) {
        for (int it = c; it < 256; it += G) mlstm_item(a, lds, it);
        for (int it = c; it < 1024; it += G) attn_item(a, lds, it);
    }
    SEAM(3);
    if (IN(4)) {
        if (c < 256) { const int pm = c;
            mlstm_out_rows(a, pm * 256, 256);
            __syncthreads();
            Gemm g{(const bf16_t*)(ws + WS_MIX), (const bf16_t*)(ws + WS_WOUT), MT, D, D};
            SeqOrder S{pm, 4, 4};
            EpiOut E{a.in[0], (const float*)(ws + WS_MOD), a.out};
            pg8::gemm_phase<EpiOut, SeqOrder, true, true>(lds, g, S, E);
            __syncthreads();
            post_rows(a, lds, pm * 256, 256);
        }
    }
    SEAM(4);
    if (IN(5)) {
        if (c < 256) { const int z = c;
            const int b = z >> 4, e = z & 15;
            topk_select(a, lds, z);
            bf16_t* XG = (bf16_t*)(ws + WS_M4) + (size_t)z * CAP * D; const bf16_t* HX2 = (const bf16_t*)(ws + WS_HX); const int* idx = (const int*)(ws + WS_IDX) + z * CAP;
            for (int r = wave; r < CAP; r += NWAVES) { const u32x4* src = (const u32x4*)(HX2 + ((size_t)b * NT + idx[r]) * D); u32x4* dst = (u32x4*)(XG + (size_t)r * D);
                const u32x4 v0 = src[lane], v1 = src[lane + 64]; dst[lane] = v0; dst[lane + 64] = v1; }
            __syncthreads();
            bf16_t* ACT = (bf16_t*)(ws + WS_ACT) + (size_t)z * CAP * FF;
            { Gemm g{XG, (const bf16_t*)(ws + WS_WGU) + (size_t)e * 1024 * D, CAP, 1024, D}; SeqOrder S{0, 4, 8}; EpiAct E{ACT};
              pg8::gemm_phase<EpiAct, SeqOrder, true, true>(lds, g, S, E); }
            __syncthreads();
            { Gemm g{ACT, (const bf16_t*)(ws + WS_WD) + (size_t)e * D * FF, CAP, D, FF}; SeqOrder S{0, 4, 8}; EpiDown E{(bf16_t*)(ws + WS_MIX) + (size_t)z * CAP * D, (const float*)(ws + WS_GATE) + z * CAP};
              pg8::gemm_phase<EpiDown, SeqOrder, true, true>(lds, g, S, E); }
            __syncthreads();
        }
    }
    SEAM(5);
    if (IN(6)) {
        const int gw = c * NWAVES + wave, NGW = G * NWAVES;
        const int* SL = (const int*)(ws + WS_SLOT); const bf16_t* Y = (const bf16_t*)(ws + WS_MIX); const float* mod = (const float*)(ws + WS_MOD);
        for (int m = gw; m < MT; m += NGW) {
            const int b = m >> 12, n = m & (NT - 1);
            const int sv = lane < 16 ? SL[((size_t)b * NE + lane) * NT + n] : -1;
            if (__ballot(sv >= 0) == 0ull) continue;
            float acc[16];
#pragma unroll
            for (int i = 0; i < 16; ++i) acc[i] = 0.f;
            for (int e = 0; e < 16; ++e) { const int s = __shfl(sv, e); if (s < 0) continue;
                const bf16_t* yr = Y + ((size_t)(b * NE + e) * CAP + s) * D;
#pragma unroll
                for (int j = 0; j < 2; ++j) { const u32x4 y = *(const u32x4*)(yr + 8 * lane + 512 * j);
#pragma unroll
                    for (int q = 0; q < 4; ++q) { acc[8 * j + 2 * q] += bflo(y[q]); acc[8 * j + 2 * q + 1] += bfhi(y[q]); } } }
            const float* g2 = mod + b * 6144 + 5 * D; float* orow = a.out + (size_t)m * D;
#pragma unroll
            for (int j = 0; j < 2; ++j)
#pragma unroll
                for (int q = 0; q < 2; ++q) { const int col = 8 * lane + 512 * j + 4 * q; const f32x4 xv = *(const f32x4*)(orow + col), gv = *(const f32x4*)(g2 + col);
                    f32x4 o; o[0] = xv[0] + gv[0] * acc[8 * j + 4 * q]; o[1] = xv[1] + gv[1] * acc[8 * j + 4 * q + 1]; o[2] = xv[2] + gv[2] * acc[8 * j + 4 * q + 2]; o[3] = xv[3] + gv[3] * acc[8 * j + 4 * q + 3];
                    *(f32x4*)(orow + col) = o; }
        }
    }
#undef IN
#undef SEAM
}
}

#ifndef MK_N_LAUNCHES
#define MK_N_LAUNCHES 1
#endif
extern "C" void kernel_launch(void* const* d_in, const int* in_sizes, int n_in, void* d_out, int out_size, void* d_ws, size_t ws_size, hipStream_t stream) {
    using namespace mk;
    static int grid = 0;
    if (grid == 0) {
        if (n_in != 20 || out_size != MT * D || ws_size < WS_END) { fprintf(stderr, "kernel_launch: unexpected problem (n_in %d out %d ws %zu need %zu)\n", n_in, out_size, ws_size, (size_t)WS_END); grid = -1; return; }
        int dev = 0, cus = 0, per_cu = 0;
        hipGetDevice(&dev); hipDeviceGetAttribute(&cus, hipDeviceAttributeMultiprocessorCount, dev);
        if (hipFuncSetAttribute((const void*)mk_fwd, hipFuncAttributeMaxDynamicSharedMemorySize, LDS_BYTES) != hipSuccess) { fprintf(stderr, "kernel_launch: hipFuncSetAttribute failed\n"); grid = -1; return; }
        hipOccupancyMaxActiveBlocksPerMultiprocessor(&per_cu, (const void*)mk_fwd, NTHREADS, LDS_BYTES);
        (void)hipGetLastError();
        if (per_cu < 1) { fprintf(stderr, "kernel_launch: occupancy query says %d blocks per CU\n", per_cu); per_cu = 1; }
        grid = cus;
        if (grid > 256) grid = 256;
    }
    if (grid < 0) return;
    Args a{};
    for (int i = 0; i < 20; ++i) a.in[i] = (const float*)d_in[i];
    a.out = (float*)d_out; a.ws = (unsigned char*)d_ws;
#if MK_N_LAUNCHES == 1
    a.ph_lo = 0; a.ph_hi = 7;
    void* args[] = {&a};
    hipError_t e = hipLaunchCooperativeKernel((const void*)mk_fwd, dim3(grid), dim3(NTHREADS), args, LDS_BYTES, stream);
    if (e != hipSuccess) fprintf(stderr, "cooperative launch failed: %s (grid %d)\n", hipGetErrorString(e), grid);
#else
    for (int p = 0; p < 7; ++p) { a.ph_lo = p; a.ph_hi = p + 1; hipLaunchKernelGGL(mk_fwd, dim3(grid), dim3(NTHREADS), LDS_BYTES, stream, a); }
#endif
}
```

```cpp
#include <hip/hip_runtime.h>
#include <hip/hip_cooperative_groups.h>
#include <cstdio>
#include <cstdint>
namespace cg = cooperative_groups;
namespace pg8 {
#define PG8_LAS __attribute__((address_space(3)))
typedef unsigned short bf16_t;
typedef short bf16x8 __attribute__((ext_vector_type(8)));
typedef float f32x4 __attribute__((ext_vector_type(4)));
typedef unsigned u32x4 __attribute__((ext_vector_type(4)));
constexpr int BM = 256, BK = 64, HALF = 128, HTB = HALF * BK * 2  , STAGE_BYTES = 8 * HTB, NXCD = 8, WGM = 8;

__host__ __device__ __forceinline__ int lds_byte(int r, int c) { const int st = (r >> 4) * 2 + (c >> 5), rr = r & 15, cc = c & 31, ob = rr * 64 + cc * 2; return st * 1024 + (ob ^ (((ob >> 9) & 1) << 5)); }
__host__ __device__ __forceinline__ void stage_rc(int b, int& R, int& C) { const int st = b / 1024, sb = b % 1024, swz = sb ^ (((sb >> 9) & 1) << 5); R = (st >> 1) * 16 + swz / 64; C = (st & 1) * 32 + (swz % 64) / 2; }
__host__ __device__ __forceinline__ int perm32(int rho) { const int n = rho >> 4, i = rho & 15; return 8 * (i >> 2) + 4 * n + (i & 3); }

struct Unit { int pm, pn; };
struct Gemm { const bf16_t* A; const bf16_t* Bt; int M, N, K; const int* gidx = nullptr; };

struct StaticOrder {
    int nM, nN, nwg, G, c;
    __host__ __device__ void init(int M, int N, int G_, int c_) { nM = M / BM; nN = N / BM; nwg = nM * nN; G = G_; c = c_; }
    __host__ __device__ bool next(int i, Unit& u) const {
        const long L = (long)i * G + c; if (L >= nwg) return false;
        int wgid = (int)L; { const int q = nwg / NXCD, r = nwg % NXCD, xcd = wgid % NXCD, off = wgid / NXCD; wgid = (xcd < r ? xcd * (q + 1) : r * (q + 1) + (xcd - r) * q) + off; }
        const int nig = WGM * nN, gid = wgid / nig, fm = gid * WGM, gsz = (nM - fm) < WGM ? (nM - fm) : WGM;
        u.pm = fm + ((wgid % nig) % gsz); u.pn = (wgid % nig) / gsz; return true;
    }
    __device__ __forceinline__ void a_ready(const Unit&) const {}
    __device__ __forceinline__ void done(const Unit&) const {}
};
__device__ __forceinline__ unsigned cvt_pk_bf16(float lo, float hi) { unsigned r; asm volatile("v_cvt_pk_bf16_f32 %0, %1, %2" : "=v"(r) : "v"(lo), "v"(hi)); return r; }
typedef float f32x2 __attribute__((ext_vector_type(2)));
template <class Epi, class Sched, bool ALIGN_EPI = false, bool SP2 = false>
__device__ __forceinline__ void gemm_phase(PG8_LAS unsigned char* lds, const Gemm g, const Sched& S, const Epi& E) {
    int tid_ = threadIdx.x; asm volatile("" : "+v"(tid_));
    const int tid = tid_, wid = __builtin_amdgcn_readfirstlane(tid >> 6), lane = tid & 63, wr = wid >> 2, wc = wid & 3, fr = lane & 15, fq = lane >> 4;
    const int K = g.K, nt = K / BK;
    unsigned voffA[2], voffB[2];
#pragma unroll
    for (int i = 0; i < 2; ++i) { int R, C; stage_rc(tid * 16 + i * 8192, R, C); const int Rb = Epi::PERM ? ((R & ~31) + perm32(R & 31)) : R;
        voffA[i] = (unsigned)(R * K + C) * 2u; voffB[i] = (unsigned)(Rb * K + C) * 2u; }
    const size_t kstep = (size_t)(BK * 2);
    const size_t hstep = (size_t)HALF * K * 2;
    const size_t tstep = 2 * hstep;
    unsigned voffAh[2][2];
#pragma unroll
    for (int i = 0; i < 2; ++i) { int R, C; stage_rc(tid * 16 + i * 8192, R, C);
        if (g.gidx) { voffAh[0][i] = (unsigned)(g.gidx[R] * K + C) * 2u; voffAh[1][i] = (unsigned)(g.gidx[HALF + R] * K + C) * 2u; }
        else { voffAh[0][i] = voffA[i]; voffAh[1][i] = voffA[i] + (unsigned)hstep; } }
    const size_t atstep = g.gidx ? (size_t)0 : tstep;
    const unsigned ldsw = (unsigned)wid * 1024u;
    const int aoff = lds_byte(wr * 64 + fr, fq * 8), boff = lds_byte(wc * 32 + fr, fq * 8);
#define PG8_SA(b, h) (((b) * 2 + (h)) * HTB)
#define PG8_SB(b, h) ((4 + (b) * 2 + (h)) * HTB)
#define PG8_STAGE(bufoff, gbase, voff) do { _Pragma("unroll") for (int _i = 0; _i < 2; ++_i) \
        __builtin_amdgcn_global_load_lds((const unsigned*)((const char*)(gbase) + (voff)[_i]), (PG8_LAS unsigned*)(lds + (bufoff) + ldsw + _i * 8192), 16, 0, 0); } while (0)
#define PG8_LDA(dst, b, h) do { _Pragma("unroll") for (int m = 0; m < 4; ++m) _Pragma("unroll") for (int k = 0; k < 2; ++k) dst[m][k] = *(const PG8_LAS bf16x8*)(lds + PG8_SA(b, h) + aoff + m * 2048 + k * 1024); } while (0)
#define PG8_LDB(dst, b, h) do { _Pragma("unroll") for (int n = 0; n < 2; ++n) _Pragma("unroll") for (int k = 0; k < 2; ++k) dst[n][k] = *(const PG8_LAS bf16x8*)(lds + PG8_SB(b, h) + boff + n * 2048 + k * 1024); } while (0)
#define PG8_MMA(ai, bj, At, Bt) do { __builtin_amdgcn_s_setprio(1); _Pragma("unroll") for (int m = 0; m < 4; ++m) _Pragma("unroll") for (int n = 0; n < 2; ++n) _Pragma("unroll") for (int k = 0; k < 2; ++k) \
        acc[ai][bj][m][n] = __builtin_amdgcn_mfma_f32_16x16x32_bf16(Bt[n][k], At[m][k], acc[ai][bj][m][n], 0, 0, 0); __builtin_amdgcn_s_setprio(0); } while (0)
#define PG8_WAIT_V(n) asm volatile("s_waitcnt vmcnt(" #n ")" ::: "memory")
#define PG8_WAIT_L(n) asm volatile("s_waitcnt lgkmcnt(" #n ")" ::: "memory")
#define PG8_BAR __builtin_amdgcn_s_barrier()
#define PG8_SCHED __builtin_amdgcn_sched_barrier(0)
    Unit cur, nxt; int ui = 0;
    if (!S.next(0, cur)) return;
    f32x4 acc[2][2][4][2];
#pragma unroll
    for (int a = 0; a < 2; ++a)
#pragma unroll
        for (int b = 0; b < 2; ++b)
#pragma unroll
            for (int m = 0; m < 4; ++m)
#pragma unroll
                for (int n = 0; n < 2; ++n) acc[a][b][m][n] = (f32x4){0.f, 0.f, 0.f, 0.f};
    bf16x8 At[4][2], B0[2][2], B1[2][2];
    const char* cA = (const char*)g.A + (size_t)cur.pm * atstep; const char* cB = (const char*)g.Bt + (size_t)cur.pn * tstep;
    S.a_ready(cur);
    if constexpr (SP2) {
        PG8_STAGE(PG8_SB(0, 0), cB, voffB); PG8_STAGE(PG8_SB(0, 1), cB + hstep, voffB); PG8_STAGE(PG8_SA(0, 0), cA, voffAh[0]); PG8_STAGE(PG8_SA(0, 1), cA, voffAh[1]);
        if (wr == 1) PG8_BAR;
        PG8_WAIT_V(2); PG8_BAR;
        PG8_STAGE(PG8_SB(1, 0), cB + kstep, voffB); PG8_STAGE(PG8_SA(1, 0), cA + kstep, voffAh[0]); PG8_STAGE(PG8_SB(1, 1), cB + hstep + kstep, voffB);
        PG8_WAIT_V(6); PG8_BAR;
    } else {
        PG8_STAGE(PG8_SB(0, 0), cB, voffB); PG8_STAGE(PG8_SA(0, 0), cA, voffAh[0]); PG8_STAGE(PG8_SB(0, 1), cB + hstep, voffB); PG8_STAGE(PG8_SA(0, 1), cA, voffAh[1]);
        if (wr == 1) PG8_BAR;
        PG8_WAIT_V(4); PG8_BAR;
        PG8_STAGE(PG8_SB(1, 0), cB + kstep, voffB); PG8_STAGE(PG8_SA(1, 0), cA + kstep, voffAh[0]); PG8_STAGE(PG8_SB(1, 1), cB + hstep + kstep, voffB);
        PG8_WAIT_V(6); PG8_BAR;
    }
    for (;;) {
        const bool has_next = S.next(ui + 1, nxt);
        const char* nA = has_next ? (const char*)g.A + (size_t)nxt.pm * atstep : cA; const char* nB = has_next ? (const char*)g.Bt + (size_t)nxt.pn * tstep : cB;
        for (int t = 0; t < nt; t += 2) {
            const bool last = (t == nt - 2);
            const char* a1 = cA + (size_t)(t + 1) * kstep;
            const char* a2 = last ? nA : cA + (size_t)(t + 2) * kstep; const char* b2 = last ? nB : cB + (size_t)(t + 2) * kstep;
            const char* a3 = a2 + kstep; const char* b3 = b2 + kstep;
            if (last && has_next) S.a_ready(nxt);
            if constexpr (SP2) {
            PG8_LDB(B0, 0, 0); PG8_LDB(B1, 0, 1); PG8_SCHED; PG8_LDA(At, 0, 0); PG8_STAGE(PG8_SA(1, 1), a1, voffAh[1]);
            PG8_WAIT_V(8); PG8_WAIT_L(0); PG8_BAR; PG8_MMA(0, 0, At, B0); PG8_MMA(0, 1, At, B1); PG8_BAR; PG8_SCHED;
            PG8_LDA(At, 0, 1); PG8_STAGE(PG8_SB(0, 0), b2, voffB); PG8_STAGE(PG8_SB(0, 1), b2 + hstep, voffB); PG8_STAGE(PG8_SA(0, 0), a2, voffAh[0]);
            PG8_WAIT_V(8); PG8_WAIT_L(0); PG8_BAR; PG8_MMA(1, 0, At, B0); PG8_MMA(1, 1, At, B1); PG8_BAR; PG8_SCHED;
            PG8_LDB(B0, 1, 0); PG8_LDB(B1, 1, 1); PG8_SCHED; PG8_LDA(At, 1, 0); PG8_STAGE(PG8_SA(0, 1), a2, voffAh[1]);
            PG8_WAIT_V(8); PG8_WAIT_L(0); PG8_BAR; PG8_MMA(0, 0, At, B0); PG8_MMA(0, 1, At, B1); PG8_BAR; PG8_SCHED;
            PG8_LDA(At, 1, 1); PG8_STAGE(PG8_SB(1, 0), b3, voffB); PG8_STAGE(PG8_SB(1, 1), b3 + hstep, voffB); PG8_STAGE(PG8_SA(1, 0), a3, voffAh[0]);
            PG8_WAIT_V(8); PG8_WAIT_L(0); PG8_BAR; PG8_MMA(1, 0, At, B0); PG8_MMA(1, 1, At, B1); PG8_BAR; PG8_SCHED;
            } else {
            PG8_LDB(B0, 0, 0); PG8_SCHED; PG8_LDA(At, 0, 0); PG8_STAGE(PG8_SA(1, 1), a1, voffAh[1]);
            PG8_WAIT_L(8); PG8_BAR; PG8_WAIT_L(0); PG8_MMA(0, 0, At, B0); PG8_BAR; PG8_SCHED;
            PG8_LDB(B1, 0, 1); PG8_STAGE(PG8_SB(0, 0), b2, voffB);
            PG8_BAR; PG8_WAIT_L(0); PG8_MMA(0, 1, At, B1); PG8_BAR;
            PG8_LDA(At, 0, 1); PG8_STAGE(PG8_SA(0, 0), a2, voffAh[0]);
            PG8_BAR; PG8_WAIT_L(0); PG8_MMA(1, 0, At, B0); PG8_BAR; PG8_SCHED;
            PG8_STAGE(PG8_SB(0, 1), b2 + hstep, voffB);
            PG8_WAIT_V(6); PG8_BAR; PG8_MMA(1, 1, At, B1); PG8_BAR;
            PG8_LDB(B0, 1, 0); PG8_SCHED; PG8_LDA(At, 1, 0); PG8_STAGE(PG8_SA(0, 1), a2, voffAh[1]);
            PG8_WAIT_L(8); PG8_BAR; PG8_WAIT_L(0); PG8_MMA(0, 0, At, B0); PG8_BAR; PG8_SCHED;
            PG8_LDB(B1, 1, 1); PG8_STAGE(PG8_SB(1, 0), b3, voffB);
            PG8_BAR; PG8_WAIT_L(0); PG8_MMA(0, 1, At, B1); PG8_BAR;
            PG8_LDA(At, 1, 1); PG8_STAGE(PG8_SA(1, 0), a3, voffAh[0]);
            PG8_BAR; PG8_WAIT_L(0); PG8_MMA(1, 0, At, B0); PG8_BAR; PG8_SCHED;
            PG8_STAGE(PG8_SB(1, 1), b3 + hstep, voffB);
            PG8_WAIT_V(6); PG8_BAR; PG8_MMA(1, 1, At, B1); PG8_BAR;
            }
        }
        if constexpr (ALIGN_EPI) { if (wr == 0) PG8_BAR; }
        if constexpr (!Epi::AFTER_DRAIN) { E(acc, cur, wr, wc, fr, fq); S.done(cur); }
        if (!has_next) break;
#pragma unroll
        for (int a = 0; a < 2; ++a)
#pragma unroll
            for (int b = 0; b < 2; ++b)
#pragma unroll
                for (int m = 0; m < 4; ++m)
#pragma unroll
                    for (int n = 0; n < 2; ++n) acc[a][b][m][n] = (f32x4){0.f, 0.f, 0.f, 0.f};
        cur = nxt; cA = nA; cB = nB; ++ui;
        if constexpr (ALIGN_EPI) { if (wr == 1) PG8_BAR; }
    }
    PG8_WAIT_V(0);
    if constexpr (!ALIGN_EPI) { if (wr == 0) PG8_BAR; }
    PG8_BAR;
    if constexpr (Epi::AFTER_DRAIN) { E.fused(acc, cur, wr, wc, fr, fq, lds, wid, lane); S.done(cur); }
#undef PG8_SA
#undef PG8_SB
#undef PG8_STAGE
#undef PG8_LDA
#undef PG8_LDB
#undef PG8_MMA
#undef PG8_WAIT_V
#undef PG8_WAIT_L
#undef PG8_BAR
#undef PG8_SCHED
}
}
namespace mk {
using pg8::bf16_t; using pg8::bf16x8; using pg8::f32x4; using pg8::u32x4; using pg8::Unit; using pg8::Gemm;
#define LAS __attribute__((address_space(3)))
typedef short v4i16 __attribute__((ext_vector_type(4)));
typedef unsigned u32x2 __attribute__((ext_vector_type(2)));

constexpr int D = 1024, NB = 16, NT = 4096, NL = 256;
constexpr int MT = NB * NT, MC = NB * NL, MA = MT + MC;
constexpr int NPROJ = 2816, INC = 2832;
constexpr int NE = 16, FF = 512, CAP = 512;
constexpr float EPS = 1e-6f, LOG2E = 1.4426950408889634f;
constexpr int NWAVES = 8, NTHREADS = 512;
constexpr int LDS_BYTES = 144 * 1024;

constexpr size_t al256(size_t x) { return (x + 255) & ~(size_t)255; }
constexpr size_t WS_MOD = 0;
constexpr size_t WS_ROPE = WS_MOD + al256(17 * 6144 * 4);
constexpr size_t WS_MISC = WS_ROPE + al256(2 * 1024 * 4);
constexpr size_t WS_GATES = WS_MISC + 256;
constexpr size_t WS_AFF = WS_GATES + al256((size_t)MA * 16 * 4);
constexpr size_t WS_IDX = WS_AFF + al256((size_t)NB * NE * NT * 4);
constexpr size_t WS_GATE = WS_IDX + al256(256 * CAP * 4);
constexpr size_t WS_SLOT = WS_GATE + al256(256 * CAP * 4);
constexpr size_t WS_WIN = WS_SLOT + al256((size_t)256 * NT * 4);
constexpr size_t WS_WOUT = WS_WIN + al256((size_t)NPROJ * D * 2);
constexpr size_t WS_WGU = WS_WOUT + al256((size_t)D * D * 2);
constexpr size_t WS_WD = WS_WGU + al256((size_t)NE * 1024 * D * 2);
constexpr size_t WS_HX = WS_WD + al256((size_t)NE * D * FF * 2);
constexpr size_t WS_Q = WS_HX + al256((size_t)MA * D * 2);
constexpr size_t WS_KK = WS_Q + al256((size_t)MT * 512 * 2);
constexpr size_t WS_VV = WS_KK + al256((size_t)MA * 128 * 2);
constexpr size_t WS_M4 = WS_VV + al256((size_t)MA * 128 * 2);
constexpr size_t WS_MIX = WS_M4 + al256((size_t)4 * MA * 512 * 2);
constexpr size_t WS_HF = WS_MIX + (size_t)MT * D * 2;
constexpr size_t WS_HB = WS_HF + (size_t)MT * 512 * 2;
constexpr size_t WS_ACT = WS_HB + (size_t)MT * 512 * 2;
constexpr size_t WS_TBL = WS_ACT + al256((size_t)256 * CAP * FF * 2);
constexpr size_t WS_END = WS_TBL + al256((size_t)256 * 34 * 384 * 4);
static_assert(WS_END <= ((size_t)1 << 30), "workspace map exceeds 1 GiB");
static_assert((size_t)256 * CAP * D * 2 <= (size_t)4 * MA * 512 * 2, "XG overlay fits");

struct Args { const float* in[20]; float* out; unsigned char* ws; int ph_lo, ph_hi, sub, pad; };

__device__ __forceinline__ float wave_sum(float v) {
#pragma unroll
    for (int o = 1; o < 64; o <<= 1) v += __shfl_xor(v, o);
    return v;
}
__device__ __forceinline__ float bflo(unsigned w) { return __builtin_bit_cast(float, w << 16); }
__device__ __forceinline__ float bfhi(unsigned w) { return __builtin_bit_cast(float, w & 0xffff0000u); }
typedef float f32x2_t __attribute__((ext_vector_type(2))); typedef __bf16 bf16x2_t __attribute__((ext_vector_type(2)));
__device__ __forceinline__ unsigned pkbf(float lo, float hi) { f32x2_t v = {lo, hi}; bf16x2_t b = __builtin_convertvector(v, bf16x2_t); return __builtin_bit_cast(unsigned, b); }
__device__ __forceinline__ float silu_f(float x) { return x * __builtin_amdgcn_rcpf(1.f + __expf(-x)); }
__device__ __forceinline__ float logsig_f(float x) { return fminf(x, 0.f) - log1pf(expf(-fabsf(x))); }
__device__ __forceinline__ f32x4 mfma16(bf16x8 a, bf16x8 b, f32x4 c) { return __builtin_amdgcn_mfma_f32_16x16x32_bf16(a, b, c, 0, 0, 0); }
__device__ __forceinline__ bf16x8 tr2(const LAS bf16_t* p0, const LAS bf16_t* p1) {
    const v4i16 a = __builtin_amdgcn_ds_read_tr16_b64_v4i16((LAS v4i16*)p0), b = __builtin_amdgcn_ds_read_tr16_b64_v4i16((LAS v4i16*)p1);
    return (bf16x8){a[0], a[1], a[2], a[3], b[0], b[1], b[2], b[3]};
}
__device__ __forceinline__ bf16x8 pack8(const f32x4 a, const f32x4 b) {
    u32x4 w; w.x = pkbf(a[0], a[1]); w.y = pkbf(a[2], a[3]); w.z = pkbf(b[0], b[1]); w.w = pkbf(b[2], b[3]); return __builtin_bit_cast(bf16x8, w);
}
__host__ __device__ __forceinline__ int win_dst_row(int n) {
    if (n >= 768) return n;
    const int pn = n >> 8, r = n & 255, wc = r >> 6, bj = (r >> 5) & 1, p = r & 31;
    return 256 * pn + 128 * bj + 32 * wc + p;
}

__device__ __forceinline__ void transpose_item(const float* W, int N, int k0, int n0, bf16_t* WT, int K, int drow0, LAS float* scr, int lane) {
#pragma unroll 8
    for (int i = 0; i < 32; ++i) { const int kk = 2 * i + (lane >> 5); scr[kk * 33 + (lane & 31)] = W[(size_t)(k0 + kk) * N + n0 + (lane & 31)]; }
    asm volatile("s_waitcnt lgkmcnt(0)" ::: "memory");
    const int c = lane & 7;
#pragma unroll
    for (int j = 0; j < 4; ++j) { const int n = (lane >> 3) + 8 * j; const LAS float* s = scr + (8 * c) * 33 + n;
        u32x4 o; o.x = pkbf(s[0 * 33], s[1 * 33]); o.y = pkbf(s[2 * 33], s[3 * 33]); o.z = pkbf(s[4 * 33], s[5 * 33]); o.w = pkbf(s[6 * 33], s[7 * 33]);
        *(u32x4*)(WT + (size_t)(drow0 + n) * K + k0 + 8 * c) = o; }
    asm volatile("s_waitcnt lgkmcnt(0)" ::: "memory");
}
__device__ __forceinline__ void phase0(const Args& a, LAS unsigned char* lds) {
    const int tid = threadIdx.x, lane = tid & 63, wave = tid >> 6, wg = blockIdx.x, G = gridDim.x;
    unsigned char* ws = a.ws;
    {
        LAS float* sc = (LAS float*)lds;
        LAS float* part = sc + 17 * 1024;
        const float* c = a.in[1]; const float* cctx = a.in[3]; const float* w_mod = a.in[4]; const float* b_mod = a.in[5];
        float* mod = (float*)(ws + WS_MOD);
        for (int i = tid; i < 17 * 1024; i += NTHREADS) { const int r = i >> 10, k = i & 1023; const float v = r < 16 ? c[r * 1024 + k] : cctx[k]; sc[i] = v / (1.f + expf(-v)); }
        __syncthreads();
        for (int it = wg; it < 256; it += G) {
            const int col0 = it * 24;
            if (tid < 504) {
                const int j = tid % 24, kg = tid / 24; float acc[17];
#pragma unroll
                for (int r = 0; r < 17; ++r) acc[r] = 0.f;
                for (int k = kg; k < 1024; k += 21) { const float w = w_mod[(size_t)k * 6144 + col0 + j];
#pragma unroll
                    for (int r = 0; r < 17; ++r) acc[r] += sc[r * 1024 + k] * w; }
#pragma unroll
                for (int r = 0; r < 17; ++r) part[(kg * 17 + r) * 24 + j] = acc[r];
            }
            __syncthreads();
            if (tid < 408) { const int r = tid / 24, j = tid % 24; float s = b_mod[col0 + j]; for (int kg = 0; kg < 21; ++kg) s += part[(kg * 17 + r) * 24 + j]; mod[r * 6144 + col0 + j] = s; }
            __syncthreads();
        }
    }
    if (wg == 0) {
        float* rope = (float*)(ws + WS_ROPE);
        for (int i = tid; i < 1024; i += NTHREADS) { const int pos = i >> 4, f = i & 15; const float ang = (float)pos * powf(10000.f, -(float)f / 16.f); rope[i] = cosf(ang); rope[1024 + i] = sinf(ang); }
        if (tid == 0) { float mq = 0.f, mkk = 0.f; for (int i = 0; i < 64; ++i) { mq = fmaxf(mq, fabsf(a.in[11][i])); mkk = fmaxf(mkk, fabsf(a.in[12][i])); }
            ((float*)(ws + WS_MISC))[0] = fmaxf(0.f, 8.f * mq * mkk * LOG2E - 16.f); }
    }
    {
        LAS float* scr = (LAS float*)lds + wave * (64 * 33);
        const int gw = wg * NWAVES + wave, NGW = G * NWAVES;
        constexpr int I_IN = 16 * 88, I_OUT = 16 * 32, I_G = 16 * 16, I_D = 8 * 32;
        constexpr int NITEMS = I_IN + I_OUT + NE * (2 * I_G + I_D);
        bf16_t* WIN = (bf16_t*)(ws + WS_WIN); bf16_t* WOUT = (bf16_t*)(ws + WS_WOUT); bf16_t* WGU = (bf16_t*)(ws + WS_WGU); bf16_t* WDT = (bf16_t*)(ws + WS_WD);
        for (int it = gw; it < NITEMS; it += NGW) {
            int r = it;
            if (r < I_IN) { const int kb = r / 88, nb = r % 88; transpose_item(a.in[8], INC, 64 * kb, 32 * nb, WIN, D, win_dst_row(32 * nb), scr, lane); continue; } r -= I_IN;
            if (r < I_OUT) { const int kb = r / 32, nb = r % 32; transpose_item(a.in[15], D, 64 * kb, 32 * nb, WOUT, D, 32 * nb, scr, lane); continue; } r -= I_OUT;
            const int e = r / (2 * I_G + I_D); r -= e * (2 * I_G + I_D);
            if (r < 2 * I_G) { const int up = r / I_G, rr = r % I_G, kb = rr / 16, nb = rr % 16, n0 = 32 * nb;
                transpose_item((up ? a.in[18] : a.in[17]) + (size_t)e * D * FF, FF, 64 * kb, n0, WGU + (size_t)e * 1024 * D, D, 256 * (n0 >> 7) + (n0 & 127) + 128 * up, scr, lane); continue; }
            r -= 2 * I_G;
            { const int kb = r / 32, nb = r % 32; transpose_item(a.in[19] + (size_t)e * FF * D, D, 64 * kb, 32 * nb, WDT + (size_t)e * D * FF, FF, 32 * nb, scr, lane); }
        }
    }
}

__device__ __forceinline__ void fill_w16(LAS float* W16, const float* src, int pitch, int tid) {
    for (int idx = tid; idx < 1024 * 16; idx += NTHREADS) { const int k = idx >> 4, t = idx & 15; const int ln = (k & 255) >> 2, i = k & 3, j = k >> 8;
        W16[((j * 4 + i) * 64 + ln) * 20 + t] = src[(size_t)k * pitch + t]; }
}
__device__ __forceinline__ float reduce16(const float (&g)[16], int lane) {
    float r8[8], r4[4], r2[2];
    const bool b5 = (lane & 32) != 0, b4 = (lane & 16) != 0, b3 = (lane & 8) != 0, b2 = (lane & 4) != 0;
#pragma unroll
    for (int t = 0; t < 8; ++t) { const float keep = b5 ? g[t + 8] : g[t], send = b5 ? g[t] : g[t + 8]; r8[t] = keep + __shfl_xor(send, 32); }
#pragma unroll
    for (int t = 0; t < 4; ++t) { const float keep = b4 ? r8[t + 4] : r8[t], send = b4 ? r8[t] : r8[t + 4]; r4[t] = keep + __shfl_xor(send, 16); }
#pragma unroll
    for (int t = 0; t < 2; ++t) { const float keep = b3 ? r4[t + 2] : r4[t], send = b3 ? r4[t] : r4[t + 2]; r2[t] = keep + __shfl_xor(send, 8); }
    const float keep = b2 ? r2[1] : r2[0], send = b2 ? r2[0] : r2[1];
    float r1 = keep + __shfl_xor(send, 4);
    r1 += __shfl_xor(r1, 1); r1 += __shfl_xor(r1, 2);
    return r1;
}
__device__ __forceinline__ int reduce16_index(int lane) { return ((lane >> 5) & 1) * 8 + ((lane >> 4) & 1) * 4 + ((lane >> 3) & 1) * 2 + ((lane >> 2) & 1); }
__device__ __forceinline__ float row_norm_dots(f32x4 (&v)[4], const f32x4 (&sc)[4], const f32x4 (&sh)[4], const LAS float* W16, int lane) {
    float s = 0.f;
#pragma unroll
    for (int j = 0; j < 4; ++j) s += (v[j][0] * v[j][0] + v[j][1] * v[j][1]) + (v[j][2] * v[j][2] + v[j][3] * v[j][3]);
    const float rinv = rsqrtf(wave_sum(s) * (1.f / D) + EPS);
    float g[16];
#pragma unroll
    for (int t = 0; t < 16; ++t) g[t] = 0.f;
    int off0 = lane * 20, off1 = lane * 20;
#pragma unroll
    for (int j = 0; j < 4; ++j) {
        v[j] = v[j] * rinv * sc[j] + sh[j];
#pragma unroll
        for (int i = 0; i < 4; ++i) { const int off = (i & 1) ? off1 : off0; const LAS f32x4* wp = (const LAS f32x4*)(W16 + (j * 4 + i) * 64 * 20 + off); const float hv = v[j][i];
#pragma unroll
            for (int q = 0; q < 4; ++q) { const f32x4 w = wp[q]; g[4 * q + 0] += hv * w[0]; g[4 * q + 1] += hv * w[1]; g[4 * q + 2] += hv * w[2]; g[4 * q + 3] += hv * w[3]; }
            if (i & 1) asm volatile("" : "+v"(off1), "+v"(g[0]), "+v"(g[1]), "+v"(g[2]), "+v"(g[3]), "+v"(g[4]), "+v"(g[5]), "+v"(g[6]), "+v"(g[7]), "+v"(g[8]), "+v"(g[9]), "+v"(g[10]), "+v"(g[11]), "+v"(g[12]), "+v"(g[13]), "+v"(g[14]), "+v"(g[15])); else asm volatile("" : "+v"(off0), "+v"(g[0]), "+v"(g[1]), "+v"(g[2]), "+v"(g[3]), "+v"(g[4]), "+v"(g[5]), "+v"(g[6]), "+v"(g[7]), "+v"(g[8]), "+v"(g[9]), "+v"(g[10]), "+v"(g[11]), "+v"(g[12]), "+v"(g[13]), "+v"(g[14]), "+v"(g[15])); }
    }
    return reduce16(g, lane);
}
__device__ __forceinline__ void store_row_bf16(bf16_t* orow, const f32x4 (&v)[4], int lane) {
#pragma unroll
    for (int j = 0; j < 4; ++j) { u32x2 o; o.x = pkbf(v[j][0], v[j][1]); o.y = pkbf(v[j][2], v[j][3]); *(u32x2*)(orow + 4 * lane + 256 * j) = o; }
}
__device__ __forceinline__ void phase1(const Args& a, LAS unsigned char* lds) {
    const int tid = threadIdx.x, lane = tid & 63, wave = tid >> 6;
    LAS float* W16 = (LAS float*)lds;
    fill_w16(W16, a.in[8] + NPROJ, INC, tid);
    __syncthreads();
    const float* mod = (const float*)(a.ws + WS_MOD); const float* n1w = a.in[6]; const float* bg = a.in[9];
    bf16_t* HX = (bf16_t*)(a.ws + WS_HX); float* GATES = (float*)(a.ws + WS_GATES);
    const int gw = blockIdx.x * NWAVES + wave, NGW = gridDim.x * NWAVES;
    const int per = (MA + NGW - 1) / NGW; const int r0 = gw * per, r1 = min(MA, r0 + per);
    const int ti = reduce16_index(lane); const float bgv = bg[ti]; const bool isf = ((ti >> 2) & 1) != 0;
    int curb = -1; f32x4 sc[4], sh[4], vn[4];
    if (r0 < r1) { const float* xr = r0 < MT ? a.in[0] + (size_t)r0 * D : a.in[2] + (size_t)(r0 - MT) * D;
#pragma unroll
        for (int j = 0; j < 4; ++j) vn[j] = *(const f32x4*)(xr + 4 * lane + 256 * j); }
#pragma unroll 1
    for (int m = r0; m < r1; ++m) {
        f32x4 v[4];
#pragma unroll
        for (int j = 0; j < 4; ++j) v[j] = vn[j];
        if (m + 1 < r1) { const int mn = m + 1; const float* xr = mn < MT ? a.in[0] + (size_t)mn * D : a.in[2] + (size_t)(mn - MT) * D;
#pragma unroll
            for (int j = 0; j < 4; ++j) vn[j] = *(const f32x4*)(xr + 4 * lane + 256 * j); }
        const int b = m < MT ? m >> 12 : 16;
        if (b != curb) { curb = b; const float* mr = mod + b * 6144;
#pragma unroll
            for (int j = 0; j < 4; ++j) { const int k = 4 * lane + 256 * j; const f32x4 w = *(const f32x4*)(n1w + k), s1 = *(const f32x4*)(mr + D + k); sc[j] = w * (1.f + s1); sh[j] = *(const f32x4*)(mr + k); } }
        float gv = row_norm_dots(v, sc, sh, W16, lane) + bgv;
        store_row_bf16(HX + (size_t)m * D, v, lane);
        if (isf) gv = logsig_f(gv);
        if ((lane & 3) == 0) GATES[(size_t)m * 16 + ti] = gv;
    }
}

struct SeqOrder {
    int pm0, nN, n;
    __device__ __forceinline__ bool next(int i, Unit& u) const { if (i >= n) return false; u.pm = pm0 + i / nN; u.pn = i % nN; return true; }
    __device__ __forceinline__ void a_ready(const Unit&) const {}
    __device__ __forceinline__ void done(const Unit&) const {}
};
struct EpiProj {
    static constexpr bool PERM = true, AFTER_DRAIN = false;
    bf16_t *Q, *KK, *VV, *M4; const float *qw, *kw, *rope; float qscale;
    __device__ __forceinline__ void operator()(const f32x4 (&acc)[2][2][4][2], const Unit& u, int wr, int wc, int fr, int fq) const {
        const int pn = u.pn, row0 = u.pm * 256 + wr * 64 + fr;
        bf16_t *Q_ = Q, *KK_ = KK, *VV_ = VV, *M4_ = M4; asm volatile("" : "+s"(Q_), "+s"(KK_), "+s"(VV_), "+s"(M4_));
        if (pn >= 3) {
            bf16_t* base = M4_ + (size_t)((pn - 3) >> 1) * MA * 512 + ((pn - 3) & 1) * 256 + wc * 32 + 8 * fq;
#pragma unroll
            for (int ai = 0; ai < 2; ++ai)
#pragma unroll
                for (int m = 0; m < 4; ++m) { bf16_t* rowp = base + (size_t)(row0 + ai * 128 + m * 16) * 512;
#pragma unroll
                    for (int bj = 0; bj < 2; ++bj) { const f32x4 v0 = acc[ai][bj][m][0], v1 = acc[ai][bj][m][1]; u32x4 w; w.x = pkbf(v0[0], v0[1]); w.y = pkbf(v0[2], v0[3]); w.z = pkbf(v1[0], v1[1]); w.w = pkbf(v1[2], v1[3]);
                        *(u32x4*)(rowp + bj * 128) = w; } }
            return;
        }
        const bool latent = u.pm < 256;
        if (pn < 2 && !latent) return;
        const bool isv = (pn == 2) && (wc >= 2);
        bf16_t* dst; int ld; const float* nw; float osc = 1.f;
        if (pn < 2) { dst = Q_ + (4 * pn + wc) * 64; ld = 512; nw = qw; osc = qscale; }
        else if (!isv) { dst = KK_ + wc * 64; ld = 128; nw = kw; }
        else { dst = VV_ + (wc - 2) * 64; ld = 128; nw = kw; }
        f32x4 w4[2][2];
#pragma unroll
        for (int bj = 0; bj < 2; ++bj)
#pragma unroll
            for (int n = 0; n < 2; ++n) w4[bj][n] = *(const f32x4*)(nw + 32 * bj + 8 * fq + 4 * n);
#pragma unroll
        for (int ai = 0; ai < 2; ++ai)
#pragma unroll
            for (int m = 0; m < 4; ++m) {
                const int row = row0 + ai * 128 + m * 16;
                f32x4 y[2][2];
#pragma unroll
                for (int bj = 0; bj < 2; ++bj)
#pragma unroll
                    for (int n = 0; n < 2; ++n) y[bj][n] = acc[ai][bj][m][n];
                if (!isv) {
                    float ss = 0.f;
#pragma unroll
                    for (int bj = 0; bj < 2; ++bj)
#pragma unroll
                        for (int n = 0; n < 2; ++n) ss += (y[bj][n][0] * y[bj][n][0] + y[bj][n][1] * y[bj][n][1]) + (y[bj][n][2] * y[bj][n][2] + y[bj][n][3] * y[bj][n][3]);
                    ss += __shfl_xor(ss, 16); ss += __shfl_xor(ss, 32);
                    const float rinv = rsqrtf(ss * (1.f / 64.f) + EPS);
#pragma unroll
                    for (int bj = 0; bj < 2; ++bj)
#pragma unroll
                        for (int n = 0; n < 2; ++n) y[bj][n] = y[bj][n] * rinv * w4[bj][n];
                    if (latent) {
                        const int ntok = row & (NT - 1); const int pos = (fq < 2) ? (ntok >> 6) : (ntok & 63);
                        const float* rp = rope + pos * 16 + 8 * (fq & 1);
#pragma unroll
                        for (int n = 0; n < 2; ++n) { const f32x4 cs = *(const f32x4*)(rp + 4 * n), sn = *(const f32x4*)(rp + 1024 + 4 * n);
                            const f32x4 x1 = y[0][n], x2 = y[1][n]; y[0][n] = x1 * cs - x2 * sn; y[1][n] = x2 * cs + x1 * sn; }
                    }
                }
                bf16_t* rowp = dst + (size_t)row * ld + 8 * fq;
#pragma unroll
                for (int bj = 0; bj < 2; ++bj) { const f32x4 v0 = y[bj][0] * osc, v1 = y[bj][1] * osc; u32x4 w; w.x = pkbf(v0[0], v0[1]); w.y = pkbf(v0[2], v0[3]); w.z = pkbf(v1[0], v1[1]); w.w = pkbf(v1[2], v1[3]);
                    *(u32x4*)(rowp + 32 * bj) = w; }
            }
    }
};
struct EpiOut {
    static constexpr bool PERM = false, AFTER_DRAIN = false;
    const float* x; const float* mod; float* out;
    __device__ __forceinline__ void operator()(const f32x4 (&acc)[2][2][4][2], const Unit& u, int wr, int wc, int fr, int fq) const {
        const int row0 = u.pm * 256 + wr * 64 + fr, col0 = u.pn * 256 + wc * 32 + 4 * fq;
        const float* x_ = x; float* out_ = out; asm volatile("" : "+s"(x_), "+s"(out_));
        const float* g1 = mod + (u.pm >> 4) * 6144 + 2 * D;
        f32x4 gv[2][2];
#pragma unroll
        for (int bj = 0; bj < 2; ++bj)
#pragma unroll
            for (int n = 0; n < 2; ++n) gv[bj][n] = *(const f32x4*)(g1 + col0 + bj * 128 + n * 16);
#pragma unroll
        for (int ai = 0; ai < 2; ++ai)
#pragma unroll
            for (int m = 0; m < 4; ++m) { const size_t off = (size_t)(row0 + ai * 128 + m * 16) * D + col0;
#pragma unroll
                for (int bj = 0; bj < 2; ++bj)
#pragma unroll
                    for (int n = 0; n < 2; ++n) { const f32x4 xv = *(const f32x4*)(x_ + off + bj * 128 + n * 16); *(f32x4*)(out_ + off + bj * 128 + n * 16) = xv + gv[bj][n] * acc[ai][bj][m][n]; }
                asm volatile("" ::: "memory"); }
    }
};
struct EpiAct {
    static constexpr bool PERM = true, AFTER_DRAIN = false;
    bf16_t* ACT;
    __device__ __forceinline__ void operator()(const f32x4 (&acc)[2][2][4][2], const Unit& u, int wr, int wc, int fr, int fq) const {
        const int row0 = u.pm * 256 + wr * 64 + fr, col0 = u.pn * 128 + wc * 32 + 8 * fq;
        bf16_t* ACT_ = ACT; asm volatile("" : "+s"(ACT_));
#pragma unroll
        for (int ai = 0; ai < 2; ++ai)
#pragma unroll
            for (int m = 0; m < 4; ++m) { f32x4 o[2];
#pragma unroll
                for (int n = 0; n < 2; ++n) { const f32x4 gt = acc[ai][0][m][n], up = acc[ai][1][m][n];
#pragma unroll
                    for (int j = 0; j < 4; ++j) o[n][j] = silu_f(gt[j]) * up[j]; }
                u32x4 w; w.x = pkbf(o[0][0], o[0][1]); w.y = pkbf(o[0][2], o[0][3]); w.z = pkbf(o[1][0], o[1][1]); w.w = pkbf(o[1][2], o[1][3]);
                *(u32x4*)(ACT_ + (size_t)(row0 + ai * 128 + m * 16) * FF + col0) = w; asm volatile("" ::: "memory"); }
    }
};
struct EpiDown {
    static constexpr bool PERM = true, AFTER_DRAIN = false;
    bf16_t* Y; const float* gate;
    __device__ __forceinline__ void operator()(const f32x4 (&acc)[2][2][4][2], const Unit& u, int wr, int wc, int fr, int fq) const {
        const int row0 = u.pm * 256 + wr * 64 + fr, col0 = u.pn * 256 + wc * 32 + 8 * fq;
        bf16_t* Y_ = Y; const float* gate_ = gate; asm volatile("" : "+s"(Y_), "+s"(gate_));
#pragma unroll
        for (int ai = 0; ai < 2; ++ai)
#pragma unroll
            for (int m = 0; m < 4; ++m) { const int row = row0 + ai * 128 + m * 16; const float gt = gate_[row];
#pragma unroll
                for (int bj = 0; bj < 2; ++bj) { const f32x4 v0 = acc[ai][bj][m][0] * gt, v1 = acc[ai][bj][m][1] * gt; u32x4 w; w.x = pkbf(v0[0], v0[1]); w.y = pkbf(v0[2], v0[3]); w.z = pkbf(v1[0], v1[1]); w.w = pkbf(v1[2], v1[3]);
                    *(u32x4*)(Y_ + (size_t)row * D + col0 + bj * 128) = w; } asm volatile("" ::: "memory"); }
    }
};

constexpr int AT_STRIDE = 72;
constexpr int AT_K = 0, AT_V = 384 * AT_STRIDE * 2;
__device__ __forceinline__ void attn_tile(const LAS bf16_t* AK, const LAS bf16_t* AV, int kb, bool masked, int kpos_base  , int qpos0  ,
                                          const bf16x8 (&Qf)[4][2], f32x4 (&O)[4][4], float (&ls)[4], float cshift, int fr, int fq) {
    const int q4 = fr >> 2, p4 = fr & 3;
#pragma unroll 1
    for (int kk2 = 0; kk2 < 2; ++kk2) {
        f32x4 S[2][4];
#pragma unroll
        for (int hh = 0; hh < 2; ++hh) {
            const LAS bf16_t* kp = AK + (kb + 32 * kk2 + 16 * hh + fr) * AT_STRIDE + 8 * fq;
            const bf16x8 A0 = *(const LAS bf16x8*)kp, A1 = *(const LAS bf16x8*)(kp + 32);
#pragma unroll
            for (int qt = 0; qt < 4; ++qt) { f32x4 z = {0.f, 0.f, 0.f, 0.f}; z = mfma16(A0, Qf[qt][0], z); S[hh][qt] = mfma16(A1, Qf[qt][1], z); }
        }
        if (masked) {
#pragma unroll
            for (int hh = 0; hh < 2; ++hh)
#pragma unroll
                for (int qt = 0; qt < 4; ++qt)
#pragma unroll
                    for (int r = 0; r < 4; ++r) {
                        float p = __builtin_amdgcn_exp2f(S[hh][qt][r] - cshift);
                        const int kpos = kpos_base + kb + 32 * kk2 + 16 * hh + 4 * fq + r, qpos = qpos0 + 16 * qt + fr; const int dd = kpos - qpos;
                        if (kpos < 0 || kpos >= NT || dd > 128 || dd < -128) p = 0.f;
                        ls[qt] += p; S[hh][qt][r] = p;
                    }
        } else {
#pragma unroll
            for (int hh = 0; hh < 2; ++hh)
#pragma unroll
                for (int qt = 0; qt < 4; ++qt)
#pragma unroll
                    for (int r = 0; r < 4; ++r) { const float p = __builtin_amdgcn_exp2f(S[hh][qt][r] - cshift); ls[qt] += p; S[hh][qt][r] = p; }
        }
        bf16x8 Bp[4];
#pragma unroll
        for (int qt = 0; qt < 4; ++qt) Bp[qt] = pack8(S[0][qt], S[1][qt]);
#pragma unroll
        for (int dt = 0; dt < 4; ++dt) {
            const LAS bf16_t* vp = AV + (kb + 32 * kk2 + 4 * fq + q4) * AT_STRIDE + 16 * dt + 4 * p4;
            const bf16x8 A = tr2(vp, vp + 16 * AT_STRIDE);
#pragma unroll
            for (int qt = 0; qt < 4; ++qt) O[dt][qt] = mfma16(A, Bp[qt], O[dt][qt]);
        }
    }
}
__device__ __forceinline__ void attn_item(const Args& a, LAS unsigned char* lds, int item) {
    const int tid = threadIdx.x, lane = tid & 63, w = __builtin_amdgcn_readfirstlane(tid >> 6), fr = lane & 15, fq = lane >> 4;
    const int qblk = item & 31, kvh = (item >> 5) & 1, b = item >> 6;
    const int g = w >> 1, qh = w & 1, head = 4 * kvh + g;
    const bf16_t* Q = (const bf16_t*)(a.ws + WS_Q); const bf16_t* KK = (const bf16_t*)(a.ws + WS_KK); const bf16_t* VV = (const bf16_t*)(a.ws + WS_VV);
    bf16_t* MIX = (bf16_t*)(a.ws + WS_MIX);
    LAS bf16_t* AK = (LAS bf16_t*)(lds + AT_K); LAS bf16_t* AV = (LAS bf16_t*)(lds + AT_V);
    const float cshift = ((const float*)(a.ws + WS_MISC))[0];
    const int qpos0 = 128 * qblk + 64 * qh;
    bf16x8 Qf[4][2];
#pragma unroll
    for (int qt = 0; qt < 4; ++qt) { const bf16_t* qp = Q + (size_t)(b * NT + qpos0 + 16 * qt + fr) * 512 + head * 64 + 8 * fq; Qf[qt][0] = *(const bf16x8*)qp; Qf[qt][1] = *(const bf16x8*)(qp + 32); }
    f32x4 O[4][4]; float ls[4];
#pragma unroll
    for (int dt = 0; dt < 4; ++dt)
#pragma unroll
        for (int qt = 0; qt < 4; ++qt) O[dt][qt] = (f32x4){0.f, 0.f, 0.f, 0.f};
#pragma unroll
    for (int qt = 0; qt < 4; ++qt) ls[qt] = 0.f;
    const int kpos_base = 128 * qblk - 128;
    for (int i = tid; i < 384 * 8; i += NTHREADS) { const int r = i >> 3, c = i & 7; int kp = kpos_base + r; kp = kp < 0 ? 0 : (kp > NT - 1 ? NT - 1 : kp);
        const size_t src = (size_t)(b * NT + kp) * 128 + kvh * 64 + 8 * c;
        *(LAS u32x4*)(AK + r * AT_STRIDE + 8 * c) = *(const u32x4*)(KK + src); *(LAS u32x4*)(AV + r * AT_STRIDE + 8 * c) = *(const u32x4*)(VV + src); }
    __syncthreads();
    const bool edge = (qblk == 0) || (qblk == 31);
    for (int jt = 0; jt < 5; ++jt) { const bool msk = edge || jt == 0 || jt == 4;
        attn_tile(AK, AV, 64 * qh + 64 * jt, msk, kpos_base, qpos0, Qf, O, ls, cshift, fr, fq); }
    __syncthreads();
    for (int i = tid; i < 256 * 8; i += NTHREADS) { const int r = i >> 3, c = i & 7; const size_t src = (size_t)(MT + b * NL + r) * 128 + kvh * 64 + 8 * c;
        *(LAS u32x4*)(AK + r * AT_STRIDE + 8 * c) = *(const u32x4*)(KK + src); *(LAS u32x4*)(AV + r * AT_STRIDE + 8 * c) = *(const u32x4*)(VV + src); }
    __syncthreads();
    for (int jt = 0; jt < 4; ++jt) attn_tile(AK, AV, 64 * jt, false, 0, qpos0, Qf, O, ls, cshift, fr, fq);
    __syncthreads();
    const float psink = __builtin_amdgcn_exp2f(a.in[13][head] * LOG2E - cshift);
#pragma unroll
    for (int qt = 0; qt < 4; ++qt) {
        float l = ls[qt]; l += __shfl_xor(l, 16); l += __shfl_xor(l, 32); const float inv = 1.f / (l + psink);
        bf16_t* op = MIX + (size_t)(b * NT + qpos0 + 16 * qt + fr) * D + head * 64 + 4 * fq;
#pragma unroll
        for (int dt = 0; dt < 4; ++dt) { const f32x4 o = O[dt][qt] * inv; u32x2 wv; wv.x = pkbf(o[0], o[1]); wv.y = pkbf(o[2], o[3]); *(u32x2*)(op + 16 * dt) = wv; }
    }
}

constexpr int KS_ST = 136, VS_ST = 88;
constexpr int ML_KS = 0, ML_VN = ML_KS + 128 * KS_ST * 2, ML_VW = ML_VN + 128 * VS_ST * 2, ML_CN = ML_VW + 128 * VS_ST * 2, ML_F = ML_CN + 128 * VS_ST * 2, ML_CW = ML_F + 1024 * 4, ML_END = ML_CW + 768 * 4;
static_assert(ML_END <= LDS_BYTES, "mLSTM LDS map");
#define ML_GEOM(ci, seq0, seqlen, nbase) do { if ((ci) < 2) { seq0 = MT + b * NL; seqlen = NL; nbase = dir ? 128 * (1 - (ci)) : 128 * (ci); } \
    else { const int k_ = (ci) - 2; seq0 = b * NT; seqlen = NT; nbase = dir ? 128 * (31 - k_) : 128 * k_; } } while (0)
#define ML_POS(s) (dir ? nbase + 127 - (s) : nbase + (s))
__device__ __forceinline__ void mlstm_item(const Args& a, LAS unsigned char* lds, int item) {
    const int tid = threadIdx.x, lane = tid & 63, w = __builtin_amdgcn_readfirstlane(tid >> 6), fr = lane & 15, fq = lane >> 4, q4 = fr >> 2, p4 = fr & 3;
    const int vh = item & 1, dir = (item >> 1) & 1, h = (item >> 2) & 3, b = item >> 4;
    LAS bf16_t* Ks = (LAS bf16_t*)(lds + ML_KS); LAS bf16_t* Vn = (LAS bf16_t*)(lds + ML_VN); LAS bf16_t* Vw = (LAS bf16_t*)(lds + ML_VW); LAS bf16_t* Cn = (LAS bf16_t*)(lds + ML_CN);
    LAS float* F = (LAS float*)(lds + ML_F); LAS float* mstA = F, *aA = F + 64, *MlA = F + 128, *blA = F + 192, *plA = F + 256, *gA = F + 512; LAS float* cw = (LAS float*)(lds + ML_CW);
    const bf16_t* MQ = (const bf16_t*)(a.ws + WS_M4); const bf16_t* MK = MQ + (size_t)MA * 512; const bf16_t* MV = MK + (size_t)MA * 512;
    const float* GATES = (const float*)(a.ws + WS_GATES);
    float* TBL = (float*)(a.ws + WS_TBL) + (size_t)item * 34 * 384;
    bf16_t* H = (bf16_t*)(a.ws + (dir ? WS_HB : WS_HF));
    const float* conv = a.in[10];
    for (int i = tid; i < 768; i += NTHREADS) { const int j = i >> 8, c = i & 255; cw[i] = conv[j * 1024 + (c < 128 ? h * 128 + c : 512 + h * 128 + (c - 128))]; }
    for (int i = tid; i < 128 * VS_ST / 2; i += NTHREADS) ((LAS unsigned*)Cn)[i] = 0u;
    for (int i = tid; i < 128 * 12; i += NTHREADS) { const int s = i / 12, c = i % 12; ((LAS unsigned*)(Vn + s * VS_ST + 64))[c] = (c == 0) ? 0x00003f80u : 0u; ((LAS unsigned*)(Vw + s * VS_ST + 64))[c] = 0u; }
    for (int ci = w; ci < 34; ci += NWAVES) {
        int seq0, seqlen, nbase; ML_GEOM(ci, seq0, seqlen, nbase); (void)seqlen;
        const int s0 = 2 * lane, s1 = s0 + 1;
        const float* G0 = GATES + (size_t)(seq0 + ML_POS(s0)) * 16 + h; const float* G1 = GATES + (size_t)(seq0 + ML_POS(s1)) * 16 + h;
        const float li0 = G0[dir ? 8 : 0], lf0 = G0[dir ? 12 : 4], li1 = G1[dir ? 8 : 0], lf1 = G1[dir ? 12 : 4];
        float cs = lf0 + lf1;
#pragma unroll
        for (int o = 1; o < 64; o <<= 1) { const float y = __shfl_up(cs, o); if (lane >= o) cs += y; }
        const float b1 = cs, b0 = cs - lf1;
        const float g0 = li0 - b0, g1 = li1 - b1;
        float mx = fmaxf(g0, g1);
#pragma unroll
        for (int o = 1; o < 64; o <<= 1) { const float y = __shfl_up(mx, o); if (lane >= o) mx = fmaxf(mx, y); }
        float ex = __shfl_up(mx, 1); if (lane == 0) ex = -INFINITY;
        const float pm0 = fmaxf(ex, g0), pm1 = mx;
        float* T = TBL + ci * 384;
        typedef float f32x2t __attribute__((ext_vector_type(2)));
        *(f32x2t*)(T + s0) = (f32x2t){b0, b1}; *(f32x2t*)(T + 128 + s0) = (f32x2t){g0, g1}; *(f32x2t*)(T + 256 + s0) = (f32x2t){pm0, pm1};
        if (lane == 63) { blA[ci] = b1; plA[ci] = pm1; }
    }
    __syncthreads();
    if (w == 0) {
        float m = 0.f;
        for (int ci = 0; ci < 34; ++ci) { const float bl = blA[ci], pl = plA[ci]; const float Ml = fmaxf(m, pl); if (lane == 0) { mstA[ci] = m; aA[ci] = expf(m - Ml); MlA[ci] = Ml; } m = bl + Ml; }
    }
    f32x4 accC[5];
#pragma unroll
    for (int vt = 0; vt < 5; ++vt) accC[vt] = (f32x4){0.f, 0.f, 0.f, 0.f};
    u32x4 kr[4][3], vr[2];
#define ML_LOAD_KV(cj) do { int seq0_, seqlen_, nbase_; { const int dir_ = dir; (void)dir_; if ((cj) < 2) { seq0_ = MT + b * NL; seqlen_ = NL; nbase_ = dir ? 128 * (1 - (cj)) : 128 * (cj); } else { const int k_ = (cj) - 2; seq0_ = b * NT; seqlen_ = NT; nbase_ = dir ? 128 * (31 - k_) : 128 * k_; } } \
        _Pragma("unroll") for (int ps = 0; ps < 4; ++ps) { const int s_ = (tid >> 4) + 32 * ps, pos_ = dir ? nbase_ + 127 - s_ : nbase_ + s_; const bf16_t* kp = MK + (size_t)(seq0_ + pos_) * 512 + h * 128 + 8 * (tid & 15); \
            kr[ps][1] = *(const u32x4*)kp; kr[ps][0] = (u32x4){0u, 0u, 0u, 0u}; kr[ps][2] = (u32x4){0u, 0u, 0u, 0u}; if (pos_ > 0) kr[ps][0] = *(const u32x4*)(kp - 512); if (pos_ < seqlen_ - 1) kr[ps][2] = *(const u32x4*)(kp + 512); } \
        _Pragma("unroll") for (int ps = 0; ps < 2; ++ps) { const int s_ = (tid >> 3) + 64 * ps, pos_ = dir ? nbase_ + 127 - s_ : nbase_ + s_; vr[ps] = *(const u32x4*)(MV + (size_t)(seq0_ + pos_) * 512 + h * 128 + vh * 64 + 8 * (tid & 7)); } } while (0)
    ML_LOAD_KV(0);
    __syncthreads();
#pragma unroll 1
    for (int ci = 0; ci < 34; ++ci) {
        const bool isctx = ci < 2;
        int seq0, seqlen, nbase; ML_GEOM(ci, seq0, seqlen, nbase);
        const float mst = mstA[ci], Ml = MlA[ci], av = aA[ci];
        const float* T = TBL + ci * 384;
        const int t = 16 * w + fr, post = ML_POS(t);
        u32x4 qr[4][3]; float bt = 0.f, pmt = 0.f;
        if (!isctx) {
            const bf16_t* qp = MQ + (size_t)(seq0 + post) * 512 + h * 128 + 8 * fq;
#pragma unroll
            for (int kk = 0; kk < 4; ++kk) { qr[kk][1] = *(const u32x4*)(qp + 32 * kk); qr[kk][0] = (u32x4){0u, 0u, 0u, 0u}; qr[kk][2] = (u32x4){0u, 0u, 0u, 0u};
                if (post > 0) qr[kk][0] = *(const u32x4*)(qp + 32 * kk - 512); if (post < seqlen - 1) qr[kk][2] = *(const u32x4*)(qp + 32 * kk + 512); }
            bt = T[t]; pmt = T[256 + t];
        }
        float gv0 = T[128 + (tid >> 3)], gv1 = T[128 + (tid >> 3) + 64];
        const float gmine = tid < 128 ? T[128 + tid] : 0.f;
#pragma unroll
        for (int ps = 0; ps < 4; ++ps) {
            const int s = (tid >> 4) + 32 * ps, dc = tid & 15;
            const LAS float* c0 = cw + 128 + 8 * dc; float u[8];
#pragma unroll
            for (int e = 0; e < 4; ++e) {
                const float a0 = bflo(kr[ps][0][e]), a1 = bflo(kr[ps][1][e]), a2 = bflo(kr[ps][2][e]), b0 = bfhi(kr[ps][0][e]), b1 = bfhi(kr[ps][1][e]), b2 = bfhi(kr[ps][2][e]);
                u[2 * e] = silu_f(a0 * c0[2 * e] + a1 * c0[256 + 2 * e] + a2 * c0[512 + 2 * e]);
                u[2 * e + 1] = silu_f(b0 * c0[2 * e + 1] + b1 * c0[256 + 2 * e + 1] + b2 * c0[512 + 2 * e + 1]);
            }
            u32x4 o; o.x = pkbf(u[0], u[1]); o.y = pkbf(u[2], u[3]); o.z = pkbf(u[4], u[5]); o.w = pkbf(u[6], u[7]);
            *(LAS u32x4*)(Ks + s * KS_ST + 8 * dc) = o;
        }
#pragma unroll
        for (int ps = 0; ps < 2; ++ps) {
            const int s = (tid >> 3) + 64 * ps, vc = tid & 7; const float wv = __expf((ps ? gv1 : gv0) - Ml); u32x4 o;
            *(LAS u32x4*)(Vn + s * VS_ST + 8 * vc) = vr[ps];
#pragma unroll
            for (int e = 0; e < 4; ++e) o[e] = pkbf(bflo(vr[ps][e]) * wv, bfhi(vr[ps][e]) * wv);
            *(LAS u32x4*)(Vw + s * VS_ST + 8 * vc) = o;
        }
        if (tid < 128) { ((LAS unsigned*)(Vw + tid * VS_ST + 64))[0] = pkbf(__expf(gmine - Ml), 0.f); gA[tid] = gmine; }
        bf16x8 Bq[4];
        if (!isctx) {
#pragma unroll
            for (int kk = 0; kk < 4; ++kk) {
                const LAS float* c0 = cw + 32 * kk + 8 * fq; float u[8];
#pragma unroll
                for (int e = 0; e < 4; ++e) {
                    const float a0 = bflo(qr[kk][0][e]), a1 = bflo(qr[kk][1][e]), a2 = bflo(qr[kk][2][e]), b0 = bfhi(qr[kk][0][e]), b1 = bfhi(qr[kk][1][e]), b2 = bfhi(qr[kk][2][e]);
                    u[2 * e] = silu_f(a0 * c0[2 * e] + a1 * c0[256 + 2 * e] + a2 * c0[512 + 2 * e]) * 0.08838834764831845f;
                    u[2 * e + 1] = silu_f(b0 * c0[2 * e + 1] + b1 * c0[256 + 2 * e + 1] + b2 * c0[512 + 2 * e + 1]) * 0.08838834764831845f;
                }
                u32x4 o; o.x = pkbf(u[0], u[1]); o.y = pkbf(u[2], u[3]); o.z = pkbf(u[4], u[5]); o.w = pkbf(u[6], u[7]);
                Bq[kk] = __builtin_bit_cast(bf16x8, o);
            }
        } else {
#pragma unroll
            for (int kk = 0; kk < 4; ++kk) Bq[kk] = (bf16x8){0, 0, 0, 0, 0, 0, 0, 0};
        }
        __syncthreads();
        if (!isctx) {
            const float Mt = fmaxf(mst, pmt);
            f32x4 num[5], itr[5];
#pragma unroll
            for (int vt = 0; vt < 5; ++vt) { num[vt] = (f32x4){0.f, 0.f, 0.f, 0.f}; itr[vt] = (f32x4){0.f, 0.f, 0.f, 0.f}; }
#pragma unroll
            for (int kk2 = 0; kk2 < 4; ++kk2) {
                if (2 * kk2 <= w) {
                    f32x4 Pp[2];
#pragma unroll
                    for (int hh = 0; hh < 2; ++hh) {
                        const int i = 2 * kk2 + hh;
                        Pp[hh] = (f32x4){0.f, 0.f, 0.f, 0.f};
                        if (i <= w) {
#pragma unroll
                            for (int kk = 0; kk < 4; ++kk) { const bf16x8 Ak = *(const LAS bf16x8*)(Ks + (16 * i + fr) * KS_ST + 32 * kk + 8 * fq); Pp[hh] = mfma16(Ak, Bq[kk], Pp[hh]); }
                            const f32x4 gs = *(const LAS f32x4*)(gA + 16 * i + 4 * fq);
#pragma unroll
                            for (int r = 0; r < 4; ++r) { const int s = 16 * i + 4 * fq + r; const float wgt = (s <= t) ? __builtin_amdgcn_exp2f((gs[r] - Mt) * LOG2E) : 0.f; Pp[hh][r] *= wgt; }
                        }
                    }
                    const bf16x8 Bw = pack8(Pp[0], Pp[1]);
#pragma unroll
                    for (int vt = 0; vt < 5; ++vt) { const LAS bf16_t* vp = Vn + (32 * kk2 + 4 * fq + q4) * VS_ST + 16 * vt + 4 * p4; num[vt] = mfma16(tr2(vp, vp + 16 * VS_ST), Bw, num[vt]); }
                }
            }
            __builtin_amdgcn_sched_barrier(0);
            if (ci + 1 < 34) ML_LOAD_KV(ci + 1);
#pragma unroll
            for (int kk = 0; kk < 4; ++kk)
#pragma unroll
                for (int vt = 0; vt < 5; ++vt) { const LAS bf16_t* cp = Cn + (32 * kk + 8 * fq + q4) * VS_ST + 16 * vt + 4 * p4; itr[vt] = mfma16(tr2(cp, cp + 4 * VS_ST), Bq[kk], itr[vt]); }
            const float dect = __expf(mst - Mt), ebt = __expf(-bt - Mt);
#pragma unroll
            for (int vt = 0; vt < 5; ++vt) num[vt] = num[vt] + itr[vt] * dect;
            const float den = __shfl(num[4][0], fr);
            const float inv = 1.f / fmaxf(fabsf(den), ebt);
            bf16_t* hp = H + (size_t)(seq0 + post) * 512 + h * 128 + vh * 64 + 4 * fq;
#pragma unroll
            for (int vt = 0; vt < 4; ++vt) { const f32x4 o = num[vt] * inv; u32x2 wv; wv.x = pkbf(o[0], o[1]); wv.y = pkbf(o[2], o[3]); *(u32x2*)(hp + 16 * vt) = wv; }
        }
        if (isctx) ML_LOAD_KV(ci + 1);
        {
#pragma unroll
            for (int vt = 0; vt < 5; ++vt) accC[vt] = accC[vt] * av;
#pragma unroll
            for (int kk2 = 0; kk2 < 4; ++kk2) {
                const LAS bf16_t* kp = Ks + (32 * kk2 + 8 * fq + q4) * KS_ST + 16 * w + 4 * p4; const bf16x8 Bk = tr2(kp, kp + 4 * KS_ST);
#pragma unroll
                for (int vt = 0; vt < 5; ++vt) { const LAS bf16_t* vp = Vw + (32 * kk2 + 8 * fq + q4) * VS_ST + 16 * vt + 4 * p4; accC[vt] = mfma16(tr2(vp, vp + 4 * VS_ST), Bk, accC[vt]); }
            }
        }
        __syncthreads();
#pragma unroll
        for (int vt = 0; vt < 5; ++vt) { u32x2 wv; wv.x = pkbf(accC[vt][0], accC[vt][1]); wv.y = pkbf(accC[vt][2], accC[vt][3]); *(LAS u32x2*)(Cn + (16 * w + fr) * VS_ST + 16 * vt + 4 * fq) = wv; }
    }
    __syncthreads();
}
#undef ML_LOAD_KV
#undef ML_POS
#undef ML_GEOM

__device__ __forceinline__ void mlstm_out_rows(const Args& a, int row_lo, int nrows) {
    const int tid = threadIdx.x, lane = tid & 63, wave = tid >> 6;
    const bf16_t* HF = (const bf16_t*)(a.ws + WS_HF); const bf16_t* HB = (const bf16_t*)(a.ws + WS_HB);
    const bf16_t* MO = (const bf16_t*)(a.ws + WS_M4) + (size_t)3 * MA * 512;
    bf16_t* MIX = (bf16_t*)(a.ws + WS_MIX);
    const f32x4 nw0 = *(const f32x4*)(a.in[14] + 8 * lane), nw1 = *(const f32x4*)(a.in[14] + 8 * lane + 4);
    for (int i0 = wave; i0 < nrows; i0 += 4 * NWAVES) {
        u32x4 f[4], bb[4], mo[4];
#pragma unroll
        for (int u = 0; u < 4; ++u) { const size_t o = (size_t)(row_lo + i0 + u * NWAVES) * 512 + 8 * lane; f[u] = *(const u32x4*)(HF + o); bb[u] = *(const u32x4*)(HB + o); mo[u] = *(const u32x4*)(MO + o); }
#pragma unroll
        for (int u = 0; u < 4; ++u) {
            float sv[8]; float ss = 0.f;
#pragma unroll
            for (int e = 0; e < 4; ++e) { sv[2 * e] = bflo(f[u][e]) + bflo(bb[u][e]); sv[2 * e + 1] = bfhi(f[u][e]) + bfhi(bb[u][e]); ss += sv[2 * e] * sv[2 * e] + sv[2 * e + 1] * sv[2 * e + 1]; }
            ss += __shfl_xor(ss, 1); ss += __shfl_xor(ss, 2); ss += __shfl_xor(ss, 4); ss += __shfl_xor(ss, 8);
            const float r = rsqrtf(ss * (1.f / 128.f) + EPS);
            float ov[8];
#pragma unroll
            for (int e = 0; e < 4; ++e) {
                ov[2 * e] = sv[2 * e] * r * (e < 2 ? nw0[2 * e] : nw1[2 * e - 4]) * __builtin_amdgcn_rcpf(1.f + __expf(-bflo(mo[u][e])));
                ov[2 * e + 1] = sv[2 * e + 1] * r * (e < 2 ? nw0[2 * e + 1] : nw1[2 * e - 3]) * __builtin_amdgcn_rcpf(1.f + __expf(-bfhi(mo[u][e])));
            }
            u32x4 o; o.x = pkbf(ov[0], ov[1]); o.y = pkbf(ov[2], ov[3]); o.z = pkbf(ov[4], ov[5]); o.w = pkbf(ov[6], ov[7]);
            *(u32x4*)(MIX + (size_t)(row_lo + i0 + u * NWAVES) * D + 512 + 8 * lane) = o;
        }
    }
}
__device__ __forceinline__ void post_rows(const Args& a, LAS unsigned char* lds, int row_lo, int nrows) {
    const int tid = threadIdx.x, lane = tid & 63, wave = tid >> 6;
    LAS float* W16 = (LAS float*)lds;
    fill_w16(W16, a.in[16], 16, tid);
    __syncthreads();
    const float* mod = (const float*)(a.ws + WS_MOD); const float* n2w = a.in[7];
    bf16_t* HX2 = (bf16_t*)(a.ws + WS_HX); float* AFF = (float*)(a.ws + WS_AFF);
    const int b = row_lo >> 12; const float* mr = mod + b * 6144;
    const int ti = reduce16_index(lane);
    f32x4 sc[4], sh[4], vn[4];
#pragma unroll
    for (int j = 0; j < 4; ++j) { const int k = 4 * lane + 256 * j; const f32x4 wv = *(const f32x4*)(n2w + k), s2 = *(const f32x4*)(mr + 4 * D + k); sc[j] = wv * (1.f + s2); sh[j] = *(const f32x4*)(mr + 3 * D + k); }
    if (wave < nrows) {
#pragma unroll
        for (int j = 0; j < 4; ++j) vn[j] = *(const f32x4*)(a.out + (size_t)(row_lo + wave) * D + 4 * lane + 256 * j); }
#pragma unroll 1
    for (int i = wave; i < nrows; i += NWAVES) {
        const int m = row_lo + i;
        f32x4 v[4];
#pragma unroll
        for (int j = 0; j < 4; ++j) v[j] = vn[j];
        if (i + NWAVES < nrows) {
#pragma unroll
            for (int j = 0; j < 4; ++j) vn[j] = *(const f32x4*)(a.out + (size_t)(m + NWAVES) * D + 4 * lane + 256 * j); }
        const float g = row_norm_dots(v, sc, sh, W16, lane);
        store_row_bf16(HX2 + (size_t)m * D, v, lane);
        float mx = g;
        mx = fmaxf(mx, __shfl_xor(mx, 4)); mx = fmaxf(mx, __shfl_xor(mx, 8)); mx = fmaxf(mx, __shfl_xor(mx, 16)); mx = fmaxf(mx, __shfl_xor(mx, 32));
        const float e = expf(g - mx);
        float sum = e;
        sum += __shfl_xor(sum, 4); sum += __shfl_xor(sum, 8); sum += __shfl_xor(sum, 16); sum += __shfl_xor(sum, 32);
        if ((lane & 3) == 0) AFF[((size_t)b * NE + ti) * NT + (m & (NT - 1))] = e / sum;
    }
    __syncthreads();
}

__device__ __forceinline__ void topk_select(const Args& a, LAS unsigned char* lds, int z) {
    const int tid = threadIdx.x, lane = tid & 63, wave = tid >> 6;
    LAS unsigned* hist = (LAS unsigned*)lds; LAS unsigned* sc = hist + 256; LAS unsigned* wsum = hist + 272;
    const float* aff = (const float*)(a.ws + WS_AFF) + (size_t)z * NT;
    int* idx = (int*)(a.ws + WS_IDX) + z * CAP; float* gate = (float*)(a.ws + WS_GATE) + z * CAP; int* slot = (int*)(a.ws + WS_SLOT) + (size_t)z * NT;
    unsigned key[8];
    { const u32x4 k0 = *(const u32x4*)(aff + 8 * tid), k1 = *(const u32x4*)(aff + 8 * tid + 4); key[0] = k0.x; key[1] = k0.y; key[2] = k0.z; key[3] = k0.w; key[4] = k1.x; key[5] = k1.y; key[6] = k1.z; key[7] = k1.w; }
    unsigned prefix = 0u, need = CAP;
#pragma unroll 1
    for (int pass = 0; pass < 4; ++pass) {
        const int shift = 24 - 8 * pass;
        if (tid < 256) hist[tid] = 0u;
        __syncthreads();
#pragma unroll
        for (int i = 0; i < 8; ++i) { const bool match = (pass == 0) || ((key[i] >> (shift + 8)) == prefix); if (match) __hip_atomic_fetch_add(&hist[(key[i] >> shift) & 255u], 1u, __ATOMIC_RELAXED, __HIP_MEMORY_SCOPE_WORKGROUP); }
        __syncthreads();
        if (wave == 0) {
            unsigned c[4]; unsigned s = 0u;
#pragma unroll
            for (int j = 0; j < 4; ++j) { c[j] = hist[255 - (4 * lane + j)]; s += c[j]; }
            unsigned incl = s;
#pragma unroll
            for (int o = 1; o < 64; o <<= 1) { const unsigned y = __shfl_up(incl, o); if (lane >= o) incl += y; }
            unsigned cb = incl - s;
#pragma unroll
            for (int j = 0; j < 4; ++j) { if (cb < need && need <= cb + c[j]) { sc[0] = (prefix << 8) | (unsigned)(255 - (4 * lane + j)); sc[1] = need - cb; } cb += c[j]; }
        }
        __syncthreads();
        prefix = sc[0]; need = sc[1];
        __syncthreads();
    }
    const unsigned T = prefix;
    unsigned cg = 0u, ce = 0u;
#pragma unroll
    for (int i = 0; i < 8; ++i) { cg += key[i] > T ? 1u : 0u; ce += key[i] == T ? 1u : 0u; }
    const unsigned mine = cg | (ce << 16);
    unsigned incl = mine;
#pragma unroll
    for (int o = 1; o < 64; o <<= 1) { const unsigned y = __shfl_up(incl, o); if (lane >= o) incl += y; }
    if (lane == 63) wsum[wave] = incl;
    __syncthreads();
    unsigned base = 0u;
    for (int q = 0; q < wave; ++q) base += wsum[q];
    const unsigned excl = base + incl - mine;
    unsigned pg = excl & 0xffffu, pe = excl >> 16;
    const unsigned total_gt = CAP - need;
#pragma unroll
    for (int i = 0; i < 8; ++i) {
        const int tok = 8 * tid + i; int sl = -1;
        if (key[i] > T) { sl = (int)pg; ++pg; }
        else if (key[i] == T) { if (pe < need) sl = (int)(total_gt + pe); ++pe; }
        if (sl >= 0) { idx[sl] = tok; gate[sl] = __builtin_bit_cast(float, key[i]); }
        slot[tok] = sl;
    }
    __syncthreads();
}

template <int MASK> __global__ void __launch_bounds__(NTHREADS, 2) mk_fwd_t(Args a) {
    extern __shared__ __attribute__((aligned(16))) unsigned char lds_raw[];
    LAS unsigned char* lds = (LAS unsigned char*)lds_raw;
    __builtin_assume(__builtin_amdgcn_workitem_id_y() == 0); __builtin_assume(__builtin_amdgcn_workitem_id_z() == 0);
    cg::grid_group grid = cg::this_grid();
    const int lo = a.ph_lo, hi = a.ph_hi;
    const int c = blockIdx.x, G = gridDim.x, tid = threadIdx.x, lane = tid & 63, wave = tid >> 6;
#define IN(k) ((((MASK) >> (k)) & 1) && lo <= (k) && (k) < hi)
#define SEAM(k) do { if (IN(k) && IN((k) + 1)) grid.sync(); } while (0)
    unsigned char* ws = a.ws;

    if (IN(0)) phase0(a, lds);
    SEAM(0);
    if (IN(1)) phase1(a, lds);
    SEAM(1);
    if (IN(2)) {
        Gemm g{(const bf16_t*)(ws + WS_HX), (const bf16_t*)(ws + WS_WIN), MA, NPROJ, D};
        pg8::StaticOrder S; S.init(MA, NPROJ, G, c);
        EpiProj E{(bf16_t*)(ws + WS_Q), (bf16_t*)(ws + WS_KK), (bf16_t*)(ws + WS_VV), (bf16_t*)(ws + WS_M4), a.in[11], a.in[12], (const float*)(ws + WS_ROPE), 0.125f * LOG2E};
        pg8::gemm_phase<EpiProj, pg8::StaticOrder, true, true>(lds, g, S, E);
        __syncthreads();
    }
    SEAM(2);
    if (IN(3)) {
#ifndef MK_NO_ML
        if (a.sub & 1) for (int it = c; it < 256; it += G) mlstm_item(a, lds, it);
#endif
#ifndef MK_NO_ATTN
        if (a.sub & 2) for (int it = c; it < 1024; it += G) attn_item(a, lds, it);
#endif
    }
    SEAM(3);
    if (IN(4)) {
        if (c < 256) { const int pm = c;
            mlstm_out_rows(a, pm * 256, 256);
            __syncthreads();
            Gemm g{(const bf16_t*)(ws + WS_MIX), (const bf16_t*)(ws + WS_WOUT), MT, D, D};
            SeqOrder S{pm, 4, 4};
            EpiOut E{a.in[0], (const float*)(ws + WS_MOD), a.out};
            pg8::gemm_phase<EpiOut, SeqOrder, true, true>(lds, g, S, E);
            __syncthreads();
            post_rows(a, lds, pm * 256, 256);
        }
    }
    SEAM(4);
    if (IN(5)) {
        if (c < 256) { const int z = c;
            const int b = z >> 4, e = z & 15;
            topk_select(a, lds, z);
            const bf16_t* HX2 = (const bf16_t*)(ws + WS_HX) + (size_t)b * NT * D; const int* idx = (const int*)(ws + WS_IDX) + z * CAP;
            bf16_t* ACT = (bf16_t*)(ws + WS_ACT) + (size_t)z * CAP * FF;
            { Gemm g{HX2, (const bf16_t*)(ws + WS_WGU) + (size_t)e * 1024 * D, 256, 1024, D, idx}; SeqOrder S{0, 4, 4}; EpiAct E{ACT};
              pg8::gemm_phase<EpiAct, SeqOrder, true, true>(lds, g, S, E); __syncthreads(); }
            { Gemm g{HX2, (const bf16_t*)(ws + WS_WGU) + (size_t)e * 1024 * D, 256, 1024, D, idx + 256}; SeqOrder S{0, 4, 4}; EpiAct E{ACT + (size_t)256 * FF};
              pg8::gemm_phase<EpiAct, SeqOrder, true, true>(lds, g, S, E); __syncthreads(); }
            { Gemm g{ACT, (const bf16_t*)(ws + WS_WD) + (size_t)e * D * FF, CAP, D, FF}; SeqOrder S{0, 4, 8}; EpiDown E{(bf16_t*)(ws + WS_MIX) + (size_t)z * CAP * D, (const float*)(ws + WS_GATE) + z * CAP};
              pg8::gemm_phase<EpiDown, SeqOrder, true, true>(lds, g, S, E); }
            __syncthreads();
        }
    }
    SEAM(5);
    if (IN(6)) {
        const int gw = c * NWAVES + wave, NGW = G * NWAVES;
        const int* SL = (const int*)(ws + WS_SLOT); const bf16_t* Y = (const bf16_t*)(ws + WS_MIX); const float* mod = (const float*)(ws + WS_MOD);
        for (int grp = gw; grp < MT / 4; grp += NGW) {
            const int mbase = 4 * grp, b = mbase >> 12, n0 = mbase & (NT - 1);
            const int sv = SL[((size_t)b * NE + (lane & 15)) * NT + n0 + (lane >> 4)];
            const unsigned long long ball = __ballot(sv >= 0);
            if (ball == 0ull) continue;
            const float* g2 = mod + b * 6144 + 5 * D;
#pragma unroll 1
            for (int u = 0; u < 4; ++u) {
                unsigned mask = (unsigned)(ball >> (16 * u)) & 0xffffu;
                if (mask == 0u) continue;
                float* orow = a.out + (size_t)(mbase + u) * D;
                f32x4 xv[2][2];
#pragma unroll
                for (int j = 0; j < 2; ++j)
#pragma unroll
                    for (int q = 0; q < 2; ++q) xv[j][q] = *(const f32x4*)(orow + 8 * lane + 512 * j + 4 * q);
                float acc[16];
#pragma unroll
                for (int i = 0; i < 16; ++i) acc[i] = 0.f;
                while (mask) {
                    const int e0 = __builtin_ctz(mask); mask &= mask - 1u;
                    const bool two = mask != 0u; const int e1 = two ? __builtin_ctz(mask) : e0; if (two) mask &= mask - 1u;
                    const int s0 = __shfl(sv, 16 * u + e0), s1 = __shfl(sv, 16 * u + e1);
                    const bf16_t* y0 = Y + ((size_t)(b * NE + e0) * CAP + s0) * D + 8 * lane; const bf16_t* y1 = Y + ((size_t)(b * NE + e1) * CAP + s1) * D + 8 * lane;
                    const u32x4 a0 = *(const u32x4*)y0, a1 = *(const u32x4*)(y0 + 512), b0 = *(const u32x4*)y1, b1 = *(const u32x4*)(y1 + 512);
                    const float w1 = two ? 1.f : 0.f;
#pragma unroll
                    for (int q = 0; q < 4; ++q) { acc[2 * q] += bflo(a0[q]) + w1 * bflo(b0[q]); acc[2 * q + 1] += bfhi(a0[q]) + w1 * bfhi(b0[q]);
                        acc[8 + 2 * q] += bflo(a1[q]) + w1 * bflo(b1[q]); acc[8 + 2 * q + 1] += bfhi(a1[q]) + w1 * bfhi(b1[q]); }
                }
#pragma unroll
                for (int j = 0; j < 2; ++j)
#pragma unroll
                    for (int q = 0; q < 2; ++q) { const int col = 8 * lane + 512 * j + 4 * q; const f32x4 gv = *(const f32x4*)(g2 + col);
                        f32x4 o; o[0] = xv[j][q][0] + gv[0] * acc[8 * j + 4 * q]; o[1] = xv[j][q][1] + gv[1] * acc[8 * j + 4 * q + 1]; o[2] = xv[j][q][2] + gv[2] * acc[8 * j + 4 * q + 2]; o[3] = xv[j][q][3] + gv[3] * acc[8 * j + 4 * q + 3];
                        *(f32x4*)(orow + col) = o; }
            }
        }
    }
#undef IN
#undef SEAM
}
}

#ifndef MK_N_LAUNCHES
#define MK_N_LAUNCHES 1
#endif
extern "C" void kernel_launch(void* const* d_in, const int* in_sizes, int n_in, void* d_out, int out_size, void* d_ws, size_t ws_size, hipStream_t stream) {
    using namespace mk;
    static int grid = 0;
    if (grid == 0) {
        if (n_in != 20 || out_size != MT * D || ws_size < WS_END) { fprintf(stderr, "kernel_launch: unexpected problem (n_in %d out %d ws %zu need %zu)\n", n_in, out_size, ws_size, (size_t)WS_END); grid = -1; return; }
        int dev = 0, cus = 0, per_cu = 0;
        hipGetDevice(&dev); hipDeviceGetAttribute(&cus, hipDeviceAttributeMultiprocessorCount, dev);
#if MK_N_LAUNCHES == 1
        if (hipFuncSetAttribute((const void*)mk_fwd_t<0x7f>, hipFuncAttributeMaxDynamicSharedMemorySize, LDS_BYTES) != hipSuccess) { fprintf(stderr, "kernel_launch: hipFuncSetAttribute failed\n"); grid = -1; return; }
        hipOccupancyMaxActiveBlocksPerMultiprocessor(&per_cu, (const void*)mk_fwd_t<0x7f>, NTHREADS, LDS_BYTES);
#else
        per_cu = 1;
#endif
        (void)hipGetLastError();
        if (per_cu < 1) { fprintf(stderr, "kernel_launch: occupancy query says %d blocks per CU\n", per_cu); per_cu = 1; }
        grid = cus;
        if (grid > 256) grid = 256;
    }
    if (grid < 0) return;
    Args a{};
    for (int i = 0; i < 20; ++i) a.in[i] = (const float*)d_in[i];
    a.out = (float*)d_out; a.ws = (unsigned char*)d_ws; a.sub = 3;
#if MK_N_LAUNCHES == 1
    a.ph_lo = 0; a.ph_hi = 7;
    void* args[] = {&a};
    hipError_t e = hipLaunchCooperativeKernel((const void*)mk_fwd_t<0x7f>, dim3(grid), dim3(NTHREADS), args, LDS_BYTES, stream);
    if (e != hipSuccess) fprintf(stderr, "cooperative launch failed: %s (grid %d)\n", hipGetErrorString(e), grid);
#else
#define MK_LAUNCH_P(p) do { hipFuncSetAttribute((const void*)mk_fwd_t<(1 << (p))>, hipFuncAttributeMaxDynamicSharedMemorySize, LDS_BYTES); a.ph_lo = (p); a.ph_hi = (p) + 1; hipLaunchKernelGGL(mk_fwd_t<(1 << (p))>, dim3(grid), dim3(NTHREADS), LDS_BYTES, stream, a); } while (0)
    MK_LAUNCH_P(0); MK_LAUNCH_P(1); MK_LAUNCH_P(2); MK_LAUNCH_P(3); MK_LAUNCH_P(4); MK_LAUNCH_P(5); MK_LAUNCH_P(6);
#endif
}
```

```cpp
#include <hip/hip_runtime.h>
#include <hip/hip_cooperative_groups.h>
#include <cstdio>
#include <cstdint>
namespace cg = cooperative_groups;
namespace pg8 {
#define PG8_LAS __attribute__((address_space(3)))
typedef unsigned short bf16_t;
typedef short bf16x8 __attribute__((ext_vector_type(8)));
typedef float f32x4 __attribute__((ext_vector_type(4)));
typedef unsigned u32x4 __attribute__((ext_vector_type(4)));
constexpr int BM = 256, BK = 64, HALF = 128, HTB = HALF * BK * 2  , STAGE_BYTES = 8 * HTB, NXCD = 8, WGM = 8;

__host__ __device__ __forceinline__ int lds_byte(int r, int c) { const int st = (r >> 4) * 2 + (c >> 5), rr = r & 15, cc = c & 31, ob = rr * 64 + cc * 2; return st * 1024 + (ob ^ (((ob >> 9) & 1) << 5)); }
__host__ __device__ __forceinline__ void stage_rc(int b, int& R, int& C) { const int st = b / 1024, sb = b % 1024, swz = sb ^ (((sb >> 9) & 1) << 5); R = (st >> 1) * 16 + swz / 64; C = (st & 1) * 32 + (swz % 64) / 2; }
__host__ __device__ __forceinline__ int perm32(int rho) { const int n = rho >> 4, i = rho & 15; return 8 * (i >> 2) + 4 * n + (i & 3); }

struct Unit { int pm, pn; };
struct Gemm { const bf16_t* A; const bf16_t* Bt; int M, N, K; const int* gidx = nullptr; };

struct StaticOrder {
    int nM, nN, nwg, G, c;
    __host__ __device__ void init(int M, int N, int G_, int c_) { nM = M / BM; nN = N / BM; nwg = nM * nN; G = G_; c = c_; }
    __host__ __device__ bool next(int i, Unit& u) const {
        const long L = (long)i * G + c; if (L >= nwg) return false;
        int wgid = (int)L; { const int q = nwg / NXCD, r = nwg % NXCD, xcd = wgid % NXCD, off = wgid / NXCD; wgid = (xcd < r ? xcd * (q + 1) : r * (q + 1) + (xcd - r) * q) + off; }
        const int nig = WGM * nN, gid = wgid / nig, fm = gid * WGM, gsz = (nM - fm) < WGM ? (nM - fm) : WGM;
        u.pm = fm + ((wgid % nig) % gsz); u.pn = (wgid % nig) / gsz; return true;
    }
    __device__ __forceinline__ void a_ready(const Unit&) const {}
    __device__ __forceinline__ void done(const Unit&) const {}
};
__device__ __forceinline__ unsigned cvt_pk_bf16(float lo, float hi) { unsigned r; asm volatile("v_cvt_pk_bf16_f32 %0, %1, %2" : "=v"(r) : "v"(lo), "v"(hi)); return r; }
typedef float f32x2 __attribute__((ext_vector_type(2)));
template <class Epi, class Sched, bool ALIGN_EPI = false, bool SP2 = false>
__device__ __forceinline__ void gemm_phase(PG8_LAS unsigned char* lds, const Gemm g, const Sched& S, const Epi& E) {
    int tid_ = threadIdx.x; asm volatile("" : "+v"(tid_));
    const int tid = tid_, wid = __builtin_amdgcn_readfirstlane(tid >> 6), lane = tid & 63, wr = wid >> 2, wc = wid & 3, fr = lane & 15, fq = lane >> 4;
    const int K = g.K, nt = K / BK;
    unsigned voffA[2], voffB[2];
#pragma unroll
    for (int i = 0; i < 2; ++i) { int R, C; stage_rc(tid * 16 + i * 8192, R, C); const int Rb = Epi::PERM ? ((R & ~31) + perm32(R & 31)) : R;
        voffA[i] = (unsigned)(R * K + C) * 2u; voffB[i] = (unsigned)(Rb * K + C) * 2u; }
    const size_t kstep = (size_t)(BK * 2);
    const size_t hstep = (size_t)HALF * K * 2;
    const size_t tstep = 2 * hstep;
    unsigned voffAh[2][2];
#pragma unroll
    for (int i = 0; i < 2; ++i) { int R, C; stage_rc(tid * 16 + i * 8192, R, C);
        if (g.gidx) { voffAh[0][i] = (unsigned)(g.gidx[R] * K + C) * 2u; voffAh[1][i] = (unsigned)(g.gidx[HALF + R] * K + C) * 2u; }
        else { voffAh[0][i] = voffA[i]; voffAh[1][i] = voffA[i] + (unsigned)hstep; } }
    const size_t atstep = g.gidx ? (size_t)0 : tstep;
    const unsigned ldsw = (unsigned)wid * 1024u;
    const int aoff = lds_byte(wr * 64 + fr, fq * 8), boff = lds_byte(wc * 32 + fr, fq * 8);
#define PG8_SA(b, h) (((b) * 2 + (h)) * HTB)
#define PG8_SB(b, h) ((4 + (b) * 2 + (h)) * HTB)
#define PG8_STAGE(bufoff, gbase, voff) do { _Pragma("unroll") for (int _i = 0; _i < 2; ++_i) \
        __builtin_amdgcn_global_load_lds((const unsigned*)((const char*)(gbase) + (voff)[_i]), (PG8_LAS unsigned*)(lds + (bufoff) + ldsw + _i * 8192), 16, 0, 0); } while (0)
#define PG8_LDA(dst, b, h) do { _Pragma("unroll") for (int m = 0; m < 4; ++m) _Pragma("unroll") for (int k = 0; k < 2; ++k) dst[m][k] = *(const PG8_LAS bf16x8*)(lds + PG8_SA(b, h) + aoff + m * 2048 + k * 1024); } while (0)
#define PG8_LDB(dst, b, h) do { _Pragma("unroll") for (int n = 0; n < 2; ++n) _Pragma("unroll") for (int k = 0; k < 2; ++k) dst[n][k] = *(const PG8_LAS bf16x8*)(lds + PG8_SB(b, h) + boff + n * 2048 + k * 1024); } while (0)
#define PG8_MMA(ai, bj, At, Bt) do { __builtin_amdgcn_s_setprio(1); _Pragma("unroll") for (int m = 0; m < 4; ++m) _Pragma("unroll") for (int n = 0; n < 2; ++n) _Pragma("unroll") for (int k = 0; k < 2; ++k) \
        acc[ai][bj][m][n] = __builtin_amdgcn_mfma_f32_16x16x32_bf16(Bt[n][k], At[m][k], acc[ai][bj][m][n], 0, 0, 0); __builtin_amdgcn_s_setprio(0); } while (0)
#define PG8_WAIT_V(n) asm volatile("s_waitcnt vmcnt(" #n ")" ::: "memory")
#define PG8_WAIT_L(n) asm volatile("s_waitcnt lgkmcnt(" #n ")" ::: "memory")
#define PG8_BAR __builtin_amdgcn_s_barrier()
#define PG8_SCHED __builtin_amdgcn_sched_barrier(0)
    Unit cur, nxt; int ui = 0;
    if (!S.next(0, cur)) return;
    f32x4 acc[2][2][4][2];
#pragma unroll
    for (int a = 0; a < 2; ++a)
#pragma unroll
        for (int b = 0; b < 2; ++b)
#pragma unroll
            for (int m = 0; m < 4; ++m)
#pragma unroll
                for (int n = 0; n < 2; ++n) acc[a][b][m][n] = (f32x4){0.f, 0.f, 0.f, 0.f};
    bf16x8 At[4][2], B0[2][2], B1[2][2];
    const char* cA = (const char*)g.A + (size_t)cur.pm * atstep; const char* cB = (const char*)g.Bt + (size_t)cur.pn * tstep;
    S.a_ready(cur);
    if constexpr (SP2) {
        PG8_STAGE(PG8_SB(0, 0), cB, voffB); PG8_STAGE(PG8_SB(0, 1), cB + hstep, voffB); PG8_STAGE(PG8_SA(0, 0), cA, voffAh[0]); PG8_STAGE(PG8_SA(0, 1), cA, voffAh[1]);
        if (wr == 1) PG8_BAR;
        PG8_WAIT_V(2); PG8_BAR;
        PG8_STAGE(PG8_SB(1, 0), cB + kstep, voffB); PG8_STAGE(PG8_SA(1, 0), cA + kstep, voffAh[0]); PG8_STAGE(PG8_SB(1, 1), cB + hstep + kstep, voffB);
        PG8_WAIT_V(6); PG8_BAR;
    } else {
        PG8_STAGE(PG8_SB(0, 0), cB, voffB); PG8_STAGE(PG8_SA(0, 0), cA, voffAh[0]); PG8_STAGE(PG8_SB(0, 1), cB + hstep, voffB); PG8_STAGE(PG8_SA(0, 1), cA, voffAh[1]);
        if (wr == 1) PG8_BAR;
        PG8_WAIT_V(4); PG8_BAR;
        PG8_STAGE(PG8_SB(1, 0), cB + kstep, voffB); PG8_STAGE(PG8_SA(1, 0), cA + kstep, voffAh[0]); PG8_STAGE(PG8_SB(1, 1), cB + hstep + kstep, voffB);
        PG8_WAIT_V(6); PG8_BAR;
    }
    for (;;) {
        const bool has_next = S.next(ui + 1, nxt);
        const char* nA = has_next ? (const char*)g.A + (size_t)nxt.pm * atstep : cA; const char* nB = has_next ? (const char*)g.Bt + (size_t)nxt.pn * tstep : cB;
        for (int t = 0; t < nt; t += 2) {
            const bool last = (t == nt - 2);
            const char* a1 = cA + (size_t)(t + 1) * kstep;
            const char* a2 = last ? nA : cA + (size_t)(t + 2) * kstep; const char* b2 = last ? nB : cB + (size_t)(t + 2) * kstep;
            const char* a3 = a2 + kstep; const char* b3 = b2 + kstep;
            if (last && has_next) S.a_ready(nxt);
            if constexpr (SP2) {
            PG8_LDB(B0, 0, 0); PG8_LDB(B1, 0, 1); PG8_SCHED; PG8_LDA(At, 0, 0); PG8_STAGE(PG8_SA(1, 1), a1, voffAh[1]);
            PG8_WAIT_V(8); PG8_WAIT_L(0); PG8_BAR; PG8_MMA(0, 0, At, B0); PG8_MMA(0, 1, At, B1); PG8_BAR; PG8_SCHED;
            PG8_LDA(At, 0, 1); PG8_STAGE(PG8_SB(0, 0), b2, voffB); PG8_STAGE(PG8_SB(0, 1), b2 + hstep, voffB); PG8_STAGE(PG8_SA(0, 0), a2, voffAh[0]);
            PG8_WAIT_V(8); PG8_WAIT_L(0); PG8_BAR; PG8_MMA(1, 0, At, B0); PG8_MMA(1, 1, At, B1); PG8_BAR; PG8_SCHED;
            PG8_LDB(B0, 1, 0); PG8_LDB(B1, 1, 1); PG8_SCHED; PG8_LDA(At, 1, 0); PG8_STAGE(PG8_SA(0, 1), a2, voffAh[1]);
            PG8_WAIT_V(8); PG8_WAIT_L(0); PG8_BAR; PG8_MMA(0, 0, At, B0); PG8_MMA(0, 1, At, B1); PG8_BAR; PG8_SCHED;
            PG8_LDA(At, 1, 1); PG8_STAGE(PG8_SB(1, 0), b3, voffB); PG8_STAGE(PG8_SB(1, 1), b3 + hstep, voffB); PG8_STAGE(PG8_SA(1, 0), a3, voffAh[0]);
            PG8_WAIT_V(8); PG8_WAIT_L(0); PG8_BAR; PG8_MMA(1, 0, At, B0); PG8_MMA(1, 1, At, B1); PG8_BAR; PG8_SCHED;
            } else {
            PG8_LDB(B0, 0, 0); PG8_SCHED; PG8_LDA(At, 0, 0); PG8_STAGE(PG8_SA(1, 1), a1, voffAh[1]);
            PG8_WAIT_L(8); PG8_BAR; PG8_WAIT_L(0); PG8_MMA(0, 0, At, B0); PG8_BAR; PG8_SCHED;
            PG8_LDB(B1, 0, 1); PG8_STAGE(PG8_SB(0, 0), b2, voffB);
            PG8_BAR; PG8_WAIT_L(0); PG8_MMA(0, 1, At, B1); PG8_BAR;
            PG8_LDA(At, 0, 1); PG8_STAGE(PG8_SA(0, 0), a2, voffAh[0]);
            PG8_BAR; PG8_WAIT_L(0); PG8_MMA(1, 0, At, B0); PG8_BAR; PG8_SCHED;
            PG8_STAGE(PG8_SB(0, 1), b2 + hstep, voffB);
            PG8_WAIT_V(6); PG8_BAR; PG8_MMA(1, 1, At, B1); PG8_BAR;
            PG8_LDB(B0, 1, 0); PG8_SCHED; PG8_LDA(At, 1, 0); PG8_STAGE(PG8_SA(0, 1), a2, voffAh[1]);
            PG8_WAIT_L(8); PG8_BAR; PG8_WAIT_L(0); PG8_MMA(0, 0, At, B0); PG8_BAR; PG8_SCHED;
            PG8_LDB(B1, 1, 1); PG8_STAGE(PG8_SB(1, 0), b3, voffB);
            PG8_BAR; PG8_WAIT_L(0); PG8_MMA(0, 1, At, B1); PG8_BAR;
            PG8_LDA(At, 1, 1); PG8_STAGE(PG8_SA(1, 0), a3, voffAh[0]);
            PG8_BAR; PG8_WAIT_L(0); PG8_MMA(1, 0, At, B0); PG8_BAR; PG8_SCHED;
            PG8_STAGE(PG8_SB(1, 1), b3 + hstep, voffB);
            PG8_WAIT_V(6); PG8_BAR; PG8_MMA(1, 1, At, B1); PG8_BAR;
            }
        }
        if constexpr (ALIGN_EPI) { if (wr == 0) PG8_BAR; }
        if constexpr (!Epi::AFTER_DRAIN) { E(acc, cur, wr, wc, fr, fq); S.done(cur); }
        if (!has_next) break;
#pragma unroll
        for (int a = 0; a < 2; ++a)
#pragma unroll
            for (int b = 0; b < 2; ++b)
#pragma unroll
                for (int m = 0; m < 4; ++m)
#pragma unroll
                    for (int n = 0; n < 2; ++n) acc[a][b][m][n] = (f32x4){0.f, 0.f, 0.f, 0.f};
        cur = nxt; cA = nA; cB = nB; ++ui;
        if constexpr (ALIGN_EPI) { if (wr == 1) PG8_BAR; }
    }
    PG8_WAIT_V(0);
    if constexpr (!ALIGN_EPI) { if (wr == 0) PG8_BAR; }
    PG8_BAR;
    if constexpr (Epi::AFTER_DRAIN) { E.fused(acc, cur, wr, wc, fr, fq, lds, wid, lane); S.done(cur); }
#undef PG8_SA
#undef PG8_SB
#undef PG8_STAGE
#undef PG8_LDA
#undef PG8_LDB
#undef PG8_MMA
#undef PG8_WAIT_V
#undef PG8_WAIT_L
#undef PG8_BAR
#undef PG8_SCHED
}
}
namespace mk {
using pg8::bf16_t; using pg8::bf16x8; using pg8::f32x4; using pg8::u32x4; using pg8::Unit; using pg8::Gemm;
#define LAS __attribute__((address_space(3)))
typedef short v4i16 __attribute__((ext_vector_type(4)));
typedef unsigned u32x2 __attribute__((ext_vector_type(2)));

constexpr int D = 1024, NB = 16, NT = 4096, NL = 256;
constexpr int MT = NB * NT, MC = NB * NL, MA = MT + MC;
constexpr int NPROJ = 2816, INC = 2832;
constexpr int NE = 16, FF = 512, CAP = 512;
constexpr float EPS = 1e-6f, LOG2E = 1.4426950408889634f;
constexpr int NWAVES = 8, NTHREADS = 512;
constexpr int LDS_BYTES = 144 * 1024;

constexpr size_t al256(size_t x) { return (x + 255) & ~(size_t)255; }
constexpr size_t WS_MOD = 0;
constexpr size_t WS_ROPE = WS_MOD + al256(17 * 6144 * 4);
constexpr size_t WS_MISC = WS_ROPE + al256(2 * 1024 * 4);
constexpr size_t WS_GATES = WS_MISC + 256;
constexpr size_t WS_AFF = WS_GATES + al256((size_t)MA * 16 * 4);
constexpr size_t WS_IDX = WS_AFF + al256((size_t)NB * NE * NT * 4);
constexpr size_t WS_GATE = WS_IDX + al256(256 * CAP * 4);
constexpr size_t WS_SLOT = WS_GATE + al256(256 * CAP * 4);
constexpr size_t WS_WIN = WS_SLOT + al256((size_t)256 * NT * 4);
constexpr size_t WS_WOUT = WS_WIN + al256((size_t)NPROJ * D * 2);
constexpr size_t WS_WGU = WS_WOUT + al256((size_t)D * D * 2);
constexpr size_t WS_WD = WS_WGU + al256((size_t)NE * 1024 * D * 2);
constexpr size_t WS_HX = WS_WD + al256((size_t)NE * D * FF * 2);
constexpr size_t WS_Q = WS_HX + al256((size_t)MA * D * 2);
constexpr size_t WS_KK = WS_Q + al256((size_t)MT * 512 * 2);
constexpr size_t WS_VV = WS_KK + al256((size_t)MA * 128 * 2);
constexpr size_t WS_M4 = WS_VV + al256((size_t)MA * 128 * 2);
constexpr size_t WS_MIX = WS_M4 + al256((size_t)4 * MA * 512 * 2);
constexpr size_t WS_HF = WS_MIX + (size_t)MT * D * 2;
constexpr size_t WS_HB = WS_HF + (size_t)MT * 512 * 2;
constexpr size_t WS_ACT = WS_HB + (size_t)MT * 512 * 2;
constexpr size_t WS_TBL = WS_ACT + al256((size_t)256 * CAP * FF * 2);
constexpr size_t WS_BAR = WS_TBL + al256((size_t)256 * 34 * 384 * 4);
constexpr size_t WS_END = WS_BAR + 16384;
constexpr int LDS_BAR_OFF = 140 * 1024;
static_assert(WS_END <= ((size_t)1 << 30), "workspace map exceeds 1 GiB");
static_assert((size_t)256 * CAP * D * 2 <= (size_t)4 * MA * 512 * 2, "XG overlay fits");

struct Args { const float* in[20]; float* out; unsigned char* ws; int ph_lo, ph_hi, sub, pad; };

__device__ __forceinline__ float wave_sum(float v) {
#pragma unroll
    for (int o = 1; o < 64; o <<= 1) v += __shfl_xor(v, o);
    return v;
}
__device__ __forceinline__ float bflo(unsigned w) { return __builtin_bit_cast(float, w << 16); }
__device__ __forceinline__ float bfhi(unsigned w) { return __builtin_bit_cast(float, w & 0xffff0000u); }
typedef float f32x2_t __attribute__((ext_vector_type(2))); typedef __bf16 bf16x2_t __attribute__((ext_vector_type(2)));
__device__ __forceinline__ unsigned pkbf(float lo, float hi) { f32x2_t v = {lo, hi}; bf16x2_t b = __builtin_convertvector(v, bf16x2_t); return __builtin_bit_cast(unsigned, b); }
__device__ __forceinline__ float silu_f(float x) { return x * __builtin_amdgcn_rcpf(1.f + __expf(-x)); }
__device__ __forceinline__ float logsig_f(float x) { return fminf(x, 0.f) - log1pf(expf(-fabsf(x))); }
__device__ __forceinline__ f32x4 mfma16(bf16x8 a, bf16x8 b, f32x4 c) { return __builtin_amdgcn_mfma_f32_16x16x32_bf16(a, b, c, 0, 0, 0); }
__device__ __forceinline__ bf16x8 tr2(const LAS bf16_t* p0, const LAS bf16_t* p1) {
    const v4i16 a = __builtin_amdgcn_ds_read_tr16_b64_v4i16((LAS v4i16*)p0), b = __builtin_amdgcn_ds_read_tr16_b64_v4i16((LAS v4i16*)p1);
    return (bf16x8){a[0], a[1], a[2], a[3], b[0], b[1], b[2], b[3]};
}
__device__ __forceinline__ bf16x8 pack8(const f32x4 a, const f32x4 b) {
    u32x4 w; w.x = pkbf(a[0], a[1]); w.y = pkbf(a[2], a[3]); w.z = pkbf(b[0], b[1]); w.w = pkbf(b[2], b[3]); return __builtin_bit_cast(bf16x8, w);
}
__host__ __device__ __forceinline__ int win_dst_row(int n) {
    if (n >= 768) return n;
    const int pn = n >> 8, r = n & 255, wc = r >> 6, bj = (r >> 5) & 1, p = r & 31;
    return 256 * pn + 128 * bj + 32 * wc + p;
}

__device__ __forceinline__ void transpose_item(const float* W, int N, int k0, int n0, bf16_t* WT, int K, int drow0, LAS float* scr, int lane) {
#pragma unroll 8
    for (int i = 0; i < 32; ++i) { const int kk = 2 * i + (lane >> 5); scr[kk * 33 + (lane & 31)] = W[(size_t)(k0 + kk) * N + n0 + (lane & 31)]; }
    asm volatile("s_waitcnt lgkmcnt(0)" ::: "memory");
    const int c = lane & 7;
#pragma unroll
    for (int j = 0; j < 4; ++j) { const int n = (lane >> 3) + 8 * j; const LAS float* s = scr + (8 * c) * 33 + n;
        u32x4 o; o.x = pkbf(s[0 * 33], s[1 * 33]); o.y = pkbf(s[2 * 33], s[3 * 33]); o.z = pkbf(s[4 * 33], s[5 * 33]); o.w = pkbf(s[6 * 33], s[7 * 33]);
        *(u32x4*)(WT + (size_t)(drow0 + n) * K + k0 + 8 * c) = o; }
    asm volatile("s_waitcnt lgkmcnt(0)" ::: "memory");
}
__device__ __forceinline__ void phase0(const Args& a, LAS unsigned char* lds) {
    const int tid = threadIdx.x, lane = tid & 63, wave = tid >> 6, wg = blockIdx.x, G = gridDim.x;
    unsigned char* ws = a.ws;
    {
        LAS float* sc = (LAS float*)lds;
        LAS float* part = sc + 17 * 1024;
        const float* c = a.in[1]; const float* cctx = a.in[3]; const float* w_mod = a.in[4]; const float* b_mod = a.in[5];
        float* mod = (float*)(ws + WS_MOD);
        for (int i = tid; i < 17 * 1024; i += NTHREADS) { const int r = i >> 10, k = i & 1023; const float v = r < 16 ? c[r * 1024 + k] : cctx[k]; sc[i] = v / (1.f + expf(-v)); }
        __syncthreads();
        for (int it = wg; it < 256; it += G) {
            const int col0 = it * 24;
            if (tid < 504) {
                const int j = tid % 24, kg = tid / 24; float acc[17];
#pragma unroll
                for (int r = 0; r < 17; ++r) acc[r] = 0.f;
                for (int k = kg; k < 1024; k += 21) { const float w = w_mod[(size_t)k * 6144 + col0 + j];
#pragma unroll
                    for (int r = 0; r < 17; ++r) acc[r] += sc[r * 1024 + k] * w; }
#pragma unroll
                for (int r = 0; r < 17; ++r) part[(kg * 17 + r) * 24 + j] = acc[r];
            }
            __syncthreads();
            if (tid < 408) { const int r = tid / 24, j = tid % 24; float s = b_mod[col0 + j]; for (int kg = 0; kg < 21; ++kg) s += part[(kg * 17 + r) * 24 + j]; mod[r * 6144 + col0 + j] = s; }
            __syncthreads();
        }
    }
    if (wg == 0) {
        float* rope = (float*)(ws + WS_ROPE);
        for (int i = tid; i < 1024; i += NTHREADS) { const int pos = i >> 4, f = i & 15; const float ang = (float)pos * powf(10000.f, -(float)f / 16.f); rope[i] = cosf(ang); rope[1024 + i] = sinf(ang); }
        if (tid == 0) { float mq = 0.f, mkk = 0.f; for (int i = 0; i < 64; ++i) { mq = fmaxf(mq, fabsf(a.in[11][i])); mkk = fmaxf(mkk, fabsf(a.in[12][i])); }
            ((float*)(ws + WS_MISC))[0] = fmaxf(0.f, 8.f * mq * mkk * LOG2E - 16.f); }
    }
    {
        LAS float* scr = (LAS float*)lds + wave * (64 * 33);
        const int gw = wg * NWAVES + wave, NGW = G * NWAVES;
        constexpr int I_IN = 16 * 88, I_OUT = 16 * 32, I_G = 16 * 16, I_D = 8 * 32;
        constexpr int NITEMS = I_IN + I_OUT + NE * (2 * I_G + I_D);
        bf16_t* WIN = (bf16_t*)(ws + WS_WIN); bf16_t* WOUT = (bf16_t*)(ws + WS_WOUT); bf16_t* WGU = (bf16_t*)(ws + WS_WGU); bf16_t* WDT = (bf16_t*)(ws + WS_WD);
        for (int it = gw; it < NITEMS; it += NGW) {
            int r = it;
            if (r < I_IN) { const int kb = r / 88, nb = r % 88; transpose_item(a.in[8], INC, 64 * kb, 32 * nb, WIN, D, win_dst_row(32 * nb), scr, lane); continue; } r -= I_IN;
            if (r < I_OUT) { const int kb = r / 32, nb = r % 32; transpose_item(a.in[15], D, 64 * kb, 32 * nb, WOUT, D, 32 * nb, scr, lane); continue; } r -= I_OUT;
            const int e = r / (2 * I_G + I_D); r -= e * (2 * I_G + I_D);
            if (r < 2 * I_G) { const int up = r / I_G, rr = r % I_G, kb = rr / 16, nb = rr % 16, n0 = 32 * nb;
                transpose_item((up ? a.in[18] : a.in[17]) + (size_t)e * D * FF, FF, 64 * kb, n0, WGU + (size_t)e * 1024 * D, D, 256 * (n0 >> 7) + (n0 & 127) + 128 * up, scr, lane); continue; }
            r -= 2 * I_G;
            { const int kb = r / 32, nb = r % 32; transpose_item(a.in[19] + (size_t)e * FF * D, D, 64 * kb, 32 * nb, WDT + (size_t)e * D * FF, FF, 32 * nb, scr, lane); }
        }
    }
}

__device__ __forceinline__ void fill_w16(LAS float* W16, const float* src, int pitch, int tid) {
    for (int idx = tid; idx < 1024 * 16; idx += NTHREADS) { const int k = idx >> 4, t = idx & 15; const int ln = (k & 255) >> 2, i = k & 3, j = k >> 8;
        W16[((j * 4 + i) * 64 + ln) * 20 + t] = src[(size_t)k * pitch + t]; }
}
__device__ __forceinline__ float reduce16(const float (&g)[16], int lane) {
    float r8[8], r4[4], r2[2];
    const bool b5 = (lane & 32) != 0, b4 = (lane & 16) != 0, b3 = (lane & 8) != 0, b2 = (lane & 4) != 0;
#pragma unroll
    for (int t = 0; t < 8; ++t) { const float keep = b5 ? g[t + 8] : g[t], send = b5 ? g[t] : g[t + 8]; r8[t] = keep + __shfl_xor(send, 32); }
#pragma unroll
    for (int t = 0; t < 4; ++t) { const float keep = b4 ? r8[t + 4] : r8[t], send = b4 ? r8[t] : r8[t + 4]; r4[t] = keep + __shfl_xor(send, 16); }
#pragma unroll
    for (int t = 0; t < 2; ++t) { const float keep = b3 ? r4[t + 2] : r4[t], send = b3 ? r4[t] : r4[t + 2]; r2[t] = keep + __shfl_xor(send, 8); }
    const float keep = b2 ? r2[1] : r2[0], send = b2 ? r2[0] : r2[1];
    float r1 = keep + __shfl_xor(send, 4);
    r1 += __shfl_xor(r1, 1); r1 += __shfl_xor(r1, 2);
    return r1;
}
__device__ __forceinline__ int reduce16_index(int lane) { return ((lane >> 5) & 1) * 8 + ((lane >> 4) & 1) * 4 + ((lane >> 3) & 1) * 2 + ((lane >> 2) & 1); }
__device__ __forceinline__ float row_norm_dots(f32x4 (&v)[4], const f32x4 (&sc)[4], const f32x4 (&sh)[4], const LAS float* W16, int lane) {
    float s = 0.f;
#pragma unroll
    for (int j = 0; j < 4; ++j) s += (v[j][0] * v[j][0] + v[j][1] * v[j][1]) + (v[j][2] * v[j][2] + v[j][3] * v[j][3]);
    const float rinv = rsqrtf(wave_sum(s) * (1.f / D) + EPS);
    float g[16];
#pragma unroll
    for (int t = 0; t < 16; ++t) g[t] = 0.f;
    int off0 = lane * 20, off1 = lane * 20;
#pragma unroll
    for (int j = 0; j < 4; ++j) {
        v[j] = v[j] * rinv * sc[j] + sh[j];
#pragma unroll
        for (int i = 0; i < 4; ++i) { const int off = (i & 1) ? off1 : off0; const LAS f32x4* wp = (const LAS f32x4*)(W16 + (j * 4 + i) * 64 * 20 + off); const float hv = v[j][i];
#pragma unroll
            for (int q = 0; q < 4; ++q) { const f32x4 w = wp[q]; g[4 * q + 0] += hv * w[0]; g[4 * q + 1] += hv * w[1]; g[4 * q + 2] += hv * w[2]; g[4 * q + 3] += hv * w[3]; }
            if (i & 1) asm volatile("" : "+v"(off1), "+v"(g[0]), "+v"(g[1]), "+v"(g[2]), "+v"(g[3]), "+v"(g[4]), "+v"(g[5]), "+v"(g[6]), "+v"(g[7]), "+v"(g[8]), "+v"(g[9]), "+v"(g[10]), "+v"(g[11]), "+v"(g[12]), "+v"(g[13]), "+v"(g[14]), "+v"(g[15])); else asm volatile("" : "+v"(off0), "+v"(g[0]), "+v"(g[1]), "+v"(g[2]), "+v"(g[3]), "+v"(g[4]), "+v"(g[5]), "+v"(g[6]), "+v"(g[7]), "+v"(g[8]), "+v"(g[9]), "+v"(g[10]), "+v"(g[11]), "+v"(g[12]), "+v"(g[13]), "+v"(g[14]), "+v"(g[15])); }
    }
    return reduce16(g, lane);
}
__device__ __forceinline__ void store_row_bf16(bf16_t* orow, const f32x4 (&v)[4], int lane) {
#pragma unroll
    for (int j = 0; j < 4; ++j) { u32x2 o; o.x = pkbf(v[j][0], v[j][1]); o.y = pkbf(v[j][2], v[j][3]); *(u32x2*)(orow + 4 * lane + 256 * j) = o; }
}
__device__ __forceinline__ void phase1(const Args& a, LAS unsigned char* lds) {
    const int tid = threadIdx.x, lane = tid & 63, wave = tid >> 6;
    LAS float* W16 = (LAS float*)lds;
    fill_w16(W16, a.in[8] + NPROJ, INC, tid);
    __syncthreads();
    const float* mod = (const float*)(a.ws + WS_MOD); const float* n1w = a.in[6]; const float* bg = a.in[9];
    bf16_t* HX = (bf16_t*)(a.ws + WS_HX); float* GATES = (float*)(a.ws + WS_GATES);
    const int gw = blockIdx.x * NWAVES + wave, NGW = gridDim.x * NWAVES;
    const int per = (MA + NGW - 1) / NGW; const int r0 = gw * per, r1 = min(MA, r0 + per);
    const int ti = reduce16_index(lane); const float bgv = bg[ti]; const bool isf = ((ti >> 2) & 1) != 0;
    int curb = -1; f32x4 sc[4], sh[4], vn[4];
    if (r0 < r1) { const float* xr = r0 < MT ? a.in[0] + (size_t)r0 * D : a.in[2] + (size_t)(r0 - MT) * D;
#pragma unroll
        for (int j = 0; j < 4; ++j) vn[j] = *(const f32x4*)(xr + 4 * lane + 256 * j); }
#pragma unroll 1
    for (int m = r0; m < r1; ++m) {
        f32x4 v[4];
#pragma unroll
        for (int j = 0; j < 4; ++j) v[j] = vn[j];
        if (m + 1 < r1) { const int mn = m + 1; const float* xr = mn < MT ? a.in[0] + (size_t)mn * D : a.in[2] + (size_t)(mn - MT) * D;
#pragma unroll
            for (int j = 0; j < 4; ++j) vn[j] = *(const f32x4*)(xr + 4 * lane + 256 * j); }
        const int b = m < MT ? m >> 12 : 16;
        if (b != curb) { curb = b; const float* mr = mod + b * 6144;
#pragma unroll
            for (int j = 0; j < 4; ++j) { const int k = 4 * lane + 256 * j; const f32x4 w = *(const f32x4*)(n1w + k), s1 = *(const f32x4*)(mr + D + k); sc[j] = w * (1.f + s1); sh[j] = *(const f32x4*)(mr + k); } }
        float gv = row_norm_dots(v, sc, sh, W16, lane) + bgv;
        store_row_bf16(HX + (size_t)m * D, v, lane);
        if (isf) gv = logsig_f(gv);
        if ((lane & 3) == 0) GATES[(size_t)m * 16 + ti] = gv;
    }
}

struct SeqOrder {
    int pm0, nN, n;
    __device__ __forceinline__ bool next(int i, Unit& u) const { if (i >= n) return false; u.pm = pm0 + i / nN; u.pn = i % nN; return true; }
    __device__ __forceinline__ void a_ready(const Unit&) const {}
    __device__ __forceinline__ void done(const Unit&) const {}
};
struct EpiProj {
    static constexpr bool PERM = true, AFTER_DRAIN = false;
    bf16_t *Q, *KK, *VV, *M4; const float *qw, *kw, *rope; float qscale;
    __device__ __forceinline__ void operator()(const f32x4 (&acc)[2][2][4][2], const Unit& u, int wr, int wc, int fr, int fq) const {
        const int pn = u.pn, row0 = u.pm * 256 + wr * 64 + fr;
        bf16_t *Q_ = Q, *KK_ = KK, *VV_ = VV, *M4_ = M4; asm volatile("" : "+s"(Q_), "+s"(KK_), "+s"(VV_), "+s"(M4_));
        if (pn >= 3) {
            bf16_t* base = M4_ + (size_t)((pn - 3) >> 1) * MA * 512 + ((pn - 3) & 1) * 256 + wc * 32 + 8 * fq;
#pragma unroll
            for (int ai = 0; ai < 2; ++ai)
#pragma unroll
                for (int m = 0; m < 4; ++m) { bf16_t* rowp = base + (size_t)(row0 + ai * 128 + m * 16) * 512;
#pragma unroll
                    for (int bj = 0; bj < 2; ++bj) { const f32x4 v0 = acc[ai][bj][m][0], v1 = acc[ai][bj][m][1]; u32x4 w; w.x = pkbf(v0[0], v0[1]); w.y = pkbf(v0[2], v0[3]); w.z = pkbf(v1[0], v1[1]); w.w = pkbf(v1[2], v1[3]);
                        *(u32x4*)(rowp + bj * 128) = w; } }
            return;
        }
        const bool latent = u.pm < 256;
        if (pn < 2 && !latent) return;
        const bool isv = (pn == 2) && (wc >= 2);
        bf16_t* dst; int ld; const float* nw; float osc = 1.f;
        if (pn < 2) { dst = Q_ + (4 * pn + wc) * 64; ld = 512; nw = qw; osc = qscale; }
        else if (!isv) { dst = KK_ + wc * 64; ld = 128; nw = kw; }
        else { dst = VV_ + (wc - 2) * 64; ld = 128; nw = kw; }
        f32x4 w4[2][2];
#pragma unroll
        for (int bj = 0; bj < 2; ++bj)
#pragma unroll
            for (int n = 0; n < 2; ++n) w4[bj][n] = *(const f32x4*)(nw + 32 * bj + 8 * fq + 4 * n);
#pragma unroll
        for (int ai = 0; ai < 2; ++ai)
#pragma unroll
            for (int m = 0; m < 4; ++m) {
                const int row = row0 + ai * 128 + m * 16;
                f32x4 y[2][2];
#pragma unroll
                for (int bj = 0; bj < 2; ++bj)
#pragma unroll
                    for (int n = 0; n < 2; ++n) y[bj][n] = acc[ai][bj][m][n];
                if (!isv) {
                    float ss = 0.f;
#pragma unroll
                    for (int bj = 0; bj < 2; ++bj)
#pragma unroll
                        for (int n = 0; n < 2; ++n) ss += (y[bj][n][0] * y[bj][n][0] + y[bj][n][1] * y[bj][n][1]) + (y[bj][n][2] * y[bj][n][2] + y[bj][n][3] * y[bj][n][3]);
                    ss += __shfl_xor(ss, 16); ss += __shfl_xor(ss, 32);
                    const float rinv = rsqrtf(ss * (1.f / 64.f) + EPS);
#pragma unroll
                    for (int bj = 0; bj < 2; ++bj)
#pragma unroll
                        for (int n = 0; n < 2; ++n) y[bj][n] = y[bj][n] * rinv * w4[bj][n];
                    if (latent) {
                        const int ntok = row & (NT - 1); const int pos = (fq < 2) ? (ntok >> 6) : (ntok & 63);
                        const float* rp = rope + pos * 16 + 8 * (fq & 1);
#pragma unroll
                        for (int n = 0; n < 2; ++n) { const f32x4 cs = *(const f32x4*)(rp + 4 * n), sn = *(const f32x4*)(rp + 1024 + 4 * n);
                            const f32x4 x1 = y[0][n], x2 = y[1][n]; y[0][n] = x1 * cs - x2 * sn; y[1][n] = x2 * cs + x1 * sn; }
                    }
                }
                bf16_t* rowp = dst + (size_t)row * ld + 8 * fq;
#pragma unroll
                for (int bj = 0; bj < 2; ++bj) { const f32x4 v0 = y[bj][0] * osc, v1 = y[bj][1] * osc; u32x4 w; w.x = pkbf(v0[0], v0[1]); w.y = pkbf(v0[2], v0[3]); w.z = pkbf(v1[0], v1[1]); w.w = pkbf(v1[2], v1[3]);
                    *(u32x4*)(rowp + 32 * bj) = w; }
            }
    }
};
struct EpiOut {
    static constexpr bool PERM = false, AFTER_DRAIN = false;
    const float* x; const float* mod; float* out;
    __device__ __forceinline__ void operator()(const f32x4 (&acc)[2][2][4][2], const Unit& u, int wr, int wc, int fr, int fq) const {
        const int row0 = u.pm * 256 + wr * 64 + fr, col0 = u.pn * 256 + wc * 32 + 4 * fq;
        const float* x_ = x; float* out_ = out; asm volatile("" : "+s"(x_), "+s"(out_));
        const float* g1 = mod + (u.pm >> 4) * 6144 + 2 * D;
        f32x4 gv[2][2];
#pragma unroll
        for (int bj = 0; bj < 2; ++bj)
#pragma unroll
            for (int n = 0; n < 2; ++n) gv[bj][n] = *(const f32x4*)(g1 + col0 + bj * 128 + n * 16);
#pragma unroll
        for (int ai = 0; ai < 2; ++ai)
#pragma unroll
            for (int m = 0; m < 4; ++m) { const size_t off = (size_t)(row0 + ai * 128 + m * 16) * D + col0;
#pragma unroll
                for (int bj = 0; bj < 2; ++bj)
#pragma unroll
                    for (int n = 0; n < 2; ++n) { const f32x4 xv = *(const f32x4*)(x_ + off + bj * 128 + n * 16); *(f32x4*)(out_ + off + bj * 128 + n * 16) = xv + gv[bj][n] * acc[ai][bj][m][n]; }
                asm volatile("" ::: "memory"); }
    }
};
struct EpiAct {
    static constexpr bool PERM = true, AFTER_DRAIN = false;
    bf16_t* ACT;
    __device__ __forceinline__ void operator()(const f32x4 (&acc)[2][2][4][2], const Unit& u, int wr, int wc, int fr, int fq) const {
        const int row0 = u.pm * 256 + wr * 64 + fr, col0 = u.pn * 128 + wc * 32 + 8 * fq;
        bf16_t* ACT_ = ACT; asm volatile("" : "+s"(ACT_));
#pragma unroll
        for (int ai = 0; ai < 2; ++ai)
#pragma unroll
            for (int m = 0; m < 4; ++m) { f32x4 o[2];
#pragma unroll
                for (int n = 0; n < 2; ++n) { const f32x4 gt = acc[ai][0][m][n], up = acc[ai][1][m][n];
#pragma unroll
                    for (int j = 0; j < 4; ++j) o[n][j] = silu_f(gt[j]) * up[j]; }
                u32x4 w; w.x = pkbf(o[0][0], o[0][1]); w.y = pkbf(o[0][2], o[0][3]); w.z = pkbf(o[1][0], o[1][1]); w.w = pkbf(o[1][2], o[1][3]);
                *(u32x4*)(ACT_ + (size_t)(row0 + ai * 128 + m * 16) * FF + col0) = w; asm volatile("" ::: "memory"); }
    }
};
struct EpiDown {
    static constexpr bool PERM = true, AFTER_DRAIN = false;
    bf16_t* Y; const float* gate;
    __device__ __forceinline__ void operator()(const f32x4 (&acc)[2][2][4][2], const Unit& u, int wr, int wc, int fr, int fq) const {
        const int row0 = u.pm * 256 + wr * 64 + fr, col0 = u.pn * 256 + wc * 32 + 8 * fq;
        bf16_t* Y_ = Y; const float* gate_ = gate; asm volatile("" : "+s"(Y_), "+s"(gate_));
#pragma unroll
        for (int ai = 0; ai < 2; ++ai)
#pragma unroll
            for (int m = 0; m < 4; ++m) { const int row = row0 + ai * 128 + m * 16; const float gt = gate_[row];
#pragma unroll
                for (int bj = 0; bj < 2; ++bj) { const f32x4 v0 = acc[ai][bj][m][0] * gt, v1 = acc[ai][bj][m][1] * gt; u32x4 w; w.x = pkbf(v0[0], v0[1]); w.y = pkbf(v0[2], v0[3]); w.z = pkbf(v1[0], v1[1]); w.w = pkbf(v1[2], v1[3]);
                    *(u32x4*)(Y_ + (size_t)row * D + col0 + bj * 128) = w; } asm volatile("" ::: "memory"); }
    }
};

constexpr int AT_STRIDE = 72;
constexpr int AT_K = 0, AT_V = 384 * AT_STRIDE * 2;
__device__ __forceinline__ void attn_tile(const LAS bf16_t* AK, const LAS bf16_t* AV, int kb, bool masked, int kpos_base  , int qpos0  ,
                                          const bf16x8 (&Qf)[4][2], f32x4 (&O)[4][4], float (&ls)[4], float cshift, int fr, int fq) {
    const int q4 = fr >> 2, p4 = fr & 3;
#pragma unroll 1
    for (int kk2 = 0; kk2 < 2; ++kk2) {
        f32x4 S[2][4];
#pragma unroll
        for (int hh = 0; hh < 2; ++hh) {
            const LAS bf16_t* kp = AK + (kb + 32 * kk2 + 16 * hh + fr) * AT_STRIDE + 8 * fq;
            const bf16x8 A0 = *(const LAS bf16x8*)kp, A1 = *(const LAS bf16x8*)(kp + 32);
#pragma unroll
            for (int qt = 0; qt < 4; ++qt) { f32x4 z = {0.f, 0.f, 0.f, 0.f}; z = mfma16(A0, Qf[qt][0], z); S[hh][qt] = mfma16(A1, Qf[qt][1], z); }
        }
        if (masked) {
#pragma unroll
            for (int hh = 0; hh < 2; ++hh)
#pragma unroll
                for (int qt = 0; qt < 4; ++qt)
#pragma unroll
                    for (int r = 0; r < 4; ++r) {
                        float p = __builtin_amdgcn_exp2f(S[hh][qt][r] - cshift);
                        const int kpos = kpos_base + kb + 32 * kk2 + 16 * hh + 4 * fq + r, qpos = qpos0 + 16 * qt + fr; const int dd = kpos - qpos;
                        if (kpos < 0 || kpos >= NT || dd > 128 || dd < -128) p = 0.f;
                        ls[qt] += p; S[hh][qt][r] = p;
                    }
        } else {
#pragma unroll
            for (int hh = 0; hh < 2; ++hh)
#pragma unroll
                for (int qt = 0; qt < 4; ++qt)
#pragma unroll
                    for (int r = 0; r < 4; ++r) { const float p = __builtin_amdgcn_exp2f(S[hh][qt][r] - cshift); ls[qt] += p; S[hh][qt][r] = p; }
        }
        bf16x8 Bp[4];
#pragma unroll
        for (int qt = 0; qt < 4; ++qt) Bp[qt] = pack8(S[0][qt], S[1][qt]);
#pragma unroll
        for (int dt = 0; dt < 4; ++dt) {
            const LAS bf16_t* vp = AV + (kb + 32 * kk2 + 4 * fq + q4) * AT_STRIDE + 16 * dt + 4 * p4;
            const bf16x8 A = tr2(vp, vp + 16 * AT_STRIDE);
#pragma unroll
            for (int qt = 0; qt < 4; ++qt) O[dt][qt] = mfma16(A, Bp[qt], O[dt][qt]);
        }
    }
}
__device__ __forceinline__ void attn_item(const Args& a, LAS unsigned char* lds, int item) {
    const int tid = threadIdx.x, lane = tid & 63, w = __builtin_amdgcn_readfirstlane(tid >> 6), fr = lane & 15, fq = lane >> 4;
    const int qblk = item & 31, kvh = (item >> 5) & 1, b = item >> 6;
    const int g = w >> 1, qh = w & 1, head = 4 * kvh + g;
    const bf16_t* Q = (const bf16_t*)(a.ws + WS_Q); const bf16_t* KK = (const bf16_t*)(a.ws + WS_KK); const bf16_t* VV = (const bf16_t*)(a.ws + WS_VV);
    bf16_t* MIX = (bf16_t*)(a.ws + WS_MIX);
    LAS bf16_t* AK = (LAS bf16_t*)(lds + AT_K); LAS bf16_t* AV = (LAS bf16_t*)(lds + AT_V);
    const float cshift = ((const float*)(a.ws + WS_MISC))[0];
    const int qpos0 = 128 * qblk + 64 * qh;
    bf16x8 Qf[4][2];
#pragma unroll
    for (int qt = 0; qt < 4; ++qt) { const bf16_t* qp = Q + (size_t)(b * NT + qpos0 + 16 * qt + fr) * 512 + head * 64 + 8 * fq; Qf[qt][0] = *(const bf16x8*)qp; Qf[qt][1] = *(const bf16x8*)(qp + 32); }
    f32x4 O[4][4]; float ls[4];
#pragma unroll
    for (int dt = 0; dt < 4; ++dt)
#pragma unroll
        for (int qt = 0; qt < 4; ++qt) O[dt][qt] = (f32x4){0.f, 0.f, 0.f, 0.f};
#pragma unroll
    for (int qt = 0; qt < 4; ++qt) ls[qt] = 0.f;
    const int kpos_base = 128 * qblk - 128;
    for (int i = tid; i < 384 * 8; i += NTHREADS) { const int r = i >> 3, c = i & 7; int kp = kpos_base + r; kp = kp < 0 ? 0 : (kp > NT - 1 ? NT - 1 : kp);
        const size_t src = (size_t)(b * NT + kp) * 128 + kvh * 64 + 8 * c;
        *(LAS u32x4*)(AK + r * AT_STRIDE + 8 * c) = *(const u32x4*)(KK + src); *(LAS u32x4*)(AV + r * AT_STRIDE + 8 * c) = *(const u32x4*)(VV + src); }
    __syncthreads();
    const bool edge = (qblk == 0) || (qblk == 31);
    for (int jt = 0; jt < 5; ++jt) { const bool msk = edge || jt == 0 || jt == 4;
        attn_tile(AK, AV, 64 * qh + 64 * jt, msk, kpos_base, qpos0, Qf, O, ls, cshift, fr, fq); }
    __syncthreads();
    for (int i = tid; i < 256 * 8; i += NTHREADS) { const int r = i >> 3, c = i & 7; const size_t src = (size_t)(MT + b * NL + r) * 128 + kvh * 64 + 8 * c;
        *(LAS u32x4*)(AK + r * AT_STRIDE + 8 * c) = *(const u32x4*)(KK + src); *(LAS u32x4*)(AV + r * AT_STRIDE + 8 * c) = *(const u32x4*)(VV + src); }
    __syncthreads();
    for (int jt = 0; jt < 4; ++jt) attn_tile(AK, AV, 64 * jt, false, 0, qpos0, Qf, O, ls, cshift, fr, fq);
    __syncthreads();
    const float psink = __builtin_amdgcn_exp2f(a.in[13][head] * LOG2E - cshift);
#pragma unroll
    for (int qt = 0; qt < 4; ++qt) {
        float l = ls[qt]; l += __shfl_xor(l, 16); l += __shfl_xor(l, 32); const float inv = 1.f / (l + psink);
        bf16_t* op = MIX + (size_t)(b * NT + qpos0 + 16 * qt + fr) * D + head * 64 + 4 * fq;
#pragma unroll
        for (int dt = 0; dt < 4; ++dt) { const f32x4 o = O[dt][qt] * inv; u32x2 wv; wv.x = pkbf(o[0], o[1]); wv.y = pkbf(o[2], o[3]); *(u32x2*)(op + 16 * dt) = wv; }
    }
}

constexpr int KS_ST = 136, VS_ST = 88;
constexpr int ML_KS = 0, ML_VN = ML_KS + 128 * KS_ST * 2, ML_VW = ML_VN + 128 * VS_ST * 2, ML_CN = ML_VW + 128 * VS_ST * 2, ML_F = ML_CN + 128 * VS_ST * 2, ML_CW = ML_F + 1024 * 4, ML_END = ML_CW + 768 * 4;
static_assert(ML_END <= LDS_BYTES, "mLSTM LDS map");
#define ML_GEOM(ci, seq0, seqlen, nbase) do { if ((ci) < 2) { seq0 = MT + b * NL; seqlen = NL; nbase = dir ? 128 * (1 - (ci)) : 128 * (ci); } \
    else { const int k_ = (ci) - 2; seq0 = b * NT; seqlen = NT; nbase = dir ? 128 * (31 - k_) : 128 * k_; } } while (0)
#define ML_POS(s) (dir ? nbase + 127 - (s) : nbase + (s))
__device__ __forceinline__ void mlstm_item(const Args& a, LAS unsigned char* lds, int item) {
    const int tid = threadIdx.x, lane = tid & 63, w = __builtin_amdgcn_readfirstlane(tid >> 6), fr = lane & 15, fq = lane >> 4, q4 = fr >> 2, p4 = fr & 3;
    const int vh = item & 1, dir = (item >> 1) & 1, h = (item >> 2) & 3, b = item >> 4;
    LAS bf16_t* Ks = (LAS bf16_t*)(lds + ML_KS); LAS bf16_t* Vn = (LAS bf16_t*)(lds + ML_VN); LAS bf16_t* Vw = (LAS bf16_t*)(lds + ML_VW); LAS bf16_t* Cn = (LAS bf16_t*)(lds + ML_CN);
    LAS float* F = (LAS float*)(lds + ML_F); LAS float* mstA = F, *aA = F + 64, *MlA = F + 128, *blA = F + 192, *plA = F + 256, *gA = F + 512; LAS float* cw = (LAS float*)(lds + ML_CW);
    const bf16_t* MQ = (const bf16_t*)(a.ws + WS_M4); const bf16_t* MK = MQ + (size_t)MA * 512; const bf16_t* MV = MK + (size_t)MA * 512;
    const float* GATES = (const float*)(a.ws + WS_GATES);
    float* TBL = (float*)(a.ws + WS_TBL) + (size_t)item * 34 * 384;
    bf16_t* H = (bf16_t*)(a.ws + (dir ? WS_HB : WS_HF));
    const float* conv = a.in[10];
    for (int i = tid; i < 768; i += NTHREADS) { const int j = i >> 8, c = i & 255; cw[i] = conv[j * 1024 + (c < 128 ? h * 128 + c : 512 + h * 128 + (c - 128))]; }
    for (int i = tid; i < 128 * VS_ST / 2; i += NTHREADS) ((LAS unsigned*)Cn)[i] = 0u;
    for (int i = tid; i < 128 * 12; i += NTHREADS) { const int s = i / 12, c = i % 12; ((LAS unsigned*)(Vn + s * VS_ST + 64))[c] = (c == 0) ? 0x00003f80u : 0u; ((LAS unsigned*)(Vw + s * VS_ST + 64))[c] = 0u; }
    for (int ci = w; ci < 34; ci += NWAVES) {
        int seq0, seqlen, nbase; ML_GEOM(ci, seq0, seqlen, nbase); (void)seqlen;
        const int s0 = 2 * lane, s1 = s0 + 1;
        const float* G0 = GATES + (size_t)(seq0 + ML_POS(s0)) * 16 + h; const float* G1 = GATES + (size_t)(seq0 + ML_POS(s1)) * 16 + h;
        const float li0 = G0[dir ? 8 : 0], lf0 = G0[dir ? 12 : 4], li1 = G1[dir ? 8 : 0], lf1 = G1[dir ? 12 : 4];
        float cs = lf0 + lf1;
#pragma unroll
        for (int o = 1; o < 64; o <<= 1) { const float y = __shfl_up(cs, o); if (lane >= o) cs += y; }
        const float b1 = cs, b0 = cs - lf1;
        const float g0 = li0 - b0, g1 = li1 - b1;
        float mx = fmaxf(g0, g1);
#pragma unroll
        for (int o = 1; o < 64; o <<= 1) { const float y = __shfl_up(mx, o); if (lane >= o) mx = fmaxf(mx, y); }
        float ex = __shfl_up(mx, 1); if (lane == 0) ex = -INFINITY;
        const float pm0 = fmaxf(ex, g0), pm1 = mx;
        float* T = TBL + ci * 384;
        typedef float f32x2t __attribute__((ext_vector_type(2)));
        *(f32x2t*)(T + s0) = (f32x2t){b0, b1}; *(f32x2t*)(T + 128 + s0) = (f32x2t){g0, g1}; *(f32x2t*)(T + 256 + s0) = (f32x2t){pm0, pm1};
        if (lane == 63) { blA[ci] = b1; plA[ci] = pm1; }
    }
    __syncthreads();
    if (w == 0) {
        float m = 0.f;
        for (int ci = 0; ci < 34; ++ci) { const float bl = blA[ci], pl = plA[ci]; const float Ml = fmaxf(m, pl); if (lane == 0) { mstA[ci] = m; aA[ci] = expf(m - Ml); MlA[ci] = Ml; } m = bl + Ml; }
    }
    f32x4 accC[5];
#pragma unroll
    for (int vt = 0; vt < 5; ++vt) accC[vt] = (f32x4){0.f, 0.f, 0.f, 0.f};
    u32x4 kr[4][3], vr[2];
#define ML_LOAD_KV(cj) do { int seq0_, seqlen_, nbase_; { const int dir_ = dir; (void)dir_; if ((cj) < 2) { seq0_ = MT + b * NL; seqlen_ = NL; nbase_ = dir ? 128 * (1 - (cj)) : 128 * (cj); } else { const int k_ = (cj) - 2; seq0_ = b * NT; seqlen_ = NT; nbase_ = dir ? 128 * (31 - k_) : 128 * k_; } } \
        _Pragma("unroll") for (int ps = 0; ps < 4; ++ps) { const int s_ = (tid >> 4) + 32 * ps, pos_ = dir ? nbase_ + 127 - s_ : nbase_ + s_; const bf16_t* kp = MK + (size_t)(seq0_ + pos_) * 512 + h * 128 + 8 * (tid & 15); \
            kr[ps][1] = *(const u32x4*)kp; kr[ps][0] = (u32x4){0u, 0u, 0u, 0u}; kr[ps][2] = (u32x4){0u, 0u, 0u, 0u}; if (pos_ > 0) kr[ps][0] = *(const u32x4*)(kp - 512); if (pos_ < seqlen_ - 1) kr[ps][2] = *(const u32x4*)(kp + 512); } \
        _Pragma("unroll") for (int ps = 0; ps < 2; ++ps) { const int s_ = (tid >> 3) + 64 * ps, pos_ = dir ? nbase_ + 127 - s_ : nbase_ + s_; vr[ps] = *(const u32x4*)(MV + (size_t)(seq0_ + pos_) * 512 + h * 128 + vh * 64 + 8 * (tid & 7)); } } while (0)
    ML_LOAD_KV(0);
    __syncthreads();
#pragma unroll 1
    for (int ci = 0; ci < 34; ++ci) {
        const bool isctx = ci < 2;
        int seq0, seqlen, nbase; ML_GEOM(ci, seq0, seqlen, nbase);
        const float mst = mstA[ci], Ml = MlA[ci], av = aA[ci];
        const float* T = TBL + ci * 384;
        const int t = 16 * w + fr, post = ML_POS(t);
        u32x4 qr[4][3]; float bt = 0.f, pmt = 0.f;
        if (!isctx) {
            const bf16_t* qp = MQ + (size_t)(seq0 + post) * 512 + h * 128 + 8 * fq;
#pragma unroll
            for (int kk = 0; kk < 4; ++kk) { qr[kk][1] = *(const u32x4*)(qp + 32 * kk); qr[kk][0] = (u32x4){0u, 0u, 0u, 0u}; qr[kk][2] = (u32x4){0u, 0u, 0u, 0u};
                if (post > 0) qr[kk][0] = *(const u32x4*)(qp + 32 * kk - 512); if (post < seqlen - 1) qr[kk][2] = *(const u32x4*)(qp + 32 * kk + 512); }
            bt = T[t]; pmt = T[256 + t];
        }
        float gv0 = T[128 + (tid >> 3)], gv1 = T[128 + (tid >> 3) + 64];
        const float gmine = tid < 128 ? T[128 + tid] : 0.f;
#pragma unroll
        for (int ps = 0; ps < 4; ++ps) {
            const int s = (tid >> 4) + 32 * ps, dc = tid & 15;
            const LAS float* c0 = cw + 128 + 8 * dc; float u[8];
#pragma unroll
            for (int e = 0; e < 4; ++e) {
                const float a0 = bflo(kr[ps][0][e]), a1 = bflo(kr[ps][1][e]), a2 = bflo(kr[ps][2][e]), b0 = bfhi(kr[ps][0][e]), b1 = bfhi(kr[ps][1][e]), b2 = bfhi(kr[ps][2][e]);
                u[2 * e] = silu_f(a0 * c0[2 * e] + a1 * c0[256 + 2 * e] + a2 * c0[512 + 2 * e]);
                u[2 * e + 1] = silu_f(b0 * c0[2 * e + 1] + b1 * c0[256 + 2 * e + 1] + b2 * c0[512 + 2 * e + 1]);
            }
            u32x4 o; o.x = pkbf(u[0], u[1]); o.y = pkbf(u[2], u[3]); o.z = pkbf(u[4], u[5]); o.w = pkbf(u[6], u[7]);
            *(LAS u32x4*)(Ks + s * KS_ST + 8 * dc) = o;
        }
#pragma unroll
        for (int ps = 0; ps < 2; ++ps) {
            const int s = (tid >> 3) + 64 * ps, vc = tid & 7; const float wv = __expf((ps ? gv1 : gv0) - Ml); u32x4 o;
            *(LAS u32x4*)(Vn + s * VS_ST + 8 * vc) = vr[ps];
#pragma unroll
            for (int e = 0; e < 4; ++e) o[e] = pkbf(bflo(vr[ps][e]) * wv, bfhi(vr[ps][e]) * wv);
            *(LAS u32x4*)(Vw + s * VS_ST + 8 * vc) = o;
        }
        if (tid < 128) { ((LAS unsigned*)(Vw + tid * VS_ST + 64))[0] = pkbf(__expf(gmine - Ml), 0.f); gA[tid] = gmine; }
        bf16x8 Bq[4];
        if (!isctx) {
#pragma unroll
            for (int kk = 0; kk < 4; ++kk) {
                const LAS float* c0 = cw + 32 * kk + 8 * fq; float u[8];
#pragma unroll
                for (int e = 0; e < 4; ++e) {
                    const float a0 = bflo(qr[kk][0][e]), a1 = bflo(qr[kk][1][e]), a2 = bflo(qr[kk][2][e]), b0 = bfhi(qr[kk][0][e]), b1 = bfhi(qr[kk][1][e]), b2 = bfhi(qr[kk][2][e]);
                    u[2 * e] = silu_f(a0 * c0[2 * e] + a1 * c0[256 + 2 * e] + a2 * c0[512 + 2 * e]) * 0.08838834764831845f;
                    u[2 * e + 1] = silu_f(b0 * c0[2 * e + 1] + b1 * c0[256 + 2 * e + 1] + b2 * c0[512 + 2 * e + 1]) * 0.08838834764831845f;
                }
                u32x4 o; o.x = pkbf(u[0], u[1]); o.y = pkbf(u[2], u[3]); o.z = pkbf(u[4], u[5]); o.w = pkbf(u[6], u[7]);
                Bq[kk] = __builtin_bit_cast(bf16x8, o);
            }
        } else {
#pragma unroll
            for (int kk = 0; kk < 4; ++kk) Bq[kk] = (bf16x8){0, 0, 0, 0, 0, 0, 0, 0};
        }
        __syncthreads();
        if (!isctx) {
            const float Mt = fmaxf(mst, pmt);
            f32x4 num[5], itr[5];
#pragma unroll
            for (int vt = 0; vt < 5; ++vt) { num[vt] = (f32x4){0.f, 0.f, 0.f, 0.f}; itr[vt] = (f32x4){0.f, 0.f, 0.f, 0.f}; }
#pragma unroll
            for (int kk2 = 0; kk2 < 4; ++kk2) {
                if (2 * kk2 <= w) {
                    f32x4 Pp[2];
#pragma unroll
                    for (int hh = 0; hh < 2; ++hh) {
                        const int i = 2 * kk2 + hh;
                        Pp[hh] = (f32x4){0.f, 0.f, 0.f, 0.f};
                        if (i <= w) {
#pragma unroll
                            for (int kk = 0; kk < 4; ++kk) { const bf16x8 Ak = *(const LAS bf16x8*)(Ks + (16 * i + fr) * KS_ST + 32 * kk + 8 * fq); Pp[hh] = mfma16(Ak, Bq[kk], Pp[hh]); }
                            const f32x4 gs = *(const LAS f32x4*)(gA + 16 * i + 4 * fq);
#pragma unroll
                            for (int r = 0; r < 4; ++r) { const int s = 16 * i + 4 * fq + r; const float wgt = (s <= t) ? __builtin_amdgcn_exp2f((gs[r] - Mt) * LOG2E) : 0.f; Pp[hh][r] *= wgt; }
                        }
                    }
                    const bf16x8 Bw = pack8(Pp[0], Pp[1]);
#pragma unroll
                    for (int vt = 0; vt < 5; ++vt) { const LAS bf16_t* vp = Vn + (32 * kk2 + 4 * fq + q4) * VS_ST + 16 * vt + 4 * p4; num[vt] = mfma16(tr2(vp, vp + 16 * VS_ST), Bw, num[vt]); }
                }
            }
            __builtin_amdgcn_sched_barrier(0);
            if (ci + 1 < 34) ML_LOAD_KV(ci + 1);
#pragma unroll
            for (int kk = 0; kk < 4; ++kk)
#pragma unroll
                for (int vt = 0; vt < 5; ++vt) { const LAS bf16_t* cp = Cn + (32 * kk + 8 * fq + q4) * VS_ST + 16 * vt + 4 * p4; itr[vt] = mfma16(tr2(cp, cp + 4 * VS_ST), Bq[kk], itr[vt]); }
            const float dect = __expf(mst - Mt), ebt = __expf(-bt - Mt);
#pragma unroll
            for (int vt = 0; vt < 5; ++vt) num[vt] = num[vt] + itr[vt] * dect;
            const float den = __shfl(num[4][0], fr);
            const float inv = 1.f / fmaxf(fabsf(den), ebt);
            bf16_t* hp = H + (size_t)(seq0 + post) * 512 + h * 128 + vh * 64 + 4 * fq;
#pragma unroll
            for (int vt = 0; vt < 4; ++vt) { const f32x4 o = num[vt] * inv; u32x2 wv; wv.x = pkbf(o[0], o[1]); wv.y = pkbf(o[2], o[3]); *(u32x2*)(hp + 16 * vt) = wv; }
        }
        if (isctx) ML_LOAD_KV(ci + 1);
        {
#pragma unroll
            for (int vt = 0; vt < 5; ++vt) accC[vt] = accC[vt] * av;
#pragma unroll
            for (int kk2 = 0; kk2 < 4; ++kk2) {
                const LAS bf16_t* kp = Ks + (32 * kk2 + 8 * fq + q4) * KS_ST + 16 * w + 4 * p4; const bf16x8 Bk = tr2(kp, kp + 4 * KS_ST);
#pragma unroll
                for (int vt = 0; vt < 5; ++vt) { const LAS bf16_t* vp = Vw + (32 * kk2 + 8 * fq + q4) * VS_ST + 16 * vt + 4 * p4; accC[vt] = mfma16(tr2(vp, vp + 4 * VS_ST), Bk, accC[vt]); }
            }
        }
        __syncthreads();
#pragma unroll
        for (int vt = 0; vt < 5; ++vt) { u32x2 wv; wv.x = pkbf(accC[vt][0], accC[vt][1]); wv.y = pkbf(accC[vt][2], accC[vt][3]); *(LAS u32x2*)(Cn + (16 * w + fr) * VS_ST + 16 * vt + 4 * fq) = wv; }
    }
    __syncthreads();
}
#undef ML_LOAD_KV
#undef ML_POS
#undef ML_GEOM

__device__ __forceinline__ void mlstm_out_rows(const Args& a, int row_lo, int nrows) {
    const int tid = threadIdx.x, lane = tid & 63, wave = tid >> 6;
    const bf16_t* HF = (const bf16_t*)(a.ws + WS_HF); const bf16_t* HB = (const bf16_t*)(a.ws + WS_HB);
    const bf16_t* MO = (const bf16_t*)(a.ws + WS_M4) + (size_t)3 * MA * 512;
    bf16_t* MIX = (bf16_t*)(a.ws + WS_MIX);
    const f32x4 nw0 = *(const f32x4*)(a.in[14] + 8 * lane), nw1 = *(const f32x4*)(a.in[14] + 8 * lane + 4);
    for (int i0 = wave; i0 < nrows; i0 += 4 * NWAVES) {
        u32x4 f[4], bb[4], mo[4];
#pragma unroll
        for (int u = 0; u < 4; ++u) { const size_t o = (size_t)(row_lo + i0 + u * NWAVES) * 512 + 8 * lane; f[u] = *(const u32x4*)(HF + o); bb[u] = *(const u32x4*)(HB + o); mo[u] = *(const u32x4*)(MO + o); }
#pragma unroll
        for (int u = 0; u < 4; ++u) {
            float sv[8]; float ss = 0.f;
#pragma unroll
            for (int e = 0; e < 4; ++e) { sv[2 * e] = bflo(f[u][e]) + bflo(bb[u][e]); sv[2 * e + 1] = bfhi(f[u][e]) + bfhi(bb[u][e]); ss += sv[2 * e] * sv[2 * e] + sv[2 * e + 1] * sv[2 * e + 1]; }
            ss += __shfl_xor(ss, 1); ss += __shfl_xor(ss, 2); ss += __shfl_xor(ss, 4); ss += __shfl_xor(ss, 8);
            const float r = rsqrtf(ss * (1.f / 128.f) + EPS);
            float ov[8];
#pragma unroll
            for (int e = 0; e < 4; ++e) {
                ov[2 * e] = sv[2 * e] * r * (e < 2 ? nw0[2 * e] : nw1[2 * e - 4]) * __builtin_amdgcn_rcpf(1.f + __expf(-bflo(mo[u][e])));
                ov[2 * e + 1] = sv[2 * e + 1] * r * (e < 2 ? nw0[2 * e + 1] : nw1[2 * e - 3]) * __builtin_amdgcn_rcpf(1.f + __expf(-bfhi(mo[u][e])));
            }
            u32x4 o; o.x = pkbf(ov[0], ov[1]); o.y = pkbf(ov[2], ov[3]); o.z = pkbf(ov[4], ov[5]); o.w = pkbf(ov[6], ov[7]);
            *(u32x4*)(MIX + (size_t)(row_lo + i0 + u * NWAVES) * D + 512 + 8 * lane) = o;
        }
    }
}
__device__ __forceinline__ void post_rows(const Args& a, LAS unsigned char* lds, int row_lo, int nrows) {
    const int tid = threadIdx.x, lane = tid & 63, wave = tid >> 6;
    LAS float* W16 = (LAS float*)lds;
    fill_w16(W16, a.in[16], 16, tid);
    __syncthreads();
    const float* mod = (const float*)(a.ws + WS_MOD); const float* n2w = a.in[7];
    bf16_t* HX2 = (bf16_t*)(a.ws + WS_HX); float* AFF = (float*)(a.ws + WS_AFF);
    const int b = row_lo >> 12; const float* mr = mod + b * 6144;
    const int ti = reduce16_index(lane);
    f32x4 sc[4], sh[4], vn[4];
#pragma unroll
    for (int j = 0; j < 4; ++j) { const int k = 4 * lane + 256 * j; const f32x4 wv = *(const f32x4*)(n2w + k), s2 = *(const f32x4*)(mr + 4 * D + k); sc[j] = wv * (1.f + s2); sh[j] = *(const f32x4*)(mr + 3 * D + k); }
    if (wave < nrows) {
#pragma unroll
        for (int j = 0; j < 4; ++j) vn[j] = *(const f32x4*)(a.out + (size_t)(row_lo + wave) * D + 4 * lane + 256 * j); }
#pragma unroll 1
    for (int i = wave; i < nrows; i += NWAVES) {
        const int m = row_lo + i;
        f32x4 v[4];
#pragma unroll
        for (int j = 0; j < 4; ++j) v[j] = vn[j];
        if (i + NWAVES < nrows) {
#pragma unroll
            for (int j = 0; j < 4; ++j) vn[j] = *(const f32x4*)(a.out + (size_t)(m + NWAVES) * D + 4 * lane + 256 * j); }
        const float g = row_norm_dots(v, sc, sh, W16, lane);
        store_row_bf16(HX2 + (size_t)m * D, v, lane);
        float mx = g;
        mx = fmaxf(mx, __shfl_xor(mx, 4)); mx = fmaxf(mx, __shfl_xor(mx, 8)); mx = fmaxf(mx, __shfl_xor(mx, 16)); mx = fmaxf(mx, __shfl_xor(mx, 32));
        const float e = expf(g - mx);
        float sum = e;
        sum += __shfl_xor(sum, 4); sum += __shfl_xor(sum, 8); sum += __shfl_xor(sum, 16); sum += __shfl_xor(sum, 32);
        if ((lane & 3) == 0) AFF[((size_t)b * NE + ti) * NT + (m & (NT - 1))] = e / sum;
    }
    __syncthreads();
}

__device__ __forceinline__ void topk_select(const Args& a, LAS unsigned char* lds, int z) {
    const int tid = threadIdx.x, lane = tid & 63, wave = tid >> 6;
    LAS unsigned* hist = (LAS unsigned*)lds; LAS unsigned* sc = hist + 256; LAS unsigned* wsum = hist + 272;
    const float* aff = (const float*)(a.ws + WS_AFF) + (size_t)z * NT;
    int* idx = (int*)(a.ws + WS_IDX) + z * CAP; float* gate = (float*)(a.ws + WS_GATE) + z * CAP; int* slot = (int*)(a.ws + WS_SLOT) + (size_t)z * NT;
    unsigned key[8];
    { const u32x4 k0 = *(const u32x4*)(aff + 8 * tid), k1 = *(const u32x4*)(aff + 8 * tid + 4); key[0] = k0.x; key[1] = k0.y; key[2] = k0.z; key[3] = k0.w; key[4] = k1.x; key[5] = k1.y; key[6] = k1.z; key[7] = k1.w; }
    unsigned prefix = 0u, need = CAP;
#pragma unroll 1
    for (int pass = 0; pass < 4; ++pass) {
        const int shift = 24 - 8 * pass;
        if (tid < 256) hist[tid] = 0u;
        __syncthreads();
#pragma unroll
        for (int i = 0; i < 8; ++i) { const bool match = (pass == 0) || ((key[i] >> (shift + 8)) == prefix); if (match) __hip_atomic_fetch_add(&hist[(key[i] >> shift) & 255u], 1u, __ATOMIC_RELAXED, __HIP_MEMORY_SCOPE_WORKGROUP); }
        __syncthreads();
        if (wave == 0) {
            unsigned c[4]; unsigned s = 0u;
#pragma unroll
            for (int j = 0; j < 4; ++j) { c[j] = hist[255 - (4 * lane + j)]; s += c[j]; }
            unsigned incl = s;
#pragma unroll
            for (int o = 1; o < 64; o <<= 1) { const unsigned y = __shfl_up(incl, o); if (lane >= o) incl += y; }
            unsigned cb = incl - s;
#pragma unroll
            for (int j = 0; j < 4; ++j) { if (cb < need && need <= cb + c[j]) { sc[0] = (prefix << 8) | (unsigned)(255 - (4 * lane + j)); sc[1] = need - cb; } cb += c[j]; }
        }
        __syncthreads();
        prefix = sc[0]; need = sc[1];
        __syncthreads();
    }
    const unsigned T = prefix;
    unsigned cg = 0u, ce = 0u;
#pragma unroll
    for (int i = 0; i < 8; ++i) { cg += key[i] > T ? 1u : 0u; ce += key[i] == T ? 1u : 0u; }
    const unsigned mine = cg | (ce << 16);
    unsigned incl = mine;
#pragma unroll
    for (int o = 1; o < 64; o <<= 1) { const unsigned y = __shfl_up(incl, o); if (lane >= o) incl += y; }
    if (lane == 63) wsum[wave] = incl;
    __syncthreads();
    unsigned base = 0u;
    for (int q = 0; q < wave; ++q) base += wsum[q];
    const unsigned excl = base + incl - mine;
    unsigned pg = excl & 0xffffu, pe = excl >> 16;
    const unsigned total_gt = CAP - need;
#pragma unroll
    for (int i = 0; i < 8; ++i) {
        const int tok = 8 * tid + i; int sl = -1;
        if (key[i] > T) { sl = (int)pg; ++pg; }
        else if (key[i] == T) { if (pe < need) sl = (int)(total_gt + pe); ++pe; }
        if (sl >= 0) { idx[sl] = tok; gate[sl] = __builtin_bit_cast(float, key[i]); }
        slot[tok] = sl;
    }
    __syncthreads();
}

#define XB_TMO      128
#define XB_XCNT(j)  (256  + 64 * (j))
#define XB_XSUB(j)  (1280 + 64 * (j))
#define XB_XGEN(j)  (2304 + 64 * (j))
#define XB_TOP      3328
#define XB_TOPGEN   3392
#define XCD_BAR_WORDS 3456
#define XB_SPIN_CAP (1u << 18)

__device__ __forceinline__ unsigned xb_ld(unsigned* p)              { return __hip_atomic_load(p, __ATOMIC_RELAXED, __HIP_MEMORY_SCOPE_AGENT); }
__device__ __forceinline__ unsigned xb_add(unsigned* p, unsigned v) { return __hip_atomic_fetch_add(p, v, __ATOMIC_RELAXED, __HIP_MEMORY_SCOPE_AGENT); }
__device__ __forceinline__ unsigned xb_xcc_id() { return (unsigned)__builtin_amdgcn_s_getreg((3 << 11) | 20) & 0xFu; }
#define XB_SPIN(cond, bar) do { unsigned _sp = 0; while (cond) { __builtin_amdgcn_s_sleep(1); \
    if ((++_sp & 255u) == 0u) { if (xb_ld(&(bar)[XB_TMO])) break; if (_sp > XB_SPIN_CAP) { atomicAdd(&(bar)[XB_TMO], 1u); break; } } } } while (0)

struct XcdBarrier {
    unsigned* bar; unsigned x;
    volatile LAS unsigned* st;
};

__device__ __forceinline__ XcdBarrier xcd_barrier_post(unsigned* bar, volatile LAS unsigned* st) {
    XcdBarrier b; b.bar = bar; b.x = xb_xcc_id(); b.st = st;
    if (threadIdx.x == 0) (void)xb_add(&bar[XB_XCNT(b.x)], 1u);
    return b;
}
__device__ __forceinline__ void xcd_barrier_complete(unsigned* bar, unsigned x, unsigned& nloc, unsigned& nx) {
    const unsigned G = gridDim.x * gridDim.y * gridDim.z;
    unsigned sum, cnt, mine, sp = 0u;
    for (;;) {
        sum = 0u; cnt = 0u; mine = 0u;
#pragma unroll
        for (unsigned j = 0; j < 16; ++j) { const unsigned c = xb_ld(&bar[XB_XCNT(j)]); sum += c; cnt += (c > 0u) ? 1u : 0u; mine = (j == x) ? c : mine; }
        if (sum == G) break;
        __builtin_amdgcn_s_sleep(1);
        if ((++sp & 255u) == 0u) { if (xb_ld(&bar[XB_TMO])) break; if (sp > XB_SPIN_CAP) { atomicAdd(&bar[XB_TMO], 1u); break; } }
    }
    nloc = mine > 0u ? mine : 1u; nx = cnt > 0u ? cnt : 1u;
}

__device__ __forceinline__ void xcd_barrier(const XcdBarrier& b) {
    asm volatile("s_waitcnt vmcnt(0)" ::: "memory");
    __syncthreads();
    if (threadIdx.x == 0) {
        unsigned* bar = b.bar;
        __builtin_amdgcn_s_waitcnt(0);
        unsigned nloc = b.st[0], nx = b.st[1];
        if (nloc == 0u) { xcd_barrier_complete(bar, b.x, nloc, nx); b.st[0] = nloc; b.st[1] = nx; }
        const unsigned old = xb_add(&bar[XB_XSUB(b.x)], 1u);
        const unsigned gen = old / nloc;
        if (old + 1u == (gen + 1u) * nloc) {
            __builtin_amdgcn_fence(__ATOMIC_RELEASE, "agent");
            asm volatile("s_waitcnt vmcnt(0)" ::: "memory");
            const unsigned og = xb_add(&bar[XB_TOP], 1u);
            const unsigned tg = og / nx;
            if (og + 1u == (tg + 1u) * nx) xb_add(&bar[XB_TOPGEN], 1u);
            else XB_SPIN(xb_ld(&bar[XB_TOPGEN]) == tg, bar);
            __builtin_amdgcn_fence(__ATOMIC_ACQUIRE, "agent");
            xb_add(&bar[XB_XGEN(b.x)], 1u);
            asm volatile("s_waitcnt vmcnt(0)" ::: "memory");
        } else {
            XB_SPIN(xb_ld(&bar[XB_XGEN(b.x)]) == gen, bar);
            __builtin_amdgcn_fence(__ATOMIC_ACQUIRE, "agent");
            asm volatile("s_waitcnt vmcnt(0)" ::: "memory");
        }
    }
    __syncthreads();
}

template <int MASK> __global__ void __launch_bounds__(NTHREADS, 2) mk_fwd_t(Args a) {
    extern __shared__ __attribute__((aligned(16))) unsigned char lds_raw[];
    LAS unsigned char* lds = (LAS unsigned char*)lds_raw;
    __builtin_assume(__builtin_amdgcn_workitem_id_y() == 0); __builtin_assume(__builtin_amdgcn_workitem_id_z() == 0);
    cg::grid_group grid = cg::this_grid();
    if (threadIdx.x < 2) ((LAS unsigned*)(lds + LDS_BAR_OFF))[threadIdx.x] = 0u;
    __syncthreads();
    XcdBarrier xbar = xcd_barrier_post((unsigned*)(a.ws + WS_BAR), (volatile LAS unsigned*)(lds + LDS_BAR_OFF));
    const int lo = a.ph_lo, hi = a.ph_hi;
    const int c = blockIdx.x, G = gridDim.x, tid = threadIdx.x, lane = tid & 63, wave = tid >> 6;
#define IN(k) ((((MASK) >> (k)) & 1) && lo <= (k) && (k) < hi)
#define SEAM(k) do { if (IN(k) && IN((k) + 1)) xcd_barrier(xbar); } while (0)
    if (lo < 0) grid.sync();
    unsigned char* ws = a.ws;

    if (IN(0)) phase0(a, lds);
    SEAM(0);
    if (IN(1)) phase1(a, lds);
    SEAM(1);
    if (IN(2)) {
        Gemm g{(const bf16_t*)(ws + WS_HX), (const bf16_t*)(ws + WS_WIN), MA, NPROJ, D};
        pg8::StaticOrder S; S.init(MA, NPROJ, G, c);
        EpiProj E{(bf16_t*)(ws + WS_Q), (bf16_t*)(ws + WS_KK), (bf16_t*)(ws + WS_VV), (bf16_t*)(ws + WS_M4), a.in[11], a.in[12], (const float*)(ws + WS_ROPE), 0.125f * LOG2E};
        pg8::gemm_phase<EpiProj, pg8::StaticOrder, true, true>(lds, g, S, E);
        __syncthreads();
    }
    SEAM(2);
    if (IN(3)) {
#ifndef MK_NO_ML
        if (a.sub & 1) for (int it = c; it < 256; it += G) mlstm_item(a, lds, it);
#endif
#ifndef MK_NO_ATTN
        if (a.sub & 2) for (int it = c; it < 1024; it += G) attn_item(a, lds, it);
#endif
    }
    SEAM(3);
    if (IN(4)) {
        if (c < 256) { const int pm = c;
            mlstm_out_rows(a, pm * 256, 256);
            __syncthreads();
            Gemm g{(const bf16_t*)(ws + WS_MIX), (const bf16_t*)(ws + WS_WOUT), MT, D, D};
            SeqOrder S{pm, 4, 4};
            EpiOut E{a.in[0], (const float*)(ws + WS_MOD), a.out};
            pg8::gemm_phase<EpiOut, SeqOrder, true, true>(lds, g, S, E);
            __syncthreads();
            post_rows(a, lds, pm * 256, 256);
        }
    }
    SEAM(4);
    if (IN(5)) {
        if (c < 256) { const int z = c;
            const int b = z >> 4, e = z & 15;
            topk_select(a, lds, z);
            const bf16_t* HX2 = (const bf16_t*)(ws + WS_HX) + (size_t)b * NT * D; const int* idx = (const int*)(ws + WS_IDX) + z * CAP;
            bf16_t* ACT = (bf16_t*)(ws + WS_ACT) + (size_t)z * CAP * FF;
            { Gemm g{HX2, (const bf16_t*)(ws + WS_WGU) + (size_t)e * 1024 * D, 256, 1024, D, idx}; SeqOrder S{0, 4, 4}; EpiAct E{ACT};
              pg8::gemm_phase<EpiAct, SeqOrder, true, true>(lds, g, S, E); __syncthreads(); }
            { Gemm g{HX2, (const bf16_t*)(ws + WS_WGU) + (size_t)e * 1024 * D, 256, 1024, D, idx + 256}; SeqOrder S{0, 4, 4}; EpiAct E{ACT + (size_t)256 * FF};
              pg8::gemm_phase<EpiAct, SeqOrder, true, true>(lds, g, S, E); __syncthreads(); }
            { Gemm g{ACT, (const bf16_t*)(ws + WS_WD) + (size_t)e * D * FF, CAP, D, FF}; SeqOrder S{0, 4, 8}; EpiDown E{(bf16_t*)(ws + WS_MIX) + (size_t)z * CAP * D, (const float*)(ws + WS_GATE) + z * CAP};
              pg8::gemm_phase<EpiDown, SeqOrder, true, true>(lds, g, S, E); }
            __syncthreads();
        }
    }
    SEAM(5);
    if (IN(6)) {
        const int gw = c * NWAVES + wave, NGW = G * NWAVES;
        const int* SL = (const int*)(ws + WS_SLOT); const bf16_t* Y = (const bf16_t*)(ws + WS_MIX); const float* mod = (const float*)(ws + WS_MOD);
        for (int grp = gw; grp < MT / 4; grp += NGW) {
            const int mbase = 4 * grp, b = mbase >> 12, n0 = mbase & (NT - 1);
            const int sv = SL[((size_t)b * NE + (lane & 15)) * NT + n0 + (lane >> 4)];
            const unsigned long long ball = __ballot(sv >= 0);
            if (ball == 0ull) continue;
            const float* g2 = mod + b * 6144 + 5 * D;
#pragma unroll 1
            for (int u = 0; u < 4; ++u) {
                unsigned mask = (unsigned)(ball >> (16 * u)) & 0xffffu;
                if (mask == 0u) continue;
                float* orow = a.out + (size_t)(mbase + u) * D;
                f32x4 xv[2][2];
#pragma unroll
                for (int j = 0; j < 2; ++j)
#pragma unroll
                    for (int q = 0; q < 2; ++q) xv[j][q] = *(const f32x4*)(orow + 8 * lane + 512 * j + 4 * q);
                float acc[16];
#pragma unroll
                for (int i = 0; i < 16; ++i) acc[i] = 0.f;
                while (mask) {
                    const int e0 = __builtin_ctz(mask); mask &= mask - 1u;
                    const bool two = mask != 0u; const int e1 = two ? __builtin_ctz(mask) : e0; if (two) mask &= mask - 1u;
                    const int s0 = __shfl(sv, 16 * u + e0), s1 = __shfl(sv, 16 * u + e1);
                    const bf16_t* y0 = Y + ((size_t)(b * NE + e0) * CAP + s0) * D + 8 * lane; const bf16_t* y1 = Y + ((size_t)(b * NE + e1) * CAP + s1) * D + 8 * lane;
                    const u32x4 a0 = *(const u32x4*)y0, a1 = *(const u32x4*)(y0 + 512), b0 = *(const u32x4*)y1, b1 = *(const u32x4*)(y1 + 512);
                    const float w1 = two ? 1.f : 0.f;
#pragma unroll
                    for (int q = 0; q < 4; ++q) { acc[2 * q] += bflo(a0[q]) + w1 * bflo(b0[q]); acc[2 * q + 1] += bfhi(a0[q]) + w1 * bfhi(b0[q]);
                        acc[8 + 2 * q] += bflo(a1[q]) + w1 * bflo(b1[q]); acc[8 + 2 * q + 1] += bfhi(a1[q]) + w1 * bfhi(b1[q]); }
                }
#pragma unroll
                for (int j = 0; j < 2; ++j)
#pragma unroll
                    for (int q = 0; q < 2; ++q) { const int col = 8 * lane + 512 * j + 4 * q; const f32x4 gv = *(const f32x4*)(g2 + col);
                        f32x4 o; o[0] = xv[j][q][0] + gv[0] * acc[8 * j + 4 * q]; o[1] = xv[j][q][1] + gv[1] * acc[8 * j + 4 * q + 1]; o[2] = xv[j][q][2] + gv[2] * acc[8 * j + 4 * q + 2]; o[3] = xv[j][q][3] + gv[3] * acc[8 * j + 4 * q + 3];
                        *(f32x4*)(orow + col) = o; }
            }
        }
    }
#undef IN
#undef SEAM
}
}

#ifndef MK_N_LAUNCHES
#define MK_N_LAUNCHES 1
#endif
extern "C" void kernel_launch(void* const* d_in, const int* in_sizes, int n_in, void* d_out, int out_size, void* d_ws, size_t ws_size, hipStream_t stream) {
    using namespace mk;
    static int grid = 0;
    if (grid == 0) {
        if (n_in != 20 || out_size != MT * D || ws_size < WS_END) { fprintf(stderr, "kernel_launch: unexpected problem (n_in %d out %d ws %zu need %zu)\n", n_in, out_size, ws_size, (size_t)WS_END); grid = -1; return; }
        int dev = 0, cus = 0, per_cu = 0;
        hipGetDevice(&dev); hipDeviceGetAttribute(&cus, hipDeviceAttributeMultiprocessorCount, dev);
#if MK_N_LAUNCHES == 1
        if (hipFuncSetAttribute((const void*)mk_fwd_t<0x7f>, hipFuncAttributeMaxDynamicSharedMemorySize, LDS_BYTES) != hipSuccess) { fprintf(stderr, "kernel_launch: hipFuncSetAttribute failed\n"); grid = -1; return; }
        hipOccupancyMaxActiveBlocksPerMultiprocessor(&per_cu, (const void*)mk_fwd_t<0x7f>, NTHREADS, LDS_BYTES);
#else
        per_cu = 1;
#endif
        (void)hipGetLastError();
        if (per_cu < 1) { fprintf(stderr, "kernel_launch: occupancy query says %d blocks per CU\n", per_cu); per_cu = 1; }
        grid = cus;
        if (grid > 256) grid = 256;
    }
    if (grid < 0) return;
    if (hipMemsetAsync((char*)d_ws + WS_BAR, 0, 16384, stream) != hipSuccess) { fprintf(stderr, "kernel_launch: hipMemsetAsync failed\n"); return; }
    Args a{};
    for (int i = 0; i < 20; ++i) a.in[i] = (const float*)d_in[i];
    a.out = (float*)d_out; a.ws = (unsigned char*)d_ws; a.sub = 3;
#if MK_N_LAUNCHES == 1
    a.ph_lo = 0; a.ph_hi = 7;
    void* args[] = {&a};
    hipError_t e = hipLaunchCooperativeKernel((const void*)mk_fwd_t<0x7f>, dim3(grid), dim3(NTHREADS), args, LDS_BYTES, stream);
    if (e != hipSuccess) fprintf(stderr, "cooperative launch failed: %s (grid %d)\n", hipGetErrorString(e), grid);
#else
#define MK_LAUNCH_P(p) do { hipFuncSetAttribute((const void*)mk_fwd_t<(1 << (p))>, hipFuncAttributeMaxDynamicSharedMemorySize, LDS_BYTES); a.ph_lo = (p); a.ph_hi = (p) + 1; hipLaunchKernelGGL(mk_fwd_t<(1 << (p))>, dim3(grid), dim3(NTHREADS), LDS_BYTES, stream, a); } while (0)
#ifndef MK_DUP
#define MK_DUP -1
#endif
#ifndef MK_DUP_SUB
#define MK_DUP_SUB 3
#endif
#define MK_LAUNCH_D(p) do { MK_LAUNCH_P(p); if (MK_DUP == (p)) { a.sub = MK_DUP_SUB; MK_LAUNCH_P(p); a.sub = 3; } } while (0)
    MK_LAUNCH_D(0); MK_LAUNCH_D(1); MK_LAUNCH_D(2); MK_LAUNCH_D(3); MK_LAUNCH_D(4); MK_LAUNCH_D(5); MK_LAUNCH_D(6);
#endif
}
```

```cpp
#include <hip/hip_runtime.h>
#include <hip/hip_cooperative_groups.h>
#include <cstdio>
#include <cstdint>
namespace cg = cooperative_groups;
namespace pg8 {
#define PG8_LAS __attribute__((address_space(3)))
typedef unsigned short bf16_t;
typedef short bf16x8 __attribute__((ext_vector_type(8)));
typedef float f32x4 __attribute__((ext_vector_type(4)));
typedef unsigned u32x4 __attribute__((ext_vector_type(4)));
constexpr int BM = 256, BK = 64, HALF = 128, HTB = HALF * BK * 2  , STAGE_BYTES = 8 * HTB, NXCD = 8, WGM = 8;

__host__ __device__ __forceinline__ int lds_byte(int r, int c) { const int st = (r >> 4) * 2 + (c >> 5), rr = r & 15, cc = c & 31, ob = rr * 64 + cc * 2; return st * 1024 + (ob ^ (((ob >> 9) & 1) << 5)); }
__host__ __device__ __forceinline__ void stage_rc(int b, int& R, int& C) { const int st = b / 1024, sb = b % 1024, swz = sb ^ (((sb >> 9) & 1) << 5); R = (st >> 1) * 16 + swz / 64; C = (st & 1) * 32 + (swz % 64) / 2; }
__host__ __device__ __forceinline__ int perm32(int rho) { const int n = rho >> 4, i = rho & 15; return 8 * (i >> 2) + 4 * n + (i & 3); }

struct Unit { int pm, pn; };
struct Gemm { const bf16_t* A; const bf16_t* Bt; int M, N, K; const int* gidx = nullptr; };

struct StaticOrder {
    int nM, nN, nwg, G, c;
    __host__ __device__ void init(int M, int N, int G_, int c_) { nM = M / BM; nN = N / BM; nwg = nM * nN; G = G_; c = c_; }
    __host__ __device__ bool next(int i, Unit& u) const {
        const long L = (long)i * G + c; if (L >= nwg) return false;
        int wgid = (int)L; { const int q = nwg / NXCD, r = nwg % NXCD, xcd = wgid % NXCD, off = wgid / NXCD; wgid = (xcd < r ? xcd * (q + 1) : r * (q + 1) + (xcd - r) * q) + off; }
        const int nig = WGM * nN, gid = wgid / nig, fm = gid * WGM, gsz = (nM - fm) < WGM ? (nM - fm) : WGM;
        u.pm = fm + ((wgid % nig) % gsz); u.pn = (wgid % nig) / gsz; return true;
    }
    __device__ __forceinline__ void a_ready(const Unit&) const {}
    __device__ __forceinline__ void done(const Unit&) const {}
};
__device__ __forceinline__ unsigned cvt_pk_bf16(float lo, float hi) { unsigned r; asm volatile("v_cvt_pk_bf16_f32 %0, %1, %2" : "=v"(r) : "v"(lo), "v"(hi)); return r; }
typedef float f32x2 __attribute__((ext_vector_type(2)));
typedef int pg8_v8i __attribute__((ext_vector_type(8))); typedef int pg8_v4i __attribute__((ext_vector_type(4)));
template <int FMT> struct pg8_frag;
template <> struct pg8_frag<0> { bf16x8 v[2]; };
template <> struct pg8_frag<1> { pg8_v4i v[2]; };
template <class Epi, class Sched, bool ALIGN_EPI = false, bool SP2 = false, int FMT = 0, int FP8_SCALE_W = 0x7F7F7F7F>
__device__ __forceinline__ void gemm_phase(PG8_LAS unsigned char* lds, const Gemm g, const Sched& S, const Epi& E) {
    int tid_ = threadIdx.x; asm volatile("" : "+v"(tid_));
    const int tid = tid_, wid = __builtin_amdgcn_readfirstlane(tid >> 6), lane = tid & 63, wr = wid >> 2, wc = wid & 3, fr = lane & 15, fq = lane >> 4;
    const int K = g.K, nt = K / BK;
    unsigned voffA[2], voffB[2];
#pragma unroll
    for (int i = 0; i < 2; ++i) { int R, C; stage_rc(tid * 16 + i * 8192, R, C); const int Rb = Epi::PERM ? ((R & ~31) + perm32(R & 31)) : R;
        voffA[i] = (unsigned)(R * K + C) * 2u; voffB[i] = (unsigned)(Rb * K + C) * 2u; }
    const size_t kstep = (size_t)(BK * 2);
    const size_t hstep = (size_t)HALF * K * 2;
    const size_t tstep = 2 * hstep;
    unsigned voffAh[2][2];
#pragma unroll
    for (int i = 0; i < 2; ++i) { int R, C; stage_rc(tid * 16 + i * 8192, R, C);
        if (g.gidx) { voffAh[0][i] = (unsigned)(g.gidx[R] * K + C) * 2u; voffAh[1][i] = (unsigned)(g.gidx[HALF + R] * K + C) * 2u; }
        else { voffAh[0][i] = 0u; voffAh[1][i] = 0u; } }
    const __amdgpu_buffer_rsrc_t rsA = __builtin_amdgcn_make_buffer_rsrc((void*)g.A, 0, -1, 0x00020000), rsB = __builtin_amdgcn_make_buffer_rsrc((void*)g.Bt, 0, -1, 0x00020000);
    const size_t atstep = g.gidx ? (size_t)0 : tstep; const int p1step = 64 * K * 2;
    const unsigned ldsw = (unsigned)wid * 1024u;
    const int aoff = lds_byte(wr * 64 + fr, fq * 8), boff = lds_byte(wc * 32 + fr, fq * 8);
#define PG8_SA(b, h) (((b) * 2 + (h)) * HTB)
#define PG8_SB(b, h) ((4 + (b) * 2 + (h)) * HTB)
#define PG8_STAGE_R(rs, base0, bufoff, gbase, voff) do { const int so_ = (int)((const char*)(gbase) - (const char*)(base0)); _Pragma("unroll") for (int _i = 0; _i < 2; ++_i) \
        __builtin_amdgcn_raw_ptr_buffer_load_lds(rs, (PG8_LAS unsigned*)(lds + (bufoff) + ldsw + _i * 8192), 16, (int)(voff)[_i], so_, 0, 0); } while (0)
#define PG8_STAGE_U(rs, base0, bufoff, gbase, voff0, xtra) do { const int so_ = (int)((const char*)(gbase) - (const char*)(base0)) + (int)(xtra); _Pragma("unroll") for (int _i = 0; _i < 2; ++_i) \
        __builtin_amdgcn_raw_ptr_buffer_load_lds(rs, (PG8_LAS unsigned*)(lds + (bufoff) + ldsw + _i * 8192), 16, (int)(voff0), so_ + _i * (int)p1step, 0, 0); } while (0)
#define PG8_LD1(dst, k, addr) do { if constexpr (FMT == 0) dst.v[k] = *(const PG8_LAS bf16x8*)(addr); else dst.v[k] = *(const PG8_LAS pg8_v4i*)(addr); } while (0)
#define PG8_LDA(dst, b, h) do { _Pragma("unroll") for (int m = 0; m < 4; ++m) _Pragma("unroll") for (int k = 0; k < 2; ++k) PG8_LD1(dst[m], k, lds + PG8_SA(b, h) + aoff + m * 2048 + k * 1024); } while (0)
#define PG8_LDB(dst, b, h) do { _Pragma("unroll") for (int n = 0; n < 2; ++n) _Pragma("unroll") for (int k = 0; k < 2; ++k) PG8_LD1(dst[n], k, lds + PG8_SB(b, h) + boff + n * 2048 + k * 1024); } while (0)
#define PG8_MMA(ai, bj, At, Bt) do { __builtin_amdgcn_s_setprio(1); \
        if constexpr (FMT == 0) { _Pragma("unroll") for (int m = 0; m < 4; ++m) _Pragma("unroll") for (int n = 0; n < 2; ++n) _Pragma("unroll") for (int k = 0; k < 2; ++k) \
            acc[ai][bj][m][n] = __builtin_amdgcn_mfma_f32_16x16x32_bf16(Bt[n].v[k], At[m].v[k], acc[ai][bj][m][n], 0, 0, 0); } \
        else { _Pragma("unroll") for (int m = 0; m < 4; ++m) _Pragma("unroll") for (int n = 0; n < 2; ++n) \
            acc[ai][bj][m][n] = __builtin_amdgcn_mfma_scale_f32_16x16x128_f8f6f4(__builtin_shufflevector(Bt[n].v[0], Bt[n].v[1], 0, 1, 2, 3, 4, 5, 6, 7), __builtin_shufflevector(At[m].v[0], At[m].v[1], 0, 1, 2, 3, 4, 5, 6, 7), acc[ai][bj][m][n], 0, 0, 0, 0x7F7F7F7F, 0, 0x7F7F7F7F); \
            asm volatile("" :: "v"(acc[ai][bj][0][0]), "v"(acc[ai][bj][0][1]), "v"(acc[ai][bj][1][0]), "v"(acc[ai][bj][1][1]), "v"(acc[ai][bj][2][0]), "v"(acc[ai][bj][2][1]), "v"(acc[ai][bj][3][0]), "v"(acc[ai][bj][3][1])); }   \
        __builtin_amdgcn_s_setprio(0); } while (0)
#define PG8_WAIT_V(n) asm volatile("s_waitcnt vmcnt(" #n ")" ::: "memory")
#define PG8_WAIT_L(n) asm volatile("s_waitcnt lgkmcnt(" #n ")" ::: "memory")
#define PG8_BAR __builtin_amdgcn_s_barrier()
#define PG8_SCHED __builtin_amdgcn_sched_barrier(0)
    Unit cur, nxt; int ui = 0;
    if (!S.next(0, cur)) return;
    f32x4 acc[2][2][4][2];
#pragma unroll
    for (int a = 0; a < 2; ++a)
#pragma unroll
        for (int b = 0; b < 2; ++b)
#pragma unroll
            for (int m = 0; m < 4; ++m)
#pragma unroll
                for (int n = 0; n < 2; ++n) acc[a][b][m][n] = (f32x4){0.f, 0.f, 0.f, 0.f};
    pg8_frag<FMT> At[4], B0[2], B1[2];
    const char* cA = (const char*)g.A + (size_t)cur.pm * atstep; const char* cB = (const char*)g.Bt + (size_t)cur.pn * tstep;
    S.a_ready(cur);
    if constexpr (SP2) {
        PG8_STAGE_U(rsB, g.Bt, PG8_SB(0, 0), cB, voffB[0], 0); PG8_STAGE_U(rsB, g.Bt, PG8_SB(0, 1), cB + hstep, voffB[0], 0); do { if (g.gidx) PG8_STAGE_R(rsA, g.A, PG8_SA(0, 0), cA, voffAh[0]); else PG8_STAGE_U(rsA, g.A, PG8_SA(0, 0), cA, voffA[0], 0 * hstep); } while (0); do { if (g.gidx) PG8_STAGE_R(rsA, g.A, PG8_SA(0, 1), cA, voffAh[1]); else PG8_STAGE_U(rsA, g.A, PG8_SA(0, 1), cA, voffA[0], 1 * hstep); } while (0);
        if (wr == 1) PG8_BAR;
        PG8_WAIT_V(2); PG8_BAR;
        PG8_STAGE_U(rsB, g.Bt, PG8_SB(1, 0), cB + kstep, voffB[0], 0); do { if (g.gidx) PG8_STAGE_R(rsA, g.A, PG8_SA(1, 0), cA + kstep, voffAh[0]); else PG8_STAGE_U(rsA, g.A, PG8_SA(1, 0), cA + kstep, voffA[0], 0 * hstep); } while (0); PG8_STAGE_U(rsB, g.Bt, PG8_SB(1, 1), cB + hstep + kstep, voffB[0], 0);
        PG8_WAIT_V(6); PG8_BAR;
    } else {
        PG8_STAGE_U(rsB, g.Bt, PG8_SB(0, 0), cB, voffB[0], 0); do { if (g.gidx) PG8_STAGE_R(rsA, g.A, PG8_SA(0, 0), cA, voffAh[0]); else PG8_STAGE_U(rsA, g.A, PG8_SA(0, 0), cA, voffA[0], 0 * hstep); } while (0); PG8_STAGE_U(rsB, g.Bt, PG8_SB(0, 1), cB + hstep, voffB[0], 0); do { if (g.gidx) PG8_STAGE_R(rsA, g.A, PG8_SA(0, 1), cA, voffAh[1]); else PG8_STAGE_U(rsA, g.A, PG8_SA(0, 1), cA, voffA[0], 1 * hstep); } while (0);
        if (wr == 1) PG8_BAR;
        PG8_WAIT_V(4); PG8_BAR;
        PG8_STAGE_U(rsB, g.Bt, PG8_SB(1, 0), cB + kstep, voffB[0], 0); do { if (g.gidx) PG8_STAGE_R(rsA, g.A, PG8_SA(1, 0), cA + kstep, voffAh[0]); else PG8_STAGE_U(rsA, g.A, PG8_SA(1, 0), cA + kstep, voffA[0], 0 * hstep); } while (0); PG8_STAGE_U(rsB, g.Bt, PG8_SB(1, 1), cB + hstep + kstep, voffB[0], 0);
        PG8_WAIT_V(6); PG8_BAR;
    }
    for (;;) {
        const bool has_next = S.next(ui + 1, nxt);
        const char* nA = has_next ? (const char*)g.A + (size_t)nxt.pm * atstep : cA; const char* nB = has_next ? (const char*)g.Bt + (size_t)nxt.pn * tstep : cB;
        for (int t = 0; t < nt; t += 2) {
            const bool last = (t == nt - 2);
            const char* a1 = cA + (size_t)(t + 1) * kstep;
            const char* a2 = last ? nA : cA + (size_t)(t + 2) * kstep; const char* b2 = last ? nB : cB + (size_t)(t + 2) * kstep;
            const char* a3 = a2 + kstep; const char* b3 = b2 + kstep;
            if (last && has_next) S.a_ready(nxt);
            if constexpr (SP2) {
            PG8_LDB(B0, 0, 0); PG8_LDB(B1, 0, 1); PG8_SCHED; PG8_LDA(At, 0, 0); do { if (g.gidx) PG8_STAGE_R(rsA, g.A, PG8_SA(1, 1), a1, voffAh[1]); else PG8_STAGE_U(rsA, g.A, PG8_SA(1, 1), a1, voffA[0], 1 * hstep); } while (0);
            PG8_WAIT_V(8); PG8_WAIT_L(0); PG8_BAR; PG8_MMA(0, 0, At, B0); PG8_MMA(0, 1, At, B1); PG8_BAR; PG8_SCHED;
            PG8_LDA(At, 0, 1); PG8_STAGE_U(rsB, g.Bt, PG8_SB(0, 0), b2, voffB[0], 0); PG8_STAGE_U(rsB, g.Bt, PG8_SB(0, 1), b2 + hstep, voffB[0], 0); do { if (g.gidx) PG8_STAGE_R(rsA, g.A, PG8_SA(0, 0), a2, voffAh[0]); else PG8_STAGE_U(rsA, g.A, PG8_SA(0, 0), a2, voffA[0], 0 * hstep); } while (0);
            PG8_WAIT_V(8); PG8_WAIT_L(0); PG8_BAR; PG8_MMA(1, 0, At, B0); PG8_MMA(1, 1, At, B1); PG8_BAR; PG8_SCHED;
            PG8_LDB(B0, 1, 0); PG8_LDB(B1, 1, 1); PG8_SCHED; PG8_LDA(At, 1, 0); do { if (g.gidx) PG8_STAGE_R(rsA, g.A, PG8_SA(0, 1), a2, voffAh[1]); else PG8_STAGE_U(rsA, g.A, PG8_SA(0, 1), a2, voffA[0], 1 * hstep); } while (0);
            PG8_WAIT_V(8); PG8_WAIT_L(0); PG8_BAR; PG8_MMA(0, 0, At, B0); PG8_MMA(0, 1, At, B1); PG8_BAR; PG8_SCHED;
            PG8_LDA(At, 1, 1); PG8_STAGE_U(rsB, g.Bt, PG8_SB(1, 0), b3, voffB[0], 0); PG8_STAGE_U(rsB, g.Bt, PG8_SB(1, 1), b3 + hstep, voffB[0], 0); do { if (g.gidx) PG8_STAGE_R(rsA, g.A, PG8_SA(1, 0), a3, voffAh[0]); else PG8_STAGE_U(rsA, g.A, PG8_SA(1, 0), a3, voffA[0], 0 * hstep); } while (0);
            PG8_WAIT_V(8); PG8_WAIT_L(0); PG8_BAR; PG8_MMA(1, 0, At, B0); PG8_MMA(1, 1, At, B1); PG8_BAR; PG8_SCHED;
            } else {
            PG8_LDB(B0, 0, 0); PG8_SCHED; PG8_LDA(At, 0, 0); do { if (g.gidx) PG8_STAGE_R(rsA, g.A, PG8_SA(1, 1), a1, voffAh[1]); else PG8_STAGE_U(rsA, g.A, PG8_SA(1, 1), a1, voffA[0], 1 * hstep); } while (0);
            PG8_WAIT_L(8); PG8_BAR; PG8_WAIT_L(0); PG8_MMA(0, 0, At, B0); PG8_BAR; PG8_SCHED;
            PG8_LDB(B1, 0, 1); PG8_STAGE_U(rsB, g.Bt, PG8_SB(0, 0), b2, voffB[0], 0);
            PG8_BAR; PG8_WAIT_L(0); PG8_MMA(0, 1, At, B1); PG8_BAR;
            PG8_LDA(At, 0, 1); do { if (g.gidx) PG8_STAGE_R(rsA, g.A, PG8_SA(0, 0), a2, voffAh[0]); else PG8_STAGE_U(rsA, g.A, PG8_SA(0, 0), a2, voffA[0], 0 * hstep); } while (0);
            PG8_BAR; PG8_WAIT_L(0); PG8_MMA(1, 0, At, B0); PG8_BAR; PG8_SCHED;
            PG8_STAGE_U(rsB, g.Bt, PG8_SB(0, 1), b2 + hstep, voffB[0], 0);
            PG8_WAIT_V(6); PG8_BAR; PG8_MMA(1, 1, At, B1); PG8_BAR;
            PG8_LDB(B0, 1, 0); PG8_SCHED; PG8_LDA(At, 1, 0); do { if (g.gidx) PG8_STAGE_R(rsA, g.A, PG8_SA(0, 1), a2, voffAh[1]); else PG8_STAGE_U(rsA, g.A, PG8_SA(0, 1), a2, voffA[0], 1 * hstep); } while (0);
            PG8_WAIT_L(8); PG8_BAR; PG8_WAIT_L(0); PG8_MMA(0, 0, At, B0); PG8_BAR; PG8_SCHED;
            PG8_LDB(B1, 1, 1); PG8_STAGE_U(rsB, g.Bt, PG8_SB(1, 0), b3, voffB[0], 0);
            PG8_BAR; PG8_WAIT_L(0); PG8_MMA(0, 1, At, B1); PG8_BAR;
            PG8_LDA(At, 1, 1); do { if (g.gidx) PG8_STAGE_R(rsA, g.A, PG8_SA(1, 0), a3, voffAh[0]); else PG8_STAGE_U(rsA, g.A, PG8_SA(1, 0), a3, voffA[0], 0 * hstep); } while (0);
            PG8_BAR; PG8_WAIT_L(0); PG8_MMA(1, 0, At, B0); PG8_BAR; PG8_SCHED;
            PG8_STAGE_U(rsB, g.Bt, PG8_SB(1, 1), b3 + hstep, voffB[0], 0);
            PG8_WAIT_V(6); PG8_BAR; PG8_MMA(1, 1, At, B1); PG8_BAR;
            }
        }
        if constexpr (ALIGN_EPI) { if (wr == 0) PG8_BAR; }
        if constexpr (!Epi::AFTER_DRAIN) { int t2_ = threadIdx.x; asm volatile("" : "+v"(t2_)); const int l2_ = t2_ & 63;
            E(acc, cur, wr, wc, l2_ & 15, l2_ >> 4); S.done(cur); }
        if (!has_next) break;
#pragma unroll
        for (int a = 0; a < 2; ++a)
#pragma unroll
            for (int b = 0; b < 2; ++b)
#pragma unroll
                for (int m = 0; m < 4; ++m)
#pragma unroll
                    for (int n = 0; n < 2; ++n) acc[a][b][m][n] = (f32x4){0.f, 0.f, 0.f, 0.f};
        cur = nxt; cA = nA; cB = nB; ++ui;
        if constexpr (ALIGN_EPI) { if (wr == 1) PG8_BAR; }
    }
    PG8_WAIT_V(0);
    if constexpr (!ALIGN_EPI) { if (wr == 0) PG8_BAR; }
    PG8_BAR;
    if constexpr (Epi::AFTER_DRAIN) { E.fused(acc, cur, wr, wc, fr, fq, lds, wid, lane); S.done(cur); }
#undef PG8_SA
#undef PG8_SB
#undef PG8_STAGE_R
#undef PG8_STAGE_U
#undef PG8_LDA
#undef PG8_LD1
#undef PG8_LDB
#undef PG8_MMA
#undef PG8_WAIT_V
#undef PG8_WAIT_L
#undef PG8_BAR
#undef PG8_SCHED
}
}
namespace mk {
using pg8::bf16_t; using pg8::bf16x8; using pg8::f32x4; using pg8::u32x4; using pg8::Unit; using pg8::Gemm;
#define LAS __attribute__((address_space(3)))
typedef short v4i16 __attribute__((ext_vector_type(4)));
typedef unsigned u32x2 __attribute__((ext_vector_type(2)));

constexpr int D = 1024, NB = 16, NT = 4096, NL = 256;
constexpr int MT = NB * NT, MC = NB * NL, MA = MT + MC;
constexpr int NPROJ = 2816, INC = 2832;
constexpr int NE = 16, FF = 512, CAP = 512;
constexpr float EPS = 1e-6f, LOG2E = 1.4426950408889634f;
constexpr int NWAVES = 8, NTHREADS = 512;
constexpr int LDS_BYTES = 144 * 1024;

constexpr size_t al256(size_t x) { return (x + 255) & ~(size_t)255; }
constexpr size_t WS_MOD = 0;
constexpr size_t WS_ROPE = WS_MOD + al256(17 * 6144 * 4);
constexpr size_t WS_MISC = WS_ROPE + al256(2 * 1024 * 4);
constexpr size_t WS_GATES = WS_MISC + 256;
constexpr size_t WS_AFF = WS_GATES + al256((size_t)MA * 16 * 4);
constexpr size_t WS_IDX = WS_AFF + al256((size_t)NB * NE * NT * 4);
constexpr size_t WS_GATE = WS_IDX + al256(256 * CAP * 4);
constexpr size_t WS_SLOT = WS_GATE + al256(256 * CAP * 4);
constexpr size_t WS_WIN = WS_SLOT + al256((size_t)256 * NT * 4);
constexpr size_t WS_WOUT = WS_WIN + al256((size_t)NPROJ * D * 2);
constexpr size_t WS_WGU = WS_WOUT + al256((size_t)D * D * 2);
constexpr size_t WS_WD = WS_WGU + al256((size_t)NE * 1024 * D * 2);
constexpr size_t WS_HX = WS_WD + al256((size_t)NE * D * FF * 2);
constexpr size_t WS_CQ = WS_HX;
constexpr size_t WS_CK = WS_HX + (size_t)MA * 512 * 2;
constexpr size_t WS_Q = WS_HX + al256((size_t)MA * D * 2);
constexpr size_t WS_KK = WS_Q + al256((size_t)MT * 512 * 2);
constexpr size_t WS_VV = WS_KK + al256((size_t)MA * 128 * 2);
constexpr size_t WS_M4 = WS_VV + al256((size_t)MA * 128 * 2);
constexpr size_t WS_MIX = WS_M4 + al256((size_t)4 * MA * 512 * 2);
constexpr size_t WS_HF = WS_MIX + (size_t)MT * D * 2;
constexpr size_t WS_HB = WS_HF + (size_t)MT * 512 * 2;
constexpr size_t WS_ACT = WS_HB + (size_t)MT * 512 * 2;
constexpr size_t WS_TBL = WS_ACT + al256((size_t)256 * CAP * FF * 2);
constexpr size_t WS_X1 = WS_M4;
static_assert((size_t)MT * D * 2 <= (size_t)136 * 1024 * 1024 && (size_t)136 * 1024 * 1024 + (size_t)256 * CAP * D <= (size_t)4 * MA * 512 * 2, "X1 and the gathered fp8 panels overlay MQ|MK and MV|MO");
constexpr size_t WS_BAR = WS_TBL + al256((size_t)256 * 34 * 384 * 4);
constexpr size_t WS_END = WS_BAR + 16384;
constexpr int LDS_GATE_OFF = 132 * 1024;
constexpr int LDS_BAR_OFF = 140 * 1024;
static_assert(WS_END <= ((size_t)1 << 30), "workspace map exceeds 1 GiB");
static_assert((size_t)256 * CAP * D * 2 <= (size_t)4 * MA * 512 * 2, "XG overlay fits");

struct Args { const float* in[20]; float* out; unsigned char* ws; int ph_lo, ph_hi, sub, pad; };

__device__ __forceinline__ float wave_sum(float v) {
#pragma unroll
    for (int o = 1; o < 64; o <<= 1) v += __shfl_xor(v, o);
    return v;
}
__device__ __forceinline__ float bflo(unsigned w) { return __builtin_bit_cast(float, w << 16); }
__device__ __forceinline__ float bfhi(unsigned w) { return __builtin_bit_cast(float, w & 0xffff0000u); }
typedef float f32x2_t __attribute__((ext_vector_type(2))); typedef __bf16 bf16x2_t __attribute__((ext_vector_type(2)));
__device__ __forceinline__ unsigned pkbf(float lo, float hi) { f32x2_t v = {lo, hi}; bf16x2_t b = __builtin_convertvector(v, bf16x2_t); return __builtin_bit_cast(unsigned, b); }
__device__ __forceinline__ unsigned pk4_fp8(float a, float b, float c, float d) { int p = __builtin_amdgcn_cvt_pk_fp8_f32(a, b, 0, false); p = __builtin_amdgcn_cvt_pk_fp8_f32(c, d, p, true); return (unsigned)p; }
constexpr float FP8_W_UP = 32.f;
constexpr int FP8_W_SCALE = 0x7A7A7A7A;
__device__ __forceinline__ float silu_f(float x) { return x * __builtin_amdgcn_rcpf(1.f + __expf(-x)); }
__device__ __forceinline__ float logsig_f(float x) { return fminf(x, 0.f) - log1pf(expf(-fabsf(x))); }
__device__ __forceinline__ f32x4 mfma16(bf16x8 a, bf16x8 b, f32x4 c) { return __builtin_amdgcn_mfma_f32_16x16x32_bf16(a, b, c, 0, 0, 0); }
__device__ __forceinline__ bf16x8 tr2(const LAS bf16_t* p0, const LAS bf16_t* p1) {
    const v4i16 a = __builtin_amdgcn_ds_read_tr16_b64_v4i16((LAS v4i16*)p0), b = __builtin_amdgcn_ds_read_tr16_b64_v4i16((LAS v4i16*)p1);
    return (bf16x8){a[0], a[1], a[2], a[3], b[0], b[1], b[2], b[3]};
}
__device__ __forceinline__ bf16x8 pack8(const f32x4 a, const f32x4 b) {
    u32x4 w; w.x = pkbf(a[0], a[1]); w.y = pkbf(a[2], a[3]); w.z = pkbf(b[0], b[1]); w.w = pkbf(b[2], b[3]); return __builtin_bit_cast(bf16x8, w);
}
__host__ __device__ __forceinline__ int win_dst_row(int n) {
    if (n >= 768) return n;
    const int pn = n >> 8, r = n & 255, wc = r >> 6, bj = (r >> 5) & 1, p = r & 31;
    return 256 * pn + 128 * bj + 32 * wc + p;
}

__device__ __forceinline__ void transpose_item(const float* W, int N, int k0, int n0, bf16_t* WT, int K, int drow0, LAS float* scr, int lane) {
    float tv[32];
#pragma unroll
    for (int i = 0; i < 32; ++i) tv[i] = W[(size_t)(k0 + 2 * i + (lane >> 5)) * N + n0 + (lane & 31)];
#pragma unroll
    for (int i = 0; i < 32; ++i) scr[(2 * i + (lane >> 5)) * 33 + (lane & 31)] = tv[i];
    asm volatile("s_waitcnt lgkmcnt(0)" ::: "memory");
    const int c = lane & 7;
#pragma unroll
    for (int j = 0; j < 4; ++j) { const int n = (lane >> 3) + 8 * j; const LAS float* s = scr + (8 * c) * 33 + n;
        u32x4 o; o.x = pkbf(s[0 * 33], s[1 * 33]); o.y = pkbf(s[2 * 33], s[3 * 33]); o.z = pkbf(s[4 * 33], s[5 * 33]); o.w = pkbf(s[6 * 33], s[7 * 33]);
        *(u32x4*)(WT + (size_t)(drow0 + n) * K + k0 + 8 * c) = o; }
    asm volatile("s_waitcnt lgkmcnt(0)" ::: "memory");
}
__device__ __forceinline__ void transpose_item8(const float* W, int N, int k0, int n0, unsigned char* WT, int K, int drow0, LAS float* scr, int lane) {
    float tv[32];
#pragma unroll
    for (int i = 0; i < 32; ++i) tv[i] = W[(size_t)(k0 + 2 * i + (lane >> 5)) * N + n0 + (lane & 31)];
#pragma unroll
    for (int i = 0; i < 32; ++i) scr[(2 * i + (lane >> 5)) * 33 + (lane & 31)] = tv[i];
    asm volatile("s_waitcnt lgkmcnt(0)" ::: "memory");
    const int c = lane & 7;
#pragma unroll
    for (int j = 0; j < 4; ++j) { const int n = (lane >> 3) + 8 * j; const LAS float* s = scr + (8 * c) * 33 + n;
        u32x2 o; o.x = pk4_fp8(s[0 * 33] * FP8_W_UP, s[1 * 33] * FP8_W_UP, s[2 * 33] * FP8_W_UP, s[3 * 33] * FP8_W_UP); o.y = pk4_fp8(s[4 * 33] * FP8_W_UP, s[5 * 33] * FP8_W_UP, s[6 * 33] * FP8_W_UP, s[7 * 33] * FP8_W_UP);
        *(u32x2*)(WT + (size_t)(drow0 + n) * K + k0 + 8 * c) = o; }
    asm volatile("s_waitcnt lgkmcnt(0)" ::: "memory");
}
__device__ __forceinline__ void phase0(const Args& a, LAS unsigned char* lds) {
    const int tid = threadIdx.x, lane = tid & 63, wave = tid >> 6, wg = blockIdx.x, G = gridDim.x;
    unsigned char* ws = a.ws;
    {
        LAS float* sc = (LAS float*)lds;
        LAS float* part = sc + 17 * 1024;
        const float* c = a.in[1]; const float* cctx = a.in[3]; const float* w_mod = a.in[4]; const float* b_mod = a.in[5];
        float* mod = (float*)(ws + WS_MOD);
        for (int i = tid; i < 17 * 1024; i += NTHREADS) { const int r = i >> 10, k = i & 1023; const float v = r < 16 ? c[r * 1024 + k] : cctx[k]; sc[i] = v / (1.f + expf(-v)); }
        __syncthreads();
        for (int it = wg; it < 256; it += G) {
            const int col0 = it * 24;
            if (tid < 504) {
                const int j = tid % 24, kg = tid / 24; float acc[17];
#pragma unroll
                for (int r = 0; r < 17; ++r) acc[r] = 0.f;
#pragma unroll 7
                for (int k = kg; k < 1024; k += 21) { const float w = w_mod[(size_t)k * 6144 + col0 + j];
#pragma unroll
                    for (int r = 0; r < 17; ++r) acc[r] += sc[r * 1024 + k] * w; }
#pragma unroll
                for (int r = 0; r < 17; ++r) part[(kg * 17 + r) * 24 + j] = acc[r];
            }
            __syncthreads();
            if (tid < 408) { const int r = tid / 24, j = tid % 24; float s = b_mod[col0 + j]; for (int kg = 0; kg < 21; ++kg) s += part[(kg * 17 + r) * 24 + j]; mod[r * 6144 + col0 + j] = s; }
            __syncthreads();
        }
    }
    if (wg == 0) {
        float* rope = (float*)(ws + WS_ROPE);
        for (int i = tid; i < 1024; i += NTHREADS) { const int pos = i >> 4, f = i & 15; const float ang = (float)pos * powf(10000.f, -(float)f / 16.f); rope[i] = cosf(ang); rope[1024 + i] = sinf(ang); }
        if (tid == 0) { float mq = 0.f, mkk = 0.f; for (int i = 0; i < 64; ++i) { mq = fmaxf(mq, fabsf(a.in[11][i])); mkk = fmaxf(mkk, fabsf(a.in[12][i])); }
            ((float*)(ws + WS_MISC))[0] = fmaxf(0.f, 8.f * mq * mkk * LOG2E - 16.f); }
    }
    {
        LAS float* scr = (LAS float*)lds + wave * (64 * 33);
        const int gw = wg * NWAVES + wave, NGW = G * NWAVES;
        bf16_t* WIN = (bf16_t*)(ws + WS_WIN);
        for (int it = gw; it < 16 * 88; it += NGW) { const int kb = it / 88, nb = it % 88; transpose_item(a.in[8], INC, 64 * kb, 32 * nb, WIN, D, win_dst_row(32 * nb), scr, lane); }
    }
}
__device__ __forceinline__ void transpose_late(const Args& a, LAS unsigned char* lds) {
    const int tid = threadIdx.x, lane = tid & 63, wave = tid >> 6, wg = blockIdx.x, G = gridDim.x;
    unsigned char* ws = a.ws;
    LAS float* scr = (LAS float*)lds + wave * (64 * 33);
    const int gw = wg * NWAVES + wave, NGW = G * NWAVES;
    constexpr int I_OUT = 16 * 32, I_G = 16 * 16, I_D = 8 * 32;
    constexpr int NITEMS = I_OUT + NE * (2 * I_G + I_D);
    bf16_t* WOUT = (bf16_t*)(ws + WS_WOUT); unsigned char* WGU = ws + WS_WGU; unsigned char* WDT = ws + WS_WD;
    for (int it = gw; it < NITEMS; it += NGW) {
        int r = it;
        if (r < I_OUT) { const int kb = r / 32, nb = r % 32; transpose_item(a.in[15], D, 64 * kb, 32 * nb, WOUT, D, 32 * nb, scr, lane); continue; } r -= I_OUT;
        const int e = r / (2 * I_G + I_D); r -= e * (2 * I_G + I_D);
        if (r < 2 * I_G) { const int up = r / I_G, rr = r % I_G, kb = rr / 16, nb = rr % 16, n0 = 32 * nb;
            transpose_item8((up ? a.in[18] : a.in[17]) + (size_t)e * D * FF, FF, 64 * kb, n0, WGU + (size_t)e * 1024 * D, D, 256 * (n0 >> 7) + (n0 & 127) + 128 * up, scr, lane); continue; }
        r -= 2 * I_G;
        { const int kb = r / 32, nb = r % 32; transpose_item8(a.in[19] + (size_t)e * FF * D, D, 64 * kb, 32 * nb, WDT + (size_t)e * D * FF, FF, 32 * nb, scr, lane); }
    }
}

__device__ __forceinline__ void fill_w16(LAS float* W16, const float* src, int pitch, int tid) {
    for (int idx = tid; idx < 1024 * 16; idx += NTHREADS) { const int k = idx >> 4, t = idx & 15; const int ln = (k & 255) >> 2, i = k & 3, j = k >> 8;
        W16[((j * 4 + i) * 64 + ln) * 20 + t] = src[(size_t)k * pitch + t]; }
}
__device__ __forceinline__ float reduce16(const float (&g)[16], int lane) {
    float r8[8], r4[4], r2[2];
    const bool b5 = (lane & 32) != 0, b4 = (lane & 16) != 0, b3 = (lane & 8) != 0, b2 = (lane & 4) != 0;
#pragma unroll
    for (int t = 0; t < 8; ++t) { const float keep = b5 ? g[t + 8] : g[t], send = b5 ? g[t] : g[t + 8]; r8[t] = keep + __shfl_xor(send, 32); }
#pragma unroll
    for (int t = 0; t < 4; ++t) { const float keep = b4 ? r8[t + 4] : r8[t], send = b4 ? r8[t] : r8[t + 4]; r4[t] = keep + __shfl_xor(send, 16); }
#pragma unroll
    for (int t = 0; t < 2; ++t) { const float keep = b3 ? r4[t + 2] : r4[t], send = b3 ? r4[t] : r4[t + 2]; r2[t] = keep + __shfl_xor(send, 8); }
    const float keep = b2 ? r2[1] : r2[0], send = b2 ? r2[0] : r2[1];
    float r1 = keep + __shfl_xor(send, 4);
    r1 += __shfl_xor(r1, 1); r1 += __shfl_xor(r1, 2);
    return r1;
}
__device__ __forceinline__ int reduce16_index(int lane) { return ((lane >> 5) & 1) * 8 + ((lane >> 4) & 1) * 4 + ((lane >> 3) & 1) * 2 + ((lane >> 2) & 1); }
__device__ __forceinline__ void rows2_norm_dots(f32x4 (&va)[4], f32x4 (&vb)[4], const f32x4 (&sc)[4], const f32x4 (&sh)[4], const LAS float* W16, int lane, float& ga, float& gb) {
    float sa = 0.f, sb = 0.f;
#pragma unroll
    for (int j = 0; j < 4; ++j) { sa += (va[j][0] * va[j][0] + va[j][1] * va[j][1]) + (va[j][2] * va[j][2] + va[j][3] * va[j][3]); sb += (vb[j][0] * vb[j][0] + vb[j][1] * vb[j][1]) + (vb[j][2] * vb[j][2] + vb[j][3] * vb[j][3]); }
    const float ra = rsqrtf(wave_sum(sa) * (1.f / D) + EPS), rb = rsqrtf(wave_sum(sb) * (1.f / D) + EPS);
    float g0[16], g1[16];
#pragma unroll
    for (int t = 0; t < 16; ++t) { g0[t] = 0.f; g1[t] = 0.f; }
    int off0 = lane * 20, off1 = lane * 20;
#pragma unroll
    for (int j = 0; j < 4; ++j) {
        va[j] = va[j] * ra * sc[j] + sh[j]; vb[j] = vb[j] * rb * sc[j] + sh[j];
#pragma unroll
        for (int i = 0; i < 4; ++i) { const int off = (i & 1) ? off1 : off0; const LAS f32x4* wp = (const LAS f32x4*)(W16 + (j * 4 + i) * 64 * 20 + off); const float ha = va[j][i], hb = vb[j][i];
#pragma unroll
            for (int q = 0; q < 4; ++q) { const f32x4 w = wp[q];
                g0[4 * q + 0] += ha * w[0]; g0[4 * q + 1] += ha * w[1]; g0[4 * q + 2] += ha * w[2]; g0[4 * q + 3] += ha * w[3];
                g1[4 * q + 0] += hb * w[0]; g1[4 * q + 1] += hb * w[1]; g1[4 * q + 2] += hb * w[2]; g1[4 * q + 3] += hb * w[3]; }
            if (i & 1) asm volatile("" : "+v"(off1), "+v"(g0[0]), "+v"(g0[1]), "+v"(g0[2]), "+v"(g0[3]), "+v"(g0[4]), "+v"(g0[5]), "+v"(g0[6]), "+v"(g0[7]), "+v"(g0[8]), "+v"(g0[9]), "+v"(g0[10]), "+v"(g0[11]), "+v"(g0[12]), "+v"(g0[13]), "+v"(g0[14]), "+v"(g0[15])); else asm volatile("" : "+v"(off0), "+v"(g0[0]), "+v"(g0[1]), "+v"(g0[2]), "+v"(g0[3]), "+v"(g0[4]), "+v"(g0[5]), "+v"(g0[6]), "+v"(g0[7]), "+v"(g0[8]), "+v"(g0[9]), "+v"(g0[10]), "+v"(g0[11]), "+v"(g0[12]), "+v"(g0[13]), "+v"(g0[14]), "+v"(g0[15]));
            asm volatile("" : "+v"(g1[0]), "+v"(g1[1]), "+v"(g1[2]), "+v"(g1[3]), "+v"(g1[4]), "+v"(g1[5]), "+v"(g1[6]), "+v"(g1[7]), "+v"(g1[8]), "+v"(g1[9]), "+v"(g1[10]), "+v"(g1[11]), "+v"(g1[12]), "+v"(g1[13]), "+v"(g1[14]), "+v"(g1[15])); }
    }
    ga = reduce16(g0, lane); gb = reduce16(g1, lane);
}
__device__ __forceinline__ void store_row_bf16(bf16_t* orow, const f32x4 (&v)[4], int lane) {
#pragma unroll
    for (int j = 0; j < 4; ++j) { u32x2 o; o.x = pkbf(v[j][0], v[j][1]); o.y = pkbf(v[j][2], v[j][3]); *(u32x2*)(orow + 4 * lane + 256 * j) = o; }
}
__device__ __forceinline__ void p1_build(const Args& a, LAS unsigned char* lds, int b, int tid) {
    const float* mr = (const float*)(a.ws + WS_MOD) + b * 6144; const float* n1w = a.in[6]; const float* Wg = a.in[8] + NPROJ; const float* bg = a.in[9];
    LAS bf16_t* WB = (LAS bf16_t*)lds; LAS float* SC = (LAS float*)(lds + 32768); LAS float* SH = (LAS float*)(lds + 36864); LAS float* CP = (LAS float*)(lds + 40960);
    for (int c = tid; c < D; c += NTHREADS) {
        const float scv = n1w[c] * (1.f + mr[D + c]); SC[c] = scv; SH[c] = mr[c];
        const int fi = ((c >> 6) * 2 + ((c >> 5) & 1)) * 64 + ((c >> 3) & 3) * 16, ee = c & 7;
#pragma unroll
        for (int j = 0; j < 4; ++j) { const f32x4 w = *(const f32x4*)(Wg + (size_t)c * INC + 4 * j);
#pragma unroll
            for (int i = 0; i < 4; ++i) WB[((fi + 4 * j + i) << 3) + ee] = (bf16_t)(pkbf(scv * w[i], 0.f) & 0xffffu); }
    }
    { const int e = tid & 15, part = tid >> 4; float cb = 0.f;
#pragma unroll 4
        for (int i = 0; i < 32; ++i) { const int c = part * 32 + i; cb += mr[c] * Wg[(size_t)c * INC + e]; }
        CP[part * 16 + e] = cb; }
    __syncthreads();
    if (tid < 16) { float t = bg[tid]; for (int p = 0; p < 32; ++p) t += CP[p * 16 + tid]; CP[512 + tid] = t; }
    __syncthreads();
}
#define P1_ROWPTR(m) ((m) < MT ? a.in[0] + (size_t)(m) * D : a.in[2] + (size_t)((m) - MT) * D)
__device__ __forceinline__ void p1_tiles(const Args& a, LAS unsigned char* lds, int row_base, int ntiles) {
    const int tid = threadIdx.x, lane = tid & 63, wave = tid >> 6, fr = lane & 15, kq = lane >> 4;
    const LAS bf16_t* WB = (const LAS bf16_t*)lds; const LAS float* SC = (const LAS float*)(lds + 32768); const LAS float* SH = (const LAS float*)(lds + 36864); const LAS float* CP = (const LAS float*)(lds + 40960);
    bf16_t* HX = (bf16_t*)(a.ws + WS_HX); float* GATES = (float*)(a.ws + WS_GATES);
    const float cbe = CP[512 + fr]; const bool isf = ((fr >> 2) & 1) != 0;
#pragma unroll 1
    for (int t0 = wave; t0 < ntiles; t0 += NWAVES) {
        int row = row_base + 8 * t0 + (lane & 7); asm volatile("" : "+v"(row));
        const int cl = 8 * (4 * ((lane >> 3) & 1) + kq);
        const float* xp = P1_ROWPTR(row) + cl;
        f32x4 xv[32];
#pragma unroll
        for (int s = 0; s < 16; ++s) { xv[2 * s] = *(const f32x4*)(xp + 64 * s); xv[2 * s + 1] = *(const f32x4*)(xp + 64 * s + 4); }
        f32x4 acc0 = {0.f, 0.f, 0.f, 0.f}, acc1 = {0.f, 0.f, 0.f, 0.f}; float ss = 0.f;
        int boff = lane * 8, coff = cl; asm volatile("" : "+v"(boff), "+v"(coff));
#pragma unroll
        for (int g = 0; g < 4; ++g) {
            bf16x8 B0[4], B1[4];
#pragma unroll
            for (int i = 0; i < 4; ++i) { B0[i] = *(const LAS bf16x8*)(WB + boff + (4 * g + i) * 1024); B1[i] = *(const LAS bf16x8*)(WB + boff + (4 * g + i) * 1024 + 512); }
#pragma unroll
            for (int i = 0; i < 4; ++i) { const f32x4 v0 = xv[8 * g + 2 * i], v1 = xv[8 * g + 2 * i + 1];
                u32x4 pk; pk.x = pkbf(v0[0], v0[1]); pk.y = pkbf(v0[2], v0[3]); pk.z = pkbf(v1[0], v1[1]); pk.w = pkbf(v1[2], v1[3]);
                const bf16x8 A = __builtin_bit_cast(bf16x8, pk);
                acc0 = mfma16(A, B0[i], acc0); acc1 = mfma16(A, B1[i], acc1);
                ss += (v0[0] * v0[0] + v0[1] * v0[1]) + (v0[2] * v0[2] + v0[3] * v0[3]) + (v1[0] * v1[0] + v1[1] * v1[1]) + (v1[2] * v1[2] + v1[3] * v1[3]); }
            asm volatile("" : "+v"(boff), "+v"(acc0), "+v"(acc1));
        }
        ss += __shfl_xor(ss, 8); ss += __shfl_xor(ss, 16); ss += __shfl_xor(ss, 32);
        const float rstd = rsqrtf(ss * (1.f / D) + EPS);
#pragma unroll
        for (int i = 0; i < 4; ++i) {
            float gv = (acc0[i] + __shfl_xor(acc1[i], 32)) * __shfl(rstd, (4 * kq + i) & 7) + cbe;
            if (isf) gv = logsig_f(gv);
            if (lane < 32) GATES[(size_t)(row_base + 8 * t0 + 4 * kq + i) * 16 + fr] = gv;
        }
        bf16_t* hp = HX + (size_t)row * D + cl;
#pragma unroll
        for (int s = 0; s < 16; ++s) {
            const int c0 = 64 * s + coff;
            const f32x4 s0 = *(const LAS f32x4*)(SC + c0), s1 = *(const LAS f32x4*)(SC + c0 + 4), h0 = *(const LAS f32x4*)(SH + c0), h1 = *(const LAS f32x4*)(SH + c0 + 4);
            const f32x4 o0 = xv[2 * s] * rstd * s0 + h0, o1 = xv[2 * s + 1] * rstd * s1 + h1;
            u32x4 o; o.x = pkbf(o0[0], o0[1]); o.y = pkbf(o0[2], o0[3]); o.z = pkbf(o1[0], o1[1]); o.w = pkbf(o1[2], o1[3]);
            *(u32x4*)(hp + 64 * s) = o;
        }
    }
}
__device__ __forceinline__ void phase1(const Args& a, LAS unsigned char* lds) {
    const int tid = threadIdx.x, c = blockIdx.x;
    for (int pm = c; pm < 256; pm += gridDim.x) {
        p1_build(a, lds, pm >> 4, tid);
        p1_tiles(a, lds, pm * 256, 32);
        __syncthreads();
        p1_build(a, lds, 16, tid);
        p1_tiles(a, lds, MT + pm * 16, 2);
        __syncthreads();
    }
}
#undef P1_ROWPTR

struct SeqOrder {
    int pm0, nN, n;
    __device__ __forceinline__ bool next(int i, Unit& u) const { if (i >= n) return false; u.pm = pm0 + i / nN; u.pn = i % nN; return true; }
    __device__ __forceinline__ void a_ready(const Unit&) const {}
    __device__ __forceinline__ void done(const Unit&) const {}
};
struct EpiProj {
    static constexpr bool PERM = true, AFTER_DRAIN = false;
    bf16_t *Q, *KK, *VV, *M4; const float *qw, *kw, *rope; float qscale;
    __device__ __forceinline__ void operator()(const f32x4 (&acc)[2][2][4][2], const Unit& u, int wr, int wc, int fr, int fq) const {
        const int pn = u.pn, row0 = u.pm * 256 + wr * 64 + fr;
        bf16_t *Q_ = Q, *KK_ = KK, *VV_ = VV, *M4_ = M4; asm volatile("" : "+s"(Q_), "+s"(KK_), "+s"(VV_), "+s"(M4_));
        if (pn >= 3) {
            bf16_t* base = M4_ + (size_t)((pn - 3) >> 1) * MA * 512 + ((pn - 3) & 1) * 256 + wc * 32 + 8 * fq;
#pragma unroll
            for (int ai = 0; ai < 2; ++ai)
#pragma unroll
                for (int m = 0; m < 4; ++m) { bf16_t* rowp = base + (size_t)(row0 + ai * 128 + m * 16) * 512;
#pragma unroll
                    for (int bj = 0; bj < 2; ++bj) { const f32x4 v0 = acc[ai][bj][m][0], v1 = acc[ai][bj][m][1]; u32x4 w; w.x = pkbf(v0[0], v0[1]); w.y = pkbf(v0[2], v0[3]); w.z = pkbf(v1[0], v1[1]); w.w = pkbf(v1[2], v1[3]);
                        *(u32x4*)(rowp + bj * 128) = w; } }
            return;
        }
        const bool latent = u.pm < 256;
        if (pn < 2 && !latent) return;
        const bool isv = (pn == 2) && (wc >= 2);
        bf16_t* dst; int ld; const float* nw; float osc = 1.f;
        if (pn < 2) { dst = Q_ + (4 * pn + wc) * 64; ld = 512; nw = qw; osc = qscale; }
        else if (!isv) { dst = KK_ + wc * 64; ld = 128; nw = kw; }
        else { dst = VV_ + (wc - 2) * 64; ld = 128; nw = kw; }
        f32x4 w4[2][2];
#pragma unroll
        for (int bj = 0; bj < 2; ++bj)
#pragma unroll
            for (int n = 0; n < 2; ++n) w4[bj][n] = *(const f32x4*)(nw + 32 * bj + 8 * fq + 4 * n);
#pragma unroll
        for (int ai = 0; ai < 2; ++ai)
#pragma unroll
            for (int m = 0; m < 4; ++m) {
                const int row = row0 + ai * 128 + m * 16;
                f32x4 y[2][2];
#pragma unroll
                for (int bj = 0; bj < 2; ++bj)
#pragma unroll
                    for (int n = 0; n < 2; ++n) y[bj][n] = acc[ai][bj][m][n];
                if (!isv) {
                    float ss = 0.f;
#pragma unroll
                    for (int bj = 0; bj < 2; ++bj)
#pragma unroll
                        for (int n = 0; n < 2; ++n) ss += (y[bj][n][0] * y[bj][n][0] + y[bj][n][1] * y[bj][n][1]) + (y[bj][n][2] * y[bj][n][2] + y[bj][n][3] * y[bj][n][3]);
                    ss += __shfl_xor(ss, 16); ss += __shfl_xor(ss, 32);
                    const float rinv = rsqrtf(ss * (1.f / 64.f) + EPS);
#pragma unroll
                    for (int bj = 0; bj < 2; ++bj)
#pragma unroll
                        for (int n = 0; n < 2; ++n) y[bj][n] = y[bj][n] * rinv * w4[bj][n];
                    if (latent) {
                        const int ntok = row & (NT - 1); const int pos = (fq < 2) ? (ntok >> 6) : (ntok & 63);
                        const float* rp = rope + pos * 16 + 8 * (fq & 1);
#pragma unroll
                        for (int n = 0; n < 2; ++n) { const f32x4 cs = *(const f32x4*)(rp + 4 * n), sn = *(const f32x4*)(rp + 1024 + 4 * n);
                            const f32x4 x1 = y[0][n], x2 = y[1][n]; y[0][n] = x1 * cs - x2 * sn; y[1][n] = x2 * cs + x1 * sn; }
                    }
                }
                bf16_t* rowp = dst + (size_t)row * ld + 8 * fq;
#pragma unroll
                for (int bj = 0; bj < 2; ++bj) { const f32x4 v0 = y[bj][0] * osc, v1 = y[bj][1] * osc; u32x4 w; w.x = pkbf(v0[0], v0[1]); w.y = pkbf(v0[2], v0[3]); w.z = pkbf(v1[0], v1[1]); w.w = pkbf(v1[2], v1[3]);
                    *(u32x4*)(rowp + 32 * bj) = w; }
            }
    }
};
struct EpiOut {
    static constexpr bool PERM = true, AFTER_DRAIN = false;
    const float* x; const float* mod; bf16_t* X1;
    __device__ __forceinline__ void operator()(const f32x4 (&acc)[2][2][4][2], const Unit& u, int wr, int wc, int fr, int fq) const {
        typedef const float __attribute__((address_space(1))) GF; typedef bf16_t __attribute__((address_space(1))) GB; typedef const f32x4 __attribute__((address_space(1))) GF4; typedef u32x4 __attribute__((address_space(1))) GU4;
        const int row0 = u.pm * 256 + wr * 64 + fr, col0 = u.pn * 256 + wc * 32 + 8 * fq;
        const float* x_ = x; bf16_t* out_ = X1; asm volatile("" : "+s"(x_), "+s"(out_));
        GF* xg = (GF*)x_ + (size_t)row0 * D + col0; GB* og = (GB*)out_ + (size_t)row0 * D + col0;
        const float* g1 = mod + (u.pm >> 4) * 6144 + 2 * D;
        f32x4 gv[2][2];
#pragma unroll
        for (int bj = 0; bj < 2; ++bj)
#pragma unroll
            for (int n = 0; n < 2; ++n) gv[bj][n] = *(const f32x4*)(g1 + col0 + bj * 128 + n * 4);
        f32x4 xr[8][2][2];
#define MK_EO_LD(b) do { const size_t off = (size_t)(((b) >> 2) * 128 + ((b) & 3) * 16) * D; _Pragma("unroll") for (int bj = 0; bj < 2; ++bj) { xr[b][bj][0] = *(GF4*)(xg + off + bj * 128); xr[b][bj][1] = *(GF4*)(xg + off + bj * 128 + 4); } } while (0)
        MK_EO_LD(0); MK_EO_LD(1); MK_EO_LD(2); MK_EO_LD(3);
#pragma unroll
        for (int b = 0; b < 8; ++b) {
            const int ai = b >> 2, m = b & 3; const size_t off = (size_t)(ai * 128 + m * 16) * D;
#pragma unroll
            for (int bj = 0; bj < 2; ++bj) { const f32x4 o0 = xr[b][bj][0] + gv[bj][0] * acc[ai][bj][m][0], o1 = xr[b][bj][1] + gv[bj][1] * acc[ai][bj][m][1];
                u32x4 w; w.x = pkbf(o0[0], o0[1]); w.y = pkbf(o0[2], o0[3]); w.z = pkbf(o1[0], o1[1]); w.w = pkbf(o1[2], o1[3]);
                *(GU4*)(og + off + bj * 128) = w; }
            if (b + 4 < 8) { switch (b) { case 0: MK_EO_LD(4); break; case 1: MK_EO_LD(5); break; case 2: MK_EO_LD(6); break; default: MK_EO_LD(7); break; } }
        }
#undef MK_EO_LD
    }
};
struct EpiAct {
    static constexpr bool PERM = true, AFTER_DRAIN = false;
    unsigned char* ACT;
    __device__ __forceinline__ void operator()(const f32x4 (&acc)[2][2][4][2], const Unit& u, int wr, int wc, int fr, int fq) const {
        const int row0 = u.pm * 256 + wr * 64 + fr, col0 = u.pn * 128 + wc * 32 + 8 * fq;
        unsigned char* ACT_ = ACT; asm volatile("" : "+s"(ACT_));
#pragma unroll
        for (int ai = 0; ai < 2; ++ai)
#pragma unroll
            for (int m = 0; m < 4; ++m) { f32x4 o[2];
#pragma unroll
                for (int n = 0; n < 2; ++n) { const f32x4 gt = acc[ai][0][m][n], up = acc[ai][1][m][n];
#pragma unroll
                    for (int j = 0; j < 4; ++j) o[n][j] = silu_f(gt[j] * (1.f / FP8_W_UP)) * (up[j] * (1.f / FP8_W_UP)); }
                u32x2 w; w.x = pk4_fp8(o[0][0], o[0][1], o[0][2], o[0][3]); w.y = pk4_fp8(o[1][0], o[1][1], o[1][2], o[1][3]);
                *(u32x2*)(ACT_ + (size_t)(row0 + ai * 128 + m * 16) * FF + col0) = w; asm volatile("" ::: "memory"); }
    }
};
struct EpiDown {
    static constexpr bool PERM = true, AFTER_DRAIN = false;
    bf16_t* Y; const LAS float* gate; float FP8SC;
    __device__ __forceinline__ void operator()(const f32x4 (&acc)[2][2][4][2], const Unit& u, int wr, int wc, int fr, int fq) const {
        const int row0 = u.pm * 256 + wr * 64 + fr, col0 = u.pn * 256 + wc * 32 + 8 * fq;
        bf16_t* Y_ = Y; const LAS float* gate_ = gate; asm volatile("" : "+s"(Y_));
#pragma unroll
        for (int ai = 0; ai < 2; ++ai)
#pragma unroll
            for (int m = 0; m < 4; ++m) { const int row = row0 + ai * 128 + m * 16; const float gt = gate_[row] * FP8SC;
#pragma unroll
                for (int bj = 0; bj < 2; ++bj) { const f32x4 v0 = acc[ai][bj][m][0] * gt, v1 = acc[ai][bj][m][1] * gt; u32x4 w; w.x = pkbf(v0[0], v0[1]); w.y = pkbf(v0[2], v0[3]); w.z = pkbf(v1[0], v1[1]); w.w = pkbf(v1[2], v1[3]);
                    *(u32x4*)(Y_ + (size_t)row * D + col0 + bj * 128) = w; } asm volatile("" ::: "memory"); }
    }
};

__device__ __forceinline__ void conv_rows(const Args& a) {
    const int tid = threadIdx.x, lane = tid & 63, wave = tid >> 6;
    const bf16_t* MQ = (const bf16_t*)(a.ws + WS_M4); const bf16_t* MK = MQ + (size_t)MA * 512;
    bf16_t* CQ = (bf16_t*)(a.ws + WS_CQ); bf16_t* CK = (bf16_t*)(a.ws + WS_CK);
    const float* conv = a.in[10];
    f32x4 wq[3][2], wk[3][2];
#pragma unroll
    for (int j = 0; j < 3; ++j) { wq[j][0] = *(const f32x4*)(conv + j * 1024 + 8 * lane); wq[j][1] = *(const f32x4*)(conv + j * 1024 + 8 * lane + 4);
        wk[j][0] = *(const f32x4*)(conv + j * 1024 + 512 + 8 * lane); wk[j][1] = *(const f32x4*)(conv + j * 1024 + 512 + 8 * lane + 4); }
    const int gw = blockIdx.x * NWAVES + wave, NGW = gridDim.x * NWAVES;
    const int per = (MA + NGW - 1) / NGW; const int r0 = gw * per, r1 = min(MA, r0 + per);
    if (r0 >= r1) return;
    const u32x4 zero = {0u, 0u, 0u, 0u};
#define CV_POS(m) ((m) < MT ? ((m) & (NT - 1)) : (((m) - MT) & (NL - 1)))
#define CV_LEN(m) ((m) < MT ? NT : NL)
#define CV_LD(dst, buf, m) do { dst = ((m) >= 0 && (m) < MA) ? *(const u32x4*)(buf + (size_t)(m) * 512 + 8 * lane) : zero; } while (0)
    u32x4 wq_[6], wk_[6], nq_[4], nk_[4];
#pragma unroll
    for (int i = 0; i < 6; ++i) { CV_LD(wq_[i], MQ, r0 - 1 + i); CV_LD(wk_[i], MK, r0 - 1 + i); }
#pragma unroll 1
    for (int m = r0; m < r1; m += 4) {
#pragma unroll
        for (int i = 0; i < 4; ++i) { CV_LD(nq_[i], MQ, m + 5 + i); CV_LD(nk_[i], MK, m + 5 + i); }
#pragma unroll
        for (int u = 0; u < 4; ++u) {
            const int mm = m + u;
            if (mm < r1) {
                const int p = CV_POS(mm), len = CV_LEN(mm); const bool first = (p == 0), last = (p == len - 1);
                const u32x4 qp = wq_[u], qc = wq_[u + 1], qn = wq_[u + 2], kp = wk_[u], kc = wk_[u + 1], kn = wk_[u + 2];
                u32x4 oq, ok;
#pragma unroll
                for (int e = 0; e < 4; ++e) {
                    const float ql0 = first ? 0.f : bflo(qp[e]), qh0 = first ? 0.f : bfhi(qp[e]), ql2 = last ? 0.f : bflo(qn[e]), qh2 = last ? 0.f : bfhi(qn[e]);
                    const float kl0 = first ? 0.f : bflo(kp[e]), kh0 = first ? 0.f : bfhi(kp[e]), kl2 = last ? 0.f : bflo(kn[e]), kh2 = last ? 0.f : bfhi(kn[e]);
                    const int h2 = e >> 1, i0 = (2 * e) & 3, i1 = (2 * e + 1) & 3;
                    const float uq0 = silu_f(ql0 * wq[0][h2][i0] + bflo(qc[e]) * wq[1][h2][i0] + ql2 * wq[2][h2][i0]) * 0.08838834764831845f;
                    const float uq1 = silu_f(qh0 * wq[0][h2][i1] + bfhi(qc[e]) * wq[1][h2][i1] + qh2 * wq[2][h2][i1]) * 0.08838834764831845f;
                    const float uk0 = silu_f(kl0 * wk[0][h2][i0] + bflo(kc[e]) * wk[1][h2][i0] + kl2 * wk[2][h2][i0]);
                    const float uk1 = silu_f(kh0 * wk[0][h2][i1] + bfhi(kc[e]) * wk[1][h2][i1] + kh2 * wk[2][h2][i1]);
                    oq[e] = pkbf(uq0, uq1); ok[e] = pkbf(uk0, uk1);
                }
                *(u32x4*)(CQ + (size_t)mm * 512 + 8 * lane) = oq; *(u32x4*)(CK + (size_t)mm * 512 + 8 * lane) = ok;
            }
        }
        wq_[0] = wq_[4]; wq_[1] = wq_[5]; wk_[0] = wk_[4]; wk_[1] = wk_[5];
#pragma unroll
        for (int i = 0; i < 4; ++i) { wq_[2 + i] = nq_[i]; wk_[2 + i] = nk_[i]; }
    }
#undef CV_LD
#undef CV_POS
#undef CV_LEN
}

constexpr int AT_STRIDE = 72;
constexpr int AT_K = 0, AT_V = 384 * AT_STRIDE * 2;
__device__ __forceinline__ void attn_tile(const LAS bf16_t* AK, const LAS bf16_t* AV, int kb, bool masked, int kpos_base  , int qpos0  ,
                                          const bf16x8 (&Qf)[4][2], f32x4 (&O)[4][4], float (&ls)[4], float cshift, int fr, int fq) {
    const int q4 = fr >> 2, p4 = fr & 3;
#pragma unroll
    for (int kk2 = 0; kk2 < 2; ++kk2) {
        f32x4 S[2][4];
#pragma unroll
        for (int hh = 0; hh < 2; ++hh) {
            const LAS bf16_t* kp = AK + (kb + 32 * kk2 + 16 * hh + fr) * AT_STRIDE + 8 * fq;
            const bf16x8 A0 = *(const LAS bf16x8*)kp, A1 = *(const LAS bf16x8*)(kp + 32);
#pragma unroll
            for (int qt = 0; qt < 4; ++qt) { f32x4 z = {-cshift, -cshift, -cshift, -cshift}; z = mfma16(A0, Qf[qt][0], z); S[hh][qt] = mfma16(A1, Qf[qt][1], z); }
        }
        if (masked) {
#pragma unroll
            for (int hh = 0; hh < 2; ++hh)
#pragma unroll
                for (int qt = 0; qt < 4; ++qt)
#pragma unroll
                    for (int r = 0; r < 4; ++r) {
                        float p = __builtin_amdgcn_exp2f(S[hh][qt][r]);
                        const int kpos = kpos_base + kb + 32 * kk2 + 16 * hh + 4 * fq + r, qpos = qpos0 + 16 * qt + fr; const int dd = kpos - qpos;
                        if (kpos < 0 || kpos >= NT || dd > 128 || dd < -128) p = 0.f;
                        ls[qt] += p; S[hh][qt][r] = p;
                    }
        } else {
#pragma unroll
            for (int hh = 0; hh < 2; ++hh)
#pragma unroll
                for (int qt = 0; qt < 4; ++qt)
#pragma unroll
                    for (int r = 0; r < 4; ++r) { const float p = __builtin_amdgcn_exp2f(S[hh][qt][r]); ls[qt] += p; S[hh][qt][r] = p; }
        }
        bf16x8 Bp[4];
#pragma unroll
        for (int qt = 0; qt < 4; ++qt) Bp[qt] = pack8(S[0][qt], S[1][qt]);
#pragma unroll
        for (int dt = 0; dt < 4; ++dt) {
            const LAS bf16_t* vp = AV + (kb + 32 * kk2 + 4 * fq + q4) * AT_STRIDE + 16 * dt + 4 * p4;
            const bf16x8 A = tr2(vp, vp + 16 * AT_STRIDE);
#pragma unroll
            for (int qt = 0; qt < 4; ++qt) O[dt][qt] = mfma16(A, Bp[qt], O[dt][qt]);
        }
    }
}
__device__ __forceinline__ void attn_item(const Args& a, LAS unsigned char* lds, int item) {
    const int tid = threadIdx.x, lane = tid & 63, w = __builtin_amdgcn_readfirstlane(tid >> 6), fr = lane & 15, fq = lane >> 4;
    const int qblk = item & 31, kvh = (item >> 5) & 1, b = item >> 6;
    const int g = w >> 1, qh = w & 1, head = 4 * kvh + g;
    const bf16_t* Q = (const bf16_t*)(a.ws + WS_Q); const bf16_t* KK = (const bf16_t*)(a.ws + WS_KK); const bf16_t* VV = (const bf16_t*)(a.ws + WS_VV);
    bf16_t* MIX = (bf16_t*)(a.ws + WS_MIX);
    LAS bf16_t* AK = (LAS bf16_t*)(lds + AT_K); LAS bf16_t* AV = (LAS bf16_t*)(lds + AT_V);
    const float cshift = ((const float*)(a.ws + WS_MISC))[0];
    const int qpos0 = 128 * qblk + 64 * qh;
    bf16x8 Qf[4][2];
#pragma unroll
    for (int qt = 0; qt < 4; ++qt) { const bf16_t* qp = Q + (size_t)(b * NT + qpos0 + 16 * qt + fr) * 512 + head * 64 + 8 * fq; Qf[qt][0] = *(const bf16x8*)qp; Qf[qt][1] = *(const bf16x8*)(qp + 32); }
    f32x4 O[4][4]; float ls[4];
#pragma unroll
    for (int dt = 0; dt < 4; ++dt)
#pragma unroll
        for (int qt = 0; qt < 4; ++qt) O[dt][qt] = (f32x4){0.f, 0.f, 0.f, 0.f};
#pragma unroll
    for (int qt = 0; qt < 4; ++qt) ls[qt] = 0.f;
    const int kpos_base = 128 * qblk - 128;
    for (int i = tid; i < 384 * 8; i += NTHREADS) { const int r = i >> 3, c = i & 7; int kp = kpos_base + r; kp = kp < 0 ? 0 : (kp > NT - 1 ? NT - 1 : kp);
        const size_t src = (size_t)(b * NT + kp) * 128 + kvh * 64 + 8 * c;
        *(LAS u32x4*)(AK + r * AT_STRIDE + 8 * c) = *(const u32x4*)(KK + src); *(LAS u32x4*)(AV + r * AT_STRIDE + 8 * c) = *(const u32x4*)(VV + src); }
    __syncthreads();
    const bool edge = (qblk == 0) || (qblk == 31);
    for (int jt = 0; jt < 5; ++jt) { const bool msk = edge || jt == 0 || jt == 4;
        attn_tile(AK, AV, 64 * qh + 64 * jt, msk, kpos_base, qpos0, Qf, O, ls, cshift, fr, fq); }
    __syncthreads();
    for (int i = tid; i < 256 * 8; i += NTHREADS) { const int r = i >> 3, c = i & 7; const size_t src = (size_t)(MT + b * NL + r) * 128 + kvh * 64 + 8 * c;
        *(LAS u32x4*)(AK + r * AT_STRIDE + 8 * c) = *(const u32x4*)(KK + src); *(LAS u32x4*)(AV + r * AT_STRIDE + 8 * c) = *(const u32x4*)(VV + src); }
    __syncthreads();
    for (int jt = 0; jt < 4; ++jt) attn_tile(AK, AV, 64 * jt, false, 0, qpos0, Qf, O, ls, cshift, fr, fq);
    __syncthreads();
    const float psink = __builtin_amdgcn_exp2f(a.in[13][head] * LOG2E - cshift);
#pragma unroll
    for (int qt = 0; qt < 4; ++qt) {
        float l = ls[qt]; l += __shfl_xor(l, 16); l += __shfl_xor(l, 32); const float inv = 1.f / (l + psink);
        bf16_t* op = MIX + (size_t)(b * NT + qpos0 + 16 * qt + fr) * D + head * 64 + 4 * fq;
#pragma unroll
        for (int dt = 0; dt < 4; ++dt) { const f32x4 o = O[dt][qt] * inv; u32x2 wv; wv.x = pkbf(o[0], o[1]); wv.y = pkbf(o[2], o[3]); *(u32x2*)(op + 16 * dt) = wv; }
    }
}

constexpr int KS_ST = 136, VS_ST = 88;
constexpr int ML_KS = 0, ML_VN = ML_KS + 128 * KS_ST * 2, ML_VW = ML_VN + 128 * VS_ST * 2, ML_CN = ML_VW + 128 * VS_ST * 2, ML_F = ML_CN + 128 * VS_ST * 2, ML_CW = ML_F + 1024 * 4, ML_END = ML_CW + 768 * 4;
static_assert(ML_END <= LDS_BYTES, "mLSTM LDS map");
#define ML_GEOM(ci, seq0, seqlen, nbase) do { if ((ci) < 2) { seq0 = MT + b * NL; seqlen = NL; nbase = dir ? 128 * (1 - (ci)) : 128 * (ci); } \
    else { const int k_ = (ci) - 2; seq0 = b * NT; seqlen = NT; nbase = dir ? 128 * (31 - k_) : 128 * k_; } } while (0)
#define ML_POS(s) (dir ? nbase + 127 - (s) : nbase + (s))
__device__ __forceinline__ void mlstm_item(const Args& a, LAS unsigned char* lds, int item) {
    const int tid = threadIdx.x, lane = tid & 63, w = __builtin_amdgcn_readfirstlane(tid >> 6), fr = lane & 15, fq = lane >> 4, q4 = fr >> 2, p4 = fr & 3;
    const int vh = item & 1, dir = (item >> 1) & 1, h = (item >> 2) & 3, b = item >> 4;
    const int tw = w < 4 ? w : 11 - w;
    LAS bf16_t* Ks = (LAS bf16_t*)(lds + ML_KS); LAS bf16_t* Vn = (LAS bf16_t*)(lds + ML_VN); LAS bf16_t* Vw = (LAS bf16_t*)(lds + ML_VW); LAS bf16_t* Cn = (LAS bf16_t*)(lds + ML_CN);
    LAS float* F = (LAS float*)(lds + ML_F); LAS float* mstA = F, *aA = F + 64, *MlA = F + 128, *blA = F + 192, *plA = F + 256, *gA = F + 512; LAS float* cw = (LAS float*)(lds + ML_CW);
    const bf16_t* MQ = (const bf16_t*)(a.ws + WS_CQ); const bf16_t* MK = (const bf16_t*)(a.ws + WS_CK); const bf16_t* MV = (const bf16_t*)(a.ws + WS_M4) + (size_t)2 * MA * 512;
    const float* GATES = (const float*)(a.ws + WS_GATES);
    float* TBL = (float*)(a.ws + WS_TBL) + (size_t)item * 34 * 384;
    bf16_t* H = (bf16_t*)(a.ws + (dir ? WS_HB : WS_HF));
    for (int i = tid; i < 128 * VS_ST / 2; i += NTHREADS) ((LAS unsigned*)Cn)[i] = 0u;
    for (int i = tid; i < 128 * 12; i += NTHREADS) { const int s = i / 12, c = i % 12; ((LAS unsigned*)(Vn + s * VS_ST + 64))[c] = (c == 0) ? 0x00003f80u : 0u; ((LAS unsigned*)(Vw + s * VS_ST + 64))[c] = 0u; }
    for (int ci = w; ci < 34; ci += NWAVES) {
        int seq0, seqlen, nbase; ML_GEOM(ci, seq0, seqlen, nbase); (void)seqlen;
        const int s0 = 2 * lane, s1 = s0 + 1;
        const float* G0 = GATES + (size_t)(seq0 + ML_POS(s0)) * 16 + h; const float* G1 = GATES + (size_t)(seq0 + ML_POS(s1)) * 16 + h;
        const float li0 = G0[dir ? 8 : 0], lf0 = G0[dir ? 12 : 4], li1 = G1[dir ? 8 : 0], lf1 = G1[dir ? 12 : 4];
        float cs = lf0 + lf1;
#pragma unroll
        for (int o = 1; o < 64; o <<= 1) { const float y = __shfl_up(cs, o); if (lane >= o) cs += y; }
        const float b1 = cs, b0 = cs - lf1;
        const float g0 = li0 - b0, g1 = li1 - b1;
        float mx = fmaxf(g0, g1);
#pragma unroll
        for (int o = 1; o < 64; o <<= 1) { const float y = __shfl_up(mx, o); if (lane >= o) mx = fmaxf(mx, y); }
        float ex = __shfl_up(mx, 1); if (lane == 0) ex = -INFINITY;
        const float pm0 = fmaxf(ex, g0), pm1 = mx;
        float* T = TBL + ci * 384;
        typedef float f32x2t __attribute__((ext_vector_type(2)));
        *(f32x2t*)(T + s0) = (f32x2t){b0, b1}; *(f32x2t*)(T + 128 + s0) = (f32x2t){g0, g1}; *(f32x2t*)(T + 256 + s0) = (f32x2t){pm0, pm1};
        if (lane == 63) { blA[ci] = b1; plA[ci] = pm1; }
    }
    __syncthreads();
    if (w == 0) {
        float m = 0.f;
#pragma unroll 1
        for (int ci = 0; ci < 34; ++ci) { const float bl = blA[ci], pl = plA[ci]; const float Ml = fmaxf(m, pl); if (lane == 0) { mstA[ci] = m; aA[ci] = expf(m - Ml); MlA[ci] = Ml; } m = bl + Ml; }
    }
    f32x4 accC[5];
#pragma unroll
    for (int vt = 0; vt < 5; ++vt) accC[vt] = (f32x4){0.f, 0.f, 0.f, 0.f};
    u32x4 kr[4], vr[2];
#define ML_LOAD_KV(cj) do { int seq0_, seqlen_, nbase_; { const int dir_ = dir; (void)dir_; (void)seqlen_; if ((cj) < 2) { seq0_ = MT + b * NL; seqlen_ = NL; nbase_ = dir ? 128 * (1 - (cj)) : 128 * (cj); } else { const int k_ = (cj) - 2; seq0_ = b * NT; seqlen_ = NT; nbase_ = dir ? 128 * (31 - k_) : 128 * k_; } } \
        _Pragma("unroll") for (int ps = 0; ps < 4; ++ps) { const int s_ = (tid >> 4) + 32 * ps, pos_ = dir ? nbase_ + 127 - s_ : nbase_ + s_; kr[ps] = *(const u32x4*)(MK + (size_t)(seq0_ + pos_) * 512 + h * 128 + 8 * (tid & 15)); } \
        _Pragma("unroll") for (int ps = 0; ps < 2; ++ps) { const int s_ = (tid >> 3) + 64 * ps, pos_ = dir ? nbase_ + 127 - s_ : nbase_ + s_; vr[ps] = *(const u32x4*)(MV + (size_t)(seq0_ + pos_) * 512 + h * 128 + vh * 64 + 8 * (tid & 7)); } } while (0)
    u32x4 qr[4]; float nbt = 0.f, npmt = 0.f;
#define ML_LOAD_Q(cj) do { int seq0_, seqlen_, nbase_; (void)seqlen_; if ((cj) < 2) { seq0_ = MT + b * NL; seqlen_ = NL; nbase_ = dir ? 128 * (1 - (cj)) : 128 * (cj); } else { const int k_ = (cj) - 2; seq0_ = b * NT; seqlen_ = NT; nbase_ = dir ? 128 * (31 - k_) : 128 * k_; } \
        const float* T_ = TBL + (cj) * 384; const int t_ = 16 * tw + fr, post_ = dir ? nbase_ + 127 - t_ : nbase_ + t_; \
        if ((cj) >= 2) { const bf16_t* qp = MQ + (size_t)(seq0_ + post_) * 512 + h * 128 + 8 * fq; \
            _Pragma("unroll") for (int kk = 0; kk < 4; ++kk) qr[kk] = *(const u32x4*)(qp + 32 * kk); \
            nbt = T_[t_]; npmt = T_[256 + t_]; } } while (0)
    ML_LOAD_KV(0);
    __syncthreads();
    ML_LOAD_Q(0);
#ifdef MK_TIME_PHASE
    unsigned long long tA_ = 0ull, tB_ = 0ull;
#endif
#pragma unroll 1
    for (int ci = 0; ci < 34; ++ci) {
        const bool isctx = ci < 2;
#ifdef MK_TIME_PHASE
        const unsigned long long t0_ = __builtin_amdgcn_s_memrealtime();
#endif
        int seq0, seqlen, nbase; ML_GEOM(ci, seq0, seqlen, nbase);
        const float mst = mstA[ci], Ml = MlA[ci], av = aA[ci];
        const float* T = TBL + ci * 384;
        const int t = 16 * tw + fr, post = ML_POS(t);
        const float bt = nbt, pmt = npmt;
        const float gv0 = T[128 + (tid >> 3)], gv1 = T[128 + (tid >> 3) + 64];
        const float gmine = tid < 128 ? T[128 + tid] : 0.f;
#pragma unroll
        for (int ps = 0; ps < 4; ++ps) *(LAS u32x4*)(Ks + ((tid >> 4) + 32 * ps) * KS_ST + 8 * (tid & 15)) = kr[ps];
#pragma unroll
        for (int ps = 0; ps < 2; ++ps) {
            const int s = (tid >> 3) + 64 * ps, vc = tid & 7; const float wv = __expf((ps ? gv1 : gv0) - Ml); u32x4 o;
            *(LAS u32x4*)(Vn + s * VS_ST + 8 * vc) = vr[ps];
#pragma unroll
            for (int e = 0; e < 4; ++e) o[e] = pkbf(bflo(vr[ps][e]) * wv, bfhi(vr[ps][e]) * wv);
            *(LAS u32x4*)(Vw + s * VS_ST + 8 * vc) = o;
        }
        if (tid < 128) { ((LAS unsigned*)(Vw + tid * VS_ST + 64))[0] = pkbf(__expf(gmine - Ml), 0.f); gA[tid] = gmine; }
        bf16x8 Bq[4];
#pragma unroll
        for (int kk = 0; kk < 4; ++kk) Bq[kk] = __builtin_bit_cast(bf16x8, qr[kk]);
        __syncthreads();
#ifdef MK_TIME_PHASE
        const unsigned long long t1_ = __builtin_amdgcn_s_memrealtime();
#endif
        if (!isctx) {
            const float Mt = fmaxf(mst, pmt);
            const float dect = __expf(mst - Mt), ebt = __expf(-bt - Mt);
            f32x4 num[5];
#pragma unroll
            for (int vt = 0; vt < 5; ++vt) num[vt] = (f32x4){0.f, 0.f, 0.f, 0.f};
            {
                bf16x8 fa[5], fb[5];
#define ML_LDC(dst, kk) do { _Pragma("unroll") for (int vt = 0; vt < 5; ++vt) { const LAS bf16_t* cp = Cn + (32 * (kk) + 8 * fq + q4) * VS_ST + 16 * vt + 4 * p4; dst[vt] = tr2(cp, cp + 4 * VS_ST); } } while (0)
#define ML_MMC(src, kk) do { _Pragma("unroll") for (int vt = 0; vt < 5; ++vt) num[vt] = mfma16(src[vt], Bq[kk], num[vt]); } while (0)
                ML_LDC(fa, 0); ML_LDC(fb, 1); ML_MMC(fa, 0); ML_LDC(fa, 2); ML_MMC(fb, 1); ML_LDC(fb, 3); ML_MMC(fa, 2); ML_MMC(fb, 3);
#undef ML_LDC
#undef ML_MMC
#pragma unroll
                for (int vt = 0; vt < 5; ++vt) num[vt] = num[vt] * dect;
            }
            if (ci + 1 < 34) ML_LOAD_KV(ci + 1);
#pragma unroll
            for (int kk2 = 0; kk2 < 4; ++kk2) {
                if (2 * kk2 <= tw) {
                    const bool two = (2 * kk2 + 1) <= tw;
                    bf16x8 ka[2][4], fv[5];
#pragma unroll
                    for (int hh = 0; hh < 2; ++hh)
#pragma unroll
                        for (int kk = 0; kk < 4; ++kk) ka[hh][kk] = *(const LAS bf16x8*)(Ks + (16 * (2 * kk2 + hh) + fr) * KS_ST + 32 * kk + 8 * fq);
                    const f32x4 gs0 = *(const LAS f32x4*)(gA + 32 * kk2 + 4 * fq), gs1 = *(const LAS f32x4*)(gA + 32 * kk2 + 16 + 4 * fq);
#pragma unroll
                    for (int vt = 0; vt < 5; ++vt) { const LAS bf16_t* vp = Vn + (32 * kk2 + 4 * fq + q4) * VS_ST + 16 * vt + 4 * p4; fv[vt] = tr2(vp, vp + 16 * VS_ST); }
                    f32x4 Pp[2];
                    Pp[0] = (f32x4){0.f, 0.f, 0.f, 0.f}; Pp[1] = (f32x4){0.f, 0.f, 0.f, 0.f};
#pragma unroll
                    for (int kk = 0; kk < 4; ++kk) { Pp[0] = mfma16(ka[0][kk], Bq[kk], Pp[0]); Pp[1] = mfma16(ka[1][kk], Bq[kk], Pp[1]); }
#pragma unroll
                    for (int r = 0; r < 4; ++r) {
                        const int s0 = 32 * kk2 + 4 * fq + r, s1 = s0 + 16;
                        Pp[0][r] *= (s0 <= t) ? __builtin_amdgcn_exp2f((gs0[r] - Mt) * LOG2E) : 0.f;
                        Pp[1][r] *= (two && s1 <= t) ? __builtin_amdgcn_exp2f((gs1[r] - Mt) * LOG2E) : 0.f;
                    }
                    const bf16x8 Bw = pack8(Pp[0], Pp[1]);
#pragma unroll
                    for (int vt = 0; vt < 5; ++vt) num[vt] = mfma16(fv[vt], Bw, num[vt]);
                }
            }
            const float den = __shfl(num[4][0], fr);
            const float inv = 1.f / fmaxf(fabsf(den), ebt);
            bf16_t* hp = H + (size_t)(seq0 + post) * 512 + h * 128 + vh * 64 + 4 * fq;
#pragma unroll
            for (int vt = 0; vt < 4; ++vt) { const f32x4 o = num[vt] * inv; u32x2 wv; wv.x = pkbf(o[0], o[1]); wv.y = pkbf(o[2], o[3]); *(u32x2*)(hp + 16 * vt) = wv; }
        }
        if (isctx) ML_LOAD_KV(ci + 1);
        if (ci + 1 < 34) ML_LOAD_Q(ci + 1);
        {
#pragma unroll
            for (int vt = 0; vt < 5; ++vt) accC[vt] = accC[vt] * av;
            bf16x8 sa[6], sb[6];
#define ML_LDS_(dst, kk2) do { _Pragma("unroll") for (int vt = 0; vt < 5; ++vt) { const LAS bf16_t* vp = Vw + (32 * (kk2) + 8 * fq + q4) * VS_ST + 16 * vt + 4 * p4; dst[vt] = tr2(vp, vp + 4 * VS_ST); } \
                { const LAS bf16_t* kp = Ks + (32 * (kk2) + 8 * fq + q4) * KS_ST + 16 * w + 4 * p4; dst[5] = tr2(kp, kp + 4 * KS_ST); } } while (0)
#define ML_MMS_(src) do { _Pragma("unroll") for (int vt = 0; vt < 5; ++vt) accC[vt] = mfma16(src[vt], src[5], accC[vt]); } while (0)
            ML_LDS_(sa, 0); ML_LDS_(sb, 1); ML_MMS_(sa); ML_LDS_(sa, 2); ML_MMS_(sb); ML_LDS_(sb, 3); ML_MMS_(sa); ML_MMS_(sb);
#undef ML_LDS_
#undef ML_MMS_
        }
        __syncthreads();
#ifdef MK_TIME_PHASE
        { const unsigned long long t2_ = __builtin_amdgcn_s_memrealtime(); tA_ += t1_ - t0_; tB_ += t2_ - t1_; }
#endif
#pragma unroll
        for (int vt = 0; vt < 5; ++vt) { u32x2 wv; wv.x = pkbf(accC[vt][0], accC[vt][1]); wv.y = pkbf(accC[vt][2], accC[vt][3]); *(LAS u32x2*)(Cn + (16 * w + fr) * VS_ST + 16 * vt + 4 * fq) = wv; }
    }
    __syncthreads();
#ifdef MK_TIME_PHASE
    if (blockIdx.x == 0 && threadIdx.x == 0) { unsigned long long* ts = (unsigned long long*)(a.ws + WS_MISC + 128); ts[12] = tA_; ts[13] = tB_; }
#endif
}
#undef ML_LOAD_KV
#undef ML_LOAD_Q
#undef ML_POS
#undef ML_GEOM

__device__ __forceinline__ void mlstm_out_rows(const Args& a, int row_lo, int nrows) {
    const int tid = threadIdx.x, lane = tid & 63, wave = tid >> 6;
    const bf16_t* HF = (const bf16_t*)(a.ws + WS_HF); const bf16_t* HB = (const bf16_t*)(a.ws + WS_HB);
    const bf16_t* MO = (const bf16_t*)(a.ws + WS_M4) + (size_t)3 * MA * 512;
    bf16_t* MIX = (bf16_t*)(a.ws + WS_MIX);
    const f32x4 nw0 = *(const f32x4*)(a.in[14] + 8 * lane), nw1 = *(const f32x4*)(a.in[14] + 8 * lane + 4);
    for (int i0 = wave; i0 < nrows; i0 += 4 * NWAVES) {
        u32x4 f[4], bb[4], mo[4];
#pragma unroll
        for (int u = 0; u < 4; ++u) { const size_t o = (size_t)(row_lo + i0 + u * NWAVES) * 512 + 8 * lane; f[u] = *(const u32x4*)(HF + o); bb[u] = *(const u32x4*)(HB + o); mo[u] = *(const u32x4*)(MO + o); }
#pragma unroll
        for (int u = 0; u < 4; ++u) {
            float sv[8]; float ss = 0.f;
#pragma unroll
            for (int e = 0; e < 4; ++e) { sv[2 * e] = bflo(f[u][e]) + bflo(bb[u][e]); sv[2 * e + 1] = bfhi(f[u][e]) + bfhi(bb[u][e]); ss += sv[2 * e] * sv[2 * e] + sv[2 * e + 1] * sv[2 * e + 1]; }
            ss += __shfl_xor(ss, 1); ss += __shfl_xor(ss, 2); ss += __shfl_xor(ss, 4); ss += __shfl_xor(ss, 8);
            const float r = rsqrtf(ss * (1.f / 128.f) + EPS);
            float ov[8];
#pragma unroll
            for (int e = 0; e < 4; ++e) {
                ov[2 * e] = sv[2 * e] * r * (e < 2 ? nw0[2 * e] : nw1[2 * e - 4]) * __builtin_amdgcn_rcpf(1.f + __expf(-bflo(mo[u][e])));
                ov[2 * e + 1] = sv[2 * e + 1] * r * (e < 2 ? nw0[2 * e + 1] : nw1[2 * e - 3]) * __builtin_amdgcn_rcpf(1.f + __expf(-bfhi(mo[u][e])));
            }
            u32x4 o; o.x = pkbf(ov[0], ov[1]); o.y = pkbf(ov[2], ov[3]); o.z = pkbf(ov[4], ov[5]); o.w = pkbf(ov[6], ov[7]);
            *(u32x4*)(MIX + (size_t)(row_lo + i0 + u * NWAVES) * D + 512 + 8 * lane) = o;
        }
    }
}
__device__ __forceinline__ void post_rows(const Args& a, LAS unsigned char* lds, int row_lo, int nrows) {
    const int tid = threadIdx.x, lane = tid & 63, wave = tid >> 6, fr = lane & 15, kq = lane >> 4;
    const int b = row_lo >> 12; const float* mr = (const float*)(a.ws + WS_MOD) + b * 6144; const float* n2w = a.in[7]; const float* Wr = a.in[16];
    LAS bf16_t* WB = (LAS bf16_t*)lds; LAS float* SC = (LAS float*)(lds + 32768); LAS float* SH = (LAS float*)(lds + 36864); LAS float* CP = (LAS float*)(lds + 40960);
    for (int c = tid; c < D; c += NTHREADS) {
        const float scv = n2w[c] * (1.f + mr[4 * D + c]); SC[c] = scv; SH[c] = mr[3 * D + c];
        const int s = 2 * (c >> 6) + ((c >> 3) & 1), q = (c >> 4) & 3, ee = c & 7;
#pragma unroll
        for (int j = 0; j < 4; ++j) { const f32x4 w = *(const f32x4*)(Wr + (size_t)c * 16 + 4 * j);
#pragma unroll
            for (int i = 0; i < 4; ++i) WB[((s * 64 + q * 16 + 4 * j + i) << 3) + ee] = (bf16_t)(pkbf(scv * w[i], 0.f) & 0xffffu); }
    }
    { const int e = tid & 15, part = tid >> 4; float cb = 0.f;
#pragma unroll 4
        for (int i = 0; i < 32; ++i) { const int c = part * 32 + i; cb += mr[3 * D + c] * Wr[(size_t)c * 16 + e]; }
        CP[part * 16 + e] = cb; }
    __syncthreads();
    if (tid < 16) { float t = 0.f; for (int p = 0; p < 32; ++p) t += CP[p * 16 + tid]; CP[512 + tid] = t; }
    __syncthreads();
    const float cbe = CP[512 + fr];
    unsigned char* HX2 = a.ws + WS_HX; float* AFF = (float*)(a.ws + WS_AFF);
    const bf16_t* X1 = (const bf16_t*)(a.ws + WS_X1);
#pragma unroll 1
    for (int t0 = wave * 16; t0 < nrows; t0 += NWAVES * 16) {
        int row = row_lo + t0 + fr; asm volatile("" : "+v"(row));
        const bf16_t* xp = X1 + (size_t)row * D + 16 * kq;
        u32x4 xv[32];
#pragma unroll
        for (int p = 0; p < 16; ++p) { xv[2 * p] = *(const u32x4*)(xp + 64 * p); xv[2 * p + 1] = *(const u32x4*)(xp + 64 * p + 8); }
        f32x4 acc = {0.f, 0.f, 0.f, 0.f}; float ss = 0.f;
        int boff = lane * 8, coff = 16 * kq; asm volatile("" : "+v"(boff), "+v"(coff));
#pragma unroll
        for (int g = 0; g < 8; ++g) {
            bf16x8 Bf[4];
#pragma unroll
            for (int i = 0; i < 4; ++i) Bf[i] = *(const LAS bf16x8*)(WB + boff + (4 * g + i) * 512);
#pragma unroll
            for (int i = 0; i < 4; ++i) { const u32x4 v = xv[4 * g + i]; acc = mfma16(__builtin_bit_cast(bf16x8, v), Bf[i], acc);
                ss += (bflo(v.x) * bflo(v.x) + bfhi(v.x) * bfhi(v.x)) + (bflo(v.y) * bflo(v.y) + bfhi(v.y) * bfhi(v.y)) + (bflo(v.z) * bflo(v.z) + bfhi(v.z) * bfhi(v.z)) + (bflo(v.w) * bflo(v.w) + bfhi(v.w) * bfhi(v.w)); }
            asm volatile("" : "+v"(boff), "+v"(acc));
        }
        ss += __shfl_xor(ss, 16); ss += __shfl_xor(ss, 32);
        const float rstd = rsqrtf(ss * (1.f / D) + EPS);
#pragma unroll
        for (int i = 0; i < 32; ++i) asm volatile("" : "+v"(xv[i]));
        f32x4 af;
#pragma unroll
        for (int i = 0; i < 4; ++i) {
            const float lg = acc[i] * __shfl(rstd, 4 * kq + i) + cbe;
            float mx = lg; mx = fmaxf(mx, __shfl_xor(mx, 1)); mx = fmaxf(mx, __shfl_xor(mx, 2)); mx = fmaxf(mx, __shfl_xor(mx, 4)); mx = fmaxf(mx, __shfl_xor(mx, 8));
            const float e = expf(lg - mx); float sum = e; sum += __shfl_xor(sum, 1); sum += __shfl_xor(sum, 2); sum += __shfl_xor(sum, 4); sum += __shfl_xor(sum, 8);
            af[i] = e / sum;
        }
        *(f32x4*)(AFF + ((size_t)b * NE + fr) * NT + ((row_lo + t0) & (NT - 1)) + 4 * kq) = af;
        unsigned char* hp = HX2 + (size_t)row * D + 16 * kq;
#pragma unroll
        for (int p = 0; p < 16; ++p) {
            u32x4 o;
#pragma unroll
            for (int h = 0; h < 2; ++h) { const u32x4 v = xv[2 * p + h]; const int c0 = 64 * p + coff + 8 * h;
                const f32x4 s0 = *(const LAS f32x4*)(SC + c0), s1 = *(const LAS f32x4*)(SC + c0 + 4), h0 = *(const LAS f32x4*)(SH + c0), h1 = *(const LAS f32x4*)(SH + c0 + 4);
                const unsigned lo = pk4_fp8(bflo(v.x) * (rstd * s0[0]) + h0[0], bfhi(v.x) * (rstd * s0[1]) + h0[1], bflo(v.y) * (rstd * s0[2]) + h0[2], bfhi(v.y) * (rstd * s0[3]) + h0[3]);
                const unsigned hi = pk4_fp8(bflo(v.z) * (rstd * s1[0]) + h1[0], bfhi(v.z) * (rstd * s1[1]) + h1[1], bflo(v.w) * (rstd * s1[2]) + h1[2], bfhi(v.w) * (rstd * s1[3]) + h1[3]);
                if (h == 0) { o.x = lo; o.y = hi; } else { o.z = lo; o.w = hi; } }
            *(u32x4*)(hp + 64 * p) = o;
        }
    }
    __syncthreads();
}

__device__ __forceinline__ void topk_select(const Args& a, LAS unsigned char* lds, int z) {
    const int tid = threadIdx.x, lane = tid & 63, wave = tid >> 6;
    LAS unsigned* hist = (LAS unsigned*)lds; LAS unsigned* sc = hist + 256; LAS unsigned* wsum = hist + 272;
    const float* aff = (const float*)(a.ws + WS_AFF) + (size_t)z * NT;
    int* idx = (int*)(a.ws + WS_IDX) + z * CAP; float* gate = (float*)(a.ws + WS_GATE) + z * CAP; int* slot = (int*)(a.ws + WS_SLOT) + (size_t)z * NT;
    unsigned key[8];
    { const u32x4 k0 = *(const u32x4*)(aff + 8 * tid), k1 = *(const u32x4*)(aff + 8 * tid + 4); key[0] = k0.x; key[1] = k0.y; key[2] = k0.z; key[3] = k0.w; key[4] = k1.x; key[5] = k1.y; key[6] = k1.z; key[7] = k1.w; }
    unsigned prefix = 0u, need = CAP;
#pragma unroll 1
    for (int pass = 0; pass < 4; ++pass) {
        const int shift = 24 - 8 * pass;
        if (tid < 256) hist[tid] = 0u;
        __syncthreads();
#pragma unroll
        for (int i = 0; i < 8; ++i) { const bool match = (pass == 0) || ((key[i] >> (shift + 8)) == prefix); if (match) __hip_atomic_fetch_add(&hist[(key[i] >> shift) & 255u], 1u, __ATOMIC_RELAXED, __HIP_MEMORY_SCOPE_WORKGROUP); }
        __syncthreads();
        if (wave == 0) {
            unsigned c[4]; unsigned s = 0u;
#pragma unroll
            for (int j = 0; j < 4; ++j) { c[j] = hist[255 - (4 * lane + j)]; s += c[j]; }
            unsigned incl = s;
#pragma unroll
            for (int o = 1; o < 64; o <<= 1) { const unsigned y = __shfl_up(incl, o); if (lane >= o) incl += y; }
            unsigned cb = incl - s;
#pragma unroll
            for (int j = 0; j < 4; ++j) { if (cb < need && need <= cb + c[j]) { sc[0] = (prefix << 8) | (unsigned)(255 - (4 * lane + j)); sc[1] = need - cb; } cb += c[j]; }
        }
        __syncthreads();
        prefix = sc[0]; need = sc[1];
        __syncthreads();
    }
    const unsigned T = prefix;
    unsigned cg = 0u, ce = 0u;
#pragma unroll
    for (int i = 0; i < 8; ++i) { cg += key[i] > T ? 1u : 0u; ce += key[i] == T ? 1u : 0u; }
    const unsigned mine = cg | (ce << 16);
    unsigned incl = mine;
#pragma unroll
    for (int o = 1; o < 64; o <<= 1) { const unsigned y = __shfl_up(incl, o); if (lane >= o) incl += y; }
    if (lane == 63) wsum[wave] = incl;
    __syncthreads();
    unsigned base = 0u;
    for (int q = 0; q < wave; ++q) base += wsum[q];
    const unsigned excl = base + incl - mine;
    unsigned pg = excl & 0xffffu, pe = excl >> 16;
    const unsigned total_gt = CAP - need;
#pragma unroll
    for (int i = 0; i < 8; ++i) {
        const int tok = 8 * tid + i; int sl = -1;
        if (key[i] > T) { sl = (int)pg; ++pg; }
        else if (key[i] == T) { if (pe < need) sl = (int)(total_gt + pe); ++pe; }
        if (sl >= 0) { idx[sl] = tok; gate[sl] = __builtin_bit_cast(float, key[i]); }
        slot[tok] = sl;
    }
    __syncthreads();
}

#define XB_TMO      128
#define XB_XCNT(j)  (256  + 64 * (j))
#define XB_XSUB(j)  (1280 + 64 * (j))
#define XB_XGEN(j)  (2304 + 64 * (j))
#define XB_TOP      3328
#define XB_TOPGEN   3392
#define XCD_BAR_WORDS 3456
#define XB_SPIN_CAP (1u << 18)

__device__ __forceinline__ unsigned xb_ld(unsigned* p)              { return __hip_atomic_load(p, __ATOMIC_RELAXED, __HIP_MEMORY_SCOPE_AGENT); }
__device__ __forceinline__ unsigned xb_add(unsigned* p, unsigned v) { return __hip_atomic_fetch_add(p, v, __ATOMIC_RELAXED, __HIP_MEMORY_SCOPE_AGENT); }
__device__ __forceinline__ unsigned xb_xcc_id() { return (unsigned)__builtin_amdgcn_s_getreg((3 << 11) | 20) & 0xFu; }
#define XB_SPIN(cond, bar) do { unsigned _sp = 0; while (cond) { __builtin_amdgcn_s_sleep(1); \
    if ((++_sp & 255u) == 0u) { if (xb_ld(&(bar)[XB_TMO])) break; if (_sp > XB_SPIN_CAP) { atomicAdd(&(bar)[XB_TMO], 1u); break; } } } } while (0)

struct XcdBarrier {
    unsigned* bar; unsigned x;
    volatile LAS unsigned* st;
};

__device__ __forceinline__ XcdBarrier xcd_barrier_post(unsigned* bar, volatile LAS unsigned* st) {
    XcdBarrier b; b.bar = bar; b.x = xb_xcc_id(); b.st = st;
    if (threadIdx.x == 0) (void)xb_add(&bar[XB_XCNT(b.x)], 1u);
    return b;
}
__device__ __forceinline__ void xcd_barrier_complete(unsigned* bar, unsigned x, unsigned& nloc, unsigned& nx) {
    const unsigned G = gridDim.x * gridDim.y * gridDim.z;
    unsigned sum, cnt, mine, sp = 0u;
    for (;;) {
        sum = 0u; cnt = 0u; mine = 0u;
#pragma unroll
        for (unsigned j = 0; j < 16; ++j) { const unsigned c = xb_ld(&bar[XB_XCNT(j)]); sum += c; cnt += (c > 0u) ? 1u : 0u; mine = (j == x) ? c : mine; }
        if (sum == G) break;
        __builtin_amdgcn_s_sleep(1);
        if ((++sp & 255u) == 0u) { if (xb_ld(&bar[XB_TMO])) break; if (sp > XB_SPIN_CAP) { atomicAdd(&bar[XB_TMO], 1u); break; } }
    }
    nloc = mine > 0u ? mine : 1u; nx = cnt > 0u ? cnt : 1u;
}

__device__ __forceinline__ void xcd_barrier(const XcdBarrier& b) {
    asm volatile("s_waitcnt vmcnt(0)" ::: "memory");
    __syncthreads();
    if (threadIdx.x == 0) {
        unsigned* bar = b.bar;
        __builtin_amdgcn_s_waitcnt(0);
        unsigned nloc = b.st[0], nx = b.st[1];
        if (nloc == 0u) { xcd_barrier_complete(bar, b.x, nloc, nx); b.st[0] = nloc; b.st[1] = nx; }
        const unsigned old = xb_add(&bar[XB_XSUB(b.x)], 1u);
        const unsigned gen = old / nloc;
        if (old + 1u == (gen + 1u) * nloc) {
            __builtin_amdgcn_fence(__ATOMIC_RELEASE, "agent");
            asm volatile("s_waitcnt vmcnt(0)" ::: "memory");
            const unsigned og = xb_add(&bar[XB_TOP], 1u);
            const unsigned tg = og / nx;
            if (og + 1u == (tg + 1u) * nx) xb_add(&bar[XB_TOPGEN], 1u);
            else XB_SPIN(xb_ld(&bar[XB_TOPGEN]) == tg, bar);
            __builtin_amdgcn_fence(__ATOMIC_ACQUIRE, "agent");
            xb_add(&bar[XB_XGEN(b.x)], 1u);
            asm volatile("s_waitcnt vmcnt(0)" ::: "memory");
        } else {
            XB_SPIN(xb_ld(&bar[XB_XGEN(b.x)]) == gen, bar);
            __builtin_amdgcn_fence(__ATOMIC_ACQUIRE, "agent");
            asm volatile("s_waitcnt vmcnt(0)" ::: "memory");
        }
    }
    __syncthreads();
}

__device__ __forceinline__ Args load_args() {
    typedef const volatile Args __attribute__((address_space(4))) KA;
    KA* p = (KA*)__builtin_amdgcn_kernarg_segment_ptr();
    Args r;
#pragma unroll
    for (int i = 0; i < 20; ++i) r.in[i] = (const float*)p->in[i];
    r.out = (float*)p->out; r.ws = (unsigned char*)p->ws; r.ph_lo = p->ph_lo; r.ph_hi = p->ph_hi; r.sub = p->sub; r.pad = 0;
    return r;
}
__device__ __forceinline__ void stagger_wait(unsigned ticks) {
    const unsigned long long t0 = __builtin_amdgcn_s_memrealtime();
    while ((unsigned)(__builtin_amdgcn_s_memrealtime() - t0) < ticks) __builtin_amdgcn_s_sleep(16);
}
#ifndef MK_STAG2
#define MK_STAG2 0
#endif
#ifndef MK_STAG6
#define MK_STAG6 0
#endif
#ifndef MK_STAG8
#define MK_STAG8 0
#endif
template <int MASK> __global__ void __launch_bounds__(NTHREADS, 2) mk_fwd_t(Args a_unused_) {
    extern __shared__ __attribute__((aligned(16))) unsigned char lds_raw[];
    LAS unsigned char* lds = (LAS unsigned char*)lds_raw;
    __builtin_assume(__builtin_amdgcn_workitem_id_y() == 0); __builtin_assume(__builtin_amdgcn_workitem_id_z() == 0);
    cg::grid_group grid = cg::this_grid();
    if (threadIdx.x < 2) ((LAS unsigned*)(lds + LDS_BAR_OFF))[threadIdx.x] = 0u;
    __syncthreads();
    int lo, hi; unsigned char* ws0; { const Args a = load_args(); lo = a.ph_lo; hi = a.ph_hi; ws0 = a.ws; }
#ifdef MK_NO_MEMSET
    if (blockIdx.x == 0) for (int i = threadIdx.x; i < 4096; i += NTHREADS) ((unsigned*)(ws0 + WS_BAR))[i] = 0u;
    XcdBarrier xbar; xbar.bar = (unsigned*)(ws0 + WS_BAR); xbar.x = 0; xbar.st = (volatile LAS unsigned*)(lds + LDS_BAR_OFF);
#else
    XcdBarrier xbar = xcd_barrier_post((unsigned*)(ws0 + WS_BAR), (volatile LAS unsigned*)(lds + LDS_BAR_OFF));
#endif
    const int c = blockIdx.x, G = gridDim.x;
#define IN(k) ((((MASK) >> (k)) & 1) && lo <= (k) && (k) < hi)
#ifdef MK_TIME_PHASE
#define MK_STAMP(k) do { if (blockIdx.x == 0 && threadIdx.x == 0) ((unsigned long long*)(load_args().ws + WS_MISC + 128))[(k)] = __builtin_amdgcn_s_memrealtime(); } while (0)
#else
#define MK_STAMP(k) do { } while (0)
#endif
#ifdef MK_NO_MEMSET
#define SEAM(k) do { if (IN(k) && IN((k) + 1)) { if ((k) == 0) { grid.sync(); xbar = xcd_barrier_post(xbar.bar, xbar.st); } else xcd_barrier(xbar); MK_STAMP((k) + 1); } } while (0)
#else
#define SEAM(k) do { if (IN(k) && IN((k) + 1)) { xcd_barrier(xbar); MK_STAMP((k) + 1); } } while (0)
#endif
    if (lo < 0) grid.sync();

    MK_STAMP(0);
    if (IN(0)) { const Args a = load_args(); phase0(a, lds); }
    SEAM(0);
    if (IN(1)) { const Args a = load_args(); phase1(a, lds); }
    SEAM(1);
    if (IN(2)) {
        const Args a = load_args(); unsigned char* const ws = a.ws; (void)ws;
        Gemm g{(const bf16_t*)(ws + WS_HX), (const bf16_t*)(ws + WS_WIN), MA, NPROJ, D};
        pg8::StaticOrder S; S.init(MA, NPROJ, G, c);
        EpiProj E{(bf16_t*)(ws + WS_Q), (bf16_t*)(ws + WS_KK), (bf16_t*)(ws + WS_VV), (bf16_t*)(ws + WS_M4), a.in[11], a.in[12], (const float*)(ws + WS_ROPE), 0.125f * LOG2E};
        if (MK_STAG2 && ((c >> 3) & 1)) stagger_wait(MK_STAG2);
        pg8::gemm_phase<EpiProj, pg8::StaticOrder, true, true>(lds, g, S, E);
        __syncthreads();
    }
    SEAM(2);
    if (IN(3)) {
        const Args a = load_args(); unsigned char* const ws = a.ws; (void)ws;
        if (c & 1) { conv_rows(a); transpose_late(a, lds); __syncthreads(); }
#ifndef MK_NO_ATTN
        if (G == 256) { const int x = c & 7, k = c >> 3; for (int i = 0; i < 4; ++i) attn_item(a, lds, ((4 * x + i) << 5) | k); }
        else for (int it = c; it < 1024; it += G) attn_item(a, lds, it);
#endif
        if (!(c & 1)) { __syncthreads(); conv_rows(a); transpose_late(a, lds); }
    }
    SEAM(3);
    if (IN(4)) {
        const Args a = load_args(); unsigned char* const ws = a.ws; (void)ws;
#ifndef MK_NO_ML
        if (G == 256) { const int x = c & 7, k = c >> 3; mlstm_item(a, lds, 4 * (8 * x + (k >> 2)) + (k & 3)); }
        else for (int it = c; it < 256; it += G) mlstm_item(a, lds, it);
#endif
    }
    SEAM(4);
    if (IN(5)) {
        const Args a = load_args(); unsigned char* const ws = a.ws; (void)ws;
        if (c < 256) mlstm_out_rows(a, c * 256, 256);
    }
    __syncthreads(); MK_STAMP(6);
    if (IN(6)) {
        const Args a = load_args(); unsigned char* const ws = a.ws; (void)ws;
        Gemm g{(const bf16_t*)(ws + WS_MIX), (const bf16_t*)(ws + WS_WOUT), MT, D, D};
        SeqOrder S{c, 4, 4};
        EpiOut E{a.in[0], (const float*)(ws + WS_MOD), (bf16_t*)(ws + WS_X1)};
        if (c < 256) pg8::gemm_phase<EpiOut, SeqOrder, true, true>(lds, g, S, E);
        __syncthreads();
    }
    __syncthreads(); MK_STAMP(7);
    if (IN(7)) {
        const Args a = load_args(); unsigned char* const ws = a.ws; (void)ws;
        if (c < 256) post_rows(a, lds, c * 256, 256);
    }
    SEAM(7);
    if (IN(8)) {
        const Args a = load_args(); unsigned char* const ws = a.ws; (void)ws;
        if (c < 256) { const int z = c;
            const int b = z >> 4, e = z & 15;
            topk_select(a, lds, z);
            MK_STAMP(16);
            const bf16_t* HX2 = (const bf16_t*)(ws + WS_HX + (size_t)b * NT * D); const int* idx = (const int*)(ws + WS_IDX) + z * CAP;
            unsigned char* ACT = ws + WS_ACT + (size_t)z * CAP * FF;
            ((LAS float*)(lds + LDS_GATE_OFF))[threadIdx.x] = ((const float*)(ws + WS_GATE) + z * CAP)[threadIdx.x];
            __syncthreads();
            MK_STAMP(17);
#pragma unroll 1
            for (int half = 0; half < 2; ++half) { Gemm g{HX2, (const bf16_t*)(ws + WS_WGU + (size_t)e * 1024 * D), 256, 1024, D / 2, idx + 256 * half}; SeqOrder S{0, 4, 4}; EpiAct E{ACT + (size_t)half * 256 * FF};
              pg8::gemm_phase<EpiAct, SeqOrder, true, true, 1, FP8_W_SCALE>(lds, g, S, E); __syncthreads(); }
            MK_STAMP(18);
            { Gemm g{(const bf16_t*)ACT, (const bf16_t*)(ws + WS_WD + (size_t)e * D * FF), CAP, D, FF / 2}; SeqOrder S{0, 4, 8}; EpiDown E{(bf16_t*)(ws + WS_MIX) + (size_t)z * CAP * D, (const LAS float*)(lds + LDS_GATE_OFF), 1.f / FP8_W_UP};
              pg8::gemm_phase<EpiDown, SeqOrder, false, true, 1, FP8_W_SCALE>(lds, g, S, E); }
            __syncthreads();
        }
    }
    SEAM(8);
    if (IN(9)) {
        const Args a = load_args(); unsigned char* const ws = a.ws; (void)ws;
        const int tid = threadIdx.x, lane = tid & 63, wave = tid >> 6;
        const int gw = c * NWAVES + wave, NGW = G * NWAVES;
        const int* SL = (const int*)(ws + WS_SLOT); const bf16_t* Y = (const bf16_t*)(ws + WS_MIX); const float* mod = (const float*)(ws + WS_MOD);
        const bf16_t* X1 = (const bf16_t*)(ws + WS_X1);
        for (int grp = gw; grp < MT / 4; grp += NGW) {
            const int mbase = 4 * grp, b = mbase >> 12, n0 = mbase & (NT - 1);
            const int sv = SL[((size_t)b * NE + (lane & 15)) * NT + n0 + (lane >> 4)];
            const unsigned long long ball = __ballot(sv >= 0);
            const float* g2 = mod + b * 6144 + 5 * D + 4 * lane;
            f32x4 gv[4];
#pragma unroll
            for (int j = 0; j < 4; ++j) gv[j] = *(const f32x4*)(g2 + 256 * j);
#pragma unroll 1
            for (int u = 0; u < 4; ++u) {
                unsigned mask = (unsigned)(ball >> (16 * u)) & 0xffffu;
                float* orow = a.out + (size_t)(mbase + u) * D + 4 * lane; const bf16_t* xrow = X1 + (size_t)(mbase + u) * D + 4 * lane;
                u32x2 xv[4];
#pragma unroll
                for (int j = 0; j < 4; ++j) xv[j] = *(const u32x2*)(xrow + 256 * j);
                float acc[16];
#pragma unroll
                for (int i = 0; i < 16; ++i) acc[i] = 0.f;
                while (mask) {
                    const int e0 = __builtin_ctz(mask); mask &= mask - 1u;
                    const bool two = mask != 0u; const int e1 = two ? __builtin_ctz(mask) : e0; if (two) mask &= mask - 1u;
                    const int s0 = __shfl(sv, 16 * u + e0), s1 = __shfl(sv, 16 * u + e1);
                    const bf16_t* y0 = Y + ((size_t)(b * NE + e0) * CAP + s0) * D + 4 * lane; const bf16_t* y1 = Y + ((size_t)(b * NE + e1) * CAP + s1) * D + 4 * lane;
                    u32x2 ya[4], yb[4];
#pragma unroll
                    for (int j = 0; j < 4; ++j) { ya[j] = __builtin_nontemporal_load((const u32x2*)(y0 + 256 * j)); yb[j] = __builtin_nontemporal_load((const u32x2*)(y1 + 256 * j)); }
                    const float w1 = two ? 1.f : 0.f;
#pragma unroll
                    for (int j = 0; j < 4; ++j) { acc[4 * j] += bflo(ya[j].x) + w1 * bflo(yb[j].x); acc[4 * j + 1] += bfhi(ya[j].x) + w1 * bfhi(yb[j].x);
                        acc[4 * j + 2] += bflo(ya[j].y) + w1 * bflo(yb[j].y); acc[4 * j + 3] += bfhi(ya[j].y) + w1 * bfhi(yb[j].y); }
                }
#pragma unroll
                for (int j = 0; j < 4; ++j) { f32x4 o; o[0] = bflo(xv[j].x) + gv[j][0] * acc[4 * j]; o[1] = bfhi(xv[j].x) + gv[j][1] * acc[4 * j + 1]; o[2] = bflo(xv[j].y) + gv[j][2] * acc[4 * j + 2]; o[3] = bfhi(xv[j].y) + gv[j][3] * acc[4 * j + 3];
                    __builtin_nontemporal_store(o, (f32x4*)(orow + 256 * j)); }
            }
        }
    }
#ifdef MK_TIME_PHASE
    xcd_barrier(xbar); MK_STAMP(10);
    xcd_barrier(xbar);
    { const Args a = load_args(); const unsigned long long* ts = (const unsigned long long*)(a.ws + WS_MISC + 128); const int k = MK_TIME_PHASE;
      const float delta = k < 0 ? 0.1f : (k == 30 ? (float)(ts[15] - ts[4]) : k == 31 ? (float)(ts[5] - ts[15]) : k == 99 ? (float)(ts[10] - ts[0]) : k == 70 ? (float)(ts[16] - ts[8]) : k == 71 ? (float)(ts[17] - ts[16]) : k == 72 ? (float)(ts[18] - ts[17]) : k == 73 ? (float)(ts[9] - ts[18]) : k == 32 ? (float)ts[12] : k == 33 ? (float)ts[13] : (float)(ts[k + 1] - ts[k])) * (float)MK_TIME_SCALE * 1e-2f;
      for (size_t i = (size_t)blockIdx.x * NTHREADS + threadIdx.x; i < (size_t)MT * D; i += (size_t)gridDim.x * NTHREADS) a.out[i] += delta; }
#endif
#undef IN
#undef SEAM
}
}

#ifndef MK_N_LAUNCHES
#define MK_N_LAUNCHES 1
#endif
extern "C" void kernel_launch(void* const* d_in, const int* in_sizes, int n_in, void* d_out, int out_size, void* d_ws, size_t ws_size, hipStream_t stream) {
    using namespace mk;
    static int grid = 0;
    if (grid == 0) {
        if (n_in != 20 || out_size != MT * D || ws_size < WS_END) { fprintf(stderr, "kernel_launch: unexpected problem (n_in %d out %d ws %zu need %zu)\n", n_in, out_size, ws_size, (size_t)WS_END); grid = -1; return; }
        int dev = 0, cus = 0, per_cu = 0;
        hipGetDevice(&dev); hipDeviceGetAttribute(&cus, hipDeviceAttributeMultiprocessorCount, dev);
#if MK_N_LAUNCHES == 1
        if (hipFuncSetAttribute((const void*)mk_fwd_t<0x3ff>, hipFuncAttributeMaxDynamicSharedMemorySize, LDS_BYTES) != hipSuccess) { fprintf(stderr, "kernel_launch: hipFuncSetAttribute failed\n"); grid = -1; return; }
        hipOccupancyMaxActiveBlocksPerMultiprocessor(&per_cu, (const void*)mk_fwd_t<0x3ff>, NTHREADS, LDS_BYTES);
#else
        per_cu = 1;
#endif
        (void)hipGetLastError();
        if (per_cu < 1) { fprintf(stderr, "kernel_launch: occupancy query says %d blocks per CU\n", per_cu); per_cu = 1; }
        grid = cus;
        if (grid > 256) grid = 256;
    }
    if (grid < 0) return;
#ifndef MK_NO_MEMSET
    if (hipMemsetAsync((char*)d_ws + WS_BAR, 0, 16384, stream) != hipSuccess) { fprintf(stderr, "kernel_launch: hipMemsetAsync failed\n"); return; }
#endif
    Args a{};
    for (int i = 0; i < 20; ++i) a.in[i] = (const float*)d_in[i];
    a.out = (float*)d_out; a.ws = (unsigned char*)d_ws; a.sub = 7;
#if MK_N_LAUNCHES == 1
    a.ph_lo = 0; a.ph_hi = 10;
    void* args[] = {&a};
#ifdef MK_PLAIN_LAUNCH
    hipLaunchKernelGGL(mk_fwd_t<0x3ff>, dim3(grid), dim3(NTHREADS), LDS_BYTES, stream, a); hipError_t e = hipGetLastError(); (void)args;
#else
    hipError_t e = hipLaunchCooperativeKernel((const void*)mk_fwd_t<0x3ff>, dim3(grid), dim3(NTHREADS), args, LDS_BYTES, stream);
#endif
    if (e != hipSuccess) fprintf(stderr, "cooperative launch failed: %s (grid %d)\n", hipGetErrorString(e), grid);
#else
#define MK_LAUNCH_P(p) do { hipFuncSetAttribute((const void*)mk_fwd_t<(1 << (p))>, hipFuncAttributeMaxDynamicSharedMemorySize, LDS_BYTES); a.ph_lo = (p); a.ph_hi = (p) + 1; hipLaunchKernelGGL(mk_fwd_t<(1 << (p))>, dim3(grid), dim3(NTHREADS), LDS_BYTES, stream, a); } while (0)
#ifndef MK_DUP
#define MK_DUP -1
#endif
#ifndef MK_DUP_SUB
#define MK_DUP_SUB 7
#endif
#define MK_LAUNCH_D(p) do { MK_LAUNCH_P(p); if (MK_DUP == (p)) { a.sub = MK_DUP_SUB; MK_LAUNCH_P(p); a.sub = 7; } } while (0)
    MK_LAUNCH_D(0); MK_LAUNCH_D(1); MK_LAUNCH_D(2); MK_LAUNCH_D(3); MK_LAUNCH_D(4); MK_LAUNCH_D(5); MK_LAUNCH_D(6); MK_LAUNCH_D(7); MK_LAUNCH_D(8); MK_LAUNCH_D(9);
#endif
}
```

```cpp
#include <hip/hip_runtime.h>
#include <hip/hip_cooperative_groups.h>
#include <cstdio>
#include <cstdint>
namespace cg = cooperative_groups;
namespace pg8 {
#define PG8_LAS __attribute__((address_space(3)))
typedef unsigned short bf16_t;
typedef short bf16x8 __attribute__((ext_vector_type(8)));
typedef float f32x4 __attribute__((ext_vector_type(4)));
typedef unsigned u32x4 __attribute__((ext_vector_type(4)));
constexpr int BM = 256, BK = 64, HALF = 128, HTB = HALF * BK * 2  , STAGE_BYTES = 8 * HTB, NXCD = 8, WGM = 8;

__host__ __device__ __forceinline__ int lds_byte(int r, int c) { const int st = (r >> 4) * 2 + (c >> 5), rr = r & 15, cc = c & 31, ob = rr * 64 + cc * 2; return st * 1024 + (ob ^ (((ob >> 9) & 1) << 5)); }
__host__ __device__ __forceinline__ void stage_rc(int b, int& R, int& C) { const int st = b / 1024, sb = b % 1024, swz = sb ^ (((sb >> 9) & 1) << 5); R = (st >> 1) * 16 + swz / 64; C = (st & 1) * 32 + (swz % 64) / 2; }
__host__ __device__ __forceinline__ int perm32(int rho) { const int n = rho >> 4, i = rho & 15; return 8 * (i >> 2) + 4 * n + (i & 3); }

struct Unit { int pm, pn; };
struct Gemm { const bf16_t* A; const bf16_t* Bt; int M, N, K; const int* gidx = nullptr; };

struct StaticOrder {
    int nM, nN, nwg, G, c;
    __host__ __device__ void init(int M, int N, int G_, int c_) { nM = M / BM; nN = N / BM; nwg = nM * nN; G = G_; c = c_; }
    __host__ __device__ bool next(int i, Unit& u) const {
        const long L = (long)i * G + c; if (L >= nwg) return false;
        int wgid = (int)L; { const int q = nwg / NXCD, r = nwg % NXCD, xcd = wgid % NXCD, off = wgid / NXCD; wgid = (xcd < r ? xcd * (q + 1) : r * (q + 1) + (xcd - r) * q) + off; }
        const int nig = WGM * nN, gid = wgid / nig, fm = gid * WGM, gsz = (nM - fm) < WGM ? (nM - fm) : WGM;
        u.pm = fm + ((wgid % nig) % gsz); u.pn = (wgid % nig) / gsz; return true;
    }
    __device__ __forceinline__ void a_ready(const Unit&) const {}
    __device__ __forceinline__ void done(const Unit&) const {}
};
__device__ __forceinline__ unsigned cvt_pk_bf16(float lo, float hi) { unsigned r; asm volatile("v_cvt_pk_bf16_f32 %0, %1, %2" : "=v"(r) : "v"(lo), "v"(hi)); return r; }
typedef float f32x2 __attribute__((ext_vector_type(2)));
typedef int pg8_v8i __attribute__((ext_vector_type(8))); typedef int pg8_v4i __attribute__((ext_vector_type(4)));
template <int FMT> struct pg8_frag;
template <> struct pg8_frag<0> { bf16x8 v[2]; };
template <> struct pg8_frag<1> { pg8_v4i v[2]; };
template <class Epi, class Sched, bool ALIGN_EPI = false, bool SP2 = false, int FMT = 0, int FP8_SCALE_W = 0x7F7F7F7F>
__device__ __forceinline__ void gemm_phase(PG8_LAS unsigned char* lds, const Gemm g, const Sched& S, const Epi& E) {
    int tid_ = threadIdx.x; asm volatile("" : "+v"(tid_));
    const int tid = tid_, wid = __builtin_amdgcn_readfirstlane(tid >> 6), lane = tid & 63, wr = wid >> 2, wc = wid & 3, fr = lane & 15, fq = lane >> 4;
    const int K = g.K, nt = K / BK;
    unsigned voffA[2], voffB[2];
#pragma unroll
    for (int i = 0; i < 2; ++i) { int R, C; stage_rc(tid * 16 + i * 8192, R, C); const int Rb = Epi::PERM ? ((R & ~31) + perm32(R & 31)) : R;
        voffA[i] = (unsigned)(R * K + C) * 2u; voffB[i] = (unsigned)(Rb * K + C) * 2u; }
    const size_t kstep = (size_t)(BK * 2);
    const size_t hstep = (size_t)HALF * K * 2;
    const size_t tstep = 2 * hstep;
    unsigned voffAh[2][2];
#pragma unroll
    for (int i = 0; i < 2; ++i) { int R, C; stage_rc(tid * 16 + i * 8192, R, C);
        if (g.gidx) { voffAh[0][i] = (unsigned)(g.gidx[R] * K + C) * 2u; voffAh[1][i] = (unsigned)(g.gidx[HALF + R] * K + C) * 2u; }
        else { voffAh[0][i] = 0u; voffAh[1][i] = 0u; } }
    const __amdgpu_buffer_rsrc_t rsA = __builtin_amdgcn_make_buffer_rsrc((void*)g.A, 0, -1, 0x00020000), rsB = __builtin_amdgcn_make_buffer_rsrc((void*)g.Bt, 0, -1, 0x00020000);
    const size_t atstep = g.gidx ? (size_t)0 : tstep; const int p1step = 64 * K * 2;
    const unsigned ldsw = (unsigned)wid * 1024u;
    const int aoff = lds_byte(wr * 64 + fr, fq * 8), boff = lds_byte(wc * 32 + fr, fq * 8);
#define PG8_SA(b, h) (((b) * 2 + (h)) * HTB)
#define PG8_SB(b, h) ((4 + (b) * 2 + (h)) * HTB)
#define PG8_STAGE_R(rs, base0, bufoff, gbase, voff) do { const int so_ = (int)((const char*)(gbase) - (const char*)(base0)); _Pragma("unroll") for (int _i = 0; _i < 2; ++_i) \
        __builtin_amdgcn_raw_ptr_buffer_load_lds(rs, (PG8_LAS unsigned*)(lds + (bufoff) + ldsw + _i * 8192), 16, (int)(voff)[_i], so_, 0, 0); } while (0)
#define PG8_STAGE_U(rs, base0, bufoff, gbase, voff0, xtra) do { const int so_ = (int)((const char*)(gbase) - (const char*)(base0)) + (int)(xtra); _Pragma("unroll") for (int _i = 0; _i < 2; ++_i) \
        __builtin_amdgcn_raw_ptr_buffer_load_lds(rs, (PG8_LAS unsigned*)(lds + (bufoff) + ldsw + _i * 8192), 16, (int)(voff0), so_ + _i * (int)p1step, 0, 0); } while (0)
#define PG8_LD1(dst, k, addr) do { if constexpr (FMT == 0) dst.v[k] = *(const PG8_LAS bf16x8*)(addr); else dst.v[k] = *(const PG8_LAS pg8_v4i*)(addr); } while (0)
#define PG8_LDA(dst, b, h) do { _Pragma("unroll") for (int m = 0; m < 4; ++m) _Pragma("unroll") for (int k = 0; k < 2; ++k) PG8_LD1(dst[m], k, lds + PG8_SA(b, h) + aoff + m * 2048 + k * 1024); } while (0)
#define PG8_LDB(dst, b, h) do { _Pragma("unroll") for (int n = 0; n < 2; ++n) _Pragma("unroll") for (int k = 0; k < 2; ++k) PG8_LD1(dst[n], k, lds + PG8_SB(b, h) + boff + n * 2048 + k * 1024); } while (0)
#define PG8_MMA(ai, bj, At, Bt) do { __builtin_amdgcn_s_setprio(1); \
        if constexpr (FMT == 0) { _Pragma("unroll") for (int m = 0; m < 4; ++m) _Pragma("unroll") for (int n = 0; n < 2; ++n) _Pragma("unroll") for (int k = 0; k < 2; ++k) \
            acc[ai][bj][m][n] = __builtin_amdgcn_mfma_f32_16x16x32_bf16(Bt[n].v[k], At[m].v[k], acc[ai][bj][m][n], 0, 0, 0); } \
        else { _Pragma("unroll") for (int m = 0; m < 4; ++m) _Pragma("unroll") for (int n = 0; n < 2; ++n) \
            acc[ai][bj][m][n] = __builtin_amdgcn_mfma_scale_f32_16x16x128_f8f6f4(__builtin_shufflevector(Bt[n].v[0], Bt[n].v[1], 0, 1, 2, 3, 4, 5, 6, 7), __builtin_shufflevector(At[m].v[0], At[m].v[1], 0, 1, 2, 3, 4, 5, 6, 7), acc[ai][bj][m][n], 0, 0, 0, 0x7F7F7F7F, 0, 0x7F7F7F7F); \
            asm volatile("" :: "v"(acc[ai][bj][0][0]), "v"(acc[ai][bj][0][1]), "v"(acc[ai][bj][1][0]), "v"(acc[ai][bj][1][1]), "v"(acc[ai][bj][2][0]), "v"(acc[ai][bj][2][1]), "v"(acc[ai][bj][3][0]), "v"(acc[ai][bj][3][1])); }   \
        __builtin_amdgcn_s_setprio(0); } while (0)
#define PG8_WAIT_V(n) asm volatile("s_waitcnt vmcnt(" #n ")" ::: "memory")
#define PG8_WAIT_L(n) asm volatile("s_waitcnt lgkmcnt(" #n ")" ::: "memory")
#define PG8_BAR __builtin_amdgcn_s_barrier()
#define PG8_SCHED __builtin_amdgcn_sched_barrier(0)
    Unit cur, nxt; int ui = 0;
    if (!S.next(0, cur)) return;
    f32x4 acc[2][2][4][2];
#pragma unroll
    for (int a = 0; a < 2; ++a)
#pragma unroll
        for (int b = 0; b < 2; ++b)
#pragma unroll
            for (int m = 0; m < 4; ++m)
#pragma unroll
                for (int n = 0; n < 2; ++n) acc[a][b][m][n] = (f32x4){0.f, 0.f, 0.f, 0.f};
    pg8_frag<FMT> At[4], B0[2], B1[2];
    const char* cA = (const char*)g.A + (size_t)cur.pm * atstep; const char* cB = (const char*)g.Bt + (size_t)cur.pn * tstep;
    S.a_ready(cur);
    if constexpr (SP2) {
        PG8_STAGE_U(rsB, g.Bt, PG8_SB(0, 0), cB, voffB[0], 0); PG8_STAGE_U(rsB, g.Bt, PG8_SB(0, 1), cB + hstep, voffB[0], 0); do { if (g.gidx) PG8_STAGE_R(rsA, g.A, PG8_SA(0, 0), cA, voffAh[0]); else PG8_STAGE_U(rsA, g.A, PG8_SA(0, 0), cA, voffA[0], 0 * hstep); } while (0); do { if (g.gidx) PG8_STAGE_R(rsA, g.A, PG8_SA(0, 1), cA, voffAh[1]); else PG8_STAGE_U(rsA, g.A, PG8_SA(0, 1), cA, voffA[0], 1 * hstep); } while (0);
        if (wr == 1) PG8_BAR;
        PG8_WAIT_V(2); PG8_BAR;
        PG8_STAGE_U(rsB, g.Bt, PG8_SB(1, 0), cB + kstep, voffB[0], 0); do { if (g.gidx) PG8_STAGE_R(rsA, g.A, PG8_SA(1, 0), cA + kstep, voffAh[0]); else PG8_STAGE_U(rsA, g.A, PG8_SA(1, 0), cA + kstep, voffA[0], 0 * hstep); } while (0); PG8_STAGE_U(rsB, g.Bt, PG8_SB(1, 1), cB + hstep + kstep, voffB[0], 0);
        PG8_WAIT_V(6); PG8_BAR;
    } else {
        PG8_STAGE_U(rsB, g.Bt, PG8_SB(0, 0), cB, voffB[0], 0); do { if (g.gidx) PG8_STAGE_R(rsA, g.A, PG8_SA(0, 0), cA, voffAh[0]); else PG8_STAGE_U(rsA, g.A, PG8_SA(0, 0), cA, voffA[0], 0 * hstep); } while (0); PG8_STAGE_U(rsB, g.Bt, PG8_SB(0, 1), cB + hstep, voffB[0], 0); do { if (g.gidx) PG8_STAGE_R(rsA, g.A, PG8_SA(0, 1), cA, voffAh[1]); else PG8_STAGE_U(rsA, g.A, PG8_SA(0, 1), cA, voffA[0], 1 * hstep); } while (0);
        if (wr == 1) PG8_BAR;
        PG8_WAIT_V(4); PG8_BAR;
        PG8_STAGE_U(rsB, g.Bt, PG8_SB(1, 0), cB + kstep, voffB[0], 0); do { if (g.gidx) PG8_STAGE_R(rsA, g.A, PG8_SA(1, 0), cA + kstep, voffAh[0]); else PG8_STAGE_U(rsA, g.A, PG8_SA(1, 0), cA + kstep, voffA[0], 0 * hstep); } while (0); PG8_STAGE_U(rsB, g.Bt, PG8_SB(1, 1), cB + hstep + kstep, voffB[0], 0);
        PG8_WAIT_V(6); PG8_BAR;
    }
    for (;;) {
        const bool has_next = S.next(ui + 1, nxt);
        const char* nA = has_next ? (const char*)g.A + (size_t)nxt.pm * atstep : cA; const char* nB = has_next ? (const char*)g.Bt + (size_t)nxt.pn * tstep : cB;
        for (int t = 0; t < nt; t += 2) {
            const bool last = (t == nt - 2);
            const char* a1 = cA + (size_t)(t + 1) * kstep;
            const char* a2 = last ? nA : cA + (size_t)(t + 2) * kstep; const char* b2 = last ? nB : cB + (size_t)(t + 2) * kstep;
            const char* a3 = a2 + kstep; const char* b3 = b2 + kstep;
            if (last && has_next) S.a_ready(nxt);
            if constexpr (SP2) {
            PG8_LDB(B0, 0, 0); PG8_LDB(B1, 0, 1); PG8_SCHED; PG8_LDA(At, 0, 0); do { if (g.gidx) PG8_STAGE_R(rsA, g.A, PG8_SA(1, 1), a1, voffAh[1]); else PG8_STAGE_U(rsA, g.A, PG8_SA(1, 1), a1, voffA[0], 1 * hstep); } while (0);
            PG8_WAIT_V(8); PG8_WAIT_L(0); PG8_BAR; PG8_MMA(0, 0, At, B0); PG8_MMA(0, 1, At, B1); PG8_BAR; PG8_SCHED;
            PG8_LDA(At, 0, 1); PG8_STAGE_U(rsB, g.Bt, PG8_SB(0, 0), b2, voffB[0], 0); PG8_STAGE_U(rsB, g.Bt, PG8_SB(0, 1), b2 + hstep, voffB[0], 0); do { if (g.gidx) PG8_STAGE_R(rsA, g.A, PG8_SA(0, 0), a2, voffAh[0]); else PG8_STAGE_U(rsA, g.A, PG8_SA(0, 0), a2, voffA[0], 0 * hstep); } while (0);
            PG8_WAIT_V(8); PG8_WAIT_L(0); PG8_BAR; PG8_MMA(1, 0, At, B0); PG8_MMA(1, 1, At, B1); PG8_BAR; PG8_SCHED;
            PG8_LDB(B0, 1, 0); PG8_LDB(B1, 1, 1); PG8_SCHED; PG8_LDA(At, 1, 0); do { if (g.gidx) PG8_STAGE_R(rsA, g.A, PG8_SA(0, 1), a2, voffAh[1]); else PG8_STAGE_U(rsA, g.A, PG8_SA(0, 1), a2, voffA[0], 1 * hstep); } while (0);
            PG8_WAIT_V(8); PG8_WAIT_L(0); PG8_BAR; PG8_MMA(0, 0, At, B0); PG8_MMA(0, 1, At, B1); PG8_BAR; PG8_SCHED;
            PG8_LDA(At, 1, 1); PG8_STAGE_U(rsB, g.Bt, PG8_SB(1, 0), b3, voffB[0], 0); PG8_STAGE_U(rsB, g.Bt, PG8_SB(1, 1), b3 + hstep, voffB[0], 0); do { if (g.gidx) PG8_STAGE_R(rsA, g.A, PG8_SA(1, 0), a3, voffAh[0]); else PG8_STAGE_U(rsA, g.A, PG8_SA(1, 0), a3, voffA[0], 0 * hstep); } while (0);
            PG8_WAIT_V(8); PG8_WAIT_L(0); PG8_BAR; PG8_MMA(1, 0, At, B0); PG8_MMA(1, 1, At, B1); PG8_BAR; PG8_SCHED;
            } else {
            PG8_LDB(B0, 0, 0); PG8_SCHED; PG8_LDA(At, 0, 0); do { if (g.gidx) PG8_STAGE_R(rsA, g.A, PG8_SA(1, 1), a1, voffAh[1]); else PG8_STAGE_U(rsA, g.A, PG8_SA(1, 1), a1, voffA[0], 1 * hstep); } while (0);
            PG8_WAIT_L(8); PG8_BAR; PG8_WAIT_L(0); PG8_MMA(0, 0, At, B0); PG8_BAR; PG8_SCHED;
            PG8_LDB(B1, 0, 1); PG8_STAGE_U(rsB, g.Bt, PG8_SB(0, 0), b2, voffB[0], 0);
            PG8_BAR; PG8_WAIT_L(0); PG8_MMA(0, 1, At, B1); PG8_BAR;
            PG8_LDA(At, 0, 1); do { if (g.gidx) PG8_STAGE_R(rsA, g.A, PG8_SA(0, 0), a2, voffAh[0]); else PG8_STAGE_U(rsA, g.A, PG8_SA(0, 0), a2, voffA[0], 0 * hstep); } while (0);
            PG8_BAR; PG8_WAIT_L(0); PG8_MMA(1, 0, At, B0); PG8_BAR; PG8_SCHED;
            PG8_STAGE_U(rsB, g.Bt, PG8_SB(0, 1), b2 + hstep, voffB[0], 0);
            PG8_WAIT_V(6); PG8_BAR; PG8_MMA(1, 1, At, B1); PG8_BAR;
            PG8_LDB(B0, 1, 0); PG8_SCHED; PG8_LDA(At, 1, 0); do { if (g.gidx) PG8_STAGE_R(rsA, g.A, PG8_SA(0, 1), a2, voffAh[1]); else PG8_STAGE_U(rsA, g.A, PG8_SA(0, 1), a2, voffA[0], 1 * hstep); } while (0);
            PG8_WAIT_L(8); PG8_BAR; PG8_WAIT_L(0); PG8_MMA(0, 0, At, B0); PG8_BAR; PG8_SCHED;
            PG8_LDB(B1, 1, 1); PG8_STAGE_U(rsB, g.Bt, PG8_SB(1, 0), b3, voffB[0], 0);
            PG8_BAR; PG8_WAIT_L(0); PG8_MMA(0, 1, At, B1); PG8_BAR;
            PG8_LDA(At, 1, 1); do { if (g.gidx) PG8_STAGE_R(rsA, g.A, PG8_SA(1, 0), a3, voffAh[0]); else PG8_STAGE_U(rsA, g.A, PG8_SA(1, 0), a3, voffA[0], 0 * hstep); } while (0);
            PG8_BAR; PG8_WAIT_L(0); PG8_MMA(1, 0, At, B0); PG8_BAR; PG8_SCHED;
            PG8_STAGE_U(rsB, g.Bt, PG8_SB(1, 1), b3 + hstep, voffB[0], 0);
            PG8_WAIT_V(6); PG8_BAR; PG8_MMA(1, 1, At, B1); PG8_BAR;
            }
        }
        if constexpr (ALIGN_EPI) { if (wr == 0) PG8_BAR; }
        if constexpr (!Epi::AFTER_DRAIN) { int t2_ = threadIdx.x; asm volatile("" : "+v"(t2_)); const int l2_ = t2_ & 63;
            E(acc, cur, wr, wc, l2_ & 15, l2_ >> 4); S.done(cur); }
        if (!has_next) break;
#pragma unroll
        for (int a = 0; a < 2; ++a)
#pragma unroll
            for (int b = 0; b < 2; ++b)
#pragma unroll
                for (int m = 0; m < 4; ++m)
#pragma unroll
                    for (int n = 0; n < 2; ++n) acc[a][b][m][n] = (f32x4){0.f, 0.f, 0.f, 0.f};
        cur = nxt; cA = nA; cB = nB; ++ui;
        if constexpr (ALIGN_EPI) { if (wr == 1) PG8_BAR; }
    }
    PG8_WAIT_V(0);
    if constexpr (!ALIGN_EPI) { if (wr == 0) PG8_BAR; }
    PG8_BAR;
    if constexpr (Epi::AFTER_DRAIN) { E.fused(acc, cur, wr, wc, fr, fq, lds, wid, lane); S.done(cur); }
#undef PG8_SA
#undef PG8_SB
#undef PG8_STAGE_R
#undef PG8_STAGE_U
#undef PG8_LDA
#undef PG8_LD1
#undef PG8_LDB
#undef PG8_MMA
#undef PG8_WAIT_V
#undef PG8_WAIT_L
#undef PG8_BAR
#undef PG8_SCHED
}
}
namespace mk {
using pg8::bf16_t; using pg8::bf16x8; using pg8::f32x4; using pg8::u32x4; using pg8::Unit; using pg8::Gemm;
#define LAS __attribute__((address_space(3)))
typedef short v4i16 __attribute__((ext_vector_type(4)));
typedef unsigned u32x2 __attribute__((ext_vector_type(2)));

constexpr int D = 1024, NB = 16, NT = 4096, NL = 256;
constexpr int MT = NB * NT, MC = NB * NL, MA = MT + MC;
constexpr int NPROJ = 2816, INC = 2832;
constexpr int NE = 16, FF = 512, CAP = 512;
constexpr float EPS = 1e-6f, LOG2E = 1.4426950408889634f;
constexpr int NWAVES = 8, NTHREADS = 512;
constexpr int LDS_BYTES = 144 * 1024;

constexpr size_t al256(size_t x) { return (x + 255) & ~(size_t)255; }
constexpr size_t WS_MOD = 0;
constexpr size_t WS_ROPE = WS_MOD + al256(17 * 6144 * 4);
constexpr size_t WS_MISC = WS_ROPE + al256(2 * 1024 * 4);
constexpr size_t WS_GATES = WS_MISC + 256;
constexpr size_t WS_AFF = WS_GATES + al256((size_t)MA * 16 * 4);
constexpr size_t WS_IDX = WS_AFF + al256((size_t)NB * NE * NT * 4);
constexpr size_t WS_GATE = WS_IDX + al256(256 * CAP * 4);
constexpr size_t WS_SLOT = WS_GATE + al256(256 * CAP * 4);
constexpr size_t WS_WIN = WS_SLOT + al256((size_t)256 * NT * 4);
constexpr size_t WS_WOUT = WS_WIN + al256((size_t)NPROJ * D * 2);
constexpr size_t WS_WGU = WS_WOUT + al256((size_t)D * D * 2);
constexpr size_t WS_WD = WS_WGU + al256((size_t)NE * 1024 * D * 2);
constexpr size_t WS_HX = WS_WD + al256((size_t)NE * D * FF * 2);
constexpr size_t WS_CQ = WS_HX;
constexpr size_t WS_CK = WS_HX + (size_t)MA * 512 * 2;
constexpr size_t WS_Q = WS_HX + al256((size_t)MA * D * 2);
constexpr size_t WS_KK = WS_Q + al256((size_t)MT * 512 * 2);
constexpr size_t WS_VV = WS_KK + al256((size_t)MA * 128 * 2);
constexpr size_t WS_M4 = WS_VV + al256((size_t)MA * 128 * 2);
constexpr size_t WS_MIX = WS_M4 + al256((size_t)4 * MA * 512 * 2);
constexpr size_t WS_HF = WS_MIX + (size_t)MT * D * 2;
constexpr size_t WS_HB = WS_HF + (size_t)MT * 512 * 2;
constexpr size_t WS_ACT = WS_HB + (size_t)MT * 512 * 2;
constexpr size_t WS_TBL = WS_ACT + al256((size_t)256 * CAP * FF * 2);
constexpr size_t WS_X1 = WS_M4;
static_assert((size_t)MT * D * 2 <= (size_t)136 * 1024 * 1024 && (size_t)136 * 1024 * 1024 + (size_t)256 * CAP * D <= (size_t)4 * MA * 512 * 2, "X1 and the gathered fp8 panels overlay MQ|MK and MV|MO");
constexpr size_t WS_BAR = WS_TBL + al256((size_t)256 * 34 * 384 * 4);
constexpr size_t WS_END = WS_BAR + 16384;
constexpr int LDS_GATE_OFF = 132 * 1024;
constexpr int LDS_BAR_OFF = 140 * 1024;
static_assert(WS_END <= ((size_t)1 << 30), "workspace map exceeds 1 GiB");
static_assert((size_t)256 * CAP * D * 2 <= (size_t)4 * MA * 512 * 2, "XG overlay fits");

struct Args { const float* in[20]; float* out; unsigned char* ws; int ph_lo, ph_hi, sub, pad; };

__device__ __forceinline__ float wave_sum(float v) {
#pragma unroll
    for (int o = 1; o < 64; o <<= 1) v += __shfl_xor(v, o);
    return v;
}
__device__ __forceinline__ float bflo(unsigned w) { return __builtin_bit_cast(float, w << 16); }
__device__ __forceinline__ float bfhi(unsigned w) { return __builtin_bit_cast(float, w & 0xffff0000u); }
typedef float f32x2_t __attribute__((ext_vector_type(2))); typedef __bf16 bf16x2_t __attribute__((ext_vector_type(2)));
__device__ __forceinline__ unsigned pkbf(float lo, float hi) { f32x2_t v = {lo, hi}; bf16x2_t b = __builtin_convertvector(v, bf16x2_t); return __builtin_bit_cast(unsigned, b); }
__device__ __forceinline__ unsigned pk4_fp8(float a, float b, float c, float d) { int p = __builtin_amdgcn_cvt_pk_fp8_f32(a, b, 0, false); p = __builtin_amdgcn_cvt_pk_fp8_f32(c, d, p, true); return (unsigned)p; }
constexpr float FP8_W_UP = 32.f;
constexpr int FP8_W_SCALE = 0x7A7A7A7A;
__device__ __forceinline__ float silu_f(float x) { return x * __builtin_amdgcn_rcpf(1.f + __expf(-x)); }
__device__ __forceinline__ float logsig_f(float x) { return fminf(x, 0.f) - log1pf(expf(-fabsf(x))); }
__device__ __forceinline__ f32x4 mfma16(bf16x8 a, bf16x8 b, f32x4 c) { return __builtin_amdgcn_mfma_f32_16x16x32_bf16(a, b, c, 0, 0, 0); }
__device__ __forceinline__ bf16x8 tr2(const LAS bf16_t* p0, const LAS bf16_t* p1) {
    const v4i16 a = __builtin_amdgcn_ds_read_tr16_b64_v4i16((LAS v4i16*)p0), b = __builtin_amdgcn_ds_read_tr16_b64_v4i16((LAS v4i16*)p1);
    return (bf16x8){a[0], a[1], a[2], a[3], b[0], b[1], b[2], b[3]};
}
__device__ __forceinline__ bf16x8 pack8(const f32x4 a, const f32x4 b) {
    u32x4 w; w.x = pkbf(a[0], a[1]); w.y = pkbf(a[2], a[3]); w.z = pkbf(b[0], b[1]); w.w = pkbf(b[2], b[3]); return __builtin_bit_cast(bf16x8, w);
}
__host__ __device__ __forceinline__ int win_dst_row(int n) {
    if (n >= 768) return n;
    const int pn = n >> 8, r = n & 255, wc = r >> 6, bj = (r >> 5) & 1, p = r & 31;
    return 256 * pn + 128 * bj + 32 * wc + p;
}

__device__ __forceinline__ void transpose_item(const float* W, int N, int k0, int n0, bf16_t* WT, int K, int drow0, LAS float* scr, int lane) {
    float tv[32];
#pragma unroll
    for (int i = 0; i < 32; ++i) tv[i] = W[(size_t)(k0 + 2 * i + (lane >> 5)) * N + n0 + (lane & 31)];
#pragma unroll
    for (int i = 0; i < 32; ++i) scr[(2 * i + (lane >> 5)) * 33 + (lane & 31)] = tv[i];
    asm volatile("s_waitcnt lgkmcnt(0)" ::: "memory");
    const int c = lane & 7;
#pragma unroll
    for (int j = 0; j < 4; ++j) { const int n = (lane >> 3) + 8 * j; const LAS float* s = scr + (8 * c) * 33 + n;
        u32x4 o; o.x = pkbf(s[0 * 33], s[1 * 33]); o.y = pkbf(s[2 * 33], s[3 * 33]); o.z = pkbf(s[4 * 33], s[5 * 33]); o.w = pkbf(s[6 * 33], s[7 * 33]);
        *(u32x4*)(WT + (size_t)(drow0 + n) * K + k0 + 8 * c) = o; }
    asm volatile("s_waitcnt lgkmcnt(0)" ::: "memory");
}
__device__ __forceinline__ void transpose_item8(const float* W, int N, int k0, int n0, unsigned char* WT, int K, int drow0, LAS float* scr, int lane) {
    float tv[32];
#pragma unroll
    for (int i = 0; i < 32; ++i) tv[i] = W[(size_t)(k0 + 2 * i + (lane >> 5)) * N + n0 + (lane & 31)];
#pragma unroll
    for (int i = 0; i < 32; ++i) scr[(2 * i + (lane >> 5)) * 33 + (lane & 31)] = tv[i];
    asm volatile("s_waitcnt lgkmcnt(0)" ::: "memory");
    const int c = lane & 7;
#pragma unroll
    for (int j = 0; j < 4; ++j) { const int n = (lane >> 3) + 8 * j; const LAS float* s = scr + (8 * c) * 33 + n;
        u32x2 o; o.x = pk4_fp8(s[0 * 33] * FP8_W_UP, s[1 * 33] * FP8_W_UP, s[2 * 33] * FP8_W_UP, s[3 * 33] * FP8_W_UP); o.y = pk4_fp8(s[4 * 33] * FP8_W_UP, s[5 * 33] * FP8_W_UP, s[6 * 33] * FP8_W_UP, s[7 * 33] * FP8_W_UP);
        *(u32x2*)(WT + (size_t)(drow0 + n) * K + k0 + 8 * c) = o; }
    asm volatile("s_waitcnt lgkmcnt(0)" ::: "memory");
}
__device__ __forceinline__ void phase0(const Args& a, LAS unsigned char* lds) {
    const int tid = threadIdx.x, lane = tid & 63, wave = tid >> 6, wg = blockIdx.x, G = gridDim.x;
    unsigned char* ws = a.ws;
    {
        LAS float* sc = (LAS float*)lds;
        LAS float* part = sc + 17 * 1024;
        const float* c = a.in[1]; const float* cctx = a.in[3]; const float* w_mod = a.in[4]; const float* b_mod = a.in[5];
        float* mod = (float*)(ws + WS_MOD);
        for (int i = tid; i < 17 * 1024; i += NTHREADS) { const int r = i >> 10, k = i & 1023; const float v = r < 16 ? c[r * 1024 + k] : cctx[k]; sc[i] = v / (1.f + expf(-v)); }
        __syncthreads();
        for (int it = wg; it < 256; it += G) {
            const int col0 = it * 24;
            if (tid < 504) {
                const int j = tid % 24, kg = tid / 24; float acc[17];
#pragma unroll
                for (int r = 0; r < 17; ++r) acc[r] = 0.f;
#pragma unroll 7
                for (int k = kg; k < 1024; k += 21) { const float w = w_mod[(size_t)k * 6144 + col0 + j];
#pragma unroll
                    for (int r = 0; r < 17; ++r) acc[r] += sc[r * 1024 + k] * w; }
#pragma unroll
                for (int r = 0; r < 17; ++r) part[(kg * 17 + r) * 24 + j] = acc[r];
            }
            __syncthreads();
            if (tid < 408) { const int r = tid / 24, j = tid % 24; float s = b_mod[col0 + j]; for (int kg = 0; kg < 21; ++kg) s += part[(kg * 17 + r) * 24 + j]; mod[r * 6144 + col0 + j] = s; }
            __syncthreads();
        }
    }
    if (wg == 0) {
        float* rope = (float*)(ws + WS_ROPE);
        for (int i = tid; i < 1024; i += NTHREADS) { const int pos = i >> 4, f = i & 15; const float ang = (float)pos * powf(10000.f, -(float)f / 16.f); rope[i] = cosf(ang); rope[1024 + i] = sinf(ang); }
        if (tid == 0) { float mq = 0.f, mkk = 0.f; for (int i = 0; i < 64; ++i) { mq = fmaxf(mq, fabsf(a.in[11][i])); mkk = fmaxf(mkk, fabsf(a.in[12][i])); }
            ((float*)(ws + WS_MISC))[0] = fmaxf(0.f, 8.f * mq * mkk * LOG2E - 16.f); }
    }
    {
        LAS float* scr = (LAS float*)lds + wave * (64 * 33);
        const int gw = wg * NWAVES + wave, NGW = G * NWAVES;
        bf16_t* WIN = (bf16_t*)(ws + WS_WIN);
        for (int it = gw; it < 16 * 88; it += NGW) { const int kb = it / 88, nb = it % 88; transpose_item(a.in[8], INC, 64 * kb, 32 * nb, WIN, D, win_dst_row(32 * nb), scr, lane); }
    }
}
__device__ __forceinline__ void transpose_late(const Args& a, LAS unsigned char* lds) {
    const int tid = threadIdx.x, lane = tid & 63, wave = tid >> 6, wg = blockIdx.x, G = gridDim.x;
    unsigned char* ws = a.ws;
    LAS float* scr = (LAS float*)lds + wave * (64 * 33);
    const int gw = wg * NWAVES + wave, NGW = G * NWAVES;
    constexpr int I_OUT = 16 * 32, I_G = 16 * 16, I_D = 8 * 32;
    constexpr int NITEMS = I_OUT + NE * (2 * I_G + I_D);
    bf16_t* WOUT = (bf16_t*)(ws + WS_WOUT); unsigned char* WGU = ws + WS_WGU; unsigned char* WDT = ws + WS_WD;
    for (int it = gw; it < NITEMS; it += NGW) {
        int r = it;
        if (r < I_OUT) { const int kb = r / 32, nb = r % 32; transpose_item(a.in[15], D, 64 * kb, 32 * nb, WOUT, D, 32 * nb, scr, lane); continue; } r -= I_OUT;
        const int e = r / (2 * I_G + I_D); r -= e * (2 * I_G + I_D);
        if (r < 2 * I_G) { const int up = r / I_G, rr = r % I_G, kb = rr / 16, nb = rr % 16, n0 = 32 * nb;
            transpose_item8((up ? a.in[18] : a.in[17]) + (size_t)e * D * FF, FF, 64 * kb, n0, WGU + (size_t)e * 1024 * D, D, 256 * (n0 >> 7) + (n0 & 127) + 128 * up, scr, lane); continue; }
        r -= 2 * I_G;
        { const int kb = r / 32, nb = r % 32; transpose_item8(a.in[19] + (size_t)e * FF * D, D, 64 * kb, 32 * nb, WDT + (size_t)e * D * FF, FF, 32 * nb, scr, lane); }
    }
}

__device__ __forceinline__ void fill_w16(LAS float* W16, const float* src, int pitch, int tid) {
    for (int idx = tid; idx < 1024 * 16; idx += NTHREADS) { const int k = idx >> 4, t = idx & 15; const int ln = (k & 255) >> 2, i = k & 3, j = k >> 8;
        W16[((j * 4 + i) * 64 + ln) * 20 + t] = src[(size_t)k * pitch + t]; }
}
__device__ __forceinline__ float reduce16(const float (&g)[16], int lane) {
    float r8[8], r4[4], r2[2];
    const bool b5 = (lane & 32) != 0, b4 = (lane & 16) != 0, b3 = (lane & 8) != 0, b2 = (lane & 4) != 0;
#pragma unroll
    for (int t = 0; t < 8; ++t) { const float keep = b5 ? g[t + 8] : g[t], send = b5 ? g[t] : g[t + 8]; r8[t] = keep + __shfl_xor(send, 32); }
#pragma unroll
    for (int t = 0; t < 4; ++t) { const float keep = b4 ? r8[t + 4] : r8[t], send = b4 ? r8[t] : r8[t + 4]; r4[t] = keep + __shfl_xor(send, 16); }
#pragma unroll
    for (int t = 0; t < 2; ++t) { const float keep = b3 ? r4[t + 2] : r4[t], send = b3 ? r4[t] : r4[t + 2]; r2[t] = keep + __shfl_xor(send, 8); }
    const float keep = b2 ? r2[1] : r2[0], send = b2 ? r2[0] : r2[1];
    float r1 = keep + __shfl_xor(send, 4);
    r1 += __shfl_xor(r1, 1); r1 += __shfl_xor(r1, 2);
    return r1;
}
__device__ __forceinline__ int reduce16_index(int lane) { return ((lane >> 5) & 1) * 8 + ((lane >> 4) & 1) * 4 + ((lane >> 3) & 1) * 2 + ((lane >> 2) & 1); }
__device__ __forceinline__ void rows2_norm_dots(f32x4 (&va)[4], f32x4 (&vb)[4], const f32x4 (&sc)[4], const f32x4 (&sh)[4], const LAS float* W16, int lane, float& ga, float& gb) {
    float sa = 0.f, sb = 0.f;
#pragma unroll
    for (int j = 0; j < 4; ++j) { sa += (va[j][0] * va[j][0] + va[j][1] * va[j][1]) + (va[j][2] * va[j][2] + va[j][3] * va[j][3]); sb += (vb[j][0] * vb[j][0] + vb[j][1] * vb[j][1]) + (vb[j][2] * vb[j][2] + vb[j][3] * vb[j][3]); }
    const float ra = rsqrtf(wave_sum(sa) * (1.f / D) + EPS), rb = rsqrtf(wave_sum(sb) * (1.f / D) + EPS);
    float g0[16], g1[16];
#pragma unroll
    for (int t = 0; t < 16; ++t) { g0[t] = 0.f; g1[t] = 0.f; }
    int off0 = lane * 20, off1 = lane * 20;
#pragma unroll
    for (int j = 0; j < 4; ++j) {
        va[j] = va[j] * ra * sc[j] + sh[j]; vb[j] = vb[j] * rb * sc[j] + sh[j];
#pragma unroll
        for (int i = 0; i < 4; ++i) { const int off = (i & 1) ? off1 : off0; const LAS f32x4* wp = (const LAS f32x4*)(W16 + (j * 4 + i) * 64 * 20 + off); const float ha = va[j][i], hb = vb[j][i];
#pragma unroll
            for (int q = 0; q < 4; ++q) { const f32x4 w = wp[q];
                g0[4 * q + 0] += ha * w[0]; g0[4 * q + 1] += ha * w[1]; g0[4 * q + 2] += ha * w[2]; g0[4 * q + 3] += ha * w[3];
                g1[4 * q + 0] += hb * w[0]; g1[4 * q + 1] += hb * w[1]; g1[4 * q + 2] += hb * w[2]; g1[4 * q + 3] += hb * w[3]; }
            if (i & 1) asm volatile("" : "+v"(off1), "+v"(g0[0]), "+v"(g0[1]), "+v"(g0[2]), "+v"(g0[3]), "+v"(g0[4]), "+v"(g0[5]), "+v"(g0[6]), "+v"(g0[7]), "+v"(g0[8]), "+v"(g0[9]), "+v"(g0[10]), "+v"(g0[11]), "+v"(g0[12]), "+v"(g0[13]), "+v"(g0[14]), "+v"(g0[15])); else asm volatile("" : "+v"(off0), "+v"(g0[0]), "+v"(g0[1]), "+v"(g0[2]), "+v"(g0[3]), "+v"(g0[4]), "+v"(g0[5]), "+v"(g0[6]), "+v"(g0[7]), "+v"(g0[8]), "+v"(g0[9]), "+v"(g0[10]), "+v"(g0[11]), "+v"(g0[12]), "+v"(g0[13]), "+v"(g0[14]), "+v"(g0[15]));
            asm volatile("" : "+v"(g1[0]), "+v"(g1[1]), "+v"(g1[2]), "+v"(g1[3]), "+v"(g1[4]), "+v"(g1[5]), "+v"(g1[6]), "+v"(g1[7]), "+v"(g1[8]), "+v"(g1[9]), "+v"(g1[10]), "+v"(g1[11]), "+v"(g1[12]), "+v"(g1[13]), "+v"(g1[14]), "+v"(g1[15])); }
    }
    ga = reduce16(g0, lane); gb = reduce16(g1, lane);
}
__device__ __forceinline__ void store_row_bf16(bf16_t* orow, const f32x4 (&v)[4], int lane) {
#pragma unroll
    for (int j = 0; j < 4; ++j) { u32x2 o; o.x = pkbf(v[j][0], v[j][1]); o.y = pkbf(v[j][2], v[j][3]); *(u32x2*)(orow + 4 * lane + 256 * j) = o; }
}
__device__ __forceinline__ void p1_build(const Args& a, LAS unsigned char* lds, int b, int tid) {
    const float* mr = (const float*)(a.ws + WS_MOD) + b * 6144; const float* n1w = a.in[6]; const float* Wg = a.in[8] + NPROJ; const float* bg = a.in[9];
    LAS bf16_t* WB = (LAS bf16_t*)lds; LAS float* SC = (LAS float*)(lds + 32768); LAS float* SH = (LAS float*)(lds + 36864); LAS float* CP = (LAS float*)(lds + 40960);
    for (int c = tid; c < D; c += NTHREADS) {
        const float scv = n1w[c] * (1.f + mr[D + c]); SC[c] = scv; SH[c] = mr[c];
        const int fi = ((c >> 6) * 2 + ((c >> 5) & 1)) * 64 + ((c >> 3) & 3) * 16, ee = c & 7;
#pragma unroll
        for (int j = 0; j < 4; ++j) { const f32x4 w = *(const f32x4*)(Wg + (size_t)c * INC + 4 * j);
#pragma unroll
            for (int i = 0; i < 4; ++i) WB[((fi + 4 * j + i) << 3) + ee] = (bf16_t)(pkbf(scv * w[i], 0.f) & 0xffffu); }
    }
    { const int e = tid & 15, part = tid >> 4; float cb = 0.f;
#pragma unroll 4
        for (int i = 0; i < 32; ++i) { const int c = part * 32 + i; cb += mr[c] * Wg[(size_t)c * INC + e]; }
        CP[part * 16 + e] = cb; }
    __syncthreads();
    if (tid < 16) { float t = bg[tid]; for (int p = 0; p < 32; ++p) t += CP[p * 16 + tid]; CP[512 + tid] = t; }
    __syncthreads();
}
#define P1_ROWPTR(m) ((m) < MT ? a.in[0] + (size_t)(m) * D : a.in[2] + (size_t)((m) - MT) * D)
__device__ __forceinline__ void p1_tiles(const Args& a, LAS unsigned char* lds, int row_base, int ntiles) {
    const int tid = threadIdx.x, lane = tid & 63, wave = tid >> 6, fr = lane & 15, kq = lane >> 4;
    const LAS bf16_t* WB = (const LAS bf16_t*)lds; const LAS float* SC = (const LAS float*)(lds + 32768); const LAS float* SH = (const LAS float*)(lds + 36864); const LAS float* CP = (const LAS float*)(lds + 40960);
    bf16_t* HX = (bf16_t*)(a.ws + WS_HX); float* GATES = (float*)(a.ws + WS_GATES);
    const float cbe = CP[512 + fr]; const bool isf = ((fr >> 2) & 1) != 0;
#pragma unroll 1
    for (int t0 = wave; t0 < ntiles; t0 += NWAVES) {
        int row = row_base + 8 * t0 + (lane & 7); asm volatile("" : "+v"(row));
        const int cl = 8 * (4 * ((lane >> 3) & 1) + kq);
        const float* xp = P1_ROWPTR(row) + cl;
        f32x4 xv[32];
#pragma unroll
        for (int s = 0; s < 16; ++s) { xv[2 * s] = *(const f32x4*)(xp + 64 * s); xv[2 * s + 1] = *(const f32x4*)(xp + 64 * s + 4); }
        f32x4 acc0 = {0.f, 0.f, 0.f, 0.f}, acc1 = {0.f, 0.f, 0.f, 0.f}; float ss = 0.f;
        int boff = lane * 8, coff = cl; asm volatile("" : "+v"(boff), "+v"(coff));
#pragma unroll
        for (int g = 0; g < 4; ++g) {
            bf16x8 B0[4], B1[4];
#pragma unroll
            for (int i = 0; i < 4; ++i) { B0[i] = *(const LAS bf16x8*)(WB + boff + (4 * g + i) * 1024); B1[i] = *(const LAS bf16x8*)(WB + boff + (4 * g + i) * 1024 + 512); }
#pragma unroll
            for (int i = 0; i < 4; ++i) { const f32x4 v0 = xv[8 * g + 2 * i], v1 = xv[8 * g + 2 * i + 1];
                u32x4 pk; pk.x = pkbf(v0[0], v0[1]); pk.y = pkbf(v0[2], v0[3]); pk.z = pkbf(v1[0], v1[1]); pk.w = pkbf(v1[2], v1[3]);
                const bf16x8 A = __builtin_bit_cast(bf16x8, pk);
                acc0 = mfma16(A, B0[i], acc0); acc1 = mfma16(A, B1[i], acc1);
                ss += (v0[0] * v0[0] + v0[1] * v0[1]) + (v0[2] * v0[2] + v0[3] * v0[3]) + (v1[0] * v1[0] + v1[1] * v1[1]) + (v1[2] * v1[2] + v1[3] * v1[3]); }
            asm volatile("" : "+v"(boff), "+v"(acc0), "+v"(acc1));
        }
        ss += __shfl_xor(ss, 8); ss += __shfl_xor(ss, 16); ss += __shfl_xor(ss, 32);
        const float rstd = rsqrtf(ss * (1.f / D) + EPS);
#pragma unroll
        for (int i = 0; i < 4; ++i) {
            float gv = (acc0[i] + __shfl_xor(acc1[i], 32)) * __shfl(rstd, (4 * kq + i) & 7) + cbe;
            if (isf) gv = logsig_f(gv);
            if (lane < 32) GATES[(size_t)(row_base + 8 * t0 + 4 * kq + i) * 16 + fr] = gv;
        }
        bf16_t* hp = HX + (size_t)row * D + cl;
#pragma unroll
        for (int s = 0; s < 16; ++s) {
            const int c0 = 64 * s + coff;
            const f32x4 s0 = *(const LAS f32x4*)(SC + c0), s1 = *(const LAS f32x4*)(SC + c0 + 4), h0 = *(const LAS f32x4*)(SH + c0), h1 = *(const LAS f32x4*)(SH + c0 + 4);
            const f32x4 o0 = xv[2 * s] * rstd * s0 + h0, o1 = xv[2 * s + 1] * rstd * s1 + h1;
            u32x4 o; o.x = pkbf(o0[0], o0[1]); o.y = pkbf(o0[2], o0[3]); o.z = pkbf(o1[0], o1[1]); o.w = pkbf(o1[2], o1[3]);
            *(u32x4*)(hp + 64 * s) = o;
        }
    }
}
__device__ __forceinline__ void phase1(const Args& a, LAS unsigned char* lds) {
    const int tid = threadIdx.x, c = blockIdx.x;
    for (int pm = c; pm < 256; pm += gridDim.x) {
        p1_build(a, lds, pm >> 4, tid);
        p1_tiles(a, lds, pm * 256, 32);
        __syncthreads();
        p1_build(a, lds, 16, tid);
        p1_tiles(a, lds, MT + pm * 16, 2);
        __syncthreads();
    }
}
#undef P1_ROWPTR

struct SeqOrder {
    int pm0, nN, n;
    __device__ __forceinline__ bool next(int i, Unit& u) const { if (i >= n) return false; u.pm = pm0 + i / nN; u.pn = i % nN; return true; }
    __device__ __forceinline__ void a_ready(const Unit&) const {}
    __device__ __forceinline__ void done(const Unit&) const {}
};
struct EpiProj {
    static constexpr bool PERM = true, AFTER_DRAIN = false;
    bf16_t *Q, *KK, *VV, *M4; const float *qw, *kw, *rope; float qscale;
    __device__ __forceinline__ void operator()(const f32x4 (&acc)[2][2][4][2], const Unit& u, int wr, int wc, int fr, int fq) const {
        const int pn = u.pn, row0 = u.pm * 256 + wr * 64 + fr;
        bf16_t *Q_ = Q, *KK_ = KK, *VV_ = VV, *M4_ = M4; asm volatile("" : "+s"(Q_), "+s"(KK_), "+s"(VV_), "+s"(M4_));
        if (pn >= 3) {
            bf16_t* base = M4_ + (size_t)((pn - 3) >> 1) * MA * 512 + ((pn - 3) & 1) * 256 + wc * 32 + 8 * fq;
#pragma unroll
            for (int ai = 0; ai < 2; ++ai)
#pragma unroll
                for (int m = 0; m < 4; ++m) { bf16_t* rowp = base + (size_t)(row0 + ai * 128 + m * 16) * 512;
#pragma unroll
                    for (int bj = 0; bj < 2; ++bj) { const f32x4 v0 = acc[ai][bj][m][0], v1 = acc[ai][bj][m][1]; u32x4 w; w.x = pkbf(v0[0], v0[1]); w.y = pkbf(v0[2], v0[3]); w.z = pkbf(v1[0], v1[1]); w.w = pkbf(v1[2], v1[3]);
                        *(u32x4*)(rowp + bj * 128) = w; } }
            return;
        }
        const bool latent = u.pm < 256;
        if (pn < 2 && !latent) return;
        const bool isv = (pn == 2) && (wc >= 2);
        bf16_t* dst; int ld; const float* nw; float osc = 1.f;
        if (pn < 2) { dst = Q_ + (4 * pn + wc) * 64; ld = 512; nw = qw; osc = qscale; }
        else if (!isv) { dst = KK_ + wc * 64; ld = 128; nw = kw; }
        else { dst = VV_ + (wc - 2) * 64; ld = 128; nw = kw; }
        f32x4 w4[2][2];
#pragma unroll
        for (int bj = 0; bj < 2; ++bj)
#pragma unroll
            for (int n = 0; n < 2; ++n) w4[bj][n] = *(const f32x4*)(nw + 32 * bj + 8 * fq + 4 * n);
#pragma unroll
        for (int ai = 0; ai < 2; ++ai)
#pragma unroll
            for (int m = 0; m < 4; ++m) {
                const int row = row0 + ai * 128 + m * 16;
                f32x4 y[2][2];
#pragma unroll
                for (int bj = 0; bj < 2; ++bj)
#pragma unroll
                    for (int n = 0; n < 2; ++n) y[bj][n] = acc[ai][bj][m][n];
                if (!isv) {
                    float ss = 0.f;
#pragma unroll
                    for (int bj = 0; bj < 2; ++bj)
#pragma unroll
                        for (int n = 0; n < 2; ++n) ss += (y[bj][n][0] * y[bj][n][0] + y[bj][n][1] * y[bj][n][1]) + (y[bj][n][2] * y[bj][n][2] + y[bj][n][3] * y[bj][n][3]);
                    ss += __shfl_xor(ss, 16); ss += __shfl_xor(ss, 32);
                    const float rinv = rsqrtf(ss * (1.f / 64.f) + EPS);
#pragma unroll
                    for (int bj = 0; bj < 2; ++bj)
#pragma unroll
                        for (int n = 0; n < 2; ++n) y[bj][n] = y[bj][n] * rinv * w4[bj][n];
                    if (latent) {
                        const int ntok = row & (NT - 1); const int pos = (fq < 2) ? (ntok >> 6) : (ntok & 63);
                        const float* rp = rope + pos * 16 + 8 * (fq & 1);
#pragma unroll
                        for (int n = 0; n < 2; ++n) { const f32x4 cs = *(const f32x4*)(rp + 4 * n), sn = *(const f32x4*)(rp + 1024 + 4 * n);
                            const f32x4 x1 = y[0][n], x2 = y[1][n]; y[0][n] = x1 * cs - x2 * sn; y[1][n] = x2 * cs + x1 * sn; }
                    }
                }
                bf16_t* rowp = dst + (size_t)row * ld + 8 * fq;
#pragma unroll
                for (int bj = 0; bj < 2; ++bj) { const f32x4 v0 = y[bj][0] * osc, v1 = y[bj][1] * osc; u32x4 w; w.x = pkbf(v0[0], v0[1]); w.y = pkbf(v0[2], v0[3]); w.z = pkbf(v1[0], v1[1]); w.w = pkbf(v1[2], v1[3]);
                    *(u32x4*)(rowp + 32 * bj) = w; }
            }
    }
};
struct EpiOut {
    static constexpr bool PERM = true, AFTER_DRAIN = false;
    const float* x; const float* mod; bf16_t* X1;
    __device__ __forceinline__ void operator()(const f32x4 (&acc)[2][2][4][2], const Unit& u, int wr, int wc, int fr, int fq) const {
        typedef const float __attribute__((address_space(1))) GF; typedef bf16_t __attribute__((address_space(1))) GB; typedef const f32x4 __attribute__((address_space(1))) GF4; typedef u32x4 __attribute__((address_space(1))) GU4;
        const int row0 = u.pm * 256 + wr * 64 + fr, col0 = u.pn * 256 + wc * 32 + 8 * fq;
        const float* x_ = x; bf16_t* out_ = X1; asm volatile("" : "+s"(x_), "+s"(out_));
        GF* xg = (GF*)x_ + (size_t)row0 * D + col0; GB* og = (GB*)out_ + (size_t)row0 * D + col0;
        const float* g1 = mod + (u.pm >> 4) * 6144 + 2 * D;
        f32x4 gv[2][2];
#pragma unroll
        for (int bj = 0; bj < 2; ++bj)
#pragma unroll
            for (int n = 0; n < 2; ++n) gv[bj][n] = *(const f32x4*)(g1 + col0 + bj * 128 + n * 4);
        f32x4 xr[8][2][2];
#define MK_EO_LD(b) do { const size_t off = (size_t)(((b) >> 2) * 128 + ((b) & 3) * 16) * D; _Pragma("unroll") for (int bj = 0; bj < 2; ++bj) { xr[b][bj][0] = *(GF4*)(xg + off + bj * 128); xr[b][bj][1] = *(GF4*)(xg + off + bj * 128 + 4); } } while (0)
        MK_EO_LD(0); MK_EO_LD(1); MK_EO_LD(2); MK_EO_LD(3);
#pragma unroll
        for (int b = 0; b < 8; ++b) {
            const int ai = b >> 2, m = b & 3; const size_t off = (size_t)(ai * 128 + m * 16) * D;
#pragma unroll
            for (int bj = 0; bj < 2; ++bj) { const f32x4 o0 = xr[b][bj][0] + gv[bj][0] * acc[ai][bj][m][0], o1 = xr[b][bj][1] + gv[bj][1] * acc[ai][bj][m][1];
                u32x4 w; w.x = pkbf(o0[0], o0[1]); w.y = pkbf(o0[2], o0[3]); w.z = pkbf(o1[0], o1[1]); w.w = pkbf(o1[2], o1[3]);
                *(GU4*)(og + off + bj * 128) = w; }
            if (b + 4 < 8) { switch (b) { case 0: MK_EO_LD(4); break; case 1: MK_EO_LD(5); break; case 2: MK_EO_LD(6); break; default: MK_EO_LD(7); break; } }
        }
#undef MK_EO_LD
    }
};
struct EpiAct {
    static constexpr bool PERM = true, AFTER_DRAIN = false;
    unsigned char* ACT;
    __device__ __forceinline__ void operator()(const f32x4 (&acc)[2][2][4][2], const Unit& u, int wr, int wc, int fr, int fq) const {
        const int row0 = u.pm * 256 + wr * 64 + fr, col0 = u.pn * 128 + wc * 32 + 8 * fq;
        unsigned char* ACT_ = ACT; asm volatile("" : "+s"(ACT_));
#pragma unroll
        for (int ai = 0; ai < 2; ++ai)
#pragma unroll
            for (int m = 0; m < 4; ++m) { f32x4 o[2];
#pragma unroll
                for (int n = 0; n < 2; ++n) { const f32x4 gt = acc[ai][0][m][n], up = acc[ai][1][m][n];
#pragma unroll
                    for (int j = 0; j < 4; ++j) o[n][j] = silu_f(gt[j] * (1.f / FP8_W_UP)) * (up[j] * (1.f / FP8_W_UP)); }
                u32x2 w; w.x = pk4_fp8(o[0][0], o[0][1], o[0][2], o[0][3]); w.y = pk4_fp8(o[1][0], o[1][1], o[1][2], o[1][3]);
                *(u32x2*)(ACT_ + (size_t)(row0 + ai * 128 + m * 16) * FF + col0) = w; asm volatile("" ::: "memory"); }
    }
};
struct EpiDown {
    static constexpr bool PERM = true, AFTER_DRAIN = false;
    bf16_t* Y; const LAS float* gate; float FP8SC;
    __device__ __forceinline__ void operator()(const f32x4 (&acc)[2][2][4][2], const Unit& u, int wr, int wc, int fr, int fq) const {
        const int row0 = u.pm * 256 + wr * 64 + fr, col0 = u.pn * 256 + wc * 32 + 8 * fq;
        bf16_t* Y_ = Y; const LAS float* gate_ = gate; asm volatile("" : "+s"(Y_));
#pragma unroll
        for (int ai = 0; ai < 2; ++ai)
#pragma unroll
            for (int m = 0; m < 4; ++m) { const int row = row0 + ai * 128 + m * 16; const float gt = gate_[row] * FP8SC;
#pragma unroll
                for (int bj = 0; bj < 2; ++bj) { const f32x4 v0 = acc[ai][bj][m][0] * gt, v1 = acc[ai][bj][m][1] * gt; u32x4 w; w.x = pkbf(v0[0], v0[1]); w.y = pkbf(v0[2], v0[3]); w.z = pkbf(v1[0], v1[1]); w.w = pkbf(v1[2], v1[3]);
                    *(u32x4*)(Y_ + (size_t)row * D + col0 + bj * 128) = w; } asm volatile("" ::: "memory"); }
    }
};

__device__ __forceinline__ void conv_rows(const Args& a) {
    const int tid = threadIdx.x, lane = tid & 63, wave = tid >> 6;
    const bf16_t* MQ = (const bf16_t*)(a.ws + WS_M4); const bf16_t* MK = MQ + (size_t)MA * 512;
    bf16_t* CQ = (bf16_t*)(a.ws + WS_CQ); bf16_t* CK = (bf16_t*)(a.ws + WS_CK);
    const float* conv = a.in[10];
    f32x4 wq[3][2], wk[3][2];
#pragma unroll
    for (int j = 0; j < 3; ++j) { wq[j][0] = *(const f32x4*)(conv + j * 1024 + 8 * lane); wq[j][1] = *(const f32x4*)(conv + j * 1024 + 8 * lane + 4);
        wk[j][0] = *(const f32x4*)(conv + j * 1024 + 512 + 8 * lane); wk[j][1] = *(const f32x4*)(conv + j * 1024 + 512 + 8 * lane + 4); }
    const int gw = blockIdx.x * NWAVES + wave, NGW = gridDim.x * NWAVES;
    const int per = (MA + NGW - 1) / NGW; const int r0 = gw * per, r1 = min(MA, r0 + per);
    if (r0 >= r1) return;
    const u32x4 zero = {0u, 0u, 0u, 0u};
#define CV_POS(m) ((m) < MT ? ((m) & (NT - 1)) : (((m) - MT) & (NL - 1)))
#define CV_LEN(m) ((m) < MT ? NT : NL)
#define CV_LD(dst, buf, m) do { dst = ((m) >= 0 && (m) < MA) ? *(const u32x4*)(buf + (size_t)(m) * 512 + 8 * lane) : zero; } while (0)
    u32x4 wq_[6], wk_[6], nq_[4], nk_[4];
#pragma unroll
    for (int i = 0; i < 6; ++i) { CV_LD(wq_[i], MQ, r0 - 1 + i); CV_LD(wk_[i], MK, r0 - 1 + i); }
#pragma unroll 1
    for (int m = r0; m < r1; m += 4) {
#pragma unroll
        for (int i = 0; i < 4; ++i) { CV_LD(nq_[i], MQ, m + 5 + i); CV_LD(nk_[i], MK, m + 5 + i); }
#pragma unroll
        for (int u = 0; u < 4; ++u) {
            const int mm = m + u;
            if (mm < r1) {
                const int p = CV_POS(mm), len = CV_LEN(mm); const bool first = (p == 0), last = (p == len - 1);
                const u32x4 qp = wq_[u], qc = wq_[u + 1], qn = wq_[u + 2], kp = wk_[u], kc = wk_[u + 1], kn = wk_[u + 2];
                u32x4 oq, ok;
#pragma unroll
                for (int e = 0; e < 4; ++e) {
                    const float ql0 = first ? 0.f : bflo(qp[e]), qh0 = first ? 0.f : bfhi(qp[e]), ql2 = last ? 0.f : bflo(qn[e]), qh2 = last ? 0.f : bfhi(qn[e]);
                    const float kl0 = first ? 0.f : bflo(kp[e]), kh0 = first ? 0.f : bfhi(kp[e]), kl2 = last ? 0.f : bflo(kn[e]), kh2 = last ? 0.f : bfhi(kn[e]);
                    const int h2 = e >> 1, i0 = (2 * e) & 3, i1 = (2 * e + 1) & 3;
                    const float uq0 = silu_f(ql0 * wq[0][h2][i0] + bflo(qc[e]) * wq[1][h2][i0] + ql2 * wq[2][h2][i0]) * 0.08838834764831845f;
                    const float uq1 = silu_f(qh0 * wq[0][h2][i1] + bfhi(qc[e]) * wq[1][h2][i1] + qh2 * wq[2][h2][i1]) * 0.08838834764831845f;
                    const float uk0 = silu_f(kl0 * wk[0][h2][i0] + bflo(kc[e]) * wk[1][h2][i0] + kl2 * wk[2][h2][i0]);
                    const float uk1 = silu_f(kh0 * wk[0][h2][i1] + bfhi(kc[e]) * wk[1][h2][i1] + kh2 * wk[2][h2][i1]);
                    oq[e] = pkbf(uq0, uq1); ok[e] = pkbf(uk0, uk1);
                }
                *(u32x4*)(CQ + (size_t)mm * 512 + 8 * lane) = oq; *(u32x4*)(CK + (size_t)mm * 512 + 8 * lane) = ok;
            }
        }
        wq_[0] = wq_[4]; wq_[1] = wq_[5]; wk_[0] = wk_[4]; wk_[1] = wk_[5];
#pragma unroll
        for (int i = 0; i < 4; ++i) { wq_[2 + i] = nq_[i]; wk_[2 + i] = nk_[i]; }
    }
#undef CV_LD
#undef CV_POS
#undef CV_LEN
}

constexpr int AT_STRIDE = 72;
constexpr int AT_K = 0, AT_V = 384 * AT_STRIDE * 2;
__device__ __forceinline__ void attn_tile(const LAS bf16_t* AK, const LAS bf16_t* AV, int kb, bool masked, int kpos_base  , int qpos0  ,
                                          const bf16x8 (&Qf)[4][2], f32x4 (&O)[4][4], float (&ls)[4], float cshift, int fr, int fq) {
    const int q4 = fr >> 2, p4 = fr & 3;
#pragma unroll
    for (int kk2 = 0; kk2 < 2; ++kk2) {
        f32x4 S[2][4];
#pragma unroll
        for (int hh = 0; hh < 2; ++hh) {
            const LAS bf16_t* kp = AK + (kb + 32 * kk2 + 16 * hh + fr) * AT_STRIDE + 8 * fq;
            const bf16x8 A0 = *(const LAS bf16x8*)kp, A1 = *(const LAS bf16x8*)(kp + 32);
#pragma unroll
            for (int qt = 0; qt < 4; ++qt) { f32x4 z = {-cshift, -cshift, -cshift, -cshift}; z = mfma16(A0, Qf[qt][0], z); S[hh][qt] = mfma16(A1, Qf[qt][1], z); }
        }
        if (masked) {
#pragma unroll
            for (int hh = 0; hh < 2; ++hh)
#pragma unroll
                for (int qt = 0; qt < 4; ++qt)
#pragma unroll
                    for (int r = 0; r < 4; ++r) {
                        float p = __builtin_amdgcn_exp2f(S[hh][qt][r]);
                        const int kpos = kpos_base + kb + 32 * kk2 + 16 * hh + 4 * fq + r, qpos = qpos0 + 16 * qt + fr; const int dd = kpos - qpos;
                        if (kpos < 0 || kpos >= NT || dd > 128 || dd < -128) p = 0.f;
                        ls[qt] += p; S[hh][qt][r] = p;
                    }
        } else {
#pragma unroll
            for (int hh = 0; hh < 2; ++hh)
#pragma unroll
                for (int qt = 0; qt < 4; ++qt)
#pragma unroll
                    for (int r = 0; r < 4; ++r) { const float p = __builtin_amdgcn_exp2f(S[hh][qt][r]); ls[qt] += p; S[hh][qt][r] = p; }
        }
        bf16x8 Bp[4];
#pragma unroll
        for (int qt = 0; qt < 4; ++qt) Bp[qt] = pack8(S[0][qt], S[1][qt]);
#pragma unroll
        for (int dt = 0; dt < 4; ++dt) {
            const LAS bf16_t* vp = AV + (kb + 32 * kk2 + 4 * fq + q4) * AT_STRIDE + 16 * dt + 4 * p4;
            const bf16x8 A = tr2(vp, vp + 16 * AT_STRIDE);
#pragma unroll
            for (int qt = 0; qt < 4; ++qt) O[dt][qt] = mfma16(A, Bp[qt], O[dt][qt]);
        }
    }
}
__device__ __forceinline__ void attn_item(const Args& a, LAS unsigned char* lds, int item) {
    const int tid = threadIdx.x, lane = tid & 63, w = __builtin_amdgcn_readfirstlane(tid >> 6), fr = lane & 15, fq = lane >> 4;
    const int qblk = item & 31, kvh = (item >> 5) & 1, b = item >> 6;
    const int g = w >> 1, qh = w & 1, head = 4 * kvh + g;
    const bf16_t* Q = (const bf16_t*)(a.ws + WS_Q); const bf16_t* KK = (const bf16_t*)(a.ws + WS_KK); const bf16_t* VV = (const bf16_t*)(a.ws + WS_VV);
    bf16_t* MIX = (bf16_t*)(a.ws + WS_MIX);
    LAS bf16_t* AK = (LAS bf16_t*)(lds + AT_K); LAS bf16_t* AV = (LAS bf16_t*)(lds + AT_V);
    const float cshift = ((const float*)(a.ws + WS_MISC))[0];
    const int qpos0 = 128 * qblk + 64 * qh;
    bf16x8 Qf[4][2];
#pragma unroll
    for (int qt = 0; qt < 4; ++qt) { const bf16_t* qp = Q + (size_t)(b * NT + qpos0 + 16 * qt + fr) * 512 + head * 64 + 8 * fq; Qf[qt][0] = *(const bf16x8*)qp; Qf[qt][1] = *(const bf16x8*)(qp + 32); }
    f32x4 O[4][4]; float ls[4];
#pragma unroll
    for (int dt = 0; dt < 4; ++dt)
#pragma unroll
        for (int qt = 0; qt < 4; ++qt) O[dt][qt] = (f32x4){0.f, 0.f, 0.f, 0.f};
#pragma unroll
    for (int qt = 0; qt < 4; ++qt) ls[qt] = 0.f;
    const int kpos_base = 128 * qblk - 128;
    for (int i = tid; i < 384 * 8; i += NTHREADS) { const int r = i >> 3, c = i & 7; int kp = kpos_base + r; kp = kp < 0 ? 0 : (kp > NT - 1 ? NT - 1 : kp);
        const size_t src = (size_t)(b * NT + kp) * 128 + kvh * 64 + 8 * c;
        *(LAS u32x4*)(AK + r * AT_STRIDE + 8 * c) = *(const u32x4*)(KK + src); *(LAS u32x4*)(AV + r * AT_STRIDE + 8 * c) = *(const u32x4*)(VV + src); }
    __syncthreads();
    u32x4 ck[4], cv[4];
#pragma unroll
    for (int j = 0; j < 4; ++j) { const int i = tid + NTHREADS * j, r = i >> 3, c = i & 7; const size_t src = (size_t)(MT + b * NL + r) * 128 + kvh * 64 + 8 * c; ck[j] = *(const u32x4*)(KK + src); cv[j] = *(const u32x4*)(VV + src); }
    const bool edge = (qblk == 0) || (qblk == 31);
    for (int jt = 0; jt < 5; ++jt) { const bool msk = edge || jt == 0 || jt == 4;
        attn_tile(AK, AV, 64 * qh + 64 * jt, msk, kpos_base, qpos0, Qf, O, ls, cshift, fr, fq); }
    __syncthreads();
#pragma unroll
    for (int j = 0; j < 4; ++j) { const int i = tid + NTHREADS * j, r = i >> 3, c = i & 7; *(LAS u32x4*)(AK + r * AT_STRIDE + 8 * c) = ck[j]; *(LAS u32x4*)(AV + r * AT_STRIDE + 8 * c) = cv[j]; }
    __syncthreads();
    for (int jt = 0; jt < 4; ++jt) attn_tile(AK, AV, 64 * jt, false, 0, qpos0, Qf, O, ls, cshift, fr, fq);
    __syncthreads();
    const float psink = __builtin_amdgcn_exp2f(a.in[13][head] * LOG2E - cshift);
#pragma unroll
    for (int qt = 0; qt < 4; ++qt) {
        float l = ls[qt]; l += __shfl_xor(l, 16); l += __shfl_xor(l, 32); const float inv = 1.f / (l + psink);
        bf16_t* op = MIX + (size_t)(b * NT + qpos0 + 16 * qt + fr) * D + head * 64 + 4 * fq;
#pragma unroll
        for (int dt = 0; dt < 4; ++dt) { const f32x4 o = O[dt][qt] * inv; u32x2 wv; wv.x = pkbf(o[0], o[1]); wv.y = pkbf(o[2], o[3]); *(u32x2*)(op + 16 * dt) = wv; }
    }
}

constexpr int KS_ST = 136, VS_ST = 88;
constexpr int ML_KS = 0, ML_VN = ML_KS + 128 * KS_ST * 2, ML_VW = ML_VN + 128 * VS_ST * 2, ML_CN = ML_VW + 128 * VS_ST * 2, ML_F = ML_CN + 128 * VS_ST * 2, ML_CW = ML_F + 1024 * 4, ML_END = ML_CW + 768 * 4;
static_assert(ML_END <= LDS_BYTES, "mLSTM LDS map");
#define ML_GEOM(ci, seq0, seqlen, nbase) do { if ((ci) < 2) { seq0 = MT + b * NL; seqlen = NL; nbase = dir ? 128 * (1 - (ci)) : 128 * (ci); } \
    else { const int k_ = (ci) - 2; seq0 = b * NT; seqlen = NT; nbase = dir ? 128 * (31 - k_) : 128 * k_; } } while (0)
#define ML_POS(s) (dir ? nbase + 127 - (s) : nbase + (s))
__device__ __forceinline__ void mlstm_item(const Args& a, LAS unsigned char* lds, int item) {
    const int tid = threadIdx.x, lane = tid & 63, w = __builtin_amdgcn_readfirstlane(tid >> 6), fr = lane & 15, fq = lane >> 4, q4 = fr >> 2, p4 = fr & 3;
    const int vh = item & 1, dir = (item >> 1) & 1, h = (item >> 2) & 3, b = item >> 4;
    const int tw = w < 4 ? w : 11 - w;
    LAS bf16_t* Ks = (LAS bf16_t*)(lds + ML_KS); LAS bf16_t* Vn = (LAS bf16_t*)(lds + ML_VN); LAS bf16_t* Vw = (LAS bf16_t*)(lds + ML_VW); LAS bf16_t* Cn = (LAS bf16_t*)(lds + ML_CN);
    LAS float* F = (LAS float*)(lds + ML_F); LAS float* mstA = F, *aA = F + 64, *MlA = F + 128, *blA = F + 192, *plA = F + 256, *gA = F + 512; LAS float* cw = (LAS float*)(lds + ML_CW);
    const bf16_t* MQ = (const bf16_t*)(a.ws + WS_CQ); const bf16_t* MK = (const bf16_t*)(a.ws + WS_CK); const bf16_t* MV = (const bf16_t*)(a.ws + WS_M4) + (size_t)2 * MA * 512;
    const float* GATES = (const float*)(a.ws + WS_GATES);
    float* TBL = (float*)(a.ws + WS_TBL) + (size_t)item * 34 * 384;
    bf16_t* H = (bf16_t*)(a.ws + (dir ? WS_HB : WS_HF));
    for (int i = tid; i < 128 * VS_ST / 2; i += NTHREADS) ((LAS unsigned*)Cn)[i] = 0u;
    for (int i = tid; i < 128 * 12; i += NTHREADS) { const int s = i / 12, c = i % 12; ((LAS unsigned*)(Vn + s * VS_ST + 64))[c] = (c == 0) ? 0x00003f80u : 0u; ((LAS unsigned*)(Vw + s * VS_ST + 64))[c] = 0u; }
    for (int ci = w; ci < 34; ci += NWAVES) {
        int seq0, seqlen, nbase; ML_GEOM(ci, seq0, seqlen, nbase); (void)seqlen;
        const int s0 = 2 * lane, s1 = s0 + 1;
        const float* G0 = GATES + (size_t)(seq0 + ML_POS(s0)) * 16 + h; const float* G1 = GATES + (size_t)(seq0 + ML_POS(s1)) * 16 + h;
        const float li0 = G0[dir ? 8 : 0], lf0 = G0[dir ? 12 : 4], li1 = G1[dir ? 8 : 0], lf1 = G1[dir ? 12 : 4];
        float cs = lf0 + lf1;
#pragma unroll
        for (int o = 1; o < 64; o <<= 1) { const float y = __shfl_up(cs, o); if (lane >= o) cs += y; }
        const float b1 = cs, b0 = cs - lf1;
        const float g0 = li0 - b0, g1 = li1 - b1;
        float mx = fmaxf(g0, g1);
#pragma unroll
        for (int o = 1; o < 64; o <<= 1) { const float y = __shfl_up(mx, o); if (lane >= o) mx = fmaxf(mx, y); }
        float ex = __shfl_up(mx, 1); if (lane == 0) ex = -INFINITY;
        const float pm0 = fmaxf(ex, g0), pm1 = mx;
        float* T = TBL + ci * 384;
        typedef float f32x2t __attribute__((ext_vector_type(2)));
        *(f32x2t*)(T + s0) = (f32x2t){b0, b1}; *(f32x2t*)(T + 128 + s0) = (f32x2t){g0, g1}; *(f32x2t*)(T + 256 + s0) = (f32x2t){pm0, pm1};
        if (lane == 63) { blA[ci] = b1; plA[ci] = pm1; }
    }
    __syncthreads();
    if (w == 0) {
        float m = 0.f;
#pragma unroll 1
        for (int ci = 0; ci < 34; ++ci) { const float bl = blA[ci], pl = plA[ci]; const float Ml = fmaxf(m, pl); if (lane == 0) { mstA[ci] = m; aA[ci] = expf(m - Ml); MlA[ci] = Ml; } m = bl + Ml; }
    }
    f32x4 accC[5];
#pragma unroll
    for (int vt = 0; vt < 5; ++vt) accC[vt] = (f32x4){0.f, 0.f, 0.f, 0.f};
    u32x4 kr[4], vr[2];
#define ML_LOAD_KV(cj) do { int seq0_, seqlen_, nbase_; { const int dir_ = dir; (void)dir_; (void)seqlen_; if ((cj) < 2) { seq0_ = MT + b * NL; seqlen_ = NL; nbase_ = dir ? 128 * (1 - (cj)) : 128 * (cj); } else { const int k_ = (cj) - 2; seq0_ = b * NT; seqlen_ = NT; nbase_ = dir ? 128 * (31 - k_) : 128 * k_; } } \
        _Pragma("unroll") for (int ps = 0; ps < 4; ++ps) { const int s_ = (tid >> 4) + 32 * ps, pos_ = dir ? nbase_ + 127 - s_ : nbase_ + s_; kr[ps] = *(const u32x4*)(MK + (size_t)(seq0_ + pos_) * 512 + h * 128 + 8 * (tid & 15)); } \
        _Pragma("unroll") for (int ps = 0; ps < 2; ++ps) { const int s_ = (tid >> 3) + 64 * ps, pos_ = dir ? nbase_ + 127 - s_ : nbase_ + s_; vr[ps] = *(const u32x4*)(MV + (size_t)(seq0_ + pos_) * 512 + h * 128 + vh * 64 + 8 * (tid & 7)); } } while (0)
    u32x4 qr[4]; float nbt = 0.f, npmt = 0.f;
#define ML_LOAD_Q(cj) do { int seq0_, seqlen_, nbase_; (void)seqlen_; if ((cj) < 2) { seq0_ = MT + b * NL; seqlen_ = NL; nbase_ = dir ? 128 * (1 - (cj)) : 128 * (cj); } else { const int k_ = (cj) - 2; seq0_ = b * NT; seqlen_ = NT; nbase_ = dir ? 128 * (31 - k_) : 128 * k_; } \
        const float* T_ = TBL + (cj) * 384; const int t_ = 16 * tw + fr, post_ = dir ? nbase_ + 127 - t_ : nbase_ + t_; \
        if ((cj) >= 2) { const bf16_t* qp = MQ + (size_t)(seq0_ + post_) * 512 + h * 128 + 8 * fq; \
            _Pragma("unroll") for (int kk = 0; kk < 4; ++kk) qr[kk] = *(const u32x4*)(qp + 32 * kk); \
            nbt = T_[t_]; npmt = T_[256 + t_]; } } while (0)
    ML_LOAD_KV(0);
    __syncthreads();
    ML_LOAD_Q(0);
#ifdef MK_TIME_PHASE
    unsigned long long tA_ = 0ull, tB_ = 0ull;
#endif
#pragma unroll 1
    for (int ci = 0; ci < 34; ++ci) {
        const bool isctx = ci < 2;
#ifdef MK_TIME_PHASE
        const unsigned long long t0_ = __builtin_amdgcn_s_memrealtime();
#endif
        int seq0, seqlen, nbase; ML_GEOM(ci, seq0, seqlen, nbase);
        const float mst = mstA[ci], Ml = MlA[ci], av = aA[ci];
        const float* T = TBL + ci * 384;
        const int t = 16 * tw + fr, post = ML_POS(t);
        const float bt = nbt, pmt = npmt;
        const float gv0 = T[128 + (tid >> 3)], gv1 = T[128 + (tid >> 3) + 64];
        const float gmine = tid < 128 ? T[128 + tid] : 0.f;
#pragma unroll
        for (int ps = 0; ps < 4; ++ps) *(LAS u32x4*)(Ks + ((tid >> 4) + 32 * ps) * KS_ST + 8 * (tid & 15)) = kr[ps];
#pragma unroll
        for (int ps = 0; ps < 2; ++ps) {
            const int s = (tid >> 3) + 64 * ps, vc = tid & 7; const float wv = __expf((ps ? gv1 : gv0) - Ml); u32x4 o;
            *(LAS u32x4*)(Vn + s * VS_ST + 8 * vc) = vr[ps];
#pragma unroll
            for (int e = 0; e < 4; ++e) o[e] = pkbf(bflo(vr[ps][e]) * wv, bfhi(vr[ps][e]) * wv);
            *(LAS u32x4*)(Vw + s * VS_ST + 8 * vc) = o;
        }
        if (tid < 128) { ((LAS unsigned*)(Vw + tid * VS_ST + 64))[0] = pkbf(__expf(gmine - Ml), 0.f); gA[tid] = gmine; }
        bf16x8 Bq[4];
#pragma unroll
        for (int kk = 0; kk < 4; ++kk) Bq[kk] = __builtin_bit_cast(bf16x8, qr[kk]);
        __syncthreads();
#ifdef MK_TIME_PHASE
        const unsigned long long t1_ = __builtin_amdgcn_s_memrealtime();
#endif
        if (!isctx) {
            const float Mt = fmaxf(mst, pmt);
            const float dect = __expf(mst - Mt), ebt = __expf(-bt - Mt);
            f32x4 num[5];
#pragma unroll
            for (int vt = 0; vt < 5; ++vt) num[vt] = (f32x4){0.f, 0.f, 0.f, 0.f};
            {
                bf16x8 fa[5], fb[5];
#define ML_LDC(dst, kk) do { _Pragma("unroll") for (int vt = 0; vt < 5; ++vt) { const LAS bf16_t* cp = Cn + (32 * (kk) + 8 * fq + q4) * VS_ST + 16 * vt + 4 * p4; dst[vt] = tr2(cp, cp + 4 * VS_ST); } } while (0)
#define ML_MMC(src, kk) do { _Pragma("unroll") for (int vt = 0; vt < 5; ++vt) num[vt] = mfma16(src[vt], Bq[kk], num[vt]); } while (0)
                ML_LDC(fa, 0); ML_LDC(fb, 1); ML_MMC(fa, 0); ML_LDC(fa, 2); ML_MMC(fb, 1); ML_LDC(fb, 3); ML_MMC(fa, 2); ML_MMC(fb, 3);
#undef ML_LDC
#undef ML_MMC
#pragma unroll
                for (int vt = 0; vt < 5; ++vt) num[vt] = num[vt] * dect;
            }
            if (ci + 1 < 34) ML_LOAD_KV(ci + 1);
#pragma unroll
            for (int kk2 = 0; kk2 < 4; ++kk2) {
                if (2 * kk2 <= tw) {
                    const bool two = (2 * kk2 + 1) <= tw;
                    bf16x8 ka[2][4], fv[5];
#pragma unroll
                    for (int hh = 0; hh < 2; ++hh)
#pragma unroll
                        for (int kk = 0; kk < 4; ++kk) ka[hh][kk] = *(const LAS bf16x8*)(Ks + (16 * (2 * kk2 + hh) + fr) * KS_ST + 32 * kk + 8 * fq);
                    const f32x4 gs0 = *(const LAS f32x4*)(gA + 32 * kk2 + 4 * fq), gs1 = *(const LAS f32x4*)(gA + 32 * kk2 + 16 + 4 * fq);
#pragma unroll
                    for (int vt = 0; vt < 5; ++vt) { const LAS bf16_t* vp = Vn + (32 * kk2 + 4 * fq + q4) * VS_ST + 16 * vt + 4 * p4; fv[vt] = tr2(vp, vp + 16 * VS_ST); }
                    f32x4 Pp[2];
                    Pp[0] = (f32x4){0.f, 0.f, 0.f, 0.f}; Pp[1] = (f32x4){0.f, 0.f, 0.f, 0.f};
#pragma unroll
                    for (int kk = 0; kk < 4; ++kk) { Pp[0] = mfma16(ka[0][kk], Bq[kk], Pp[0]); Pp[1] = mfma16(ka[1][kk], Bq[kk], Pp[1]); }
#pragma unroll
                    for (int r = 0; r < 4; ++r) {
                        const int s0 = 32 * kk2 + 4 * fq + r, s1 = s0 + 16;
                        Pp[0][r] *= (s0 <= t) ? __builtin_amdgcn_exp2f((gs0[r] - Mt) * LOG2E) : 0.f;
                        Pp[1][r] *= (two && s1 <= t) ? __builtin_amdgcn_exp2f((gs1[r] - Mt) * LOG2E) : 0.f;
                    }
                    const bf16x8 Bw = pack8(Pp[0], Pp[1]);
#pragma unroll
                    for (int vt = 0; vt < 5; ++vt) num[vt] = mfma16(fv[vt], Bw, num[vt]);
                }
            }
            const float den = __shfl(num[4][0], fr);
            const float inv = 1.f / fmaxf(fabsf(den), ebt);
            bf16_t* hp = H + (size_t)(seq0 + post) * 512 + h * 128 + vh * 64 + 4 * fq;
#pragma unroll
            for (int vt = 0; vt < 4; ++vt) { const f32x4 o = num[vt] * inv; u32x2 wv; wv.x = pkbf(o[0], o[1]); wv.y = pkbf(o[2], o[3]); *(u32x2*)(hp + 16 * vt) = wv; }
        }
        if (isctx) ML_LOAD_KV(ci + 1);
        if (ci + 1 < 34) ML_LOAD_Q(ci + 1);
        {
#pragma unroll
            for (int vt = 0; vt < 5; ++vt) accC[vt] = accC[vt] * av;
            bf16x8 sa[6], sb[6];
#define ML_LDS_(dst, kk2) do { _Pragma("unroll") for (int vt = 0; vt < 5; ++vt) { const LAS bf16_t* vp = Vw + (32 * (kk2) + 8 * fq + q4) * VS_ST + 16 * vt + 4 * p4; dst[vt] = tr2(vp, vp + 4 * VS_ST); } \
                { const LAS bf16_t* kp = Ks + (32 * (kk2) + 8 * fq + q4) * KS_ST + 16 * w + 4 * p4; dst[5] = tr2(kp, kp + 4 * KS_ST); } } while (0)
#define ML_MMS_(src) do { _Pragma("unroll") for (int vt = 0; vt < 5; ++vt) accC[vt] = mfma16(src[vt], src[5], accC[vt]); } while (0)
            ML_LDS_(sa, 0); ML_LDS_(sb, 1); ML_MMS_(sa); ML_LDS_(sa, 2); ML_MMS_(sb); ML_LDS_(sb, 3); ML_MMS_(sa); ML_MMS_(sb);
#undef ML_LDS_
#undef ML_MMS_
        }
        __syncthreads();
#ifdef MK_TIME_PHASE
        { const unsigned long long t2_ = __builtin_amdgcn_s_memrealtime(); tA_ += t1_ - t0_; tB_ += t2_ - t1_; }
#endif
#pragma unroll
        for (int vt = 0; vt < 5; ++vt) { u32x2 wv; wv.x = pkbf(accC[vt][0], accC[vt][1]); wv.y = pkbf(accC[vt][2], accC[vt][3]); *(LAS u32x2*)(Cn + (16 * w + fr) * VS_ST + 16 * vt + 4 * fq) = wv; }
    }
    __syncthreads();
#ifdef MK_TIME_PHASE
    if (blockIdx.x == 0 && threadIdx.x == 0) { unsigned long long* ts = (unsigned long long*)(a.ws + WS_MISC + 128); ts[12] = tA_; ts[13] = tB_; }
#endif
}
#undef ML_LOAD_KV
#undef ML_LOAD_Q
#undef ML_POS
#undef ML_GEOM

__device__ __forceinline__ void mlstm_out_rows(const Args& a, int row_lo, int nrows) {
    const int tid = threadIdx.x, lane = tid & 63, wave = tid >> 6;
    const bf16_t* HF = (const bf16_t*)(a.ws + WS_HF); const bf16_t* HB = (const bf16_t*)(a.ws + WS_HB);
    const bf16_t* MO = (const bf16_t*)(a.ws + WS_M4) + (size_t)3 * MA * 512;
    bf16_t* MIX = (bf16_t*)(a.ws + WS_MIX);
    const f32x4 nw0 = *(const f32x4*)(a.in[14] + 8 * lane), nw1 = *(const f32x4*)(a.in[14] + 8 * lane + 4);
    for (int i0 = wave; i0 < nrows; i0 += 4 * NWAVES) {
        u32x4 f[4], bb[4], mo[4];
#pragma unroll
        for (int u = 0; u < 4; ++u) { const size_t o = (size_t)(row_lo + i0 + u * NWAVES) * 512 + 8 * lane; f[u] = *(const u32x4*)(HF + o); bb[u] = *(const u32x4*)(HB + o); mo[u] = *(const u32x4*)(MO + o); }
#pragma unroll
        for (int u = 0; u < 4; ++u) {
            float sv[8]; float ss = 0.f;
#pragma unroll
            for (int e = 0; e < 4; ++e) { sv[2 * e] = bflo(f[u][e]) + bflo(bb[u][e]); sv[2 * e + 1] = bfhi(f[u][e]) + bfhi(bb[u][e]); ss += sv[2 * e] * sv[2 * e] + sv[2 * e + 1] * sv[2 * e + 1]; }
            ss += __shfl_xor(ss, 1); ss += __shfl_xor(ss, 2); ss += __shfl_xor(ss, 4); ss += __shfl_xor(ss, 8);
            const float r = rsqrtf(ss * (1.f / 128.f) + EPS);
            float ov[8];
#pragma unroll
            for (int e = 0; e < 4; ++e) {
                ov[2 * e] = sv[2 * e] * r * (e < 2 ? nw0[2 * e] : nw1[2 * e - 4]) * __builtin_amdgcn_rcpf(1.f + __expf(-bflo(mo[u][e])));
                ov[2 * e + 1] = sv[2 * e + 1] * r * (e < 2 ? nw0[2 * e + 1] : nw1[2 * e - 3]) * __builtin_amdgcn_rcpf(1.f + __expf(-bfhi(mo[u][e])));
            }
            u32x4 o; o.x = pkbf(ov[0], ov[1]); o.y = pkbf(ov[2], ov[3]); o.z = pkbf(ov[4], ov[5]); o.w = pkbf(ov[6], ov[7]);
            *(u32x4*)(MIX + (size_t)(row_lo + i0 + u * NWAVES) * D + 512 + 8 * lane) = o;
        }
    }
}
__device__ __forceinline__ void post_rows(const Args& a, LAS unsigned char* lds, int row_lo, int nrows) {
    const int tid = threadIdx.x, lane = tid & 63, wave = tid >> 6, fr = lane & 15, kq = lane >> 4;
    const int b = row_lo >> 12; const float* mr = (const float*)(a.ws + WS_MOD) + b * 6144; const float* n2w = a.in[7]; const float* Wr = a.in[16];
    LAS bf16_t* WB = (LAS bf16_t*)lds; LAS float* SC = (LAS float*)(lds + 32768); LAS float* SH = (LAS float*)(lds + 36864); LAS float* CP = (LAS float*)(lds + 40960);
    for (int c = tid; c < D; c += NTHREADS) {
        const float scv = n2w[c] * (1.f + mr[4 * D + c]); SC[c] = scv; SH[c] = mr[3 * D + c];
        const int s = 2 * (c >> 6) + ((c >> 3) & 1), q = (c >> 4) & 3, ee = c & 7;
#pragma unroll
        for (int j = 0; j < 4; ++j) { const f32x4 w = *(const f32x4*)(Wr + (size_t)c * 16 + 4 * j);
#pragma unroll
            for (int i = 0; i < 4; ++i) WB[((s * 64 + q * 16 + 4 * j + i) << 3) + ee] = (bf16_t)(pkbf(scv * w[i], 0.f) & 0xffffu); }
    }
    { const int e = tid & 15, part = tid >> 4; float cb = 0.f;
#pragma unroll 4
        for (int i = 0; i < 32; ++i) { const int c = part * 32 + i; cb += mr[3 * D + c] * Wr[(size_t)c * 16 + e]; }
        CP[part * 16 + e] = cb; }
    __syncthreads();
    if (tid < 16) { float t = 0.f; for (int p = 0; p < 32; ++p) t += CP[p * 16 + tid]; CP[512 + tid] = t; }
    __syncthreads();
    const float cbe = CP[512 + fr];
    unsigned char* HX2 = a.ws + WS_HX; float* AFF = (float*)(a.ws + WS_AFF);
    const bf16_t* X1 = (const bf16_t*)(a.ws + WS_X1);
#pragma unroll 1
    for (int t0 = wave * 16; t0 < nrows; t0 += NWAVES * 16) {
        int row = row_lo + t0 + fr; asm volatile("" : "+v"(row));
        const bf16_t* xp = X1 + (size_t)row * D + 16 * kq;
        u32x4 xv[32];
#pragma unroll
        for (int p = 0; p < 16; ++p) { xv[2 * p] = *(const u32x4*)(xp + 64 * p); xv[2 * p + 1] = *(const u32x4*)(xp + 64 * p + 8); }
        f32x4 acc = {0.f, 0.f, 0.f, 0.f}; float ss = 0.f;
        int boff = lane * 8, coff = 16 * kq; asm volatile("" : "+v"(boff), "+v"(coff));
#pragma unroll
        for (int g = 0; g < 8; ++g) {
            bf16x8 Bf[4];
#pragma unroll
            for (int i = 0; i < 4; ++i) Bf[i] = *(const LAS bf16x8*)(WB + boff + (4 * g + i) * 512);
#pragma unroll
            for (int i = 0; i < 4; ++i) { const u32x4 v = xv[4 * g + i]; acc = mfma16(__builtin_bit_cast(bf16x8, v), Bf[i], acc);
                ss += (bflo(v.x) * bflo(v.x) + bfhi(v.x) * bfhi(v.x)) + (bflo(v.y) * bflo(v.y) + bfhi(v.y) * bfhi(v.y)) + (bflo(v.z) * bflo(v.z) + bfhi(v.z) * bfhi(v.z)) + (bflo(v.w) * bflo(v.w) + bfhi(v.w) * bfhi(v.w)); }
            asm volatile("" : "+v"(boff), "+v"(acc));
        }
        ss += __shfl_xor(ss, 16); ss += __shfl_xor(ss, 32);
        const float rstd = rsqrtf(ss * (1.f / D) + EPS);
#pragma unroll
        for (int i = 0; i < 32; ++i) asm volatile("" : "+v"(xv[i]));
        f32x4 af;
#pragma unroll
        for (int i = 0; i < 4; ++i) {
            const float lg = acc[i] * __shfl(rstd, 4 * kq + i) + cbe;
            float mx = lg; mx = fmaxf(mx, __shfl_xor(mx, 1)); mx = fmaxf(mx, __shfl_xor(mx, 2)); mx = fmaxf(mx, __shfl_xor(mx, 4)); mx = fmaxf(mx, __shfl_xor(mx, 8));
            const float e = expf(lg - mx); float sum = e; sum += __shfl_xor(sum, 1); sum += __shfl_xor(sum, 2); sum += __shfl_xor(sum, 4); sum += __shfl_xor(sum, 8);
            af[i] = e / sum;
        }
        *(f32x4*)(AFF + ((size_t)b * NE + fr) * NT + ((row_lo + t0) & (NT - 1)) + 4 * kq) = af;
        unsigned char* hp = HX2 + (size_t)row * D + 16 * kq;
#pragma unroll
        for (int p = 0; p < 16; ++p) {
            u32x4 o;
#pragma unroll
            for (int h = 0; h < 2; ++h) { const u32x4 v = xv[2 * p + h]; const int c0 = 64 * p + coff + 8 * h;
                const f32x4 s0 = *(const LAS f32x4*)(SC + c0), s1 = *(const LAS f32x4*)(SC + c0 + 4), h0 = *(const LAS f32x4*)(SH + c0), h1 = *(const LAS f32x4*)(SH + c0 + 4);
                const unsigned lo = pk4_fp8(bflo(v.x) * (rstd * s0[0]) + h0[0], bfhi(v.x) * (rstd * s0[1]) + h0[1], bflo(v.y) * (rstd * s0[2]) + h0[2], bfhi(v.y) * (rstd * s0[3]) + h0[3]);
                const unsigned hi = pk4_fp8(bflo(v.z) * (rstd * s1[0]) + h1[0], bfhi(v.z) * (rstd * s1[1]) + h1[1], bflo(v.w) * (rstd * s1[2]) + h1[2], bfhi(v.w) * (rstd * s1[3]) + h1[3]);
                if (h == 0) { o.x = lo; o.y = hi; } else { o.z = lo; o.w = hi; } }
            *(u32x4*)(hp + 64 * p) = o;
        }
    }
    __syncthreads();
}

__device__ __forceinline__ void topk_select(const Args& a, LAS unsigned char* lds, int z) {
    const int tid = threadIdx.x, lane = tid & 63, wave = tid >> 6;
    LAS unsigned* hist = (LAS unsigned*)lds; LAS unsigned* sc = hist + 256; LAS unsigned* wsum = hist + 272;
    const float* aff = (const float*)(a.ws + WS_AFF) + (size_t)z * NT;
    int* idx = (int*)(a.ws + WS_IDX) + z * CAP; float* gate = (float*)(a.ws + WS_GATE) + z * CAP; int* slot = (int*)(a.ws + WS_SLOT) + (size_t)z * NT;
    unsigned key[8];
    { const u32x4 k0 = *(const u32x4*)(aff + 8 * tid), k1 = *(const u32x4*)(aff + 8 * tid + 4); key[0] = k0.x; key[1] = k0.y; key[2] = k0.z; key[3] = k0.w; key[4] = k1.x; key[5] = k1.y; key[6] = k1.z; key[7] = k1.w; }
    unsigned prefix = 0u, need = CAP;
#pragma unroll 1
    for (int pass = 0; pass < 4; ++pass) {
        const int shift = 24 - 8 * pass;
        if (tid < 256) hist[tid] = 0u;
        __syncthreads();
#pragma unroll
        for (int i = 0; i < 8; ++i) { const bool match = (pass == 0) || ((key[i] >> (shift + 8)) == prefix); if (match) __hip_atomic_fetch_add(&hist[(key[i] >> shift) & 255u], 1u, __ATOMIC_RELAXED, __HIP_MEMORY_SCOPE_WORKGROUP); }
        __syncthreads();
        if (wave == 0) {
            unsigned c[4]; unsigned s = 0u;
#pragma unroll
            for (int j = 0; j < 4; ++j) { c[j] = hist[255 - (4 * lane + j)]; s += c[j]; }
            unsigned incl = s;
#pragma unroll
            for (int o = 1; o < 64; o <<= 1) { const unsigned y = __shfl_up(incl, o); if (lane >= o) incl += y; }
            unsigned cb = incl - s;
#pragma unroll
            for (int j = 0; j < 4; ++j) { if (cb < need && need <= cb + c[j]) { sc[0] = (prefix << 8) | (unsigned)(255 - (4 * lane + j)); sc[1] = need - cb; } cb += c[j]; }
        }
        __syncthreads();
        prefix = sc[0]; need = sc[1];
        __syncthreads();
    }
    const unsigned T = prefix;
    unsigned cg = 0u, ce = 0u;
#pragma unroll
    for (int i = 0; i < 8; ++i) { cg += key[i] > T ? 1u : 0u; ce += key[i] == T ? 1u : 0u; }
    const unsigned mine = cg | (ce << 16);
    unsigned incl = mine;
#pragma unroll
    for (int o = 1; o < 64; o <<= 1) { const unsigned y = __shfl_up(incl, o); if (lane >= o) incl += y; }
    if (lane == 63) wsum[wave] = incl;
    __syncthreads();
    unsigned base = 0u;
    for (int q = 0; q < wave; ++q) base += wsum[q];
    const unsigned excl = base + incl - mine;
    unsigned pg = excl & 0xffffu, pe = excl >> 16;
    const unsigned total_gt = CAP - need;
#pragma unroll
    for (int i = 0; i < 8; ++i) {
        const int tok = 8 * tid + i; int sl = -1;
        if (key[i] > T) { sl = (int)pg; ++pg; }
        else if (key[i] == T) { if (pe < need) sl = (int)(total_gt + pe); ++pe; }
        if (sl >= 0) { idx[sl] = tok; gate[sl] = __builtin_bit_cast(float, key[i]); }
        slot[tok] = sl;
    }
    __syncthreads();
}

#define XB_TMO      128
#define XB_XCNT(j)  (256  + 64 * (j))
#define XB_XSUB(j)  (1280 + 64 * (j))
#define XB_XGEN(j)  (2304 + 64 * (j))
#define XB_TOP      3328
#define XB_TOPGEN   3392
#define XCD_BAR_WORDS 3456
#define XB_SPIN_CAP (1u << 18)

__device__ __forceinline__ unsigned xb_ld(unsigned* p)              { return __hip_atomic_load(p, __ATOMIC_RELAXED, __HIP_MEMORY_SCOPE_AGENT); }
__device__ __forceinline__ unsigned xb_add(unsigned* p, unsigned v) { return __hip_atomic_fetch_add(p, v, __ATOMIC_RELAXED, __HIP_MEMORY_SCOPE_AGENT); }
__device__ __forceinline__ unsigned xb_xcc_id() { return (unsigned)__builtin_amdgcn_s_getreg((3 << 11) | 20) & 0xFu; }
#define XB_SPIN(cond, bar) do { unsigned _sp = 0; while (cond) { __builtin_amdgcn_s_sleep(1); \
    if ((++_sp & 255u) == 0u) { if (xb_ld(&(bar)[XB_TMO])) break; if (_sp > XB_SPIN_CAP) { atomicAdd(&(bar)[XB_TMO], 1u); break; } } } } while (0)

struct XcdBarrier {
    unsigned* bar; unsigned x;
    volatile LAS unsigned* st;
};

__device__ __forceinline__ XcdBarrier xcd_barrier_post(unsigned* bar, volatile LAS unsigned* st) {
    XcdBarrier b; b.bar = bar; b.x = xb_xcc_id(); b.st = st;
    if (threadIdx.x == 0) (void)xb_add(&bar[XB_XCNT(b.x)], 1u);
    return b;
}
__device__ __forceinline__ void xcd_barrier_complete(unsigned* bar, unsigned x, unsigned& nloc, unsigned& nx) {
    const unsigned G = gridDim.x * gridDim.y * gridDim.z;
    unsigned sum, cnt, mine, sp = 0u;
    for (;;) {
        sum = 0u; cnt = 0u; mine = 0u;
#pragma unroll
        for (unsigned j = 0; j < 16; ++j) { const unsigned c = xb_ld(&bar[XB_XCNT(j)]); sum += c; cnt += (c > 0u) ? 1u : 0u; mine = (j == x) ? c : mine; }
        if (sum == G) break;
        __builtin_amdgcn_s_sleep(1);
        if ((++sp & 255u) == 0u) { if (xb_ld(&bar[XB_TMO])) break; if (sp > XB_SPIN_CAP) { atomicAdd(&bar[XB_TMO], 1u); break; } }
    }
    nloc = mine > 0u ? mine : 1u; nx = cnt > 0u ? cnt : 1u;
}

__device__ __forceinline__ void xcd_barrier(const XcdBarrier& b) {
    asm volatile("s_waitcnt vmcnt(0)" ::: "memory");
    __syncthreads();
    if (threadIdx.x == 0) {
        unsigned* bar = b.bar;
        __builtin_amdgcn_s_waitcnt(0);
        unsigned nloc = b.st[0], nx = b.st[1];
        if (nloc == 0u) { xcd_barrier_complete(bar, b.x, nloc, nx); b.st[0] = nloc; b.st[1] = nx; }
        const unsigned old = xb_add(&bar[XB_XSUB(b.x)], 1u);
        const unsigned gen = old / nloc;
        if (old + 1u == (gen + 1u) * nloc) {
            __builtin_amdgcn_fence(__ATOMIC_RELEASE, "agent");
            asm volatile("s_waitcnt vmcnt(0)" ::: "memory");
            const unsigned og = xb_add(&bar[XB_TOP], 1u);
            const unsigned tg = og / nx;
            if (og + 1u == (tg + 1u) * nx) xb_add(&bar[XB_TOPGEN], 1u);
            else XB_SPIN(xb_ld(&bar[XB_TOPGEN]) == tg, bar);
            __builtin_amdgcn_fence(__ATOMIC_ACQUIRE, "agent");
            xb_add(&bar[XB_XGEN(b.x)], 1u);
            asm volatile("s_waitcnt vmcnt(0)" ::: "memory");
        } else {
            XB_SPIN(xb_ld(&bar[XB_XGEN(b.x)]) == gen, bar);
            __builtin_amdgcn_fence(__ATOMIC_ACQUIRE, "agent");
            asm volatile("s_waitcnt vmcnt(0)" ::: "memory");
        }
    }
    __syncthreads();
}

__device__ __forceinline__ Args load_args() {
    typedef const volatile Args __attribute__((address_space(4))) KA;
    KA* p = (KA*)__builtin_amdgcn_kernarg_segment_ptr();
    Args r;
#pragma unroll
    for (int i = 0; i < 20; ++i) r.in[i] = (const float*)p->in[i];
    r.out = (float*)p->out; r.ws = (unsigned char*)p->ws; r.ph_lo = p->ph_lo; r.ph_hi = p->ph_hi; r.sub = p->sub; r.pad = 0;
    return r;
}
__device__ __forceinline__ void stagger_wait(unsigned ticks) {
    const unsigned long long t0 = __builtin_amdgcn_s_memrealtime();
    while ((unsigned)(__builtin_amdgcn_s_memrealtime() - t0) < ticks) __builtin_amdgcn_s_sleep(16);
}
#ifndef MK_STAG2
#define MK_STAG2 0
#endif
#ifndef MK_STAG6
#define MK_STAG6 0
#endif
#ifndef MK_STAG8
#define MK_STAG8 0
#endif
template <int MASK> __global__ void __launch_bounds__(NTHREADS, 2) mk_fwd_t(Args a_unused_) {
    extern __shared__ __attribute__((aligned(16))) unsigned char lds_raw[];
    LAS unsigned char* lds = (LAS unsigned char*)lds_raw;
    __builtin_assume(__builtin_amdgcn_workitem_id_y() == 0); __builtin_assume(__builtin_amdgcn_workitem_id_z() == 0);
    cg::grid_group grid = cg::this_grid();
    if (threadIdx.x < 2) ((LAS unsigned*)(lds + LDS_BAR_OFF))[threadIdx.x] = 0u;
    __syncthreads();
    int lo, hi; unsigned char* ws0; { const Args a = load_args(); lo = a.ph_lo; hi = a.ph_hi; ws0 = a.ws; }
#ifdef MK_NO_MEMSET
    if (blockIdx.x == 0) for (int i = threadIdx.x; i < 4096; i += NTHREADS) ((unsigned*)(ws0 + WS_BAR))[i] = 0u;
    XcdBarrier xbar; xbar.bar = (unsigned*)(ws0 + WS_BAR); xbar.x = 0; xbar.st = (volatile LAS unsigned*)(lds + LDS_BAR_OFF);
#else
    XcdBarrier xbar = xcd_barrier_post((unsigned*)(ws0 + WS_BAR), (volatile LAS unsigned*)(lds + LDS_BAR_OFF));
#endif
    const int c = blockIdx.x, G = gridDim.x;
#define IN(k) ((((MASK) >> (k)) & 1) && lo <= (k) && (k) < hi)
#ifdef MK_TIME_PHASE
#define MK_STAMP(k) do { if (blockIdx.x == 0 && threadIdx.x == 0) ((unsigned long long*)(load_args().ws + WS_MISC + 128))[(k)] = __builtin_amdgcn_s_memrealtime(); } while (0)
#else
#define MK_STAMP(k) do { } while (0)
#endif
#ifdef MK_NO_MEMSET
#define SEAM(k) do { if (IN(k) && IN((k) + 1)) { if ((k) == 0) { grid.sync(); xbar = xcd_barrier_post(xbar.bar, xbar.st); } else xcd_barrier(xbar); MK_STAMP((k) + 1); } } while (0)
#else
#define SEAM(k) do { if (IN(k) && IN((k) + 1)) { xcd_barrier(xbar); MK_STAMP((k) + 1); } } while (0)
#endif
    if (lo < 0) grid.sync();

    MK_STAMP(0);
    if (IN(0)) { const Args a = load_args(); phase0(a, lds); }
    SEAM(0);
    if (IN(1)) { const Args a = load_args(); phase1(a, lds); }
    SEAM(1);
    if (IN(2)) {
        const Args a = load_args(); unsigned char* const ws = a.ws; (void)ws;
        Gemm g{(const bf16_t*)(ws + WS_HX), (const bf16_t*)(ws + WS_WIN), MA, NPROJ, D};
        pg8::StaticOrder S; S.init(MA, NPROJ, G, c);
        EpiProj E{(bf16_t*)(ws + WS_Q), (bf16_t*)(ws + WS_KK), (bf16_t*)(ws + WS_VV), (bf16_t*)(ws + WS_M4), a.in[11], a.in[12], (const float*)(ws + WS_ROPE), 0.125f * LOG2E};
        if (MK_STAG2 && ((c >> 3) & 1)) stagger_wait(MK_STAG2);
        pg8::gemm_phase<EpiProj, pg8::StaticOrder, true, true>(lds, g, S, E);
        __syncthreads();
    }
    SEAM(2);
    if (IN(3)) {
        const Args a = load_args(); unsigned char* const ws = a.ws; (void)ws;
        if (c & 1) { conv_rows(a); transpose_late(a, lds); __syncthreads(); }
#ifndef MK_NO_ATTN
        if (G == 256) { const int x = c & 7, k = c >> 3; for (int i = 0; i < 4; ++i) attn_item(a, lds, ((4 * x + i) << 5) | k); }
        else for (int it = c; it < 1024; it += G) attn_item(a, lds, it);
#endif
        if (!(c & 1)) { __syncthreads(); conv_rows(a); transpose_late(a, lds); }
    }
    SEAM(3);
    if (IN(4)) {
        const Args a = load_args(); unsigned char* const ws = a.ws; (void)ws;
#ifndef MK_NO_ML
        if (G == 256) { const int x = c & 7, k = c >> 3; mlstm_item(a, lds, 4 * (8 * x + (k >> 2)) + (k & 3)); }
        else for (int it = c; it < 256; it += G) mlstm_item(a, lds, it);
#endif
    }
    SEAM(4);
    if (IN(5)) {
        const Args a = load_args(); unsigned char* const ws = a.ws; (void)ws;
        if (c < 256) mlstm_out_rows(a, c * 256, 256);
    }
    __syncthreads(); MK_STAMP(6);
    if (IN(6)) {
        const Args a = load_args(); unsigned char* const ws = a.ws; (void)ws;
        Gemm g{(const bf16_t*)(ws + WS_MIX), (const bf16_t*)(ws + WS_WOUT), MT, D, D};
        SeqOrder S{c, 4, 4};
        EpiOut E{a.in[0], (const float*)(ws + WS_MOD), (bf16_t*)(ws + WS_X1)};
        if (c < 256) pg8::gemm_phase<EpiOut, SeqOrder, true, true>(lds, g, S, E);
        __syncthreads();
    }
    __syncthreads(); MK_STAMP(7);
    if (IN(7)) {
        const Args a = load_args(); unsigned char* const ws = a.ws; (void)ws;
        if (c < 256) post_rows(a, lds, c * 256, 256);
    }
    SEAM(7);
    if (IN(8)) {
        const Args a = load_args(); unsigned char* const ws = a.ws; (void)ws;
        if (c < 256) { const int z = c;
            const int b = z >> 4, e = z & 15;
            topk_select(a, lds, z);
            MK_STAMP(16);
            const bf16_t* HX2 = (const bf16_t*)(ws + WS_HX + (size_t)b * NT * D); const int* idx = (const int*)(ws + WS_IDX) + z * CAP;
            unsigned char* ACT = ws + WS_ACT + (size_t)z * CAP * FF;
            ((LAS float*)(lds + LDS_GATE_OFF))[threadIdx.x] = ((const float*)(ws + WS_GATE) + z * CAP)[threadIdx.x];
            __syncthreads();
            MK_STAMP(17);
#pragma unroll 1
            for (int half = 0; half < 2; ++half) { Gemm g{HX2, (const bf16_t*)(ws + WS_WGU + (size_t)e * 1024 * D), 256, 1024, D / 2, idx + 256 * half}; SeqOrder S{0, 4, 4}; EpiAct E{ACT + (size_t)half * 256 * FF};
              pg8::gemm_phase<EpiAct, SeqOrder, true, true, 1, FP8_W_SCALE>(lds, g, S, E); __syncthreads(); }
            MK_STAMP(18);
            { Gemm g{(const bf16_t*)ACT, (const bf16_t*)(ws + WS_WD + (size_t)e * D * FF), CAP, D, FF / 2}; SeqOrder S{0, 4, 8}; EpiDown E{(bf16_t*)(ws + WS_MIX) + (size_t)z * CAP * D, (const LAS float*)(lds + LDS_GATE_OFF), 1.f / FP8_W_UP};
              pg8::gemm_phase<EpiDown, SeqOrder, false, true, 1, FP8_W_SCALE>(lds, g, S, E); }
            __syncthreads();
        }
    }
    SEAM(8);
    if (IN(9)) {
        const Args a = load_args(); unsigned char* const ws = a.ws; (void)ws;
        const int tid = threadIdx.x, lane = tid & 63, wave = tid >> 6;
        const int gw = c * NWAVES + wave, NGW = G * NWAVES;
        const int* SL = (const int*)(ws + WS_SLOT); const bf16_t* Y = (const bf16_t*)(ws + WS_MIX); const float* mod = (const float*)(ws + WS_MOD);
        const bf16_t* X1 = (const bf16_t*)(ws + WS_X1);
        for (int grp = gw; grp < MT / 4; grp += NGW) {
            const int mbase = 4 * grp, b = mbase >> 12, n0 = mbase & (NT - 1);
            const int sv = SL[((size_t)b * NE + (lane & 15)) * NT + n0 + (lane >> 4)];
            const unsigned long long ball = __ballot(sv >= 0);
            const float* g2 = mod + b * 6144 + 5 * D + 4 * lane;
            f32x4 gv[4];
#pragma unroll
            for (int j = 0; j < 4; ++j) gv[j] = *(const f32x4*)(g2 + 256 * j);
#pragma unroll 1
            for (int u = 0; u < 4; ++u) {
                unsigned mask = (unsigned)(ball >> (16 * u)) & 0xffffu;
                float* orow = a.out + (size_t)(mbase + u) * D + 4 * lane; const bf16_t* xrow = X1 + (size_t)(mbase + u) * D + 4 * lane;
                u32x2 xv[4];
#pragma unroll
                for (int j = 0; j < 4; ++j) xv[j] = *(const u32x2*)(xrow + 256 * j);
                float acc[16];
#pragma unroll
                for (int i = 0; i < 16; ++i) acc[i] = 0.f;
                while (mask) {
                    const int e0 = __builtin_ctz(mask); mask &= mask - 1u;
                    const bool two = mask != 0u; const int e1 = two ? __builtin_ctz(mask) : e0; if (two) mask &= mask - 1u;
                    const int s0 = __shfl(sv, 16 * u + e0), s1 = __shfl(sv, 16 * u + e1);
                    const bf16_t* y0 = Y + ((size_t)(b * NE + e0) * CAP + s0) * D + 4 * lane; const bf16_t* y1 = Y + ((size_t)(b * NE + e1) * CAP + s1) * D + 4 * lane;
                    u32x2 ya[4], yb[4];
#pragma unroll
                    for (int j = 0; j < 4; ++j) { ya[j] = *(const u32x2*)(y0 + 256 * j); yb[j] = *(const u32x2*)(y1 + 256 * j); }
                    const float w1 = two ? 1.f : 0.f;
#pragma unroll
                    for (int j = 0; j < 4; ++j) { acc[4 * j] += bflo(ya[j].x) + w1 * bflo(yb[j].x); acc[4 * j + 1] += bfhi(ya[j].x) + w1 * bfhi(yb[j].x);
                        acc[4 * j + 2] += bflo(ya[j].y) + w1 * bflo(yb[j].y); acc[4 * j + 3] += bfhi(ya[j].y) + w1 * bfhi(yb[j].y); }
                }
#pragma unroll
                for (int j = 0; j < 4; ++j) { f32x4 o; o[0] = bflo(xv[j].x) + gv[j][0] * acc[4 * j]; o[1] = bfhi(xv[j].x) + gv[j][1] * acc[4 * j + 1]; o[2] = bflo(xv[j].y) + gv[j][2] * acc[4 * j + 2]; o[3] = bfhi(xv[j].y) + gv[j][3] * acc[4 * j + 3];
                    *(f32x4*)(orow + 256 * j) = o; }
            }
        }
    }
#ifdef MK_TIME_PHASE
    xcd_barrier(xbar); MK_STAMP(10);
    xcd_barrier(xbar);
    { const Args a = load_args(); const unsigned long long* ts = (const unsigned long long*)(a.ws + WS_MISC + 128); const int k = MK_TIME_PHASE;
      const float delta = k < 0 ? 0.1f : (k == 30 ? (float)(ts[15] - ts[4]) : k == 31 ? (float)(ts[5] - ts[15]) : k == 99 ? (float)(ts[10] - ts[0]) : k == 70 ? (float)(ts[16] - ts[8]) : k == 71 ? (float)(ts[17] - ts[16]) : k == 72 ? (float)(ts[18] - ts[17]) : k == 73 ? (float)(ts[9] - ts[18]) : k == 32 ? (float)ts[12] : k == 33 ? (float)ts[13] : (float)(ts[k + 1] - ts[k])) * (float)MK_TIME_SCALE * 1e-2f;
      for (size_t i = (size_t)blockIdx.x * NTHREADS + threadIdx.x; i < (size_t)MT * D; i += (size_t)gridDim.x * NTHREADS) a.out[i] += delta; }
#endif
#undef IN
#undef SEAM
}
}

#ifndef MK_N_LAUNCHES
#define MK_N_LAUNCHES 1
#endif
extern "C" void kernel_launch(void* const* d_in, const int* in_sizes, int n_in, void* d_out, int out_size, void* d_ws, size_t ws_size, hipStream_t stream) {
    using namespace mk;
    static int grid = 0;
    if (grid == 0) {
        if (n_in != 20 || out_size != MT * D || ws_size < WS_END) { fprintf(stderr, "kernel_launch: unexpected problem (n_in %d out %d ws %zu need %zu)\n", n_in, out_size, ws_size, (size_t)WS_END); grid = -1; return; }
        int dev = 0, cus = 0, per_cu = 0;
        hipGetDevice(&dev); hipDeviceGetAttribute(&cus, hipDeviceAttributeMultiprocessorCount, dev);
#if MK_N_LAUNCHES == 1
        if (hipFuncSetAttribute((const void*)mk_fwd_t<0x3ff>, hipFuncAttributeMaxDynamicSharedMemorySize, LDS_BYTES) != hipSuccess) { fprintf(stderr, "kernel_launch: hipFuncSetAttribute failed\n"); grid = -1; return; }
        hipOccupancyMaxActiveBlocksPerMultiprocessor(&per_cu, (const void*)mk_fwd_t<0x3ff>, NTHREADS, LDS_BYTES);
#else
        per_cu = 1;
#endif
        (void)hipGetLastError();
        if (per_cu < 1) { fprintf(stderr, "kernel_launch: occupancy query says %d blocks per CU\n", per_cu); per_cu = 1; }
        grid = cus;
        if (grid > 256) grid = 256;
    }
    if (grid < 0) return;
#ifndef MK_NO_MEMSET
    if (hipMemsetAsync((char*)d_ws + WS_BAR, 0, 16384, stream) != hipSuccess) { fprintf(stderr, "kernel_launch: hipMemsetAsync failed\n"); return; }
#endif
    Args a{};
    for (int i = 0; i < 20; ++i) a.in[i] = (const float*)d_in[i];
    a.out = (float*)d_out; a.ws = (unsigned char*)d_ws; a.sub = 7;
#if MK_N_LAUNCHES == 1
    a.ph_lo = 0; a.ph_hi = 10;
    void* args[] = {&a};
#ifdef MK_PLAIN_LAUNCH
    hipLaunchKernelGGL(mk_fwd_t<0x3ff>, dim3(grid), dim3(NTHREADS), LDS_BYTES, stream, a); hipError_t e = hipGetLastError(); (void)args;
#else
    hipError_t e = hipLaunchCooperativeKernel((const void*)mk_fwd_t<0x3ff>, dim3(grid), dim3(NTHREADS), args, LDS_BYTES, stream);
#endif
    if (e != hipSuccess) fprintf(stderr, "cooperative launch failed: %s (grid %d)\n", hipGetErrorString(e), grid);
#else
#define MK_LAUNCH_P(p) do { hipFuncSetAttribute((const void*)mk_fwd_t<(1 << (p))>, hipFuncAttributeMaxDynamicSharedMemorySize, LDS_BYTES); a.ph_lo = (p); a.ph_hi = (p) + 1; hipLaunchKernelGGL(mk_fwd_t<(1 << (p))>, dim3(grid), dim3(NTHREADS), LDS_BYTES, stream, a); } while (0)
#ifndef MK_DUP
#define MK_DUP -1
#endif
#ifndef MK_DUP_SUB
#define MK_DUP_SUB 7
#endif
#define MK_LAUNCH_D(p) do { MK_LAUNCH_P(p); if (MK_DUP == (p)) { a.sub = MK_DUP_SUB; MK_LAUNCH_P(p); a.sub = 7; } } while (0)
    MK_LAUNCH_D(0); MK_LAUNCH_D(1); MK_LAUNCH_D(2); MK_LAUNCH_D(3); MK_LAUNCH_D(4); MK_LAUNCH_D(5); MK_LAUNCH_D(6); MK_LAUNCH_D(7); MK_LAUNCH_D(8); MK_LAUNCH_D(9);
#endif
}
```

```cpp
#include <hip/hip_runtime.h>
#include <hip/hip_cooperative_groups.h>
#include <cstdio>
#include <cstdint>
namespace cg = cooperative_groups;
namespace pg8 {
#define PG8_LAS __attribute__((address_space(3)))
typedef unsigned short bf16_t;
typedef short bf16x8 __attribute__((ext_vector_type(8)));
typedef float f32x4 __attribute__((ext_vector_type(4)));
typedef unsigned u32x4 __attribute__((ext_vector_type(4)));
constexpr int BM = 256, BK = 64, HALF = 128, HTB = HALF * BK * 2  , STAGE_BYTES = 8 * HTB, NXCD = 8, WGM = 8;

__host__ __device__ __forceinline__ int lds_byte(int r, int c) { const int st = (r >> 4) * 2 + (c >> 5), rr = r & 15, cc = c & 31, ob = rr * 64 + cc * 2; return st * 1024 + (ob ^ (((ob >> 9) & 1) << 5)); }
__host__ __device__ __forceinline__ void stage_rc(int b, int& R, int& C) { const int st = b / 1024, sb = b % 1024, swz = sb ^ (((sb >> 9) & 1) << 5); R = (st >> 1) * 16 + swz / 64; C = (st & 1) * 32 + (swz % 64) / 2; }
__host__ __device__ __forceinline__ int perm32(int rho) { const int n = rho >> 4, i = rho & 15; return 8 * (i >> 2) + 4 * n + (i & 3); }

struct Unit { int pm, pn; };
struct Gemm { const bf16_t* A; const bf16_t* Bt; int M, N, K; const int* gidx = nullptr; };

struct StaticOrder {
    int nM, nN, nwg, G, c;
    __host__ __device__ void init(int M, int N, int G_, int c_) { nM = M / BM; nN = N / BM; nwg = nM * nN; G = G_; c = c_; }
    __host__ __device__ bool next(int i, Unit& u) const {
        const long L = (long)i * G + c; if (L >= nwg) return false;
        int wgid = (int)L; { const int q = nwg / NXCD, r = nwg % NXCD, xcd = wgid % NXCD, off = wgid / NXCD; wgid = (xcd < r ? xcd * (q + 1) : r * (q + 1) + (xcd - r) * q) + off; }
        const int nig = WGM * nN, gid = wgid / nig, fm = gid * WGM, gsz = (nM - fm) < WGM ? (nM - fm) : WGM;
        u.pm = fm + ((wgid % nig) % gsz); u.pn = (wgid % nig) / gsz; return true;
    }
    __device__ __forceinline__ void a_ready(const Unit&) const {}
    __device__ __forceinline__ void done(const Unit&) const {}
};
__device__ __forceinline__ unsigned cvt_pk_bf16(float lo, float hi) { unsigned r; asm volatile("v_cvt_pk_bf16_f32 %0, %1, %2" : "=v"(r) : "v"(lo), "v"(hi)); return r; }
typedef float f32x2 __attribute__((ext_vector_type(2)));
typedef int pg8_v8i __attribute__((ext_vector_type(8))); typedef int pg8_v4i __attribute__((ext_vector_type(4)));
template <int FMT> struct pg8_frag;
template <> struct pg8_frag<0> { bf16x8 v[2]; };
template <> struct pg8_frag<1> { pg8_v4i v[2]; };
template <class Epi, class Sched, bool ALIGN_EPI = false, bool SP2 = false, int FMT = 0, int FP8_SCALE_W = 0x7F7F7F7F>
__device__ __forceinline__ void gemm_phase(PG8_LAS unsigned char* lds, const Gemm g, const Sched& S, const Epi& E) {
    int tid_ = threadIdx.x; asm volatile("" : "+v"(tid_));
    const int tid = tid_, wid = __builtin_amdgcn_readfirstlane(tid >> 6), lane = tid & 63, wr = wid >> 2, wc = wid & 3, fr = lane & 15, fq = lane >> 4;
    const int K = g.K, nt = K / BK;
    unsigned voffA[2], voffB[2];
#pragma unroll
    for (int i = 0; i < 2; ++i) { int R, C; stage_rc(tid * 16 + i * 8192, R, C); const int Rb = Epi::PERM ? ((R & ~31) + perm32(R & 31)) : R;
        voffA[i] = (unsigned)(R * K + C) * 2u; voffB[i] = (unsigned)(Rb * K + C) * 2u; }
    const size_t kstep = (size_t)(BK * 2);
    const size_t hstep = (size_t)HALF * K * 2;
    const size_t tstep = 2 * hstep;
    unsigned voffAh[2][2];
#pragma unroll
    for (int i = 0; i < 2; ++i) { int R, C; stage_rc(tid * 16 + i * 8192, R, C);
        if (g.gidx) { voffAh[0][i] = (unsigned)(g.gidx[R] * K + C) * 2u; voffAh[1][i] = (unsigned)(g.gidx[HALF + R] * K + C) * 2u; }
        else { voffAh[0][i] = 0u; voffAh[1][i] = 0u; } }
    const __amdgpu_buffer_rsrc_t rsA = __builtin_amdgcn_make_buffer_rsrc((void*)g.A, 0, -1, 0x00020000), rsB = __builtin_amdgcn_make_buffer_rsrc((void*)g.Bt, 0, -1, 0x00020000);
    const size_t atstep = g.gidx ? (size_t)0 : tstep; const int p1step = 64 * K * 2;
    const unsigned ldsw = (unsigned)wid * 1024u;
    const int aoff = lds_byte(wr * 64 + fr, fq * 8), boff = lds_byte(wc * 32 + fr, fq * 8);
#define PG8_SA(b, h) (((b) * 2 + (h)) * HTB)
#define PG8_SB(b, h) ((4 + (b) * 2 + (h)) * HTB)
#define PG8_STAGE_R(rs, base0, bufoff, gbase, voff) do { const int so_ = (int)((const char*)(gbase) - (const char*)(base0)); _Pragma("unroll") for (int _i = 0; _i < 2; ++_i) \
        __builtin_amdgcn_raw_ptr_buffer_load_lds(rs, (PG8_LAS unsigned*)(lds + (bufoff) + ldsw + _i * 8192), 16, (int)(voff)[_i], so_, 0, 0); } while (0)
#define PG8_STAGE_U(rs, base0, bufoff, gbase, voff0, xtra) do { const int so_ = (int)((const char*)(gbase) - (const char*)(base0)) + (int)(xtra); _Pragma("unroll") for (int _i = 0; _i < 2; ++_i) \
        __builtin_amdgcn_raw_ptr_buffer_load_lds(rs, (PG8_LAS unsigned*)(lds + (bufoff) + ldsw + _i * 8192), 16, (int)(voff0), so_ + _i * (int)p1step, 0, 0); } while (0)
#define PG8_LD1(dst, k, addr) do { if constexpr (FMT == 0) dst.v[k] = *(const PG8_LAS bf16x8*)(addr); else dst.v[k] = *(const PG8_LAS pg8_v4i*)(addr); } while (0)
#define PG8_LDA(dst, b, h) do { _Pragma("unroll") for (int m = 0; m < 4; ++m) _Pragma("unroll") for (int k = 0; k < 2; ++k) PG8_LD1(dst[m], k, lds + PG8_SA(b, h) + aoff + m * 2048 + k * 1024); } while (0)
#define PG8_LDB(dst, b, h) do { _Pragma("unroll") for (int n = 0; n < 2; ++n) _Pragma("unroll") for (int k = 0; k < 2; ++k) PG8_LD1(dst[n], k, lds + PG8_SB(b, h) + boff + n * 2048 + k * 1024); } while (0)
#define PG8_MMA(ai, bj, At, Bt) do { __builtin_amdgcn_s_setprio(1); \
        if constexpr (FMT == 0) { _Pragma("unroll") for (int m = 0; m < 4; ++m) _Pragma("unroll") for (int n = 0; n < 2; ++n) _Pragma("unroll") for (int k = 0; k < 2; ++k) \
            acc[ai][bj][m][n] = __builtin_amdgcn_mfma_f32_16x16x32_bf16(Bt[n].v[k], At[m].v[k], acc[ai][bj][m][n], 0, 0, 0); } \
        else { _Pragma("unroll") for (int m = 0; m < 4; ++m) _Pragma("unroll") for (int n = 0; n < 2; ++n) \
            acc[ai][bj][m][n] = __builtin_amdgcn_mfma_scale_f32_16x16x128_f8f6f4(__builtin_shufflevector(Bt[n].v[0], Bt[n].v[1], 0, 1, 2, 3, 4, 5, 6, 7), __builtin_shufflevector(At[m].v[0], At[m].v[1], 0, 1, 2, 3, 4, 5, 6, 7), acc[ai][bj][m][n], 0, 0, 0, 0x7F7F7F7F, 0, 0x7F7F7F7F); \
            asm volatile("" :: "v"(acc[ai][bj][0][0]), "v"(acc[ai][bj][0][1]), "v"(acc[ai][bj][1][0]), "v"(acc[ai][bj][1][1]), "v"(acc[ai][bj][2][0]), "v"(acc[ai][bj][2][1]), "v"(acc[ai][bj][3][0]), "v"(acc[ai][bj][3][1])); }   \
        __builtin_amdgcn_s_setprio(0); } while (0)
#define PG8_WAIT_V(n) asm volatile("s_waitcnt vmcnt(" #n ")" ::: "memory")
#define PG8_WAIT_L(n) asm volatile("s_waitcnt lgkmcnt(" #n ")" ::: "memory")
#define PG8_BAR __builtin_amdgcn_s_barrier()
#define PG8_SCHED __builtin_amdgcn_sched_barrier(0)
    Unit cur, nxt; int ui = 0;
    if (!S.next(0, cur)) return;
    f32x4 acc[2][2][4][2];
#pragma unroll
    for (int a = 0; a < 2; ++a)
#pragma unroll
        for (int b = 0; b < 2; ++b)
#pragma unroll
            for (int m = 0; m < 4; ++m)
#pragma unroll
                for (int n = 0; n < 2; ++n) acc[a][b][m][n] = (f32x4){0.f, 0.f, 0.f, 0.f};
    pg8_frag<FMT> At[4], B0[2], B1[2];
    const char* cA = (const char*)g.A + (size_t)cur.pm * atstep; const char* cB = (const char*)g.Bt + (size_t)cur.pn * tstep;
    S.a_ready(cur);
    if constexpr (SP2) {
        PG8_STAGE_U(rsB, g.Bt, PG8_SB(0, 0), cB, voffB[0], 0); PG8_STAGE_U(rsB, g.Bt, PG8_SB(0, 1), cB + hstep, voffB[0], 0); do { if (g.gidx) PG8_STAGE_R(rsA, g.A, PG8_SA(0, 0), cA, voffAh[0]); else PG8_STAGE_U(rsA, g.A, PG8_SA(0, 0), cA, voffA[0], 0 * hstep); } while (0); do { if (g.gidx) PG8_STAGE_R(rsA, g.A, PG8_SA(0, 1), cA, voffAh[1]); else PG8_STAGE_U(rsA, g.A, PG8_SA(0, 1), cA, voffA[0], 1 * hstep); } while (0);
        if (wr == 1) PG8_BAR;
        PG8_WAIT_V(2); PG8_BAR;
        PG8_STAGE_U(rsB, g.Bt, PG8_SB(1, 0), cB + kstep, voffB[0], 0); do { if (g.gidx) PG8_STAGE_R(rsA, g.A, PG8_SA(1, 0), cA + kstep, voffAh[0]); else PG8_STAGE_U(rsA, g.A, PG8_SA(1, 0), cA + kstep, voffA[0], 0 * hstep); } while (0); PG8_STAGE_U(rsB, g.Bt, PG8_SB(1, 1), cB + hstep + kstep, voffB[0], 0);
        PG8_WAIT_V(6); PG8_BAR;
    } else {
        PG8_STAGE_U(rsB, g.Bt, PG8_SB(0, 0), cB, voffB[0], 0); do { if (g.gidx) PG8_STAGE_R(rsA, g.A, PG8_SA(0, 0), cA, voffAh[0]); else PG8_STAGE_U(rsA, g.A, PG8_SA(0, 0), cA, voffA[0], 0 * hstep); } while (0); PG8_STAGE_U(rsB, g.Bt, PG8_SB(0, 1), cB + hstep, voffB[0], 0); do { if (g.gidx) PG8_STAGE_R(rsA, g.A, PG8_SA(0, 1), cA, voffAh[1]); else PG8_STAGE_U(rsA, g.A, PG8_SA(0, 1), cA, voffA[0], 1 * hstep); } while (0);
        if (wr == 1) PG8_BAR;
        PG8_WAIT_V(4); PG8_BAR;
        PG8_STAGE_U(rsB, g.Bt, PG8_SB(1, 0), cB + kstep, voffB[0], 0); do { if (g.gidx) PG8_STAGE_R(rsA, g.A, PG8_SA(1, 0), cA + kstep, voffAh[0]); else PG8_STAGE_U(rsA, g.A, PG8_SA(1, 0), cA + kstep, voffA[0], 0 * hstep); } while (0); PG8_STAGE_U(rsB, g.Bt, PG8_SB(1, 1), cB + hstep + kstep, voffB[0], 0);
        PG8_WAIT_V(6); PG8_BAR;
    }
    for (;;) {
        const bool has_next = S.next(ui + 1, nxt);
        const char* nA = has_next ? (const char*)g.A + (size_t)nxt.pm * atstep : cA; const char* nB = has_next ? (const char*)g.Bt + (size_t)nxt.pn * tstep : cB;
        for (int t = 0; t < nt; t += 2) {
            const bool last = (t == nt - 2);
            const char* a1 = cA + (size_t)(t + 1) * kstep;
            const char* a2 = last ? nA : cA + (size_t)(t + 2) * kstep; const char* b2 = last ? nB : cB + (size_t)(t + 2) * kstep;
            const char* a3 = a2 + kstep; const char* b3 = b2 + kstep;
            if (last && has_next) S.a_ready(nxt);
            if constexpr (SP2) {
            PG8_LDB(B0, 0, 0); PG8_LDB(B1, 0, 1); PG8_SCHED; PG8_LDA(At, 0, 0); do { if (g.gidx) PG8_STAGE_R(rsA, g.A, PG8_SA(1, 1), a1, voffAh[1]); else PG8_STAGE_U(rsA, g.A, PG8_SA(1, 1), a1, voffA[0], 1 * hstep); } while (0);
            PG8_WAIT_V(8); PG8_WAIT_L(0); PG8_BAR; PG8_MMA(0, 0, At, B0); PG8_MMA(0, 1, At, B1); PG8_BAR; PG8_SCHED;
            PG8_LDA(At, 0, 1); PG8_STAGE_U(rsB, g.Bt, PG8_SB(0, 0), b2, voffB[0], 0); PG8_STAGE_U(rsB, g.Bt, PG8_SB(0, 1), b2 + hstep, voffB[0], 0); do { if (g.gidx) PG8_STAGE_R(rsA, g.A, PG8_SA(0, 0), a2, voffAh[0]); else PG8_STAGE_U(rsA, g.A, PG8_SA(0, 0), a2, voffA[0], 0 * hstep); } while (0);
            PG8_WAIT_V(8); PG8_WAIT_L(0); PG8_BAR; PG8_MMA(1, 0, At, B0); PG8_MMA(1, 1, At, B1); PG8_BAR; PG8_SCHED;
            PG8_LDB(B0, 1, 0); PG8_LDB(B1, 1, 1); PG8_SCHED; PG8_LDA(At, 1, 0); do { if (g.gidx) PG8_STAGE_R(rsA, g.A, PG8_SA(0, 1), a2, voffAh[1]); else PG8_STAGE_U(rsA, g.A, PG8_SA(0, 1), a2, voffA[0], 1 * hstep); } while (0);
            PG8_WAIT_V(8); PG8_WAIT_L(0); PG8_BAR; PG8_MMA(0, 0, At, B0); PG8_MMA(0, 1, At, B1); PG8_BAR; PG8_SCHED;
            PG8_LDA(At, 1, 1); PG8_STAGE_U(rsB, g.Bt, PG8_SB(1, 0), b3, voffB[0], 0); PG8_STAGE_U(rsB, g.Bt, PG8_SB(1, 1), b3 + hstep, voffB[0], 0); do { if (g.gidx) PG8_STAGE_R(rsA, g.A, PG8_SA(1, 0), a3, voffAh[0]); else PG8_STAGE_U(rsA, g.A, PG8_SA(1, 0), a3, voffA[0], 0 * hstep); } while (0);
            PG8_WAIT_V(8); PG8_WAIT_L(0); PG8_BAR; PG8_MMA(1, 0, At, B0); PG8_MMA(1, 1, At, B1); PG8_BAR; PG8_SCHED;
            } else {
            PG8_LDB(B0, 0, 0); PG8_SCHED; PG8_LDA(At, 0, 0); do { if (g.gidx) PG8_STAGE_R(rsA, g.A, PG8_SA(1, 1), a1, voffAh[1]); else PG8_STAGE_U(rsA, g.A, PG8_SA(1, 1), a1, voffA[0], 1 * hstep); } while (0);
            PG8_WAIT_L(8); PG8_BAR; PG8_WAIT_L(0); PG8_MMA(0, 0, At, B0); PG8_BAR; PG8_SCHED;
            PG8_LDB(B1, 0, 1); PG8_STAGE_U(rsB, g.Bt, PG8_SB(0, 0), b2, voffB[0], 0);
            PG8_BAR; PG8_WAIT_L(0); PG8_MMA(0, 1, At, B1); PG8_BAR;
            PG8_LDA(At, 0, 1); do { if (g.gidx) PG8_STAGE_R(rsA, g.A, PG8_SA(0, 0), a2, voffAh[0]); else PG8_STAGE_U(rsA, g.A, PG8_SA(0, 0), a2, voffA[0], 0 * hstep); } while (0);
            PG8_BAR; PG8_WAIT_L(0); PG8_MMA(1, 0, At, B0); PG8_BAR; PG8_SCHED;
            PG8_STAGE_U(rsB, g.Bt, PG8_SB(0, 1), b2 + hstep, voffB[0], 0);
            PG8_WAIT_V(6); PG8_BAR; PG8_MMA(1, 1, At, B1); PG8_BAR;
            PG8_LDB(B0, 1, 0); PG8_SCHED; PG8_LDA(At, 1, 0); do { if (g.gidx) PG8_STAGE_R(rsA, g.A, PG8_SA(0, 1), a2, voffAh[1]); else PG8_STAGE_U(rsA, g.A, PG8_SA(0, 1), a2, voffA[0], 1 * hstep); } while (0);
            PG8_WAIT_L(8); PG8_BAR; PG8_WAIT_L(0); PG8_MMA(0, 0, At, B0); PG8_BAR; PG8_SCHED;
            PG8_LDB(B1, 1, 1); PG8_STAGE_U(rsB, g.Bt, PG8_SB(1, 0), b3, voffB[0], 0);
            PG8_BAR; PG8_WAIT_L(0); PG8_MMA(0, 1, At, B1); PG8_BAR;
            PG8_LDA(At, 1, 1); do { if (g.gidx) PG8_STAGE_R(rsA, g.A, PG8_SA(1, 0), a3, voffAh[0]); else PG8_STAGE_U(rsA, g.A, PG8_SA(1, 0), a3, voffA[0], 0 * hstep); } while (0);
            PG8_BAR; PG8_WAIT_L(0); PG8_MMA(1, 0, At, B0); PG8_BAR; PG8_SCHED;
            PG8_STAGE_U(rsB, g.Bt, PG8_SB(1, 1), b3 + hstep, voffB[0], 0);
            PG8_WAIT_V(6); PG8_BAR; PG8_MMA(1, 1, At, B1); PG8_BAR;
            }
        }
        if constexpr (ALIGN_EPI) { if (wr == 0) PG8_BAR; }
        if constexpr (!Epi::AFTER_DRAIN) { int t2_ = threadIdx.x; asm volatile("" : "+v"(t2_)); const int l2_ = t2_ & 63;
            E(acc, cur, wr, wc, l2_ & 15, l2_ >> 4); S.done(cur); }
        if (!has_next) break;
#pragma unroll
        for (int a = 0; a < 2; ++a)
#pragma unroll
            for (int b = 0; b < 2; ++b)
#pragma unroll
                for (int m = 0; m < 4; ++m)
#pragma unroll
                    for (int n = 0; n < 2; ++n) acc[a][b][m][n] = (f32x4){0.f, 0.f, 0.f, 0.f};
        cur = nxt; cA = nA; cB = nB; ++ui;
        if constexpr (ALIGN_EPI) { if (wr == 1) PG8_BAR; }
    }
    PG8_WAIT_V(0);
    if constexpr (!ALIGN_EPI) { if (wr == 0) PG8_BAR; }
    PG8_BAR;
    if constexpr (Epi::AFTER_DRAIN) { E.fused(acc, cur, wr, wc, fr, fq, lds, wid, lane); S.done(cur); }
#undef PG8_SA
#undef PG8_SB
#undef PG8_STAGE_R
#undef PG8_STAGE_U
#undef PG8_LDA
#undef PG8_LD1
#undef PG8_LDB
#undef PG8_MMA
#undef PG8_WAIT_V
#undef PG8_WAIT_L
#undef PG8_BAR
#undef PG8_SCHED
}
}
namespace mk {
using pg8::bf16_t; using pg8::bf16x8; using pg8::f32x4; using pg8::u32x4; using pg8::Unit; using pg8::Gemm;
#define LAS __attribute__((address_space(3)))
typedef short v4i16 __attribute__((ext_vector_type(4)));
typedef unsigned u32x2 __attribute__((ext_vector_type(2)));

constexpr int D = 1024, NB = 16, NT = 4096, NL = 256;
constexpr int MT = NB * NT, MC = NB * NL, MA = MT + MC;
constexpr int NPROJ = 2816, INC = 2832;
constexpr int NE = 16, FF = 512, CAP = 512;
constexpr float EPS = 1e-6f, LOG2E = 1.4426950408889634f;
constexpr int NWAVES = 8, NTHREADS = 512;
constexpr int LDS_BYTES = 144 * 1024;

constexpr size_t al256(size_t x) { return (x + 255) & ~(size_t)255; }
constexpr size_t WS_MOD = 0;
constexpr size_t WS_ROPE = WS_MOD + al256(17 * 6144 * 4);
constexpr size_t WS_MISC = WS_ROPE + al256(2 * 1024 * 4);
constexpr size_t WS_GATES = WS_MISC + 256;
constexpr size_t WS_AFF = WS_GATES + al256((size_t)MA * 16 * 4);
constexpr size_t WS_IDX = WS_AFF + al256((size_t)NB * NE * NT * 4);
constexpr size_t WS_GATE = WS_IDX + al256(256 * CAP * 4);
constexpr size_t WS_SLOT = WS_GATE + al256(256 * CAP * 4);
constexpr size_t WS_WIN = WS_SLOT + al256((size_t)256 * NT * 4);
constexpr size_t WS_WOUT = WS_WIN + al256((size_t)NPROJ * D * 2);
constexpr size_t WS_WGU = WS_WOUT + al256((size_t)D * D * 2);
constexpr size_t WS_WD = WS_WGU + al256((size_t)NE * 1024 * D * 2);
constexpr size_t WS_HX = WS_WD + al256((size_t)NE * D * FF * 2);
constexpr size_t WS_CQ = WS_HX;
constexpr size_t WS_CK = WS_HX + (size_t)MA * 512 * 2;
constexpr size_t WS_Q = WS_HX + al256((size_t)MA * D * 2);
constexpr size_t WS_KK = WS_Q + al256((size_t)MT * 512 * 2);
constexpr size_t WS_VV = WS_KK + al256((size_t)MA * 128 * 2);
constexpr size_t WS_M4 = WS_VV + al256((size_t)MA * 128 * 2);
constexpr size_t WS_MIX = WS_M4 + al256((size_t)4 * MA * 512 * 2);
constexpr size_t WS_HF = WS_MIX + (size_t)MT * D * 2;
constexpr size_t WS_HB = WS_HF + (size_t)MT * 512 * 2;
constexpr size_t WS_ACT = WS_HB + (size_t)MT * 512 * 2;
constexpr size_t WS_TBL = WS_ACT + al256((size_t)256 * CAP * FF * 2);
constexpr size_t WS_X1 = WS_M4;
static_assert((size_t)MT * D * 2 <= (size_t)136 * 1024 * 1024 && (size_t)136 * 1024 * 1024 + (size_t)256 * CAP * D <= (size_t)4 * MA * 512 * 2, "X1 and the gathered fp8 panels overlay MQ|MK and MV|MO");
constexpr size_t WS_BAR = WS_TBL + al256((size_t)256 * 34 * 384 * 4);
constexpr size_t WS_END = WS_BAR + 16384;
constexpr int LDS_GATE_OFF = 132 * 1024;
constexpr int LDS_BAR_OFF = 140 * 1024;
static_assert(WS_END <= ((size_t)1 << 30), "workspace map exceeds 1 GiB");
static_assert((size_t)256 * CAP * D * 2 <= (size_t)4 * MA * 512 * 2, "XG overlay fits");

struct Args { const float* in[20]; float* out; unsigned char* ws; int ph_lo, ph_hi, sub, pad; };

__device__ __forceinline__ float wave_sum(float v) {
#pragma unroll
    for (int o = 1; o < 64; o <<= 1) v += __shfl_xor(v, o);
    return v;
}
__device__ __forceinline__ float bflo(unsigned w) { return __builtin_bit_cast(float, w << 16); }
__device__ __forceinline__ float bfhi(unsigned w) { return __builtin_bit_cast(float, w & 0xffff0000u); }
typedef float f32x2_t __attribute__((ext_vector_type(2))); typedef __bf16 bf16x2_t __attribute__((ext_vector_type(2)));
__device__ __forceinline__ unsigned pkbf(float lo, float hi) { f32x2_t v = {lo, hi}; bf16x2_t b = __builtin_convertvector(v, bf16x2_t); return __builtin_bit_cast(unsigned, b); }
__device__ __forceinline__ unsigned pk4_fp8(float a, float b, float c, float d) { int p = __builtin_amdgcn_cvt_pk_fp8_f32(a, b, 0, false); p = __builtin_amdgcn_cvt_pk_fp8_f32(c, d, p, true); return (unsigned)p; }
constexpr float FP8_W_UP = 32.f;
constexpr int FP8_W_SCALE = 0x7A7A7A7A;
__device__ __forceinline__ float silu_f(float x) { return x * __builtin_amdgcn_rcpf(1.f + __expf(-x)); }
__device__ __forceinline__ float logsig_f(float x) { return fminf(x, 0.f) - log1pf(expf(-fabsf(x))); }
__device__ __forceinline__ f32x4 mfma16(bf16x8 a, bf16x8 b, f32x4 c) { return __builtin_amdgcn_mfma_f32_16x16x32_bf16(a, b, c, 0, 0, 0); }
__device__ __forceinline__ bf16x8 tr2(const LAS bf16_t* p0, const LAS bf16_t* p1) {
    const v4i16 a = __builtin_amdgcn_ds_read_tr16_b64_v4i16((LAS v4i16*)p0), b = __builtin_amdgcn_ds_read_tr16_b64_v4i16((LAS v4i16*)p1);
    return (bf16x8){a[0], a[1], a[2], a[3], b[0], b[1], b[2], b[3]};
}
__device__ __forceinline__ bf16x8 pack8(const f32x4 a, const f32x4 b) {
    u32x4 w; w.x = pkbf(a[0], a[1]); w.y = pkbf(a[2], a[3]); w.z = pkbf(b[0], b[1]); w.w = pkbf(b[2], b[3]); return __builtin_bit_cast(bf16x8, w);
}
__host__ __device__ __forceinline__ int win_dst_row(int n) {
    if (n >= 768) return n;
    const int pn = n >> 8, r = n & 255, wc = r >> 6, bj = (r >> 5) & 1, p = r & 31;
    return 256 * pn + 128 * bj + 32 * wc + p;
}

__device__ __forceinline__ void transpose_item(const float* W, int N, int k0, int n0, bf16_t* WT, int K, int drow0, LAS float* scr, int lane) {
    float tv[32];
#pragma unroll
    for (int i = 0; i < 32; ++i) tv[i] = W[(size_t)(k0 + 2 * i + (lane >> 5)) * N + n0 + (lane & 31)];
#pragma unroll
    for (int i = 0; i < 32; ++i) scr[(2 * i + (lane >> 5)) * 33 + (lane & 31)] = tv[i];
    asm volatile("s_waitcnt lgkmcnt(0)" ::: "memory");
    const int c = lane & 7;
#pragma unroll
    for (int j = 0; j < 4; ++j) { const int n = (lane >> 3) + 8 * j; const LAS float* s = scr + (8 * c) * 33 + n;
        u32x4 o; o.x = pkbf(s[0 * 33], s[1 * 33]); o.y = pkbf(s[2 * 33], s[3 * 33]); o.z = pkbf(s[4 * 33], s[5 * 33]); o.w = pkbf(s[6 * 33], s[7 * 33]);
        *(u32x4*)(WT + (size_t)(drow0 + n) * K + k0 + 8 * c) = o; }
    asm volatile("s_waitcnt lgkmcnt(0)" ::: "memory");
}
__device__ __forceinline__ void transpose_item8(const float* W, int N, int k0, int n0, unsigned char* WT, int K, int drow0, LAS float* scr, int lane) {
    float tv[32];
#pragma unroll
    for (int i = 0; i < 32; ++i) tv[i] = W[(size_t)(k0 + 2 * i + (lane >> 5)) * N + n0 + (lane & 31)];
#pragma unroll
    for (int i = 0; i < 32; ++i) scr[(2 * i + (lane >> 5)) * 33 + (lane & 31)] = tv[i];
    asm volatile("s_waitcnt lgkmcnt(0)" ::: "memory");
    const int c = lane & 7;
#pragma unroll
    for (int j = 0; j < 4; ++j) { const int n = (lane >> 3) + 8 * j; const LAS float* s = scr + (8 * c) * 33 + n;
        u32x2 o; o.x = pk4_fp8(s[0 * 33] * FP8_W_UP, s[1 * 33] * FP8_W_UP, s[2 * 33] * FP8_W_UP, s[3 * 33] * FP8_W_UP); o.y = pk4_fp8(s[4 * 33] * FP8_W_UP, s[5 * 33] * FP8_W_UP, s[6 * 33] * FP8_W_UP, s[7 * 33] * FP8_W_UP);
        *(u32x2*)(WT + (size_t)(drow0 + n) * K + k0 + 8 * c) = o; }
    asm volatile("s_waitcnt lgkmcnt(0)" ::: "memory");
}
__device__ __forceinline__ void phase0(const Args& a, LAS unsigned char* lds) {
    const int tid = threadIdx.x, lane = tid & 63, wave = tid >> 6, wg = blockIdx.x, G = gridDim.x;
    unsigned char* ws = a.ws;
    {
        LAS float* sc = (LAS float*)lds;
        LAS float* part = sc + 17 * 1024;
        const float* c = a.in[1]; const float* cctx = a.in[3]; const float* w_mod = a.in[4]; const float* b_mod = a.in[5];
        float* mod = (float*)(ws + WS_MOD);
        for (int i = tid; i < 17 * 1024; i += NTHREADS) { const int r = i >> 10, k = i & 1023; const float v = r < 16 ? c[r * 1024 + k] : cctx[k]; sc[i] = v / (1.f + expf(-v)); }
        __syncthreads();
        for (int it = wg; it < 256; it += G) {
            const int col0 = it * 24;
            if (tid < 504) {
                const int j = tid % 24, kg = tid / 24; float acc[17];
#pragma unroll
                for (int r = 0; r < 17; ++r) acc[r] = 0.f;
#pragma unroll 7
                for (int k = kg; k < 1024; k += 21) { const float w = w_mod[(size_t)k * 6144 + col0 + j];
#pragma unroll
                    for (int r = 0; r < 17; ++r) acc[r] += sc[r * 1024 + k] * w; }
#pragma unroll
                for (int r = 0; r < 17; ++r) part[(kg * 17 + r) * 24 + j] = acc[r];
            }
            __syncthreads();
            if (tid < 408) { const int r = tid / 24, j = tid % 24; float s = b_mod[col0 + j]; for (int kg = 0; kg < 21; ++kg) s += part[(kg * 17 + r) * 24 + j]; mod[r * 6144 + col0 + j] = s; }
            __syncthreads();
        }
    }
    if (wg == 0) {
        float* rope = (float*)(ws + WS_ROPE);
        for (int i = tid; i < 1024; i += NTHREADS) { const int pos = i >> 4, f = i & 15; const float ang = (float)pos * powf(10000.f, -(float)f / 16.f); rope[i] = cosf(ang); rope[1024 + i] = sinf(ang); }
        if (tid == 0) { float mq = 0.f, mkk = 0.f; for (int i = 0; i < 64; ++i) { mq = fmaxf(mq, fabsf(a.in[11][i])); mkk = fmaxf(mkk, fabsf(a.in[12][i])); }
            ((float*)(ws + WS_MISC))[0] = fmaxf(0.f, 8.f * mq * mkk * LOG2E - 16.f); }
    }
    {
        LAS float* scr = (LAS float*)lds + wave * (64 * 33);
        const int gw = wg * NWAVES + wave, NGW = G * NWAVES;
        bf16_t* WIN = (bf16_t*)(ws + WS_WIN);
        for (int it = gw; it < 16 * 88; it += NGW) { const int kb = it / 88, nb = it % 88; transpose_item(a.in[8], INC, 64 * kb, 32 * nb, WIN, D, win_dst_row(32 * nb), scr, lane); }
    }
}
__device__ __forceinline__ void transpose_late(const Args& a, LAS unsigned char* lds, int wg, int G) {
    const int tid = threadIdx.x, lane = tid & 63, wave = tid >> 6;
    unsigned char* ws = a.ws;
    LAS float* scr = (LAS float*)lds + wave * (64 * 33);
    const int gw = wg * NWAVES + wave, NGW = G * NWAVES;
    constexpr int I_OUT = 16 * 32, I_G = 16 * 16, I_D = 8 * 32;
    constexpr int NITEMS = I_OUT + NE * (2 * I_G + I_D);
    bf16_t* WOUT = (bf16_t*)(ws + WS_WOUT); unsigned char* WGU = ws + WS_WGU; unsigned char* WDT = ws + WS_WD;
    for (int it = gw; it < NITEMS; it += NGW) {
        int r = it;
        if (r < I_OUT) { const int kb = r / 32, nb = r % 32; transpose_item(a.in[15], D, 64 * kb, 32 * nb, WOUT, D, 32 * nb, scr, lane); continue; } r -= I_OUT;
        const int e = r / (2 * I_G + I_D); r -= e * (2 * I_G + I_D);
        if (r < 2 * I_G) { const int up = r / I_G, rr = r % I_G, kb = rr / 16, nb = rr % 16, n0 = 32 * nb;
            transpose_item8((up ? a.in[18] : a.in[17]) + (size_t)e * D * FF, FF, 64 * kb, n0, WGU + (size_t)e * 1024 * D, D, 256 * (n0 >> 7) + (n0 & 127) + 128 * up, scr, lane); continue; }
        r -= 2 * I_G;
        { const int kb = r / 32, nb = r % 32; transpose_item8(a.in[19] + (size_t)e * FF * D, D, 64 * kb, 32 * nb, WDT + (size_t)e * D * FF, FF, 32 * nb, scr, lane); }
    }
}

__device__ __forceinline__ void fill_w16(LAS float* W16, const float* src, int pitch, int tid) {
    for (int idx = tid; idx < 1024 * 16; idx += NTHREADS) { const int k = idx >> 4, t = idx & 15; const int ln = (k & 255) >> 2, i = k & 3, j = k >> 8;
        W16[((j * 4 + i) * 64 + ln) * 20 + t] = src[(size_t)k * pitch + t]; }
}
__device__ __forceinline__ float reduce16(const float (&g)[16], int lane) {
    float r8[8], r4[4], r2[2];
    const bool b5 = (lane & 32) != 0, b4 = (lane & 16) != 0, b3 = (lane & 8) != 0, b2 = (lane & 4) != 0;
#pragma unroll
    for (int t = 0; t < 8; ++t) { const float keep = b5 ? g[t + 8] : g[t], send = b5 ? g[t] : g[t + 8]; r8[t] = keep + __shfl_xor(send, 32); }
#pragma unroll
    for (int t = 0; t < 4; ++t) { const float keep = b4 ? r8[t + 4] : r8[t], send = b4 ? r8[t] : r8[t + 4]; r4[t] = keep + __shfl_xor(send, 16); }
#pragma unroll
    for (int t = 0; t < 2; ++t) { const float keep = b3 ? r4[t + 2] : r4[t], send = b3 ? r4[t] : r4[t + 2]; r2[t] = keep + __shfl_xor(send, 8); }
    const float keep = b2 ? r2[1] : r2[0], send = b2 ? r2[0] : r2[1];
    float r1 = keep + __shfl_xor(send, 4);
    r1 += __shfl_xor(r1, 1); r1 += __shfl_xor(r1, 2);
    return r1;
}
__device__ __forceinline__ int reduce16_index(int lane) { return ((lane >> 5) & 1) * 8 + ((lane >> 4) & 1) * 4 + ((lane >> 3) & 1) * 2 + ((lane >> 2) & 1); }
__device__ __forceinline__ void rows2_norm_dots(f32x4 (&va)[4], f32x4 (&vb)[4], const f32x4 (&sc)[4], const f32x4 (&sh)[4], const LAS float* W16, int lane, float& ga, float& gb) {
    float sa = 0.f, sb = 0.f;
#pragma unroll
    for (int j = 0; j < 4; ++j) { sa += (va[j][0] * va[j][0] + va[j][1] * va[j][1]) + (va[j][2] * va[j][2] + va[j][3] * va[j][3]); sb += (vb[j][0] * vb[j][0] + vb[j][1] * vb[j][1]) + (vb[j][2] * vb[j][2] + vb[j][3] * vb[j][3]); }
    const float ra = rsqrtf(wave_sum(sa) * (1.f / D) + EPS), rb = rsqrtf(wave_sum(sb) * (1.f / D) + EPS);
    float g0[16], g1[16];
#pragma unroll
    for (int t = 0; t < 16; ++t) { g0[t] = 0.f; g1[t] = 0.f; }
    int off0 = lane * 20, off1 = lane * 20;
#pragma unroll
    for (int j = 0; j < 4; ++j) {
        va[j] = va[j] * ra * sc[j] + sh[j]; vb[j] = vb[j] * rb * sc[j] + sh[j];
#pragma unroll
        for (int i = 0; i < 4; ++i) { const int off = (i & 1) ? off1 : off0; const LAS f32x4* wp = (const LAS f32x4*)(W16 + (j * 4 + i) * 64 * 20 + off); const float ha = va[j][i], hb = vb[j][i];
#pragma unroll
            for (int q = 0; q < 4; ++q) { const f32x4 w = wp[q];
                g0[4 * q + 0] += ha * w[0]; g0[4 * q + 1] += ha * w[1]; g0[4 * q + 2] += ha * w[2]; g0[4 * q + 3] += ha * w[3];
                g1[4 * q + 0] += hb * w[0]; g1[4 * q + 1] += hb * w[1]; g1[4 * q + 2] += hb * w[2]; g1[4 * q + 3] += hb * w[3]; }
            if (i & 1) asm volatile("" : "+v"(off1), "+v"(g0[0]), "+v"(g0[1]), "+v"(g0[2]), "+v"(g0[3]), "+v"(g0[4]), "+v"(g0[5]), "+v"(g0[6]), "+v"(g0[7]), "+v"(g0[8]), "+v"(g0[9]), "+v"(g0[10]), "+v"(g0[11]), "+v"(g0[12]), "+v"(g0[13]), "+v"(g0[14]), "+v"(g0[15])); else asm volatile("" : "+v"(off0), "+v"(g0[0]), "+v"(g0[1]), "+v"(g0[2]), "+v"(g0[3]), "+v"(g0[4]), "+v"(g0[5]), "+v"(g0[6]), "+v"(g0[7]), "+v"(g0[8]), "+v"(g0[9]), "+v"(g0[10]), "+v"(g0[11]), "+v"(g0[12]), "+v"(g0[13]), "+v"(g0[14]), "+v"(g0[15]));
            asm volatile("" : "+v"(g1[0]), "+v"(g1[1]), "+v"(g1[2]), "+v"(g1[3]), "+v"(g1[4]), "+v"(g1[5]), "+v"(g1[6]), "+v"(g1[7]), "+v"(g1[8]), "+v"(g1[9]), "+v"(g1[10]), "+v"(g1[11]), "+v"(g1[12]), "+v"(g1[13]), "+v"(g1[14]), "+v"(g1[15])); }
    }
    ga = reduce16(g0, lane); gb = reduce16(g1, lane);
}
__device__ __forceinline__ void store_row_bf16(bf16_t* orow, const f32x4 (&v)[4], int lane) {
#pragma unroll
    for (int j = 0; j < 4; ++j) { u32x2 o; o.x = pkbf(v[j][0], v[j][1]); o.y = pkbf(v[j][2], v[j][3]); *(u32x2*)(orow + 4 * lane + 256 * j) = o; }
}
__device__ __forceinline__ void p1_build(const Args& a, LAS unsigned char* lds, int b, int tid) {
    const float* mr = (const float*)(a.ws + WS_MOD) + b * 6144; const float* n1w = a.in[6]; const float* Wg = a.in[8] + NPROJ; const float* bg = a.in[9];
    LAS bf16_t* WB = (LAS bf16_t*)lds; LAS float* SC = (LAS float*)(lds + 32768); LAS float* SH = (LAS float*)(lds + 36864); LAS float* CP = (LAS float*)(lds + 40960);
    for (int c = tid; c < D; c += NTHREADS) {
        const float scv = n1w[c] * (1.f + mr[D + c]); SC[c] = scv; SH[c] = mr[c];
        const int fi = ((c >> 6) * 2 + ((c >> 5) & 1)) * 64 + ((c >> 3) & 3) * 16, ee = c & 7;
#pragma unroll
        for (int j = 0; j < 4; ++j) { const f32x4 w = *(const f32x4*)(Wg + (size_t)c * INC + 4 * j);
#pragma unroll
            for (int i = 0; i < 4; ++i) WB[((fi + 4 * j + i) << 3) + ee] = (bf16_t)(pkbf(scv * w[i], 0.f) & 0xffffu); }
    }
    { const int e = tid & 15, part = tid >> 4; float cb = 0.f;
#pragma unroll 4
        for (int i = 0; i < 32; ++i) { const int c = part * 32 + i; cb += mr[c] * Wg[(size_t)c * INC + e]; }
        CP[part * 16 + e] = cb; }
    __syncthreads();
    if (tid < 16) { float t = bg[tid]; for (int p = 0; p < 32; ++p) t += CP[p * 16 + tid]; CP[512 + tid] = t; }
    __syncthreads();
}
#define P1_ROWPTR(m) ((m) < MT ? a.in[0] + (size_t)(m) * D : a.in[2] + (size_t)((m) - MT) * D)
__device__ __forceinline__ void p1_tiles(const Args& a, LAS unsigned char* lds, int row_base, int ntiles) {
    const int tid = threadIdx.x, lane = tid & 63, wave = tid >> 6, fr = lane & 15, kq = lane >> 4;
    const LAS bf16_t* WB = (const LAS bf16_t*)lds; const LAS float* SC = (const LAS float*)(lds + 32768); const LAS float* SH = (const LAS float*)(lds + 36864); const LAS float* CP = (const LAS float*)(lds + 40960);
    bf16_t* HX = (bf16_t*)(a.ws + WS_HX); float* GATES = (float*)(a.ws + WS_GATES);
    const float cbe = CP[512 + fr]; const bool isf = ((fr >> 2) & 1) != 0;
#pragma unroll 1
    for (int t0 = wave; t0 < ntiles; t0 += NWAVES) {
        int row = row_base + 8 * t0 + (lane & 7); asm volatile("" : "+v"(row));
        const int cl = 8 * (4 * ((lane >> 3) & 1) + kq);
        const float* xp = P1_ROWPTR(row) + cl;
        f32x4 xv[32];
#pragma unroll
        for (int s = 0; s < 16; ++s) { xv[2 * s] = *(const f32x4*)(xp + 64 * s); xv[2 * s + 1] = *(const f32x4*)(xp + 64 * s + 4); }
        f32x4 acc0 = {0.f, 0.f, 0.f, 0.f}, acc1 = {0.f, 0.f, 0.f, 0.f}; float ss = 0.f;
        int boff = lane * 8, coff = cl; asm volatile("" : "+v"(boff), "+v"(coff));
#pragma unroll
        for (int g = 0; g < 4; ++g) {
            bf16x8 B0[4], B1[4];
#pragma unroll
            for (int i = 0; i < 4; ++i) { B0[i] = *(const LAS bf16x8*)(WB + boff + (4 * g + i) * 1024); B1[i] = *(const LAS bf16x8*)(WB + boff + (4 * g + i) * 1024 + 512); }
#pragma unroll
            for (int i = 0; i < 4; ++i) { const f32x4 v0 = xv[8 * g + 2 * i], v1 = xv[8 * g + 2 * i + 1];
                u32x4 pk; pk.x = pkbf(v0[0], v0[1]); pk.y = pkbf(v0[2], v0[3]); pk.z = pkbf(v1[0], v1[1]); pk.w = pkbf(v1[2], v1[3]);
                const bf16x8 A = __builtin_bit_cast(bf16x8, pk);
                acc0 = mfma16(A, B0[i], acc0); acc1 = mfma16(A, B1[i], acc1);
                ss += (v0[0] * v0[0] + v0[1] * v0[1]) + (v0[2] * v0[2] + v0[3] * v0[3]) + (v1[0] * v1[0] + v1[1] * v1[1]) + (v1[2] * v1[2] + v1[3] * v1[3]); }
            asm volatile("" : "+v"(boff), "+v"(acc0), "+v"(acc1));
        }
        ss += __shfl_xor(ss, 8); ss += __shfl_xor(ss, 16); ss += __shfl_xor(ss, 32);
        const float rstd = rsqrtf(ss * (1.f / D) + EPS);
#pragma unroll
        for (int i = 0; i < 4; ++i) {
            float gv = (acc0[i] + __shfl_xor(acc1[i], 32)) * __shfl(rstd, (4 * kq + i) & 7) + cbe;
            if (isf) gv = logsig_f(gv);
            if (lane < 32) GATES[(size_t)(row_base + 8 * t0 + 4 * kq + i) * 16 + fr] = gv;
        }
        bf16_t* hp = HX + (size_t)row * D + cl;
#pragma unroll
        for (int s = 0; s < 16; ++s) {
            const int c0 = 64 * s + coff;
            const f32x4 s0 = *(const LAS f32x4*)(SC + c0), s1 = *(const LAS f32x4*)(SC + c0 + 4), h0 = *(const LAS f32x4*)(SH + c0), h1 = *(const LAS f32x4*)(SH + c0 + 4);
            const f32x4 o0 = xv[2 * s] * rstd * s0 + h0, o1 = xv[2 * s + 1] * rstd * s1 + h1;
            u32x4 o; o.x = pkbf(o0[0], o0[1]); o.y = pkbf(o0[2], o0[3]); o.z = pkbf(o1[0], o1[1]); o.w = pkbf(o1[2], o1[3]);
            *(u32x4*)(hp + 64 * s) = o;
        }
    }
}
__device__ __forceinline__ void phase1(const Args& a, LAS unsigned char* lds) {
    const int tid = threadIdx.x, c = blockIdx.x;
    for (int pm = c; pm < 256; pm += gridDim.x) {
        p1_build(a, lds, pm >> 4, tid);
        p1_tiles(a, lds, pm * 256, 32);
        __syncthreads();
        p1_build(a, lds, 16, tid);
        p1_tiles(a, lds, MT + pm * 16, 2);
        __syncthreads();
    }
}
#undef P1_ROWPTR

struct SeqOrder {
    int pm0, nN, n;
    __device__ __forceinline__ bool next(int i, Unit& u) const { if (i >= n) return false; u.pm = pm0 + i / nN; u.pn = i % nN; return true; }
    __device__ __forceinline__ void a_ready(const Unit&) const {}
    __device__ __forceinline__ void done(const Unit&) const {}
};
struct P2Order {
    pg8::StaticOrder S; int c;
    __device__ __forceinline__ bool next(int i, Unit& u) const { if (i < 11) return S.next(i, u); if (i == 11 && c < 80) { const int t = c % 5; u.pm = 256 + c / 5; u.pn = t == 0 ? 2 : 4 + t; return true; } return false; }
    __device__ __forceinline__ void a_ready(const Unit&) const {}
    __device__ __forceinline__ void done(const Unit&) const {}
};
struct EpiProj {
    static constexpr bool PERM = true, AFTER_DRAIN = false;
    bf16_t *Q, *KK, *VV, *M4; const float *qw, *kw, *rope; float qscale;
    __device__ __forceinline__ void operator()(const f32x4 (&acc)[2][2][4][2], const Unit& u, int wr, int wc, int fr, int fq) const {
        const int pn = u.pn, row0 = u.pm * 256 + wr * 64 + fr;
        bf16_t *Q_ = Q, *KK_ = KK, *VV_ = VV, *M4_ = M4; asm volatile("" : "+s"(Q_), "+s"(KK_), "+s"(VV_), "+s"(M4_));
        if (pn >= 3) {
            bf16_t* base = M4_ + (size_t)((pn - 3) >> 1) * MA * 512 + ((pn - 3) & 1) * 256 + wc * 32 + 8 * fq;
#pragma unroll
            for (int ai = 0; ai < 2; ++ai)
#pragma unroll
                for (int m = 0; m < 4; ++m) { bf16_t* rowp = base + (size_t)(row0 + ai * 128 + m * 16) * 512;
#pragma unroll
                    for (int bj = 0; bj < 2; ++bj) { const f32x4 v0 = acc[ai][bj][m][0], v1 = acc[ai][bj][m][1]; u32x4 w; w.x = pkbf(v0[0], v0[1]); w.y = pkbf(v0[2], v0[3]); w.z = pkbf(v1[0], v1[1]); w.w = pkbf(v1[2], v1[3]);
                        *(u32x4*)(rowp + bj * 128) = w; } }
            return;
        }
        const bool latent = u.pm < 256;
        if (pn < 2 && !latent) return;
        const bool isv = (pn == 2) && (wc >= 2);
        bf16_t* dst; int ld; const float* nw; float osc = 1.f;
        if (pn < 2) { dst = Q_ + (4 * pn + wc) * 64; ld = 512; nw = qw; osc = qscale; }
        else if (!isv) { dst = KK_ + wc * 64; ld = 128; nw = kw; }
        else { dst = VV_ + (wc - 2) * 64; ld = 128; nw = kw; }
        f32x4 w4[2][2];
#pragma unroll
        for (int bj = 0; bj < 2; ++bj)
#pragma unroll
            for (int n = 0; n < 2; ++n) w4[bj][n] = *(const f32x4*)(nw + 32 * bj + 8 * fq + 4 * n);
#pragma unroll
        for (int ai = 0; ai < 2; ++ai)
#pragma unroll
            for (int m = 0; m < 4; ++m) {
                const int row = row0 + ai * 128 + m * 16;
                f32x4 y[2][2];
#pragma unroll
                for (int bj = 0; bj < 2; ++bj)
#pragma unroll
                    for (int n = 0; n < 2; ++n) y[bj][n] = acc[ai][bj][m][n];
                if (!isv) {
                    float ss = 0.f;
#pragma unroll
                    for (int bj = 0; bj < 2; ++bj)
#pragma unroll
                        for (int n = 0; n < 2; ++n) ss += (y[bj][n][0] * y[bj][n][0] + y[bj][n][1] * y[bj][n][1]) + (y[bj][n][2] * y[bj][n][2] + y[bj][n][3] * y[bj][n][3]);
                    ss += __shfl_xor(ss, 16); ss += __shfl_xor(ss, 32);
                    const float rinv = rsqrtf(ss * (1.f / 64.f) + EPS);
#pragma unroll
                    for (int bj = 0; bj < 2; ++bj)
#pragma unroll
                        for (int n = 0; n < 2; ++n) y[bj][n] = y[bj][n] * rinv * w4[bj][n];
                    if (latent) {
                        const int ntok = row & (NT - 1); const int pos = (fq < 2) ? (ntok >> 6) : (ntok & 63);
                        const float* rp = rope + pos * 16 + 8 * (fq & 1);
#pragma unroll
                        for (int n = 0; n < 2; ++n) { const f32x4 cs = *(const f32x4*)(rp + 4 * n), sn = *(const f32x4*)(rp + 1024 + 4 * n);
                            const f32x4 x1 = y[0][n], x2 = y[1][n]; y[0][n] = x1 * cs - x2 * sn; y[1][n] = x2 * cs + x1 * sn; }
                    }
                }
                bf16_t* rowp = dst + (size_t)row * ld + 8 * fq;
#pragma unroll
                for (int bj = 0; bj < 2; ++bj) { const f32x4 v0 = y[bj][0] * osc, v1 = y[bj][1] * osc; u32x4 w; w.x = pkbf(v0[0], v0[1]); w.y = pkbf(v0[2], v0[3]); w.z = pkbf(v1[0], v1[1]); w.w = pkbf(v1[2], v1[3]);
                    *(u32x4*)(rowp + 32 * bj) = w; }
            }
    }
};
struct EpiOut {
    static constexpr bool PERM = true, AFTER_DRAIN = false;
    const float* x; const float* mod; bf16_t* X1;
    __device__ __forceinline__ void operator()(const f32x4 (&acc)[2][2][4][2], const Unit& u, int wr, int wc, int fr, int fq) const {
        typedef const float __attribute__((address_space(1))) GF; typedef bf16_t __attribute__((address_space(1))) GB; typedef const f32x4 __attribute__((address_space(1))) GF4; typedef u32x4 __attribute__((address_space(1))) GU4;
        const int row0 = u.pm * 256 + wr * 64 + fr, col0 = u.pn * 256 + wc * 32 + 8 * fq;
        const float* x_ = x; bf16_t* out_ = X1; asm volatile("" : "+s"(x_), "+s"(out_));
        GF* xg = (GF*)x_ + (size_t)row0 * D + col0; GB* og = (GB*)out_ + (size_t)row0 * D + col0;
        const float* g1 = mod + (u.pm >> 4) * 6144 + 2 * D;
        f32x4 gv[2][2];
#pragma unroll
        for (int bj = 0; bj < 2; ++bj)
#pragma unroll
            for (int n = 0; n < 2; ++n) gv[bj][n] = *(const f32x4*)(g1 + col0 + bj * 128 + n * 4);
        f32x4 xr[8][2][2];
#define MK_EO_LD(b) do { const size_t off = (size_t)(((b) >> 2) * 128 + ((b) & 3) * 16) * D; _Pragma("unroll") for (int bj = 0; bj < 2; ++bj) { xr[b][bj][0] = *(GF4*)(xg + off + bj * 128); xr[b][bj][1] = *(GF4*)(xg + off + bj * 128 + 4); } } while (0)
        MK_EO_LD(0); MK_EO_LD(1); MK_EO_LD(2); MK_EO_LD(3);
#pragma unroll
        for (int b = 0; b < 8; ++b) {
            const int ai = b >> 2, m = b & 3; const size_t off = (size_t)(ai * 128 + m * 16) * D;
#pragma unroll
            for (int bj = 0; bj < 2; ++bj) { const f32x4 o0 = xr[b][bj][0] + gv[bj][0] * acc[ai][bj][m][0], o1 = xr[b][bj][1] + gv[bj][1] * acc[ai][bj][m][1];
                u32x4 w; w.x = pkbf(o0[0], o0[1]); w.y = pkbf(o0[2], o0[3]); w.z = pkbf(o1[0], o1[1]); w.w = pkbf(o1[2], o1[3]);
                *(GU4*)(og + off + bj * 128) = w; }
            if (b + 4 < 8) { switch (b) { case 0: MK_EO_LD(4); break; case 1: MK_EO_LD(5); break; case 2: MK_EO_LD(6); break; default: MK_EO_LD(7); break; } }
        }
#undef MK_EO_LD
    }
};
struct EpiAct {
    static constexpr bool PERM = true, AFTER_DRAIN = false;
    unsigned char* ACT;
    __device__ __forceinline__ void operator()(const f32x4 (&acc)[2][2][4][2], const Unit& u, int wr, int wc, int fr, int fq) const {
        const int row0 = u.pm * 256 + wr * 64 + fr, col0 = u.pn * 128 + wc * 32 + 8 * fq;
        unsigned char* ACT_ = ACT; asm volatile("" : "+s"(ACT_));
#pragma unroll
        for (int ai = 0; ai < 2; ++ai)
#pragma unroll
            for (int m = 0; m < 4; ++m) { f32x4 o[2];
#pragma unroll
                for (int n = 0; n < 2; ++n) { const f32x4 gt = acc[ai][0][m][n], up = acc[ai][1][m][n];
#pragma unroll
                    for (int j = 0; j < 4; ++j) o[n][j] = silu_f(gt[j] * (1.f / FP8_W_UP)) * (up[j] * (1.f / FP8_W_UP)); }
                u32x2 w; w.x = pk4_fp8(o[0][0], o[0][1], o[0][2], o[0][3]); w.y = pk4_fp8(o[1][0], o[1][1], o[1][2], o[1][3]);
                *(u32x2*)(ACT_ + (size_t)(row0 + ai * 128 + m * 16) * FF + col0) = w; asm volatile("" ::: "memory"); }
    }
};
struct EpiDown {
    static constexpr bool PERM = true, AFTER_DRAIN = false;
    bf16_t* Y; const LAS float* gate; float FP8SC;
    __device__ __forceinline__ void operator()(const f32x4 (&acc)[2][2][4][2], const Unit& u, int wr, int wc, int fr, int fq) const {
        const int row0 = u.pm * 256 + wr * 64 + fr, col0 = u.pn * 256 + wc * 32 + 8 * fq;
        bf16_t* Y_ = Y; const LAS float* gate_ = gate; asm volatile("" : "+s"(Y_));
#pragma unroll
        for (int ai = 0; ai < 2; ++ai)
#pragma unroll
            for (int m = 0; m < 4; ++m) { const int row = row0 + ai * 128 + m * 16; const float gt = gate_[row] * FP8SC;
#pragma unroll
                for (int bj = 0; bj < 2; ++bj) { const f32x4 v0 = acc[ai][bj][m][0] * gt, v1 = acc[ai][bj][m][1] * gt; u32x4 w; w.x = pkbf(v0[0], v0[1]); w.y = pkbf(v0[2], v0[3]); w.z = pkbf(v1[0], v1[1]); w.w = pkbf(v1[2], v1[3]);
                    *(u32x4*)(Y_ + (size_t)row * D + col0 + bj * 128) = w; } asm volatile("" ::: "memory"); }
    }
};

__device__ __forceinline__ void conv_rows(const Args& a) {
    const int tid = threadIdx.x, lane = tid & 63, wave = tid >> 6;
    const bf16_t* MQ = (const bf16_t*)(a.ws + WS_M4); const bf16_t* MK = MQ + (size_t)MA * 512;
    bf16_t* CQ = (bf16_t*)(a.ws + WS_CQ); bf16_t* CK = (bf16_t*)(a.ws + WS_CK);
    const float* conv = a.in[10];
    f32x4 wq[3][2], wk[3][2];
#pragma unroll
    for (int j = 0; j < 3; ++j) { wq[j][0] = *(const f32x4*)(conv + j * 1024 + 8 * lane); wq[j][1] = *(const f32x4*)(conv + j * 1024 + 8 * lane + 4);
        wk[j][0] = *(const f32x4*)(conv + j * 1024 + 512 + 8 * lane); wk[j][1] = *(const f32x4*)(conv + j * 1024 + 512 + 8 * lane + 4); }
    const int gw = blockIdx.x * NWAVES + wave, NGW = gridDim.x * NWAVES;
    const int per = (MA + NGW - 1) / NGW; const int r0 = gw * per, r1 = min(MA, r0 + per);
    if (r0 >= r1) return;
    const u32x4 zero = {0u, 0u, 0u, 0u};
#define CV_POS(m) ((m) < MT ? ((m) & (NT - 1)) : (((m) - MT) & (NL - 1)))
#define CV_LEN(m) ((m) < MT ? NT : NL)
#define CV_LD(dst, buf, m) do { dst = ((m) >= 0 && (m) < MA) ? *(const u32x4*)(buf + (size_t)(m) * 512 + 8 * lane) : zero; } while (0)
    u32x4 wq_[6], wk_[6], nq_[4], nk_[4];
#pragma unroll
    for (int i = 0; i < 6; ++i) { CV_LD(wq_[i], MQ, r0 - 1 + i); CV_LD(wk_[i], MK, r0 - 1 + i); }
#pragma unroll 1
    for (int m = r0; m < r1; m += 4) {
#pragma unroll
        for (int i = 0; i < 4; ++i) { CV_LD(nq_[i], MQ, m + 5 + i); CV_LD(nk_[i], MK, m + 5 + i); }
#pragma unroll
        for (int u = 0; u < 4; ++u) {
            const int mm = m + u;
            if (mm < r1) {
                const int p = CV_POS(mm), len = CV_LEN(mm); const bool first = (p == 0), last = (p == len - 1);
                const u32x4 qp = wq_[u], qc = wq_[u + 1], qn = wq_[u + 2], kp = wk_[u], kc = wk_[u + 1], kn = wk_[u + 2];
                u32x4 oq, ok;
#pragma unroll
                for (int e = 0; e < 4; ++e) {
                    const float ql0 = first ? 0.f : bflo(qp[e]), qh0 = first ? 0.f : bfhi(qp[e]), ql2 = last ? 0.f : bflo(qn[e]), qh2 = last ? 0.f : bfhi(qn[e]);
                    const float kl0 = first ? 0.f : bflo(kp[e]), kh0 = first ? 0.f : bfhi(kp[e]), kl2 = last ? 0.f : bflo(kn[e]), kh2 = last ? 0.f : bfhi(kn[e]);
                    const int h2 = e >> 1, i0 = (2 * e) & 3, i1 = (2 * e + 1) & 3;
                    const float uq0 = silu_f(ql0 * wq[0][h2][i0] + bflo(qc[e]) * wq[1][h2][i0] + ql2 * wq[2][h2][i0]) * 0.08838834764831845f;
                    const float uq1 = silu_f(qh0 * wq[0][h2][i1] + bfhi(qc[e]) * wq[1][h2][i1] + qh2 * wq[2][h2][i1]) * 0.08838834764831845f;
                    const float uk0 = silu_f(kl0 * wk[0][h2][i0] + bflo(kc[e]) * wk[1][h2][i0] + kl2 * wk[2][h2][i0]);
                    const float uk1 = silu_f(kh0 * wk[0][h2][i1] + bfhi(kc[e]) * wk[1][h2][i1] + kh2 * wk[2][h2][i1]);
                    oq[e] = pkbf(uq0, uq1); ok[e] = pkbf(uk0, uk1);
                }
                *(u32x4*)(CQ + (size_t)mm * 512 + 8 * lane) = oq; *(u32x4*)(CK + (size_t)mm * 512 + 8 * lane) = ok;
            }
        }
        wq_[0] = wq_[4]; wq_[1] = wq_[5]; wk_[0] = wk_[4]; wk_[1] = wk_[5];
#pragma unroll
        for (int i = 0; i < 4; ++i) { wq_[2 + i] = nq_[i]; wk_[2 + i] = nk_[i]; }
    }
#undef CV_LD
#undef CV_POS
#undef CV_LEN
}

constexpr int AT_STRIDE = 72;
constexpr int AT_K = 0, AT_V = 384 * AT_STRIDE * 2;
__device__ __forceinline__ void attn_tile(const LAS bf16_t* AK, const LAS bf16_t* AV, int kb, bool masked, int kpos_base  , int qpos0  ,
                                          const bf16x8 (&Qf)[4][2], f32x4 (&O)[4][4], float (&ls)[4], float cshift, int fr, int fq) {
    const int q4 = fr >> 2, p4 = fr & 3;
#pragma unroll
    for (int kk2 = 0; kk2 < 2; ++kk2) {
        f32x4 S[2][4];
#pragma unroll
        for (int hh = 0; hh < 2; ++hh) {
            const LAS bf16_t* kp = AK + (kb + 32 * kk2 + 16 * hh + fr) * AT_STRIDE + 8 * fq;
            const bf16x8 A0 = *(const LAS bf16x8*)kp, A1 = *(const LAS bf16x8*)(kp + 32);
#pragma unroll
            for (int qt = 0; qt < 4; ++qt) { f32x4 z = {-cshift, -cshift, -cshift, -cshift}; z = mfma16(A0, Qf[qt][0], z); S[hh][qt] = mfma16(A1, Qf[qt][1], z); }
        }
        if (masked) {
#pragma unroll
            for (int hh = 0; hh < 2; ++hh)
#pragma unroll
                for (int qt = 0; qt < 4; ++qt)
#pragma unroll
                    for (int r = 0; r < 4; ++r) {
                        float p = __builtin_amdgcn_exp2f(S[hh][qt][r]);
                        const int kpos = kpos_base + kb + 32 * kk2 + 16 * hh + 4 * fq + r, qpos = qpos0 + 16 * qt + fr; const int dd = kpos - qpos;
                        if (kpos < 0 || kpos >= NT || dd > 128 || dd < -128) p = 0.f;
                        ls[qt] += p; S[hh][qt][r] = p;
                    }
        } else {
#pragma unroll
            for (int hh = 0; hh < 2; ++hh)
#pragma unroll
                for (int qt = 0; qt < 4; ++qt)
#pragma unroll
                    for (int r = 0; r < 4; ++r) { const float p = __builtin_amdgcn_exp2f(S[hh][qt][r]); ls[qt] += p; S[hh][qt][r] = p; }
        }
        bf16x8 Bp[4];
#pragma unroll
        for (int qt = 0; qt < 4; ++qt) Bp[qt] = pack8(S[0][qt], S[1][qt]);
#pragma unroll
        for (int dt = 0; dt < 4; ++dt) {
            const LAS bf16_t* vp = AV + (kb + 32 * kk2 + 4 * fq + q4) * AT_STRIDE + 16 * dt + 4 * p4;
            const bf16x8 A = tr2(vp, vp + 16 * AT_STRIDE);
#pragma unroll
            for (int qt = 0; qt < 4; ++qt) O[dt][qt] = mfma16(A, Bp[qt], O[dt][qt]);
        }
    }
}
__device__ __forceinline__ void attn_item(const Args& a, LAS unsigned char* lds, int item) {
    const int tid = threadIdx.x, lane = tid & 63, w = __builtin_amdgcn_readfirstlane(tid >> 6), fr = lane & 15, fq = lane >> 4;
    const int qblk = item & 31, kvh = (item >> 5) & 1, b = item >> 6;
    const int g = w >> 1, qh = w & 1, head = 4 * kvh + g;
    const bf16_t* Q = (const bf16_t*)(a.ws + WS_Q); const bf16_t* KK = (const bf16_t*)(a.ws + WS_KK); const bf16_t* VV = (const bf16_t*)(a.ws + WS_VV);
    bf16_t* MIX = (bf16_t*)(a.ws + WS_MIX);
    LAS bf16_t* AK = (LAS bf16_t*)(lds + AT_K); LAS bf16_t* AV = (LAS bf16_t*)(lds + AT_V);
    const float cshift = ((const float*)(a.ws + WS_MISC))[0];
    const int qpos0 = 128 * qblk + 64 * qh;
    bf16x8 Qf[4][2];
#pragma unroll
    for (int qt = 0; qt < 4; ++qt) { const bf16_t* qp = Q + (size_t)(b * NT + qpos0 + 16 * qt + fr) * 512 + head * 64 + 8 * fq; Qf[qt][0] = *(const bf16x8*)qp; Qf[qt][1] = *(const bf16x8*)(qp + 32); }
    f32x4 O[4][4]; float ls[4];
#pragma unroll
    for (int dt = 0; dt < 4; ++dt)
#pragma unroll
        for (int qt = 0; qt < 4; ++qt) O[dt][qt] = (f32x4){0.f, 0.f, 0.f, 0.f};
#pragma unroll
    for (int qt = 0; qt < 4; ++qt) ls[qt] = 0.f;
    const int kpos_base = 128 * qblk - 128;
    for (int i = tid; i < 384 * 8; i += NTHREADS) { const int r = i >> 3, c = i & 7; int kp = kpos_base + r; kp = kp < 0 ? 0 : (kp > NT - 1 ? NT - 1 : kp);
        const size_t src = (size_t)(b * NT + kp) * 128 + kvh * 64 + 8 * c;
        *(LAS u32x4*)(AK + r * AT_STRIDE + 8 * c) = *(const u32x4*)(KK + src); *(LAS u32x4*)(AV + r * AT_STRIDE + 8 * c) = *(const u32x4*)(VV + src); }
    __syncthreads();
    const bool edge = (qblk == 0) || (qblk == 31);
    for (int jt = 0; jt < 5; ++jt) { const bool msk = edge || jt == 0 || jt == 4;
        attn_tile(AK, AV, 64 * qh + 64 * jt, msk, kpos_base, qpos0, Qf, O, ls, cshift, fr, fq); }
    __syncthreads();
    for (int i = tid; i < 256 * 8; i += NTHREADS) { const int r = i >> 3, c = i & 7; const size_t src = (size_t)(MT + b * NL + r) * 128 + kvh * 64 + 8 * c;
        *(LAS u32x4*)(AK + r * AT_STRIDE + 8 * c) = *(const u32x4*)(KK + src); *(LAS u32x4*)(AV + r * AT_STRIDE + 8 * c) = *(const u32x4*)(VV + src); }
    __syncthreads();
    for (int jt = 0; jt < 4; ++jt) attn_tile(AK, AV, 64 * jt, false, 0, qpos0, Qf, O, ls, cshift, fr, fq);
    __syncthreads();
    const float psink = __builtin_amdgcn_exp2f(a.in[13][head] * LOG2E - cshift);
#pragma unroll
    for (int qt = 0; qt < 4; ++qt) {
        float l = ls[qt]; l += __shfl_xor(l, 16); l += __shfl_xor(l, 32); const float inv = 1.f / (l + psink);
        bf16_t* op = MIX + (size_t)(b * NT + qpos0 + 16 * qt + fr) * D + head * 64 + 4 * fq;
#pragma unroll
        for (int dt = 0; dt < 4; ++dt) { const f32x4 o = O[dt][qt] * inv; u32x2 wv; wv.x = pkbf(o[0], o[1]); wv.y = pkbf(o[2], o[3]); *(u32x2*)(op + 16 * dt) = wv; }
    }
}

constexpr int KS_ST = 136, VS_ST = 88;
constexpr int ML_KS = 0, ML_VN = ML_KS + 128 * KS_ST * 2, ML_VW = ML_VN + 128 * VS_ST * 2, ML_CN = ML_VW + 128 * VS_ST * 2, ML_F = ML_CN + 128 * VS_ST * 2, ML_CW = ML_F + 1024 * 4, ML_END = ML_CW + 768 * 4;
static_assert(ML_END <= LDS_BYTES, "mLSTM LDS map");
#define ML_GEOM(ci, seq0, seqlen, nbase) do { if ((ci) < 2) { seq0 = MT + b * NL; seqlen = NL; nbase = dir ? 128 * (1 - (ci)) : 128 * (ci); } \
    else { const int k_ = (ci) - 2; seq0 = b * NT; seqlen = NT; nbase = dir ? 128 * (31 - k_) : 128 * k_; } } while (0)
#define ML_POS(s) (dir ? nbase + 127 - (s) : nbase + (s))
__device__ __forceinline__ void mlstm_item(const Args& a, LAS unsigned char* lds, int item) {
    const int tid = threadIdx.x, lane = tid & 63, w = __builtin_amdgcn_readfirstlane(tid >> 6), fr = lane & 15, fq = lane >> 4, q4 = fr >> 2, p4 = fr & 3;
    const int vh = item & 1, dir = (item >> 1) & 1, h = (item >> 2) & 3, b = item >> 4;
    const int tw = w < 4 ? w : 11 - w;
    LAS bf16_t* Ks = (LAS bf16_t*)(lds + ML_KS); LAS bf16_t* Vn = (LAS bf16_t*)(lds + ML_VN); LAS bf16_t* Vw = (LAS bf16_t*)(lds + ML_VW); LAS bf16_t* Cn = (LAS bf16_t*)(lds + ML_CN);
    LAS float* F = (LAS float*)(lds + ML_F); LAS float* mstA = F, *aA = F + 64, *MlA = F + 128, *blA = F + 192, *plA = F + 256, *gA = F + 512; LAS float* cw = (LAS float*)(lds + ML_CW);
    const bf16_t* MQ = (const bf16_t*)(a.ws + WS_CQ); const bf16_t* MK = (const bf16_t*)(a.ws + WS_CK); const bf16_t* MV = (const bf16_t*)(a.ws + WS_M4) + (size_t)2 * MA * 512;
    const float* GATES = (const float*)(a.ws + WS_GATES);
    float* TBL = (float*)(a.ws + WS_TBL) + (size_t)item * 34 * 384;
    bf16_t* H = (bf16_t*)(a.ws + (dir ? WS_HB : WS_HF));
    for (int i = tid; i < 128 * VS_ST / 2; i += NTHREADS) ((LAS unsigned*)Cn)[i] = 0u;
    for (int i = tid; i < 128 * 12; i += NTHREADS) { const int s = i / 12, c = i % 12; ((LAS unsigned*)(Vn + s * VS_ST + 64))[c] = (c == 0) ? 0x00003f80u : 0u; ((LAS unsigned*)(Vw + s * VS_ST + 64))[c] = 0u; }
    for (int ci = w; ci < 34; ci += NWAVES) {
        int seq0, seqlen, nbase; ML_GEOM(ci, seq0, seqlen, nbase); (void)seqlen;
        const int s0 = 2 * lane, s1 = s0 + 1;
        const float* G0 = GATES + (size_t)(seq0 + ML_POS(s0)) * 16 + h; const float* G1 = GATES + (size_t)(seq0 + ML_POS(s1)) * 16 + h;
        const float li0 = G0[dir ? 8 : 0], lf0 = G0[dir ? 12 : 4], li1 = G1[dir ? 8 : 0], lf1 = G1[dir ? 12 : 4];
        float cs = lf0 + lf1;
#pragma unroll
        for (int o = 1; o < 64; o <<= 1) { const float y = __shfl_up(cs, o); if (lane >= o) cs += y; }
        const float b1 = cs, b0 = cs - lf1;
        const float g0 = li0 - b0, g1 = li1 - b1;
        float mx = fmaxf(g0, g1);
#pragma unroll
        for (int o = 1; o < 64; o <<= 1) { const float y = __shfl_up(mx, o); if (lane >= o) mx = fmaxf(mx, y); }
        float ex = __shfl_up(mx, 1); if (lane == 0) ex = -INFINITY;
        const float pm0 = fmaxf(ex, g0), pm1 = mx;
        float* T = TBL + ci * 384;
        typedef float f32x2t __attribute__((ext_vector_type(2)));
        *(f32x2t*)(T + s0) = (f32x2t){b0, b1}; *(f32x2t*)(T + 128 + s0) = (f32x2t){g0, g1}; *(f32x2t*)(T + 256 + s0) = (f32x2t){pm0, pm1};
        if (lane == 63) { blA[ci] = b1; plA[ci] = pm1; }
    }
    __syncthreads();
    if (w == 0) {
        float m = 0.f;
#pragma unroll 1
        for (int ci = 0; ci < 34; ++ci) { const float bl = blA[ci], pl = plA[ci]; const float Ml = fmaxf(m, pl); if (lane == 0) { mstA[ci] = m; aA[ci] = expf(m - Ml); MlA[ci] = Ml; } m = bl + Ml; }
    }
    f32x4 accC[5];
#pragma unroll
    for (int vt = 0; vt < 5; ++vt) accC[vt] = (f32x4){0.f, 0.f, 0.f, 0.f};
    u32x4 kr[4], vr[2];
#define ML_LOAD_KV(cj) do { int seq0_, seqlen_, nbase_; { const int dir_ = dir; (void)dir_; (void)seqlen_; if ((cj) < 2) { seq0_ = MT + b * NL; seqlen_ = NL; nbase_ = dir ? 128 * (1 - (cj)) : 128 * (cj); } else { const int k_ = (cj) - 2; seq0_ = b * NT; seqlen_ = NT; nbase_ = dir ? 128 * (31 - k_) : 128 * k_; } } \
        _Pragma("unroll") for (int ps = 0; ps < 4; ++ps) { const int s_ = (tid >> 4) + 32 * ps, pos_ = dir ? nbase_ + 127 - s_ : nbase_ + s_; kr[ps] = *(const u32x4*)(MK + (size_t)(seq0_ + pos_) * 512 + h * 128 + 8 * (tid & 15)); } \
        _Pragma("unroll") for (int ps = 0; ps < 2; ++ps) { const int s_ = (tid >> 3) + 64 * ps, pos_ = dir ? nbase_ + 127 - s_ : nbase_ + s_; vr[ps] = *(const u32x4*)(MV + (size_t)(seq0_ + pos_) * 512 + h * 128 + vh * 64 + 8 * (tid & 7)); } } while (0)
    u32x4 qr[4]; float nbt = 0.f, npmt = 0.f;
#define ML_LOAD_Q(cj) do { int seq0_, seqlen_, nbase_; (void)seqlen_; if ((cj) < 2) { seq0_ = MT + b * NL; seqlen_ = NL; nbase_ = dir ? 128 * (1 - (cj)) : 128 * (cj); } else { const int k_ = (cj) - 2; seq0_ = b * NT; seqlen_ = NT; nbase_ = dir ? 128 * (31 - k_) : 128 * k_; } \
        const float* T_ = TBL + (cj) * 384; const int t_ = 16 * tw + fr, post_ = dir ? nbase_ + 127 - t_ : nbase_ + t_; \
        if ((cj) >= 2) { const bf16_t* qp = MQ + (size_t)(seq0_ + post_) * 512 + h * 128 + 8 * fq; \
            _Pragma("unroll") for (int kk = 0; kk < 4; ++kk) qr[kk] = *(const u32x4*)(qp + 32 * kk); \
            nbt = T_[t_]; npmt = T_[256 + t_]; } } while (0)
    ML_LOAD_KV(0);
    __syncthreads();
    ML_LOAD_Q(0);
#ifdef MK_TIME_PHASE
    unsigned long long tA_ = 0ull, tB_ = 0ull;
#endif
#pragma unroll 1
    for (int ci = 0; ci < 34; ++ci) {
        const bool isctx = ci < 2;
#ifdef MK_TIME_PHASE
        const unsigned long long t0_ = __builtin_amdgcn_s_memrealtime();
#endif
        int seq0, seqlen, nbase; ML_GEOM(ci, seq0, seqlen, nbase);
        const float mst = mstA[ci], Ml = MlA[ci], av = aA[ci];
        const float* T = TBL + ci * 384;
        const int t = 16 * tw + fr, post = ML_POS(t);
        const float bt = nbt, pmt = npmt;
        const float gv0 = T[128 + (tid >> 3)], gv1 = T[128 + (tid >> 3) + 64];
        const float gmine = tid < 128 ? T[128 + tid] : 0.f;
#pragma unroll
        for (int ps = 0; ps < 4; ++ps) *(LAS u32x4*)(Ks + ((tid >> 4) + 32 * ps) * KS_ST + 8 * (tid & 15)) = kr[ps];
#pragma unroll
        for (int ps = 0; ps < 2; ++ps) {
            const int s = (tid >> 3) + 64 * ps, vc = tid & 7; const float wv = __expf((ps ? gv1 : gv0) - Ml); u32x4 o;
            *(LAS u32x4*)(Vn + s * VS_ST + 8 * vc) = vr[ps];
#pragma unroll
            for (int e = 0; e < 4; ++e) o[e] = pkbf(bflo(vr[ps][e]) * wv, bfhi(vr[ps][e]) * wv);
            *(LAS u32x4*)(Vw + s * VS_ST + 8 * vc) = o;
        }
        if (tid < 128) { ((LAS unsigned*)(Vw + tid * VS_ST + 64))[0] = pkbf(__expf(gmine - Ml), 0.f); gA[tid] = gmine; }
        bf16x8 Bq[4];
#pragma unroll
        for (int kk = 0; kk < 4; ++kk) Bq[kk] = __builtin_bit_cast(bf16x8, qr[kk]);
        __syncthreads();
#ifdef MK_TIME_PHASE
        const unsigned long long t1_ = __builtin_amdgcn_s_memrealtime();
#endif
        if (!isctx) {
            const float Mt = fmaxf(mst, pmt);
            const float dect = __expf(mst - Mt), ebt = __expf(-bt - Mt);
            f32x4 num[5];
#pragma unroll
            for (int vt = 0; vt < 5; ++vt) num[vt] = (f32x4){0.f, 0.f, 0.f, 0.f};
            {
                bf16x8 fa[5], fb[5];
#define ML_LDC(dst, kk) do { _Pragma("unroll") for (int vt = 0; vt < 5; ++vt) { const LAS bf16_t* cp = Cn + (32 * (kk) + 8 * fq + q4) * VS_ST + 16 * vt + 4 * p4; dst[vt] = tr2(cp, cp + 4 * VS_ST); } } while (0)
#define ML_MMC(src, kk) do { _Pragma("unroll") for (int vt = 0; vt < 5; ++vt) num[vt] = mfma16(src[vt], Bq[kk], num[vt]); } while (0)
                ML_LDC(fa, 0); ML_LDC(fb, 1); ML_MMC(fa, 0); ML_LDC(fa, 2); ML_MMC(fb, 1); ML_LDC(fb, 3); ML_MMC(fa, 2); ML_MMC(fb, 3);
#undef ML_LDC
#undef ML_MMC
#pragma unroll
                for (int vt = 0; vt < 5; ++vt) num[vt] = num[vt] * dect;
            }
            if (ci + 1 < 34) ML_LOAD_KV(ci + 1);
#pragma unroll
            for (int kk2 = 0; kk2 < 4; ++kk2) {
                if (2 * kk2 <= tw) {
                    const bool two = (2 * kk2 + 1) <= tw;
                    bf16x8 ka[2][4], fv[5];
#pragma unroll
                    for (int hh = 0; hh < 2; ++hh)
#pragma unroll
                        for (int kk = 0; kk < 4; ++kk) ka[hh][kk] = *(const LAS bf16x8*)(Ks + (16 * (2 * kk2 + hh) + fr) * KS_ST + 32 * kk + 8 * fq);
                    const f32x4 gs0 = *(const LAS f32x4*)(gA + 32 * kk2 + 4 * fq), gs1 = *(const LAS f32x4*)(gA + 32 * kk2 + 16 + 4 * fq);
#pragma unroll
                    for (int vt = 0; vt < 5; ++vt) { const LAS bf16_t* vp = Vn + (32 * kk2 + 4 * fq + q4) * VS_ST + 16 * vt + 4 * p4; fv[vt] = tr2(vp, vp + 16 * VS_ST); }
                    f32x4 Pp[2];
                    Pp[0] = (f32x4){0.f, 0.f, 0.f, 0.f}; Pp[1] = (f32x4){0.f, 0.f, 0.f, 0.f};
#pragma unroll
                    for (int kk = 0; kk < 4; ++kk) { Pp[0] = mfma16(ka[0][kk], Bq[kk], Pp[0]); Pp[1] = mfma16(ka[1][kk], Bq[kk], Pp[1]); }
#pragma unroll
                    for (int r = 0; r < 4; ++r) {
                        const int s0 = 32 * kk2 + 4 * fq + r, s1 = s0 + 16;
                        Pp[0][r] *= (s0 <= t) ? __builtin_amdgcn_exp2f((gs0[r] - Mt) * LOG2E) : 0.f;
                        Pp[1][r] *= (two && s1 <= t) ? __builtin_amdgcn_exp2f((gs1[r] - Mt) * LOG2E) : 0.f;
                    }
                    const bf16x8 Bw = pack8(Pp[0], Pp[1]);
#pragma unroll
                    for (int vt = 0; vt < 5; ++vt) num[vt] = mfma16(fv[vt], Bw, num[vt]);
                }
            }
            const float den = __shfl(num[4][0], fr);
            const float inv = 1.f / fmaxf(fabsf(den), ebt);
            bf16_t* hp = H + (size_t)(seq0 + post) * 512 + h * 128 + vh * 64 + 4 * fq;
#pragma unroll
            for (int vt = 0; vt < 4; ++vt) { const f32x4 o = num[vt] * inv; u32x2 wv; wv.x = pkbf(o[0], o[1]); wv.y = pkbf(o[2], o[3]); *(u32x2*)(hp + 16 * vt) = wv; }
        }
        if (isctx) ML_LOAD_KV(ci + 1);
        if (ci + 1 < 34) ML_LOAD_Q(ci + 1);
        {
#pragma unroll
            for (int vt = 0; vt < 5; ++vt) accC[vt] = accC[vt] * av;
            bf16x8 sa[6], sb[6];
#define ML_LDS_(dst, kk2) do { _Pragma("unroll") for (int vt = 0; vt < 5; ++vt) { const LAS bf16_t* vp = Vw + (32 * (kk2) + 8 * fq + q4) * VS_ST + 16 * vt + 4 * p4; dst[vt] = tr2(vp, vp + 4 * VS_ST); } \
                { const LAS bf16_t* kp = Ks + (32 * (kk2) + 8 * fq + q4) * KS_ST + 16 * w + 4 * p4; dst[5] = tr2(kp, kp + 4 * KS_ST); } } while (0)
#define ML_MMS_(src) do { _Pragma("unroll") for (int vt = 0; vt < 5; ++vt) accC[vt] = mfma16(src[vt], src[5], accC[vt]); } while (0)
            ML_LDS_(sa, 0); ML_LDS_(sb, 1); ML_MMS_(sa); ML_LDS_(sa, 2); ML_MMS_(sb); ML_LDS_(sb, 3); ML_MMS_(sa); ML_MMS_(sb);
#undef ML_LDS_
#undef ML_MMS_
        }
        __syncthreads();
#ifdef MK_TIME_PHASE
        { const unsigned long long t2_ = __builtin_amdgcn_s_memrealtime(); tA_ += t1_ - t0_; tB_ += t2_ - t1_; }
#endif
#pragma unroll
        for (int vt = 0; vt < 5; ++vt) { u32x2 wv; wv.x = pkbf(accC[vt][0], accC[vt][1]); wv.y = pkbf(accC[vt][2], accC[vt][3]); *(LAS u32x2*)(Cn + (16 * w + fr) * VS_ST + 16 * vt + 4 * fq) = wv; }
    }
    __syncthreads();
#ifdef MK_TIME_PHASE
    if (blockIdx.x == 0 && threadIdx.x == 0) { unsigned long long* ts = (unsigned long long*)(a.ws + WS_MISC + 128); ts[12] = tA_; ts[13] = tB_; }
#endif
}
#undef ML_LOAD_KV
#undef ML_LOAD_Q
#undef ML_POS
#undef ML_GEOM

__device__ __forceinline__ void mlstm_out_rows(const Args& a, int row_lo, int nrows) {
    const int tid = threadIdx.x, lane = tid & 63, wave = tid >> 6;
    const bf16_t* HF = (const bf16_t*)(a.ws + WS_HF); const bf16_t* HB = (const bf16_t*)(a.ws + WS_HB);
    const bf16_t* MO = (const bf16_t*)(a.ws + WS_M4) + (size_t)3 * MA * 512;
    bf16_t* MIX = (bf16_t*)(a.ws + WS_MIX);
    const f32x4 nw0 = *(const f32x4*)(a.in[14] + 8 * lane), nw1 = *(const f32x4*)(a.in[14] + 8 * lane + 4);
    for (int i0 = wave; i0 < nrows; i0 += 4 * NWAVES) {
        u32x4 f[4], bb[4], mo[4];
#pragma unroll
        for (int u = 0; u < 4; ++u) { const size_t o = (size_t)(row_lo + i0 + u * NWAVES) * 512 + 8 * lane; f[u] = *(const u32x4*)(HF + o); bb[u] = *(const u32x4*)(HB + o); mo[u] = *(const u32x4*)(MO + o); }
#pragma unroll
        for (int u = 0; u < 4; ++u) {
            float sv[8]; float ss = 0.f;
#pragma unroll
            for (int e = 0; e < 4; ++e) { sv[2 * e] = bflo(f[u][e]) + bflo(bb[u][e]); sv[2 * e + 1] = bfhi(f[u][e]) + bfhi(bb[u][e]); ss += sv[2 * e] * sv[2 * e] + sv[2 * e + 1] * sv[2 * e + 1]; }
            ss += __shfl_xor(ss, 1); ss += __shfl_xor(ss, 2); ss += __shfl_xor(ss, 4); ss += __shfl_xor(ss, 8);
            const float r = rsqrtf(ss * (1.f / 128.f) + EPS);
            float ov[8];
#pragma unroll
            for (int e = 0; e < 4; ++e) {
                ov[2 * e] = sv[2 * e] * r * (e < 2 ? nw0[2 * e] : nw1[2 * e - 4]) * __builtin_amdgcn_rcpf(1.f + __expf(-bflo(mo[u][e])));
                ov[2 * e + 1] = sv[2 * e + 1] * r * (e < 2 ? nw0[2 * e + 1] : nw1[2 * e - 3]) * __builtin_amdgcn_rcpf(1.f + __expf(-bfhi(mo[u][e])));
            }
            u32x4 o; o.x = pkbf(ov[0], ov[1]); o.y = pkbf(ov[2], ov[3]); o.z = pkbf(ov[4], ov[5]); o.w = pkbf(ov[6], ov[7]);
            *(u32x4*)(MIX + (size_t)(row_lo + i0 + u * NWAVES) * D + 512 + 8 * lane) = o;
        }
    }
}
__device__ __forceinline__ void post_rows(const Args& a, LAS unsigned char* lds, int row_lo, int nrows) {
    const int tid = threadIdx.x, lane = tid & 63, wave = tid >> 6, fr = lane & 15, kq = lane >> 4;
    const int b = row_lo >> 12; const float* mr = (const float*)(a.ws + WS_MOD) + b * 6144; const float* n2w = a.in[7]; const float* Wr = a.in[16];
    LAS bf16_t* WB = (LAS bf16_t*)lds; LAS float* SC = (LAS float*)(lds + 32768); LAS float* SH = (LAS float*)(lds + 36864); LAS float* CP = (LAS float*)(lds + 40960);
    for (int c = tid; c < D; c += NTHREADS) {
        const float scv = n2w[c] * (1.f + mr[4 * D + c]); SC[c] = scv; SH[c] = mr[3 * D + c];
        const int s = 2 * (c >> 6) + ((c >> 3) & 1), q = (c >> 4) & 3, ee = c & 7;
#pragma unroll
        for (int j = 0; j < 4; ++j) { const f32x4 w = *(const f32x4*)(Wr + (size_t)c * 16 + 4 * j);
#pragma unroll
            for (int i = 0; i < 4; ++i) WB[((s * 64 + q * 16 + 4 * j + i) << 3) + ee] = (bf16_t)(pkbf(scv * w[i], 0.f) & 0xffffu); }
    }
    { const int e = tid & 15, part = tid >> 4; float cb = 0.f;
#pragma unroll 4
        for (int i = 0; i < 32; ++i) { const int c = part * 32 + i; cb += mr[3 * D + c] * Wr[(size_t)c * 16 + e]; }
        CP[part * 16 + e] = cb; }
    __syncthreads();
    if (tid < 16) { float t = 0.f; for (int p = 0; p < 32; ++p) t += CP[p * 16 + tid]; CP[512 + tid] = t; }
    __syncthreads();
    const float cbe = CP[512 + fr];
    unsigned char* HX2 = a.ws + WS_HX; float* AFF = (float*)(a.ws + WS_AFF);
    const bf16_t* X1 = (const bf16_t*)(a.ws + WS_X1);
#pragma unroll 1
    for (int t0 = wave * 16; t0 < nrows; t0 += NWAVES * 16) {
        int row = row_lo + t0 + fr; asm volatile("" : "+v"(row));
        const bf16_t* xp = X1 + (size_t)row * D + 16 * kq;
        u32x4 xv[32];
#pragma unroll
        for (int p = 0; p < 16; ++p) { xv[2 * p] = *(const u32x4*)(xp + 64 * p); xv[2 * p + 1] = *(const u32x4*)(xp + 64 * p + 8); }
        f32x4 acc = {0.f, 0.f, 0.f, 0.f}; float ss = 0.f;
        int boff = lane * 8, coff = 16 * kq; asm volatile("" : "+v"(boff), "+v"(coff));
#pragma unroll
        for (int g = 0; g < 8; ++g) {
            bf16x8 Bf[4];
#pragma unroll
            for (int i = 0; i < 4; ++i) Bf[i] = *(const LAS bf16x8*)(WB + boff + (4 * g + i) * 512);
#pragma unroll
            for (int i = 0; i < 4; ++i) { const u32x4 v = xv[4 * g + i]; acc = mfma16(__builtin_bit_cast(bf16x8, v), Bf[i], acc);
                ss += (bflo(v.x) * bflo(v.x) + bfhi(v.x) * bfhi(v.x)) + (bflo(v.y) * bflo(v.y) + bfhi(v.y) * bfhi(v.y)) + (bflo(v.z) * bflo(v.z) + bfhi(v.z) * bfhi(v.z)) + (bflo(v.w) * bflo(v.w) + bfhi(v.w) * bfhi(v.w)); }
            asm volatile("" : "+v"(boff), "+v"(acc));
        }
        ss += __shfl_xor(ss, 16); ss += __shfl_xor(ss, 32);
        const float rstd = rsqrtf(ss * (1.f / D) + EPS);
#pragma unroll
        for (int i = 0; i < 32; ++i) asm volatile("" : "+v"(xv[i]));
        f32x4 af;
#pragma unroll
        for (int i = 0; i < 4; ++i) {
            const float lg = acc[i] * __shfl(rstd, 4 * kq + i) + cbe;
            float mx = lg; mx = fmaxf(mx, __shfl_xor(mx, 1)); mx = fmaxf(mx, __shfl_xor(mx, 2)); mx = fmaxf(mx, __shfl_xor(mx, 4)); mx = fmaxf(mx, __shfl_xor(mx, 8));
            const float e = expf(lg - mx); float sum = e; sum += __shfl_xor(sum, 1); sum += __shfl_xor(sum, 2); sum += __shfl_xor(sum, 4); sum += __shfl_xor(sum, 8);
            af[i] = e / sum;
        }
        *(f32x4*)(AFF + ((size_t)b * NE + fr) * NT + ((row_lo + t0) & (NT - 1)) + 4 * kq) = af;
        unsigned char* hp = HX2 + (size_t)row * D + 16 * kq;
#pragma unroll
        for (int p = 0; p < 16; ++p) {
            u32x4 o;
#pragma unroll
            for (int h = 0; h < 2; ++h) { const u32x4 v = xv[2 * p + h]; const int c0 = 64 * p + coff + 8 * h;
                const f32x4 s0 = *(const LAS f32x4*)(SC + c0), s1 = *(const LAS f32x4*)(SC + c0 + 4), h0 = *(const LAS f32x4*)(SH + c0), h1 = *(const LAS f32x4*)(SH + c0 + 4);
                const unsigned lo = pk4_fp8(bflo(v.x) * (rstd * s0[0]) + h0[0], bfhi(v.x) * (rstd * s0[1]) + h0[1], bflo(v.y) * (rstd * s0[2]) + h0[2], bfhi(v.y) * (rstd * s0[3]) + h0[3]);
                const unsigned hi = pk4_fp8(bflo(v.z) * (rstd * s1[0]) + h1[0], bfhi(v.z) * (rstd * s1[1]) + h1[1], bflo(v.w) * (rstd * s1[2]) + h1[2], bfhi(v.w) * (rstd * s1[3]) + h1[3]);
                if (h == 0) { o.x = lo; o.y = hi; } else { o.z = lo; o.w = hi; } }
            *(u32x4*)(hp + 64 * p) = o;
        }
    }
    __syncthreads();
}

__device__ __forceinline__ void topk_select(const Args& a, LAS unsigned char* lds, int z) {
    const int tid = threadIdx.x, lane = tid & 63, wave = tid >> 6;
    LAS unsigned* hist = (LAS unsigned*)lds; LAS unsigned* sc = hist + 256; LAS unsigned* wsum = hist + 272;
    const float* aff = (const float*)(a.ws + WS_AFF) + (size_t)z * NT;
    int* idx = (int*)(a.ws + WS_IDX) + z * CAP; float* gate = (float*)(a.ws + WS_GATE) + z * CAP; int* slot = (int*)(a.ws + WS_SLOT) + (size_t)z * NT;
    unsigned key[8];
    { const u32x4 k0 = *(const u32x4*)(aff + 8 * tid), k1 = *(const u32x4*)(aff + 8 * tid + 4); key[0] = k0.x; key[1] = k0.y; key[2] = k0.z; key[3] = k0.w; key[4] = k1.x; key[5] = k1.y; key[6] = k1.z; key[7] = k1.w; }
    unsigned prefix = 0u, need = CAP;
#pragma unroll 1
    for (int pass = 0; pass < 4; ++pass) {
        const int shift = 24 - 8 * pass;
        if (tid < 256) hist[tid] = 0u;
        __syncthreads();
#pragma unroll
        for (int i = 0; i < 8; ++i) { const bool match = (pass == 0) || ((key[i] >> (shift + 8)) == prefix); if (match) __hip_atomic_fetch_add(&hist[(key[i] >> shift) & 255u], 1u, __ATOMIC_RELAXED, __HIP_MEMORY_SCOPE_WORKGROUP); }
        __syncthreads();
        if (wave == 0) {
            unsigned c[4]; unsigned s = 0u;
#pragma unroll
            for (int j = 0; j < 4; ++j) { c[j] = hist[255 - (4 * lane + j)]; s += c[j]; }
            unsigned incl = s;
#pragma unroll
            for (int o = 1; o < 64; o <<= 1) { const unsigned y = __shfl_up(incl, o); if (lane >= o) incl += y; }
            unsigned cb = incl - s;
#pragma unroll
            for (int j = 0; j < 4; ++j) { if (cb < need && need <= cb + c[j]) { sc[0] = (prefix << 8) | (unsigned)(255 - (4 * lane + j)); sc[1] = need - cb; } cb += c[j]; }
        }
        __syncthreads();
        prefix = sc[0]; need = sc[1];
        __syncthreads();
    }
    const unsigned T = prefix;
    unsigned cg = 0u, ce = 0u;
#pragma unroll
    for (int i = 0; i < 8; ++i) { cg += key[i] > T ? 1u : 0u; ce += key[i] == T ? 1u : 0u; }
    const unsigned mine = cg | (ce << 16);
    unsigned incl = mine;
#pragma unroll
    for (int o = 1; o < 64; o <<= 1) { const unsigned y = __shfl_up(incl, o); if (lane >= o) incl += y; }
    if (lane == 63) wsum[wave] = incl;
    __syncthreads();
    unsigned base = 0u;
    for (int q = 0; q < wave; ++q) base += wsum[q];
    const unsigned excl = base + incl - mine;
    unsigned pg = excl & 0xffffu, pe = excl >> 16;
    const unsigned total_gt = CAP - need;
#pragma unroll
    for (int i = 0; i < 8; ++i) {
        const int tok = 8 * tid + i; int sl = -1;
        if (key[i] > T) { sl = (int)pg; ++pg; }
        else if (key[i] == T) { if (pe < need) sl = (int)(total_gt + pe); ++pe; }
        if (sl >= 0) { idx[sl] = tok; gate[sl] = __builtin_bit_cast(float, key[i]); }
        slot[tok] = sl;
    }
    __syncthreads();
}

#define XB_TMO      128
#define XB_XCNT(j)  (256  + 64 * (j))
#define XB_XSUB(j)  (1280 + 64 * (j))
#define XB_XGEN(j)  (2304 + 64 * (j))
#define XB_TOP      3328
#define XB_TOPGEN   3392
#define XCD_BAR_WORDS 3456
#define XB_SPIN_CAP (1u << 18)

__device__ __forceinline__ unsigned xb_ld(unsigned* p)              { return __hip_atomic_load(p, __ATOMIC_RELAXED, __HIP_MEMORY_SCOPE_AGENT); }
__device__ __forceinline__ unsigned xb_add(unsigned* p, unsigned v) { return __hip_atomic_fetch_add(p, v, __ATOMIC_RELAXED, __HIP_MEMORY_SCOPE_AGENT); }
__device__ __forceinline__ unsigned xb_xcc_id() { return (unsigned)__builtin_amdgcn_s_getreg((3 << 11) | 20) & 0xFu; }
#define XB_SPIN(cond, bar) do { unsigned _sp = 0; while (cond) { __builtin_amdgcn_s_sleep(1); \
    if ((++_sp & 255u) == 0u) { if (xb_ld(&(bar)[XB_TMO])) break; if (_sp > XB_SPIN_CAP) { atomicAdd(&(bar)[XB_TMO], 1u); break; } } } } while (0)

struct XcdBarrier {
    unsigned* bar; unsigned x;
    volatile LAS unsigned* st;
};

__device__ __forceinline__ XcdBarrier xcd_barrier_post(unsigned* bar, volatile LAS unsigned* st) {
    XcdBarrier b; b.bar = bar; b.x = xb_xcc_id(); b.st = st;
    if (threadIdx.x == 0) (void)xb_add(&bar[XB_XCNT(b.x)], 1u);
    return b;
}
__device__ __forceinline__ void xcd_barrier_complete(unsigned* bar, unsigned x, unsigned& nloc, unsigned& nx) {
    const unsigned G = gridDim.x * gridDim.y * gridDim.z;
    unsigned sum, cnt, mine, sp = 0u;
    for (;;) {
        sum = 0u; cnt = 0u; mine = 0u;
#pragma unroll
        for (unsigned j = 0; j < 16; ++j) { const unsigned c = xb_ld(&bar[XB_XCNT(j)]); sum += c; cnt += (c > 0u) ? 1u : 0u; mine = (j == x) ? c : mine; }
        if (sum == G) break;
        __builtin_amdgcn_s_sleep(1);
        if ((++sp & 255u) == 0u) { if (xb_ld(&bar[XB_TMO])) break; if (sp > XB_SPIN_CAP) { atomicAdd(&bar[XB_TMO], 1u); break; } }
    }
    nloc = mine > 0u ? mine : 1u; nx = cnt > 0u ? cnt : 1u;
}

__device__ __forceinline__ void xcd_barrier(const XcdBarrier& b) {
    asm volatile("s_waitcnt vmcnt(0)" ::: "memory");
    __syncthreads();
    if (threadIdx.x == 0) {
        unsigned* bar = b.bar;
        __builtin_amdgcn_s_waitcnt(0);
        unsigned nloc = b.st[0], nx = b.st[1];
        if (nloc == 0u) { xcd_barrier_complete(bar, b.x, nloc, nx); b.st[0] = nloc; b.st[1] = nx; }
        const unsigned old = xb_add(&bar[XB_XSUB(b.x)], 1u);
        const unsigned gen = old / nloc;
        if (old + 1u == (gen + 1u) * nloc) {
            __builtin_amdgcn_fence(__ATOMIC_RELEASE, "agent");
            asm volatile("s_waitcnt vmcnt(0)" ::: "memory");
            const unsigned og = xb_add(&bar[XB_TOP], 1u);
            const unsigned tg = og / nx;
            if (og + 1u == (tg + 1u) * nx) xb_add(&bar[XB_TOPGEN], 1u);
            else XB_SPIN(xb_ld(&bar[XB_TOPGEN]) == tg, bar);
            __builtin_amdgcn_fence(__ATOMIC_ACQUIRE, "agent");
            xb_add(&bar[XB_XGEN(b.x)], 1u);
            asm volatile("s_waitcnt vmcnt(0)" ::: "memory");
        } else {
            XB_SPIN(xb_ld(&bar[XB_XGEN(b.x)]) == gen, bar);
            __builtin_amdgcn_fence(__ATOMIC_ACQUIRE, "agent");
            asm volatile("s_waitcnt vmcnt(0)" ::: "memory");
        }
    }
    __syncthreads();
}

__device__ __forceinline__ Args load_args() {
    typedef const volatile Args __attribute__((address_space(4))) KA;
    KA* p = (KA*)__builtin_amdgcn_kernarg_segment_ptr();
    Args r;
#pragma unroll
    for (int i = 0; i < 20; ++i) r.in[i] = (const float*)p->in[i];
    r.out = (float*)p->out; r.ws = (unsigned char*)p->ws; r.ph_lo = p->ph_lo; r.ph_hi = p->ph_hi; r.sub = p->sub; r.pad = 0;
    return r;
}
__device__ __forceinline__ void stagger_wait(unsigned ticks) {
    const unsigned long long t0 = __builtin_amdgcn_s_memrealtime();
    while ((unsigned)(__builtin_amdgcn_s_memrealtime() - t0) < ticks) __builtin_amdgcn_s_sleep(16);
}
#ifndef MK_STAG2
#define MK_STAG2 0
#endif
#ifndef MK_STAG6
#define MK_STAG6 0
#endif
#ifndef MK_STAG8
#define MK_STAG8 0
#endif
template <int MASK> __global__ void __launch_bounds__(NTHREADS, 2) mk_fwd_t(Args a_unused_) {
    extern __shared__ __attribute__((aligned(16))) unsigned char lds_raw[];
    LAS unsigned char* lds = (LAS unsigned char*)lds_raw;
    __builtin_assume(__builtin_amdgcn_workitem_id_y() == 0); __builtin_assume(__builtin_amdgcn_workitem_id_z() == 0);
    cg::grid_group grid = cg::this_grid();
    if (threadIdx.x < 2) ((LAS unsigned*)(lds + LDS_BAR_OFF))[threadIdx.x] = 0u;
    __syncthreads();
    int lo, hi; unsigned char* ws0; { const Args a = load_args(); lo = a.ph_lo; hi = a.ph_hi; ws0 = a.ws; }
#ifdef MK_NO_MEMSET
    if (blockIdx.x == 0) for (int i = threadIdx.x; i < 4096; i += NTHREADS) ((unsigned*)(ws0 + WS_BAR))[i] = 0u;
    XcdBarrier xbar; xbar.bar = (unsigned*)(ws0 + WS_BAR); xbar.x = 0; xbar.st = (volatile LAS unsigned*)(lds + LDS_BAR_OFF);
#else
    XcdBarrier xbar = xcd_barrier_post((unsigned*)(ws0 + WS_BAR), (volatile LAS unsigned*)(lds + LDS_BAR_OFF));
#endif
    const int c = blockIdx.x, G = gridDim.x;
#define IN(k) ((((MASK) >> (k)) & 1) && lo <= (k) && (k) < hi)
#ifdef MK_TIME_PHASE
#define MK_STAMP(k) do { if (blockIdx.x == 0 && threadIdx.x == 0) ((unsigned long long*)(load_args().ws + WS_MISC + 128))[(k)] = __builtin_amdgcn_s_memrealtime(); } while (0)
#else
#define MK_STAMP(k) do { } while (0)
#endif
#ifdef MK_NO_MEMSET
#define SEAM(k) do { if (IN(k) && IN((k) + 1)) { if ((k) == 0) { grid.sync(); xbar = xcd_barrier_post(xbar.bar, xbar.st); } else xcd_barrier(xbar); MK_STAMP((k) + 1); } } while (0)
#else
#define SEAM(k) do { if (IN(k) && IN((k) + 1)) { xcd_barrier(xbar); MK_STAMP((k) + 1); } } while (0)
#endif
    if (lo < 0) grid.sync();

    MK_STAMP(0);
    if (IN(0)) { const Args a = load_args(); phase0(a, lds); }
    SEAM(0);
    if (IN(1)) { const Args a = load_args(); phase1(a, lds); }
    SEAM(1);
    if (IN(2)) {
        const Args a = load_args(); unsigned char* const ws = a.ws; (void)ws;
        Gemm g{(const bf16_t*)(ws + WS_HX), (const bf16_t*)(ws + WS_WIN), MA, NPROJ, D};
        EpiProj E{(bf16_t*)(ws + WS_Q), (bf16_t*)(ws + WS_KK), (bf16_t*)(ws + WS_VV), (bf16_t*)(ws + WS_M4), a.in[11], a.in[12], (const float*)(ws + WS_ROPE), 0.125f * LOG2E};
        if (G == 256) {
            P2Order S; S.S.init(MT, NPROJ, G, c); S.c = c;
            pg8::gemm_phase<EpiProj, P2Order, true, true>(lds, g, S, E);
            __syncthreads();
            if (c >= 80) transpose_late(a, lds, c - 80, 176);
        } else {
            pg8::StaticOrder S; S.init(MA, NPROJ, G, c);
            pg8::gemm_phase<EpiProj, pg8::StaticOrder, true, true>(lds, g, S, E);
        }
        __syncthreads();
    }
    SEAM(2);
    if (IN(3)) {
        const Args a = load_args(); unsigned char* const ws = a.ws; (void)ws;
        if (c & 1) { conv_rows(a); if (G != 256) transpose_late(a, lds, c, G); __syncthreads(); }
#ifndef MK_NO_ATTN
        if (G == 256) { const int x = c & 7, k = c >> 3; for (int i = 0; i < 4; ++i) attn_item(a, lds, ((4 * x + i) << 5) | k); }
        else for (int it = c; it < 1024; it += G) attn_item(a, lds, it);
#endif
        if (!(c & 1)) { __syncthreads(); conv_rows(a); if (G != 256) transpose_late(a, lds, c, G); }
    }
    SEAM(3);
    if (IN(4)) {
        const Args a = load_args(); unsigned char* const ws = a.ws; (void)ws;
#ifndef MK_NO_ML
        if (G == 256) { const int x = c & 7, k = c >> 3; mlstm_item(a, lds, 4 * (8 * x + (k >> 2)) + (k & 3)); }
        else for (int it = c; it < 256; it += G) mlstm_item(a, lds, it);
#endif
    }
    SEAM(4);
    if (IN(5)) {
        const Args a = load_args(); unsigned char* const ws = a.ws; (void)ws;
        if (c < 256) mlstm_out_rows(a, c * 256, 256);
    }
    __syncthreads(); MK_STAMP(6);
    if (IN(6)) {
        const Args a = load_args(); unsigned char* const ws = a.ws; (void)ws;
        Gemm g{(const bf16_t*)(ws + WS_MIX), (const bf16_t*)(ws + WS_WOUT), MT, D, D};
        SeqOrder S{c, 4, 4};
        EpiOut E{a.in[0], (const float*)(ws + WS_MOD), (bf16_t*)(ws + WS_X1)};
        if (c < 256) pg8::gemm_phase<EpiOut, SeqOrder, true, true>(lds, g, S, E);
        __syncthreads();
    }
    __syncthreads(); MK_STAMP(7);
    if (IN(7)) {
        const Args a = load_args(); unsigned char* const ws = a.ws; (void)ws;
        if (c < 256) post_rows(a, lds, c * 256, 256);
    }
    SEAM(7);
    if (IN(8)) {
        const Args a = load_args(); unsigned char* const ws = a.ws; (void)ws;
        if (c < 256) { const int z = c;
            const int b = z >> 4, e = z & 15;
            topk_select(a, lds, z);
            MK_STAMP(16);
            const bf16_t* HX2 = (const bf16_t*)(ws + WS_HX + (size_t)b * NT * D); const int* idx = (const int*)(ws + WS_IDX) + z * CAP;
            unsigned char* ACT = ws + WS_ACT + (size_t)z * CAP * FF;
            ((LAS float*)(lds + LDS_GATE_OFF))[threadIdx.x] = ((const float*)(ws + WS_GATE) + z * CAP)[threadIdx.x];
            __syncthreads();
            MK_STAMP(17);
#pragma unroll 1
            for (int half = 0; half < 2; ++half) { Gemm g{HX2, (const bf16_t*)(ws + WS_WGU + (size_t)e * 1024 * D), 256, 1024, D / 2, idx + 256 * half}; SeqOrder S{0, 4, 4}; EpiAct E{ACT + (size_t)half * 256 * FF};
              pg8::gemm_phase<EpiAct, SeqOrder, true, true, 1, FP8_W_SCALE>(lds, g, S, E); __syncthreads(); }
            MK_STAMP(18);
            { Gemm g{(const bf16_t*)ACT, (const bf16_t*)(ws + WS_WD + (size_t)e * D * FF), CAP, D, FF / 2}; SeqOrder S{0, 4, 8}; EpiDown E{(bf16_t*)(ws + WS_MIX) + (size_t)z * CAP * D, (const LAS float*)(lds + LDS_GATE_OFF), 1.f / FP8_W_UP};
              pg8::gemm_phase<EpiDown, SeqOrder, false, true, 1, FP8_W_SCALE>(lds, g, S, E); }
            __syncthreads();
        }
    }
    SEAM(8);
    if (IN(9)) {
        const Args a = load_args(); unsigned char* const ws = a.ws; (void)ws;
        const int tid = threadIdx.x, lane = tid & 63, wave = tid >> 6;
        const int gw = c * NWAVES + wave, NGW = G * NWAVES;
        const int* SL = (const int*)(ws + WS_SLOT); const bf16_t* Y = (const bf16_t*)(ws + WS_MIX); const float* mod = (const float*)(ws + WS_MOD);
        const bf16_t* X1 = (const bf16_t*)(ws + WS_X1);
        for (int grp = gw; grp < MT / 4; grp += NGW) {
            const int mbase = 4 * grp, b = mbase >> 12, n0 = mbase & (NT - 1);
            const int sv = SL[((size_t)b * NE + (lane & 15)) * NT + n0 + (lane >> 4)];
            const unsigned long long ball = __ballot(sv >= 0);
            const float* g2 = mod + b * 6144 + 5 * D + 4 * lane;
            f32x4 gv[4];
#pragma unroll
            for (int j = 0; j < 4; ++j) gv[j] = *(const f32x4*)(g2 + 256 * j);
#pragma unroll 1
            for (int u = 0; u < 4; ++u) {
                unsigned mask = (unsigned)(ball >> (16 * u)) & 0xffffu;
                float* orow = a.out + (size_t)(mbase + u) * D + 4 * lane; const bf16_t* xrow = X1 + (size_t)(mbase + u) * D + 4 * lane;
                u32x2 xv[4];
#pragma unroll
                for (int j = 0; j < 4; ++j) xv[j] = *(const u32x2*)(xrow + 256 * j);
                float acc[16];
#pragma unroll
                for (int i = 0; i < 16; ++i) acc[i] = 0.f;
                while (mask) {
                    const int e0 = __builtin_ctz(mask); mask &= mask - 1u;
                    const bool two = mask != 0u; const int e1 = two ? __builtin_ctz(mask) : e0; if (two) mask &= mask - 1u;
                    const int s0 = __shfl(sv, 16 * u + e0), s1 = __shfl(sv, 16 * u + e1);
                    const bf16_t* y0 = Y + ((size_t)(b * NE + e0) * CAP + s0) * D + 4 * lane; const bf16_t* y1 = Y + ((size_t)(b * NE + e1) * CAP + s1) * D + 4 * lane;
                    u32x2 ya[4], yb[4];
#pragma unroll
                    for (int j = 0; j < 4; ++j) { ya[j] = *(const u32x2*)(y0 + 256 * j); yb[j] = *(const u32x2*)(y1 + 256 * j); }
                    const float w1 = two ? 1.f : 0.f;
#pragma unroll
                    for (int j = 0; j < 4; ++j) { acc[4 * j] += bflo(ya[j].x) + w1 * bflo(yb[j].x); acc[4 * j + 1] += bfhi(ya[j].x) + w1 * bfhi(yb[j].x);
                        acc[4 * j + 2] += bflo(ya[j].y) + w1 * bflo(yb[j].y); acc[4 * j + 3] += bfhi(ya[j].y) + w1 * bfhi(yb[j].y); }
                }
#pragma unroll
                for (int j = 0; j < 4; ++j) { f32x4 o; o[0] = bflo(xv[j].x) + gv[j][0] * acc[4 * j]; o[1] = bfhi(xv[j].x) + gv[j][1] * acc[4 * j + 1]; o[2] = bflo(xv[j].y) + gv[j][2] * acc[4 * j + 2]; o[3] = bfhi(xv[j].y) + gv[j][3] * acc[4 * j + 3];
                    *(f32x4*)(orow + 256 * j) = o; }
            }
        }
    }
#ifdef MK_TIME_PHASE
    xcd_barrier(xbar); MK_STAMP(10);
    xcd_barrier(xbar);
    { const Args a = load_args(); const unsigned long long* ts = (const unsigned long long*)(a.ws + WS_MISC + 128); const int k = MK_TIME_PHASE;
      const float delta = k < 0 ? 0.1f : (k == 30 ? (float)(ts[15] - ts[4]) : k == 31 ? (float)(ts[5] - ts[15]) : k == 99 ? (float)(ts[10] - ts[0]) : k == 70 ? (float)(ts[16] - ts[8]) : k == 71 ? (float)(ts[17] - ts[16]) : k == 72 ? (float)(ts[18] - ts[17]) : k == 73 ? (float)(ts[9] - ts[18]) : k == 32 ? (float)ts[12] : k == 33 ? (float)ts[13] : (float)(ts[k + 1] - ts[k])) * (float)MK_TIME_SCALE * 1e-2f;
      for (size_t i = (size_t)blockIdx.x * NTHREADS + threadIdx.x; i < (size_t)MT * D; i += (size_t)gridDim.x * NTHREADS) a.out[i] += delta; }
#endif
#undef IN
#undef SEAM
}
}

#ifndef MK_N_LAUNCHES
#define MK_N_LAUNCHES 1
#endif
extern "C" void kernel_launch(void* const* d_in, const int* in_sizes, int n_in, void* d_out, int out_size, void* d_ws, size_t ws_size, hipStream_t stream) {
    using namespace mk;
    static int grid = 0;
    if (grid == 0) {
        if (n_in != 20 || out_size != MT * D || ws_size < WS_END) { fprintf(stderr, "kernel_launch: unexpected problem (n_in %d out %d ws %zu need %zu)\n", n_in, out_size, ws_size, (size_t)WS_END); grid = -1; return; }
        int dev = 0, cus = 0, per_cu = 0;
        hipGetDevice(&dev); hipDeviceGetAttribute(&cus, hipDeviceAttributeMultiprocessorCount, dev);
#if MK_N_LAUNCHES == 1
        if (hipFuncSetAttribute((const void*)mk_fwd_t<0x3ff>, hipFuncAttributeMaxDynamicSharedMemorySize, LDS_BYTES) != hipSuccess) { fprintf(stderr, "kernel_launch: hipFuncSetAttribute failed\n"); grid = -1; return; }
        hipOccupancyMaxActiveBlocksPerMultiprocessor(&per_cu, (const void*)mk_fwd_t<0x3ff>, NTHREADS, LDS_BYTES);
#else
        per_cu = 1;
#endif
        (void)hipGetLastError();
        if (per_cu < 1) { fprintf(stderr, "kernel_launch: occupancy query says %d blocks per CU\n", per_cu); per_cu = 1; }
        grid = cus;
        if (grid > 256) grid = 256;
    }
    if (grid < 0) return;
#ifndef MK_NO_MEMSET
    if (hipMemsetAsync((char*)d_ws + WS_BAR, 0, 16384, stream) != hipSuccess) { fprintf(stderr, "kernel_launch: hipMemsetAsync failed\n"); return; }
#endif
    Args a{};
    for (int i = 0; i < 20; ++i) a.in[i] = (const float*)d_in[i];
    a.out = (float*)d_out; a.ws = (unsigned char*)d_ws; a.sub = 7;
#if MK_N_LAUNCHES == 1
    a.ph_lo = 0; a.ph_hi = 10;
    void* args[] = {&a};
#ifdef MK_PLAIN_LAUNCH
    hipLaunchKernelGGL(mk_fwd_t<0x3ff>, dim3(grid), dim3(NTHREADS), LDS_BYTES, stream, a); hipError_t e = hipGetLastError(); (void)args;
#else
    hipError_t e = hipLaunchCooperativeKernel((const void*)mk_fwd_t<0x3ff>, dim3(grid), dim3(NTHREADS), args, LDS_BYTES, stream);
#endif
    if (e != hipSuccess) fprintf(stderr, "cooperative launch failed: %s (grid %d)\n", hipGetErrorString(e), grid);
#else
#define MK_LAUNCH_P(p) do { hipFuncSetAttribute((const void*)mk_fwd_t<(1 << (p))>, hipFuncAttributeMaxDynamicSharedMemorySize, LDS_BYTES); a.ph_lo = (p); a.ph_hi = (p) + 1; hipLaunchKernelGGL(mk_fwd_t<(1 << (p))>, dim3(grid), dim3(NTHREADS), LDS_BYTES, stream, a); } while (0)
#ifndef MK_DUP
#define MK_DUP -1
#endif
#ifndef MK_DUP_SUB
#define MK_DUP_SUB 7
#endif
#define MK_LAUNCH_D(p) do { MK_LAUNCH_P(p); if (MK_DUP == (p)) { a.sub = MK_DUP_SUB; MK_LAUNCH_P(p); a.sub = 7; } } while (0)
    MK_LAUNCH_D(0); MK_LAUNCH_D(1); MK_LAUNCH_D(2); MK_LAUNCH_D(3); MK_LAUNCH_D(4); MK_LAUNCH_D(5); MK_LAUNCH_D(6); MK_LAUNCH_D(7); MK_LAUNCH_D(8); MK_LAUNCH_D(9);
#endif
}
```

```cpp
#include <hip/hip_runtime.h>
#include <hip/hip_cooperative_groups.h>
#include <cstdio>
#include <cstdint>
namespace cg = cooperative_groups;
namespace pg8 {
#define PG8_LAS __attribute__((address_space(3)))
typedef unsigned short bf16_t;
typedef short bf16x8 __attribute__((ext_vector_type(8)));
typedef float f32x4 __attribute__((ext_vector_type(4)));
typedef unsigned u32x4 __attribute__((ext_vector_type(4)));
constexpr int BM = 256, BK = 64, HALF = 128, HTB = HALF * BK * 2  , STAGE_BYTES = 8 * HTB, NXCD = 8, WGM = 8;

__host__ __device__ __forceinline__ int lds_byte(int r, int c) { const int st = (r >> 4) * 2 + (c >> 5), rr = r & 15, cc = c & 31, ob = rr * 64 + cc * 2; return st * 1024 + (ob ^ (((ob >> 9) & 1) << 5)); }
__host__ __device__ __forceinline__ void stage_rc(int b, int& R, int& C) { const int st = b / 1024, sb = b % 1024, swz = sb ^ (((sb >> 9) & 1) << 5); R = (st >> 1) * 16 + swz / 64; C = (st & 1) * 32 + (swz % 64) / 2; }
__host__ __device__ __forceinline__ int perm32(int rho) { const int n = rho >> 4, i = rho & 15; return 8 * (i >> 2) + 4 * n + (i & 3); }

struct Unit { int pm, pn; };
struct Gemm { const bf16_t* A; const bf16_t* Bt; int M, N, K; const int* gidx = nullptr; };

struct StaticOrder {
    int nM, nN, nwg, G, c;
    __host__ __device__ void init(int M, int N, int G_, int c_) { nM = M / BM; nN = N / BM; nwg = nM * nN; G = G_; c = c_; }
    __host__ __device__ bool next(int i, Unit& u) const {
        const long L = (long)i * G + c; if (L >= nwg) return false;
        int wgid = (int)L; { const int q = nwg / NXCD, r = nwg % NXCD, xcd = wgid % NXCD, off = wgid / NXCD; wgid = (xcd < r ? xcd * (q + 1) : r * (q + 1) + (xcd - r) * q) + off; }
        const int nig = WGM * nN, gid = wgid / nig, fm = gid * WGM, gsz = (nM - fm) < WGM ? (nM - fm) : WGM;
        u.pm = fm + ((wgid % nig) % gsz); u.pn = (wgid % nig) / gsz; return true;
    }
    __device__ __forceinline__ void a_ready(const Unit&) const {}
    __device__ __forceinline__ void done(const Unit&) const {}
};
__device__ __forceinline__ unsigned cvt_pk_bf16(float lo, float hi) { unsigned r; asm volatile("v_cvt_pk_bf16_f32 %0, %1, %2" : "=v"(r) : "v"(lo), "v"(hi)); return r; }
typedef float f32x2 __attribute__((ext_vector_type(2)));
typedef int pg8_v8i __attribute__((ext_vector_type(8))); typedef int pg8_v4i __attribute__((ext_vector_type(4)));
template <int FMT> struct pg8_frag;
template <> struct pg8_frag<0> { bf16x8 v[2]; };
template <> struct pg8_frag<1> { pg8_v4i v[2]; };
template <class Epi, class Sched, bool ALIGN_EPI = false, bool SP2 = false, int FMT = 0, int FP8_SCALE_W = 0x7F7F7F7F>
__device__ __forceinline__ void gemm_phase(PG8_LAS unsigned char* lds, const Gemm g, const Sched& S, const Epi& E) {
    int tid_ = threadIdx.x; asm volatile("" : "+v"(tid_));
    const int tid = tid_, wid = __builtin_amdgcn_readfirstlane(tid >> 6), lane = tid & 63, wr = wid >> 2, wc = wid & 3, fr = lane & 15, fq = lane >> 4;
    const int K = g.K, nt = K / BK;
    unsigned voffA[2], voffB[2];
#pragma unroll
    for (int i = 0; i < 2; ++i) { int R, C; stage_rc(tid * 16 + i * 8192, R, C); const int Rb = Epi::PERM ? ((R & ~31) + perm32(R & 31)) : R;
        voffA[i] = (unsigned)(R * K + C) * 2u; voffB[i] = (unsigned)(Rb * K + C) * 2u; }
    const size_t kstep = (size_t)(BK * 2);
    const size_t hstep = (size_t)HALF * K * 2;
    const size_t tstep = 2 * hstep;
    unsigned voffAh[2][2];
#pragma unroll
    for (int i = 0; i < 2; ++i) { int R, C; stage_rc(tid * 16 + i * 8192, R, C);
        if (g.gidx) { voffAh[0][i] = (unsigned)(g.gidx[R] * K + C) * 2u; voffAh[1][i] = (unsigned)(g.gidx[HALF + R] * K + C) * 2u; }
        else { voffAh[0][i] = 0u; voffAh[1][i] = 0u; } }
    const __amdgpu_buffer_rsrc_t rsA = __builtin_amdgcn_make_buffer_rsrc((void*)g.A, 0, -1, 0x00020000), rsB = __builtin_amdgcn_make_buffer_rsrc((void*)g.Bt, 0, -1, 0x00020000);
    const size_t atstep = g.gidx ? (size_t)0 : tstep; const int p1step = 64 * K * 2;
    const unsigned ldsw = (unsigned)wid * 1024u;
    const int aoff = lds_byte(wr * 64 + fr, fq * 8), boff = lds_byte(wc * 32 + fr, fq * 8);
#define PG8_SA(b, h) (((b) * 2 + (h)) * HTB)
#define PG8_SB(b, h) ((4 + (b) * 2 + (h)) * HTB)
#define PG8_STAGE_R(rs, base0, bufoff, gbase, voff) do { const int so_ = (int)((const char*)(gbase) - (const char*)(base0)); _Pragma("unroll") for (int _i = 0; _i < 2; ++_i) \
        __builtin_amdgcn_raw_ptr_buffer_load_lds(rs, (PG8_LAS unsigned*)(lds + (bufoff) + ldsw + _i * 8192), 16, (int)(voff)[_i], so_, 0, 0); } while (0)
#define PG8_STAGE_U(rs, base0, bufoff, gbase, voff0, xtra) do { const int so_ = (int)((const char*)(gbase) - (const char*)(base0)) + (int)(xtra); _Pragma("unroll") for (int _i = 0; _i < 2; ++_i) \
        __builtin_amdgcn_raw_ptr_buffer_load_lds(rs, (PG8_LAS unsigned*)(lds + (bufoff) + ldsw + _i * 8192), 16, (int)(voff0), so_ + _i * (int)p1step, 0, 0); } while (0)
#define PG8_LD1(dst, k, addr) do { if constexpr (FMT == 0) dst.v[k] = *(const PG8_LAS bf16x8*)(addr); else dst.v[k] = *(const PG8_LAS pg8_v4i*)(addr); } while (0)
#define PG8_LDA(dst, b, h) do { _Pragma("unroll") for (int m = 0; m < 4; ++m) _Pragma("unroll") for (int k = 0; k < 2; ++k) PG8_LD1(dst[m], k, lds + PG8_SA(b, h) + aoff + m * 2048 + k * 1024); } while (0)
#define PG8_LDB(dst, b, h) do { _Pragma("unroll") for (int n = 0; n < 2; ++n) _Pragma("unroll") for (int k = 0; k < 2; ++k) PG8_LD1(dst[n], k, lds + PG8_SB(b, h) + boff + n * 2048 + k * 1024); } while (0)
#define PG8_MMA(ai, bj, At, Bt) do { __builtin_amdgcn_s_setprio(1); \
        if constexpr (FMT == 0) { _Pragma("unroll") for (int m = 0; m < 4; ++m) _Pragma("unroll") for (int n = 0; n < 2; ++n) _Pragma("unroll") for (int k = 0; k < 2; ++k) \
            acc[ai][bj][m][n] = __builtin_amdgcn_mfma_f32_16x16x32_bf16(Bt[n].v[k], At[m].v[k], acc[ai][bj][m][n], 0, 0, 0); } \
        else { _Pragma("unroll") for (int m = 0; m < 4; ++m) _Pragma("unroll") for (int n = 0; n < 2; ++n) \
            acc[ai][bj][m][n] = __builtin_amdgcn_mfma_scale_f32_16x16x128_f8f6f4(__builtin_shufflevector(Bt[n].v[0], Bt[n].v[1], 0, 1, 2, 3, 4, 5, 6, 7), __builtin_shufflevector(At[m].v[0], At[m].v[1], 0, 1, 2, 3, 4, 5, 6, 7), acc[ai][bj][m][n], 0, 0, 0, 0x7F7F7F7F, 0, 0x7F7F7F7F); \
            asm volatile("" :: "v"(acc[ai][bj][0][0]), "v"(acc[ai][bj][0][1]), "v"(acc[ai][bj][1][0]), "v"(acc[ai][bj][1][1]), "v"(acc[ai][bj][2][0]), "v"(acc[ai][bj][2][1]), "v"(acc[ai][bj][3][0]), "v"(acc[ai][bj][3][1])); }   \
        __builtin_amdgcn_s_setprio(0); } while (0)
#define PG8_WAIT_V(n) asm volatile("s_waitcnt vmcnt(" #n ")" ::: "memory")
#define PG8_WAIT_L(n) asm volatile("s_waitcnt lgkmcnt(" #n ")" ::: "memory")
#define PG8_BAR __builtin_amdgcn_s_barrier()
#define PG8_SCHED __builtin_amdgcn_sched_barrier(0)
    Unit cur, nxt; int ui = 0;
    if (!S.next(0, cur)) return;
    f32x4 acc[2][2][4][2];
#pragma unroll
    for (int a = 0; a < 2; ++a)
#pragma unroll
        for (int b = 0; b < 2; ++b)
#pragma unroll
            for (int m = 0; m < 4; ++m)
#pragma unroll
                for (int n = 0; n < 2; ++n) acc[a][b][m][n] = (f32x4){0.f, 0.f, 0.f, 0.f};
    pg8_frag<FMT> At[4], B0[2], B1[2];
    const char* cA = (const char*)g.A + (size_t)cur.pm * atstep; const char* cB = (const char*)g.Bt + (size_t)cur.pn * tstep;
    S.a_ready(cur);
    if constexpr (SP2) {
        PG8_STAGE_U(rsB, g.Bt, PG8_SB(0, 0), cB, voffB[0], 0); PG8_STAGE_U(rsB, g.Bt, PG8_SB(0, 1), cB + hstep, voffB[0], 0); do { if (g.gidx) PG8_STAGE_R(rsA, g.A, PG8_SA(0, 0), cA, voffAh[0]); else PG8_STAGE_U(rsA, g.A, PG8_SA(0, 0), cA, voffA[0], 0 * hstep); } while (0); do { if (g.gidx) PG8_STAGE_R(rsA, g.A, PG8_SA(0, 1), cA, voffAh[1]); else PG8_STAGE_U(rsA, g.A, PG8_SA(0, 1), cA, voffA[0], 1 * hstep); } while (0);
        if (wr == 1) PG8_BAR;
        PG8_WAIT_V(2); PG8_BAR;
        PG8_STAGE_U(rsB, g.Bt, PG8_SB(1, 0), cB + kstep, voffB[0], 0); do { if (g.gidx) PG8_STAGE_R(rsA, g.A, PG8_SA(1, 0), cA + kstep, voffAh[0]); else PG8_STAGE_U(rsA, g.A, PG8_SA(1, 0), cA + kstep, voffA[0], 0 * hstep); } while (0); PG8_STAGE_U(rsB, g.Bt, PG8_SB(1, 1), cB + hstep + kstep, voffB[0], 0);
        PG8_WAIT_V(6); PG8_BAR;
    } else {
        PG8_STAGE_U(rsB, g.Bt, PG8_SB(0, 0), cB, voffB[0], 0); do { if (g.gidx) PG8_STAGE_R(rsA, g.A, PG8_SA(0, 0), cA, voffAh[0]); else PG8_STAGE_U(rsA, g.A, PG8_SA(0, 0), cA, voffA[0], 0 * hstep); } while (0); PG8_STAGE_U(rsB, g.Bt, PG8_SB(0, 1), cB + hstep, voffB[0], 0); do { if (g.gidx) PG8_STAGE_R(rsA, g.A, PG8_SA(0, 1), cA, voffAh[1]); else PG8_STAGE_U(rsA, g.A, PG8_SA(0, 1), cA, voffA[0], 1 * hstep); } while (0);
        if (wr == 1) PG8_BAR;
        PG8_WAIT_V(4); PG8_BAR;
        PG8_STAGE_U(rsB, g.Bt, PG8_SB(1, 0), cB + kstep, voffB[0], 0); do { if (g.gidx) PG8_STAGE_R(rsA, g.A, PG8_SA(1, 0), cA + kstep, voffAh[0]); else PG8_STAGE_U(rsA, g.A, PG8_SA(1, 0), cA + kstep, voffA[0], 0 * hstep); } while (0); PG8_STAGE_U(rsB, g.Bt, PG8_SB(1, 1), cB + hstep + kstep, voffB[0], 0);
        PG8_WAIT_V(6); PG8_BAR;
    }
    for (;;) {
        const bool has_next = S.next(ui + 1, nxt);
        const char* nA = has_next ? (const char*)g.A + (size_t)nxt.pm * atstep : cA; const char* nB = has_next ? (const char*)g.Bt + (size_t)nxt.pn * tstep : cB;
        for (int t = 0; t < nt; t += 2) {
            const bool last = (t == nt - 2);
            const char* a1 = cA + (size_t)(t + 1) * kstep;
            const char* a2 = last ? nA : cA + (size_t)(t + 2) * kstep; const char* b2 = last ? nB : cB + (size_t)(t + 2) * kstep;
            const char* a3 = a2 + kstep; const char* b3 = b2 + kstep;
            if (last && has_next) S.a_ready(nxt);
            if constexpr (SP2) {
            PG8_LDB(B0, 0, 0); PG8_LDB(B1, 0, 1); PG8_SCHED; PG8_LDA(At, 0, 0); do { if (g.gidx) PG8_STAGE_R(rsA, g.A, PG8_SA(1, 1), a1, voffAh[1]); else PG8_STAGE_U(rsA, g.A, PG8_SA(1, 1), a1, voffA[0], 1 * hstep); } while (0);
            PG8_WAIT_V(8); PG8_WAIT_L(0); PG8_BAR; PG8_MMA(0, 0, At, B0); PG8_MMA(0, 1, At, B1); PG8_BAR; PG8_SCHED;
            PG8_LDA(At, 0, 1); PG8_STAGE_U(rsB, g.Bt, PG8_SB(0, 0), b2, voffB[0], 0); PG8_STAGE_U(rsB, g.Bt, PG8_SB(0, 1), b2 + hstep, voffB[0], 0); do { if (g.gidx) PG8_STAGE_R(rsA, g.A, PG8_SA(0, 0), a2, voffAh[0]); else PG8_STAGE_U(rsA, g.A, PG8_SA(0, 0), a2, voffA[0], 0 * hstep); } while (0);
            PG8_WAIT_V(8); PG8_WAIT_L(0); PG8_BAR; PG8_MMA(1, 0, At, B0); PG8_MMA(1, 1, At, B1); PG8_BAR; PG8_SCHED;
            PG8_LDB(B0, 1, 0); PG8_LDB(B1, 1, 1); PG8_SCHED; PG8_LDA(At, 1, 0); do { if (g.gidx) PG8_STAGE_R(rsA, g.A, PG8_SA(0, 1), a2, voffAh[1]); else PG8_STAGE_U(rsA, g.A, PG8_SA(0, 1), a2, voffA[0], 1 * hstep); } while (0);
            PG8_WAIT_V(8); PG8_WAIT_L(0); PG8_BAR; PG8_MMA(0, 0, At, B0); PG8_MMA(0, 1, At, B1); PG8_BAR; PG8_SCHED;
            PG8_LDA(At, 1, 1); PG8_STAGE_U(rsB, g.Bt, PG8_SB(1, 0), b3, voffB[0], 0); PG8_STAGE_U(rsB, g.Bt, PG8_SB(1, 1), b3 + hstep, voffB[0], 0); do { if (g.gidx) PG8_STAGE_R(rsA, g.A, PG8_SA(1, 0), a3, voffAh[0]); else PG8_STAGE_U(rsA, g.A, PG8_SA(1, 0), a3, voffA[0], 0 * hstep); } while (0);
            PG8_WAIT_V(8); PG8_WAIT_L(0); PG8_BAR; PG8_MMA(1, 0, At, B0); PG8_MMA(1, 1, At, B1); PG8_BAR; PG8_SCHED;
            } else {
            PG8_LDB(B0, 0, 0); PG8_SCHED; PG8_LDA(At, 0, 0); do { if (g.gidx) PG8_STAGE_R(rsA, g.A, PG8_SA(1, 1), a1, voffAh[1]); else PG8_STAGE_U(rsA, g.A, PG8_SA(1, 1), a1, voffA[0], 1 * hstep); } while (0);
            PG8_WAIT_L(8); PG8_BAR; PG8_WAIT_L(0); PG8_MMA(0, 0, At, B0); PG8_BAR; PG8_SCHED;
            PG8_LDB(B1, 0, 1); PG8_STAGE_U(rsB, g.Bt, PG8_SB(0, 0), b2, voffB[0], 0);
            PG8_BAR; PG8_WAIT_L(0); PG8_MMA(0, 1, At, B1); PG8_BAR;
            PG8_LDA(At, 0, 1); do { if (g.gidx) PG8_STAGE_R(rsA, g.A, PG8_SA(0, 0), a2, voffAh[0]); else PG8_STAGE_U(rsA, g.A, PG8_SA(0, 0), a2, voffA[0], 0 * hstep); } while (0);
            PG8_BAR; PG8_WAIT_L(0); PG8_MMA(1, 0, At, B0); PG8_BAR; PG8_SCHED;
            PG8_STAGE_U(rsB, g.Bt, PG8_SB(0, 1), b2 + hstep, voffB[0], 0);
            PG8_WAIT_V(6); PG8_BAR; PG8_MMA(1, 1, At, B1); PG8_BAR;
            PG8_LDB(B0, 1, 0); PG8_SCHED; PG8_LDA(At, 1, 0); do { if (g.gidx) PG8_STAGE_R(rsA, g.A, PG8_SA(0, 1), a2, voffAh[1]); else PG8_STAGE_U(rsA, g.A, PG8_SA(0, 1), a2, voffA[0], 1 * hstep); } while (0);
            PG8_WAIT_L(8); PG8_BAR; PG8_WAIT_L(0); PG8_MMA(0, 0, At, B0); PG8_BAR; PG8_SCHED;
            PG8_LDB(B1, 1, 1); PG8_STAGE_U(rsB, g.Bt, PG8_SB(1, 0), b3, voffB[0], 0);
            PG8_BAR; PG8_WAIT_L(0); PG8_MMA(0, 1, At, B1); PG8_BAR;
            PG8_LDA(At, 1, 1); do { if (g.gidx) PG8_STAGE_R(rsA, g.A, PG8_SA(1, 0), a3, voffAh[0]); else PG8_STAGE_U(rsA, g.A, PG8_SA(1, 0), a3, voffA[0], 0 * hstep); } while (0);
            PG8_BAR; PG8_WAIT_L(0); PG8_MMA(1, 0, At, B0); PG8_BAR; PG8_SCHED;
            PG8_STAGE_U(rsB, g.Bt, PG8_SB(1, 1), b3 + hstep, voffB[0], 0);
            PG8_WAIT_V(6); PG8_BAR; PG8_MMA(1, 1, At, B1); PG8_BAR;
            }
        }
        if constexpr (ALIGN_EPI) { if (wr == 0) PG8_BAR; }
        if constexpr (!Epi::AFTER_DRAIN) { int t2_ = threadIdx.x; asm volatile("" : "+v"(t2_)); const int l2_ = t2_ & 63;
            E(acc, cur, wr, wc, l2_ & 15, l2_ >> 4); S.done(cur); }
        if (!has_next) break;
#pragma unroll
        for (int a = 0; a < 2; ++a)
#pragma unroll
            for (int b = 0; b < 2; ++b)
#pragma unroll
                for (int m = 0; m < 4; ++m)
#pragma unroll
                    for (int n = 0; n < 2; ++n) acc[a][b][m][n] = (f32x4){0.f, 0.f, 0.f, 0.f};
        cur = nxt; cA = nA; cB = nB; ++ui;
        if constexpr (ALIGN_EPI) { if (wr == 1) PG8_BAR; }
    }
    PG8_WAIT_V(0);
    if constexpr (!ALIGN_EPI) { if (wr == 0) PG8_BAR; }
    PG8_BAR;
    if constexpr (Epi::AFTER_DRAIN) { E.fused(acc, cur, wr, wc, fr, fq, lds, wid, lane); S.done(cur); }
#undef PG8_SA
#undef PG8_SB
#undef PG8_STAGE_R
#undef PG8_STAGE_U
#undef PG8_LDA
#undef PG8_LD1
#undef PG8_LDB
#undef PG8_MMA
#undef PG8_WAIT_V
#undef PG8_WAIT_L
#undef PG8_BAR
#undef PG8_SCHED
}
}
namespace mk {
using pg8::bf16_t; using pg8::bf16x8; using pg8::f32x4; using pg8::u32x4; using pg8::Unit; using pg8::Gemm;
#define LAS __attribute__((address_space(3)))
typedef short v4i16 __attribute__((ext_vector_type(4)));
typedef unsigned u32x2 __attribute__((ext_vector_type(2)));

constexpr int D = 1024, NB = 16, NT = 4096, NL = 256;
constexpr int MT = NB * NT, MC = NB * NL, MA = MT + MC;
constexpr int NPROJ = 2816, INC = 2832;
constexpr int NE = 16, FF = 512, CAP = 512;
constexpr float EPS = 1e-6f, LOG2E = 1.4426950408889634f;
constexpr int NWAVES = 8, NTHREADS = 512;
constexpr int LDS_BYTES = 144 * 1024;

constexpr size_t al256(size_t x) { return (x + 255) & ~(size_t)255; }
constexpr size_t WS_MOD = 0;
constexpr size_t WS_ROPE = WS_MOD + al256(17 * 6144 * 4);
constexpr size_t WS_MISC = WS_ROPE + al256(2 * 1024 * 4);
constexpr size_t WS_GATES = WS_MISC + 256;
constexpr size_t WS_AFF = WS_GATES + al256((size_t)MA * 16 * 4);
constexpr size_t WS_IDX = WS_AFF + al256((size_t)NB * NE * NT * 4);
constexpr size_t WS_GATE = WS_IDX + al256(256 * CAP * 4);
constexpr size_t WS_SLOT = WS_GATE + al256(256 * CAP * 4);
constexpr size_t WS_WIN = WS_SLOT + al256((size_t)256 * NT * 4);
constexpr size_t WS_WOUT = WS_WIN + al256((size_t)NPROJ * D * 2);
constexpr size_t WS_WGU = WS_WOUT + al256((size_t)D * D * 2);
constexpr size_t WS_WD = WS_WGU + al256((size_t)NE * 1024 * D * 2);
constexpr size_t WS_HX = WS_WD + al256((size_t)NE * D * FF * 2);
constexpr size_t WS_CQ = WS_HX;
constexpr size_t WS_CK = WS_HX + (size_t)MA * 512 * 2;
constexpr size_t WS_Q = WS_HX + al256((size_t)MA * D * 2);
constexpr size_t WS_KK = WS_Q + al256((size_t)MT * 512 * 2);
constexpr size_t WS_VV = WS_KK + al256((size_t)MA * 128 * 2);
constexpr size_t WS_M4 = WS_VV + al256((size_t)MA * 128 * 2);
constexpr size_t WS_MIX = WS_M4 + al256((size_t)4 * MA * 512 * 2);
constexpr size_t WS_HF = WS_MIX + (size_t)MT * D * 2;
constexpr size_t WS_HB = WS_HF + (size_t)MT * 512 * 2;
constexpr size_t WS_ACT = WS_HB + (size_t)MT * 512 * 2;
constexpr size_t WS_TBL = WS_ACT + al256((size_t)256 * CAP * FF * 2);
constexpr size_t WS_X1 = WS_M4;
static_assert((size_t)MT * D * 2 <= (size_t)136 * 1024 * 1024 && (size_t)136 * 1024 * 1024 + (size_t)256 * CAP * D <= (size_t)4 * MA * 512 * 2, "X1 and the gathered fp8 panels overlay MQ|MK and MV|MO");
constexpr size_t WS_BAR = WS_TBL + al256((size_t)256 * 34 * 384 * 4);
constexpr size_t WS_END = WS_BAR + 16384;
constexpr int LDS_GATE_OFF = 132 * 1024;
constexpr int LDS_BAR_OFF = 140 * 1024;
static_assert(WS_END <= ((size_t)1 << 30), "workspace map exceeds 1 GiB");
static_assert((size_t)256 * CAP * D * 2 <= (size_t)4 * MA * 512 * 2, "XG overlay fits");

struct Args { const float* in[20]; float* out; unsigned char* ws; int ph_lo, ph_hi, sub, pad; };

__device__ __forceinline__ float wave_sum(float v) {
#pragma unroll
    for (int o = 1; o < 64; o <<= 1) v += __shfl_xor(v, o);
    return v;
}
__device__ __forceinline__ float bflo(unsigned w) { return __builtin_bit_cast(float, w << 16); }
__device__ __forceinline__ float bfhi(unsigned w) { return __builtin_bit_cast(float, w & 0xffff0000u); }
typedef float f32x2_t __attribute__((ext_vector_type(2))); typedef __bf16 bf16x2_t __attribute__((ext_vector_type(2)));
__device__ __forceinline__ unsigned pkbf(float lo, float hi) { f32x2_t v = {lo, hi}; bf16x2_t b = __builtin_convertvector(v, bf16x2_t); return __builtin_bit_cast(unsigned, b); }
__device__ __forceinline__ unsigned pk4_fp8(float a, float b, float c, float d) { int p = __builtin_amdgcn_cvt_pk_fp8_f32(a, b, 0, false); p = __builtin_amdgcn_cvt_pk_fp8_f32(c, d, p, true); return (unsigned)p; }
constexpr float FP8_W_UP = 32.f;
constexpr int FP8_W_SCALE = 0x7A7A7A7A;
constexpr float Y_FP8_UP = 64.f;
__device__ __forceinline__ f32x4 dec4_fp8(unsigned w) { const f32x2_t lo = __builtin_amdgcn_cvt_pk_f32_fp8((int)w, false), hi = __builtin_amdgcn_cvt_pk_f32_fp8((int)w, true); return (f32x4){lo[0], lo[1], hi[0], hi[1]}; }
__device__ __forceinline__ float silu_f(float x) { return x * __builtin_amdgcn_rcpf(1.f + __expf(-x)); }
__device__ __forceinline__ float logsig_f(float x) { return fminf(x, 0.f) - log1pf(expf(-fabsf(x))); }
__device__ __forceinline__ f32x4 mfma16(bf16x8 a, bf16x8 b, f32x4 c) { return __builtin_amdgcn_mfma_f32_16x16x32_bf16(a, b, c, 0, 0, 0); }
__device__ __forceinline__ bf16x8 tr2(const LAS bf16_t* p0, const LAS bf16_t* p1) {
    const v4i16 a = __builtin_amdgcn_ds_read_tr16_b64_v4i16((LAS v4i16*)p0), b = __builtin_amdgcn_ds_read_tr16_b64_v4i16((LAS v4i16*)p1);
    return (bf16x8){a[0], a[1], a[2], a[3], b[0], b[1], b[2], b[3]};
}
__device__ __forceinline__ bf16x8 pack8(const f32x4 a, const f32x4 b) {
    u32x4 w; w.x = pkbf(a[0], a[1]); w.y = pkbf(a[2], a[3]); w.z = pkbf(b[0], b[1]); w.w = pkbf(b[2], b[3]); return __builtin_bit_cast(bf16x8, w);
}
__host__ __device__ __forceinline__ int win_dst_row(int n) {
    if (n >= 768) return n;
    const int pn = n >> 8, r = n & 255, wc = r >> 6, bj = (r >> 5) & 1, p = r & 31;
    return 256 * pn + 128 * bj + 32 * wc + p;
}

__device__ __forceinline__ void transpose_item(const float* W, int N, int k0, int n0, bf16_t* WT, int K, int drow0, LAS float* scr, int lane) {
    float tv[32];
#pragma unroll
    for (int i = 0; i < 32; ++i) tv[i] = __builtin_nontemporal_load(W + (size_t)(k0 + 2 * i + (lane >> 5)) * N + n0 + (lane & 31));
#pragma unroll
    for (int i = 0; i < 32; ++i) scr[(2 * i + (lane >> 5)) * 33 + (lane & 31)] = tv[i];
    asm volatile("s_waitcnt lgkmcnt(0)" ::: "memory");
    const int c = lane & 7;
#pragma unroll
    for (int j = 0; j < 4; ++j) { const int n = (lane >> 3) + 8 * j; const LAS float* s = scr + (8 * c) * 33 + n;
        u32x4 o; o.x = pkbf(s[0 * 33], s[1 * 33]); o.y = pkbf(s[2 * 33], s[3 * 33]); o.z = pkbf(s[4 * 33], s[5 * 33]); o.w = pkbf(s[6 * 33], s[7 * 33]);
        *(u32x4*)(WT + (size_t)(drow0 + n) * K + k0 + 8 * c) = o; }
    asm volatile("s_waitcnt lgkmcnt(0)" ::: "memory");
}
__device__ __forceinline__ void transpose_item8(const float* W, int N, int k0, int n0, unsigned char* WT, int K, int drow0, LAS float* scr, int lane) {
    float tv[32];
#pragma unroll
    for (int i = 0; i < 32; ++i) tv[i] = __builtin_nontemporal_load(W + (size_t)(k0 + 2 * i + (lane >> 5)) * N + n0 + (lane & 31));
#pragma unroll
    for (int i = 0; i < 32; ++i) scr[(2 * i + (lane >> 5)) * 33 + (lane & 31)] = tv[i];
    asm volatile("s_waitcnt lgkmcnt(0)" ::: "memory");
    const int c = lane & 7;
#pragma unroll
    for (int j = 0; j < 4; ++j) { const int n = (lane >> 3) + 8 * j; const LAS float* s = scr + (8 * c) * 33 + n;
        u32x2 o; o.x = pk4_fp8(s[0 * 33] * FP8_W_UP, s[1 * 33] * FP8_W_UP, s[2 * 33] * FP8_W_UP, s[3 * 33] * FP8_W_UP); o.y = pk4_fp8(s[4 * 33] * FP8_W_UP, s[5 * 33] * FP8_W_UP, s[6 * 33] * FP8_W_UP, s[7 * 33] * FP8_W_UP);
        *(u32x2*)(WT + (size_t)(drow0 + n) * K + k0 + 8 * c) = o; }
    asm volatile("s_waitcnt lgkmcnt(0)" ::: "memory");
}
struct TrItem { const float* W; int N, k0, n0; unsigned char* dst; int K, drow0, fp8; };
__device__ __forceinline__ void tr_load(const TrItem& t, float (&tv)[32], int lane) {
#pragma unroll
    for (int i = 0; i < 32; ++i) tv[i] = __builtin_nontemporal_load(t.W + (size_t)(t.k0 + 2 * i + (lane >> 5)) * t.N + t.n0 + (lane & 31));
}
__device__ __forceinline__ void tr_store(const TrItem& t, const float (&tv)[32], LAS float* scr, int lane) {
#pragma unroll
    for (int i = 0; i < 32; ++i) scr[(2 * i + (lane >> 5)) * 33 + (lane & 31)] = tv[i];
    asm volatile("s_waitcnt lgkmcnt(0)" ::: "memory");
    const int c = lane & 7;
#pragma unroll
    for (int j = 0; j < 4; ++j) { const int n = (lane >> 3) + 8 * j; const LAS float* s = scr + (8 * c) * 33 + n;
        if (t.fp8) { u32x2 o; o.x = pk4_fp8(s[0 * 33] * FP8_W_UP, s[1 * 33] * FP8_W_UP, s[2 * 33] * FP8_W_UP, s[3 * 33] * FP8_W_UP); o.y = pk4_fp8(s[4 * 33] * FP8_W_UP, s[5 * 33] * FP8_W_UP, s[6 * 33] * FP8_W_UP, s[7 * 33] * FP8_W_UP);
            *(u32x2*)(t.dst + (size_t)(t.drow0 + n) * t.K + t.k0 + 8 * c) = o; }
        else { u32x4 o; o.x = pkbf(s[0 * 33], s[1 * 33]); o.y = pkbf(s[2 * 33], s[3 * 33]); o.z = pkbf(s[4 * 33], s[5 * 33]); o.w = pkbf(s[6 * 33], s[7 * 33]);
            *(u32x4*)((bf16_t*)t.dst + (size_t)(t.drow0 + n) * t.K + t.k0 + 8 * c) = o; } }
    asm volatile("s_waitcnt lgkmcnt(0)" ::: "memory");
}
__device__ __forceinline__ void phase0(const Args& a, LAS unsigned char* lds) {
    const int tid = threadIdx.x, lane = tid & 63, wave = tid >> 6, wg = blockIdx.x, G = gridDim.x;
    unsigned char* ws = a.ws;
    {
        float* rope = (float*)(ws + WS_ROPE);
        for (int i = wg * 4 + tid; tid < 4 && i < 1024; i += 4 * G) { const int pos = i >> 4, f = i & 15; const float ang = (float)pos * powf(10000.f, -(float)f / 16.f); rope[i] = cosf(ang); rope[1024 + i] = sinf(ang); }
        if (wg == G - 1 && tid == 64) { float mq = 0.f, mkk = 0.f; for (int i = 0; i < 64; ++i) { mq = fmaxf(mq, fabsf(a.in[11][i])); mkk = fmaxf(mkk, fabsf(a.in[12][i])); }
            ((float*)(ws + WS_MISC))[0] = fmaxf(0.f, 8.f * mq * mkk * LOG2E - 16.f); }
    }
    {
        LAS float* sc = (LAS float*)lds;
        LAS float* part = sc + 17 * 1024;
        const float* c = a.in[1]; const float* cctx = a.in[3]; const float* w_mod = a.in[4]; const float* b_mod = a.in[5];
        float* mod = (float*)(ws + WS_MOD);
        for (int i = tid; i < 17 * 1024; i += NTHREADS) { const int r = i >> 10, k = i & 1023; const float v = r < 16 ? c[r * 1024 + k] : cctx[k]; sc[i] = v / (1.f + expf(-v)); }
        __syncthreads();
        for (int it = wg; it < 256; it += G) {
            const int col0 = it * 24;
            if (tid < 504) {
                const int j = tid % 24, kg = tid / 24; float acc[17];
#pragma unroll
                for (int r = 0; r < 17; ++r) acc[r] = 0.f;
                float wv[49];
#pragma unroll
                for (int i = 0; i < 49; ++i) { const int k = kg + 21 * i; wv[i] = k < 1024 ? __builtin_nontemporal_load(w_mod + (size_t)k * 6144 + col0 + j) : 0.f; }
#pragma unroll
                for (int i = 0; i < 49; ++i) { const int k = min(kg + 21 * i, 1023); const float w = wv[i];
#pragma unroll
                    for (int r = 0; r < 17; ++r) acc[r] += sc[r * 1024 + k] * w; }
#pragma unroll
                for (int r = 0; r < 17; ++r) part[(kg * 17 + r) * 24 + j] = acc[r];
            }
            __syncthreads();
            if (tid < 408) { const int r = tid / 24, j = tid % 24; float s = b_mod[col0 + j]; for (int kg = 0; kg < 21; ++kg) s += part[(kg * 17 + r) * 24 + j]; mod[r * 6144 + col0 + j] = s; }
            __syncthreads();
        }
    }
    {
        LAS float* scr = (LAS float*)lds + wave * (64 * 33);
        const int gw = wg * NWAVES + wave, NGW = G * NWAVES;
        bf16_t* WIN = (bf16_t*)(ws + WS_WIN);
        for (int it = gw; it < 16 * 88; it += NGW) { const int kb = it / 88, nb = it % 88; transpose_item(a.in[8], INC, 64 * kb, 32 * nb, WIN, D, win_dst_row(32 * nb), scr, lane); }
    }
}
__device__ __forceinline__ void transpose_late(const Args& a, LAS unsigned char* lds, int it_lo, int it_hi) {
    const int tid = threadIdx.x, lane = tid & 63, wave = tid >> 6, wg = blockIdx.x, G = gridDim.x;
    unsigned char* ws = a.ws;
    LAS float* scr = (LAS float*)lds + wave * (64 * 33);
    const int gw = wg * NWAVES + wave, NGW = G * NWAVES;
    constexpr int I_OUT = 16 * 32, I_G = 16 * 16, I_D = 8 * 32;
    constexpr int NITEMS = I_OUT + NE * (2 * I_G + I_D);
#define TR_DECODE(t, it_) do { int r = (it_); \
        if (r < I_OUT) { const int kb = r / 32, nb = r % 32; t = TrItem{a.in[15], D, 64 * kb, 32 * nb, ws + WS_WOUT, D, 32 * nb, 0}; } \
        else { r -= I_OUT; const int e = r / (2 * I_G + I_D); r -= e * (2 * I_G + I_D); \
            if (r < 2 * I_G) { const int up = r / I_G, rr = r % I_G, kb = rr / 16, nb = rr % 16, n0 = 32 * nb; \
                t = TrItem{(up ? a.in[18] : a.in[17]) + (size_t)e * D * FF, FF, 64 * kb, n0, ws + WS_WGU + (size_t)e * 1024 * D, D, 256 * (n0 >> 7) + (n0 & 127) + 128 * up, 1}; } \
            else { r -= 2 * I_G; const int kb = r / 32, nb = r % 32; t = TrItem{a.in[19] + (size_t)e * FF * D, D, 64 * kb, 32 * nb, ws + WS_WD + (size_t)e * D * FF, FF, 32 * nb, 1}; } } } while (0)
    (void)NITEMS; if (it_lo + gw >= it_hi) return;
    TrItem cur; TR_DECODE(cur, it_lo + gw); float tv[32]; tr_load(cur, tv, lane);
#pragma unroll 1
    for (int it = it_lo + gw; it < it_hi; it += NGW) {
        TrItem nxt = cur; float tn[32]; const bool more = it + NGW < it_hi;
        if (more) { TR_DECODE(nxt, it + NGW); tr_load(nxt, tn, lane); }
        tr_store(cur, tv, scr, lane);
        if (more) { cur = nxt;
#pragma unroll
            for (int i = 0; i < 32; ++i) tv[i] = tn[i]; }
    }
#undef TR_DECODE
}

__device__ __forceinline__ void fill_w16(LAS float* W16, const float* src, int pitch, int tid) {
    for (int idx = tid; idx < 1024 * 16; idx += NTHREADS) { const int k = idx >> 4, t = idx & 15; const int ln = (k & 255) >> 2, i = k & 3, j = k >> 8;
        W16[((j * 4 + i) * 64 + ln) * 20 + t] = src[(size_t)k * pitch + t]; }
}
__device__ __forceinline__ float reduce16(const float (&g)[16], int lane) {
    float r8[8], r4[4], r2[2];
    const bool b5 = (lane & 32) != 0, b4 = (lane & 16) != 0, b3 = (lane & 8) != 0, b2 = (lane & 4) != 0;
#pragma unroll
    for (int t = 0; t < 8; ++t) { const float keep = b5 ? g[t + 8] : g[t], send = b5 ? g[t] : g[t + 8]; r8[t] = keep + __shfl_xor(send, 32); }
#pragma unroll
    for (int t = 0; t < 4; ++t) { const float keep = b4 ? r8[t + 4] : r8[t], send = b4 ? r8[t] : r8[t + 4]; r4[t] = keep + __shfl_xor(send, 16); }
#pragma unroll
    for (int t = 0; t < 2; ++t) { const float keep = b3 ? r4[t + 2] : r4[t], send = b3 ? r4[t] : r4[t + 2]; r2[t] = keep + __shfl_xor(send, 8); }
    const float keep = b2 ? r2[1] : r2[0], send = b2 ? r2[0] : r2[1];
    float r1 = keep + __shfl_xor(send, 4);
    r1 += __shfl_xor(r1, 1); r1 += __shfl_xor(r1, 2);
    return r1;
}
__device__ __forceinline__ int reduce16_index(int lane) { return ((lane >> 5) & 1) * 8 + ((lane >> 4) & 1) * 4 + ((lane >> 3) & 1) * 2 + ((lane >> 2) & 1); }
__device__ __forceinline__ void rows2_norm_dots(f32x4 (&va)[4], f32x4 (&vb)[4], const f32x4 (&sc)[4], const f32x4 (&sh)[4], const LAS float* W16, int lane, float& ga, float& gb) {
    float sa = 0.f, sb = 0.f;
#pragma unroll
    for (int j = 0; j < 4; ++j) { sa += (va[j][0] * va[j][0] + va[j][1] * va[j][1]) + (va[j][2] * va[j][2] + va[j][3] * va[j][3]); sb += (vb[j][0] * vb[j][0] + vb[j][1] * vb[j][1]) + (vb[j][2] * vb[j][2] + vb[j][3] * vb[j][3]); }
    const float ra = rsqrtf(wave_sum(sa) * (1.f / D) + EPS), rb = rsqrtf(wave_sum(sb) * (1.f / D) + EPS);
    float g0[16], g1[16];
#pragma unroll
    for (int t = 0; t < 16; ++t) { g0[t] = 0.f; g1[t] = 0.f; }
    int off0 = lane * 20, off1 = lane * 20;
#pragma unroll
    for (int j = 0; j < 4; ++j) {
        va[j] = va[j] * ra * sc[j] + sh[j]; vb[j] = vb[j] * rb * sc[j] + sh[j];
#pragma unroll
        for (int i = 0; i < 4; ++i) { const int off = (i & 1) ? off1 : off0; const LAS f32x4* wp = (const LAS f32x4*)(W16 + (j * 4 + i) * 64 * 20 + off); const float ha = va[j][i], hb = vb[j][i];
#pragma unroll
            for (int q = 0; q < 4; ++q) { const f32x4 w = wp[q];
                g0[4 * q + 0] += ha * w[0]; g0[4 * q + 1] += ha * w[1]; g0[4 * q + 2] += ha * w[2]; g0[4 * q + 3] += ha * w[3];
                g1[4 * q + 0] += hb * w[0]; g1[4 * q + 1] += hb * w[1]; g1[4 * q + 2] += hb * w[2]; g1[4 * q + 3] += hb * w[3]; }
            if (i & 1) asm volatile("" : "+v"(off1), "+v"(g0[0]), "+v"(g0[1]), "+v"(g0[2]), "+v"(g0[3]), "+v"(g0[4]), "+v"(g0[5]), "+v"(g0[6]), "+v"(g0[7]), "+v"(g0[8]), "+v"(g0[9]), "+v"(g0[10]), "+v"(g0[11]), "+v"(g0[12]), "+v"(g0[13]), "+v"(g0[14]), "+v"(g0[15])); else asm volatile("" : "+v"(off0), "+v"(g0[0]), "+v"(g0[1]), "+v"(g0[2]), "+v"(g0[3]), "+v"(g0[4]), "+v"(g0[5]), "+v"(g0[6]), "+v"(g0[7]), "+v"(g0[8]), "+v"(g0[9]), "+v"(g0[10]), "+v"(g0[11]), "+v"(g0[12]), "+v"(g0[13]), "+v"(g0[14]), "+v"(g0[15]));
            asm volatile("" : "+v"(g1[0]), "+v"(g1[1]), "+v"(g1[2]), "+v"(g1[3]), "+v"(g1[4]), "+v"(g1[5]), "+v"(g1[6]), "+v"(g1[7]), "+v"(g1[8]), "+v"(g1[9]), "+v"(g1[10]), "+v"(g1[11]), "+v"(g1[12]), "+v"(g1[13]), "+v"(g1[14]), "+v"(g1[15])); }
    }
    ga = reduce16(g0, lane); gb = reduce16(g1, lane);
}
__device__ __forceinline__ void store_row_bf16(bf16_t* orow, const f32x4 (&v)[4], int lane) {
#pragma unroll
    for (int j = 0; j < 4; ++j) { u32x2 o; o.x = pkbf(v[j][0], v[j][1]); o.y = pkbf(v[j][2], v[j][3]); *(u32x2*)(orow + 4 * lane + 256 * j) = o; }
}
__device__ __forceinline__ void p1_build(const Args& a, LAS unsigned char* lds, int b, int tid) {
    const float* mr = (const float*)(a.ws + WS_MOD) + b * 6144; const float* n1w = a.in[6]; const float* Wg = a.in[8] + NPROJ; const float* bg = a.in[9];
    LAS bf16_t* WB = (LAS bf16_t*)lds; LAS float* SC = (LAS float*)(lds + 32768); LAS float* SH = (LAS float*)(lds + 36864); LAS float* CP = (LAS float*)(lds + 40960);
    for (int c = tid; c < D; c += NTHREADS) {
        const float scv = n1w[c] * (1.f + mr[D + c]); SC[c] = scv; SH[c] = mr[c];
        const int fi = ((c >> 6) * 2 + ((c >> 5) & 1)) * 64 + ((c >> 3) & 3) * 16, ee = c & 7;
#pragma unroll
        for (int j = 0; j < 4; ++j) { const f32x4 w = *(const f32x4*)(Wg + (size_t)c * INC + 4 * j);
#pragma unroll
            for (int i = 0; i < 4; ++i) WB[((fi + 4 * j + i) << 3) + ee] = (bf16_t)(pkbf(scv * w[i], 0.f) & 0xffffu); }
    }
    { const int e = tid & 15, part = tid >> 4; float cb = 0.f;
#pragma unroll 16
        for (int i = 0; i < 32; ++i) { const int c = part * 32 + i; cb += mr[c] * Wg[(size_t)c * INC + e]; }
        CP[part * 16 + e] = cb; }
    __syncthreads();
    if (tid < 16) { float t = bg[tid]; for (int p = 0; p < 32; ++p) t += CP[p * 16 + tid]; CP[512 + tid] = t; }
    __syncthreads();
}
#define P1_ROWPTR(m) ((m) < MT ? a.in[0] + (size_t)(m) * D : a.in[2] + (size_t)((m) - MT) * D)
__device__ __forceinline__ void p1_tiles(const Args& a, LAS unsigned char* lds, int row_base, int ntiles) {
    const int tid = threadIdx.x, lane = tid & 63, wave = tid >> 6, fr = lane & 15, kq = lane >> 4;
    const LAS bf16_t* WB = (const LAS bf16_t*)lds; const LAS float* SC = (const LAS float*)(lds + 32768); const LAS float* SH = (const LAS float*)(lds + 36864); const LAS float* CP = (const LAS float*)(lds + 40960);
    bf16_t* HX = (bf16_t*)(a.ws + WS_HX); float* GATES = (float*)(a.ws + WS_GATES);
    const float cbe = CP[512 + fr]; const bool isf = ((fr >> 2) & 1) != 0;
#pragma unroll 1
    for (int t0 = wave; t0 < ntiles; t0 += NWAVES) {
        int row = row_base + 8 * t0 + (lane & 7); asm volatile("" : "+v"(row));
        const int cl = 8 * (4 * ((lane >> 3) & 1) + kq);
        const float* xp = P1_ROWPTR(row) + cl;
        f32x4 xv[32];
#pragma unroll
        for (int s = 0; s < 16; ++s) { xv[2 * s] = __builtin_nontemporal_load((const f32x4*)(xp + 64 * s)); xv[2 * s + 1] = __builtin_nontemporal_load((const f32x4*)(xp + 64 * s + 4)); }
        f32x4 acc0 = {0.f, 0.f, 0.f, 0.f}, acc1 = {0.f, 0.f, 0.f, 0.f}; float ss = 0.f;
        int boff = lane * 8, coff = cl; asm volatile("" : "+v"(boff), "+v"(coff));
#pragma unroll
        for (int g = 0; g < 4; ++g) {
            bf16x8 B0[4], B1[4];
#pragma unroll
            for (int i = 0; i < 4; ++i) { B0[i] = *(const LAS bf16x8*)(WB + boff + (4 * g + i) * 1024); B1[i] = *(const LAS bf16x8*)(WB + boff + (4 * g + i) * 1024 + 512); }
#pragma unroll
            for (int i = 0; i < 4; ++i) { const f32x4 v0 = xv[8 * g + 2 * i], v1 = xv[8 * g + 2 * i + 1];
                u32x4 pk; pk.x = pkbf(v0[0], v0[1]); pk.y = pkbf(v0[2], v0[3]); pk.z = pkbf(v1[0], v1[1]); pk.w = pkbf(v1[2], v1[3]);
                const bf16x8 A = __builtin_bit_cast(bf16x8, pk);
                acc0 = mfma16(A, B0[i], acc0); acc1 = mfma16(A, B1[i], acc1);
                ss += (v0[0] * v0[0] + v0[1] * v0[1]) + (v0[2] * v0[2] + v0[3] * v0[3]) + (v1[0] * v1[0] + v1[1] * v1[1]) + (v1[2] * v1[2] + v1[3] * v1[3]); }
            asm volatile("" : "+v"(boff), "+v"(acc0), "+v"(acc1));
        }
        ss += __shfl_xor(ss, 8); ss += __shfl_xor(ss, 16); ss += __shfl_xor(ss, 32);
        const float rstd = rsqrtf(ss * (1.f / D) + EPS);
#pragma unroll
        for (int i = 0; i < 4; ++i) {
            float gv = (acc0[i] + __shfl_xor(acc1[i], 32)) * __shfl(rstd, (4 * kq + i) & 7) + cbe;
            if (isf) gv = logsig_f(gv);
            if (lane < 32) GATES[(size_t)(row_base + 8 * t0 + 4 * kq + i) * 16 + fr] = gv;
        }
        bf16_t* hp = HX + (size_t)row * D + cl;
#pragma unroll
        for (int s = 0; s < 16; ++s) {
            const int c0 = 64 * s + coff;
            const f32x4 s0 = *(const LAS f32x4*)(SC + c0), s1 = *(const LAS f32x4*)(SC + c0 + 4), h0 = *(const LAS f32x4*)(SH + c0), h1 = *(const LAS f32x4*)(SH + c0 + 4);
            const f32x4 o0 = xv[2 * s] * rstd * s0 + h0, o1 = xv[2 * s + 1] * rstd * s1 + h1;
            u32x4 o; o.x = pkbf(o0[0], o0[1]); o.y = pkbf(o0[2], o0[3]); o.z = pkbf(o1[0], o1[1]); o.w = pkbf(o1[2], o1[3]);
            *(u32x4*)(hp + 64 * s) = o;
        }
    }
}
__device__ __forceinline__ void phase1(const Args& a, LAS unsigned char* lds) {
    const int tid = threadIdx.x, c = blockIdx.x;
    for (int pm = c; pm < 256; pm += gridDim.x) {
        p1_build(a, lds, pm >> 4, tid);
        p1_tiles(a, lds, pm * 256, 32);
        __syncthreads();
        p1_build(a, lds, 16, tid);
        p1_tiles(a, lds, MT + pm * 16, 2);
        __syncthreads();
    }
}
#undef P1_ROWPTR

struct SeqOrder {
    int pm0, nN, n;
    __device__ __forceinline__ bool next(int i, Unit& u) const { if (i >= n) return false; u.pm = pm0 + i / nN; u.pn = i % nN; return true; }
    __device__ __forceinline__ void a_ready(const Unit&) const {}
    __device__ __forceinline__ void done(const Unit&) const {}
};
struct P2TwoPass {
    int G, c;
    static __device__ __forceinline__ void unit(int L, int nM, int nN, Unit& u) {
        const int nwg = nM * nN; int wgid = L; { const int q = nwg / pg8::NXCD, r = nwg % pg8::NXCD, xcd = wgid % pg8::NXCD, off = wgid / pg8::NXCD; wgid = (xcd < r ? xcd * (q + 1) : r * (q + 1) + (xcd - r) * q) + off; }
        const int nig = pg8::WGM * nN, gid = wgid / nig, fm = gid * pg8::WGM, gsz = (nM - fm) < pg8::WGM ? (nM - fm) : pg8::WGM;
        u.pm = fm + ((wgid % nig) % gsz); u.pn = (wgid % nig) / gsz;
    }
    __device__ __forceinline__ bool next(int i, Unit& u) const {
        int L = i * G + c; constexpr int nL = MT / 256, NA = nL * 4, CA = 32, NB = nL * 7, CB = 48;
        if (L < NA) { unit(L, nL, 4, u); u.pn += 7; return true; }
        L -= NA; if (L < CA) { u.pm = nL + (L >> 1); u.pn = 7 + (L & 1); return true; }
        L -= CA; if (L < NB) { unit(L, nL, 7, u); return true; }
        L -= NB; if (L < CB) { const int t = L % 3; u.pm = nL + L / 3; u.pn = t == 0 ? 2 : 4 + t; return true; }
        return false;
    }
    __device__ __forceinline__ void a_ready(const Unit&) const {}
    __device__ __forceinline__ void done(const Unit&) const {}
};
struct EpiProj {
    static constexpr bool PERM = true, AFTER_DRAIN = false;
    bf16_t *Q, *KK, *VV, *M4; const float *qw, *kw, *rope; float qscale;
    __device__ __forceinline__ void operator()(const f32x4 (&acc)[2][2][4][2], const Unit& u, int wr, int wc, int fr, int fq) const {
        const int pn = u.pn, row0 = u.pm * 256 + wr * 64 + fr;
        bf16_t *Q_ = Q, *KK_ = KK, *VV_ = VV, *M4_ = M4; asm volatile("" : "+s"(Q_), "+s"(KK_), "+s"(VV_), "+s"(M4_));
        if (pn >= 3) {
            bf16_t* base = M4_ + (size_t)((pn - 3) >> 1) * MA * 512 + ((pn - 3) & 1) * 256 + wc * 32 + 8 * fq;
#pragma unroll
            for (int ai = 0; ai < 2; ++ai)
#pragma unroll
                for (int m = 0; m < 4; ++m) { bf16_t* rowp = base + (size_t)(row0 + ai * 128 + m * 16) * 512;
#pragma unroll
                    for (int bj = 0; bj < 2; ++bj) { const f32x4 v0 = acc[ai][bj][m][0], v1 = acc[ai][bj][m][1]; u32x4 w; w.x = pkbf(v0[0], v0[1]); w.y = pkbf(v0[2], v0[3]); w.z = pkbf(v1[0], v1[1]); w.w = pkbf(v1[2], v1[3]);
                        *(u32x4*)(rowp + bj * 128) = w; } }
            return;
        }
        const bool latent = u.pm < 256;
        if (pn < 2 && !latent) return;
        const bool isv = (pn == 2) && (wc >= 2);
        bf16_t* dst; int ld; const float* nw; float osc = 1.f;
        if (pn < 2) { dst = Q_ + (4 * pn + wc) * 64; ld = 512; nw = qw; osc = qscale; }
        else if (!isv) { dst = KK_ + wc * 64; ld = 128; nw = kw; }
        else { dst = VV_ + (wc - 2) * 64; ld = 128; nw = kw; }
        f32x4 w4[2][2];
#pragma unroll
        for (int bj = 0; bj < 2; ++bj)
#pragma unroll
            for (int n = 0; n < 2; ++n) w4[bj][n] = *(const f32x4*)(nw + 32 * bj + 8 * fq + 4 * n);
#pragma unroll
        for (int ai = 0; ai < 2; ++ai)
#pragma unroll
            for (int m = 0; m < 4; ++m) {
                const int row = row0 + ai * 128 + m * 16;
                f32x4 y[2][2];
#pragma unroll
                for (int bj = 0; bj < 2; ++bj)
#pragma unroll
                    for (int n = 0; n < 2; ++n) y[bj][n] = acc[ai][bj][m][n];
                if (!isv) {
                    float ss = 0.f;
#pragma unroll
                    for (int bj = 0; bj < 2; ++bj)
#pragma unroll
                        for (int n = 0; n < 2; ++n) ss += (y[bj][n][0] * y[bj][n][0] + y[bj][n][1] * y[bj][n][1]) + (y[bj][n][2] * y[bj][n][2] + y[bj][n][3] * y[bj][n][3]);
                    ss += __shfl_xor(ss, 16); ss += __shfl_xor(ss, 32);
                    const float rinv = rsqrtf(ss * (1.f / 64.f) + EPS);
#pragma unroll
                    for (int bj = 0; bj < 2; ++bj)
#pragma unroll
                        for (int n = 0; n < 2; ++n) y[bj][n] = y[bj][n] * rinv * w4[bj][n];
                    if (latent) {
                        const int ntok = row & (NT - 1); const int pos = (fq < 2) ? (ntok >> 6) : (ntok & 63);
                        const float* rp = rope + pos * 16 + 8 * (fq & 1);
#pragma unroll
                        for (int n = 0; n < 2; ++n) { const f32x4 cs = *(const f32x4*)(rp + 4 * n), sn = *(const f32x4*)(rp + 1024 + 4 * n);
                            const f32x4 x1 = y[0][n], x2 = y[1][n]; y[0][n] = x1 * cs - x2 * sn; y[1][n] = x2 * cs + x1 * sn; }
                    }
                }
                bf16_t* rowp = dst + (size_t)row * ld + 8 * fq;
#pragma unroll
                for (int bj = 0; bj < 2; ++bj) { const f32x4 v0 = y[bj][0] * osc, v1 = y[bj][1] * osc; u32x4 w; w.x = pkbf(v0[0], v0[1]); w.y = pkbf(v0[2], v0[3]); w.z = pkbf(v1[0], v1[1]); w.w = pkbf(v1[2], v1[3]);
                    *(u32x4*)(rowp + 32 * bj) = w; }
            }
    }
};
struct EpiOut {
    static constexpr bool PERM = true, AFTER_DRAIN = false;
    const float* x; const float* mod; bf16_t* X1;
    __device__ __forceinline__ void operator()(const f32x4 (&acc)[2][2][4][2], const Unit& u, int wr, int wc, int fr, int fq) const {
        typedef const float __attribute__((address_space(1))) GF; typedef bf16_t __attribute__((address_space(1))) GB; typedef const f32x4 __attribute__((address_space(1))) GF4; typedef u32x4 __attribute__((address_space(1))) GU4;
        const int row0 = u.pm * 256 + wr * 64 + fr, col0 = u.pn * 256 + wc * 32 + 8 * fq;
        const float* x_ = x; bf16_t* out_ = X1; asm volatile("" : "+s"(x_), "+s"(out_));
        GF* xg = (GF*)x_ + (size_t)row0 * D + col0; GB* og = (GB*)out_ + (size_t)row0 * D + col0;
        const float* g1 = mod + (u.pm >> 4) * 6144 + 2 * D;
        f32x4 gv[2][2];
#pragma unroll
        for (int bj = 0; bj < 2; ++bj)
#pragma unroll
            for (int n = 0; n < 2; ++n) gv[bj][n] = *(const f32x4*)(g1 + col0 + bj * 128 + n * 4);
        f32x4 xr[8][2][2];
#define MK_EO_LD(b) do { const size_t off = (size_t)(((b) >> 2) * 128 + ((b) & 3) * 16) * D; _Pragma("unroll") for (int bj = 0; bj < 2; ++bj) { xr[b][bj][0] = __builtin_nontemporal_load((GF4*)(xg + off + bj * 128)); xr[b][bj][1] = __builtin_nontemporal_load((GF4*)(xg + off + bj * 128 + 4)); } } while (0)
        MK_EO_LD(0); MK_EO_LD(1); MK_EO_LD(2); MK_EO_LD(3);
#pragma unroll
        for (int b = 0; b < 8; ++b) {
            const int ai = b >> 2, m = b & 3; const size_t off = (size_t)(ai * 128 + m * 16) * D;
#pragma unroll
            for (int bj = 0; bj < 2; ++bj) { const f32x4 o0 = xr[b][bj][0] + gv[bj][0] * acc[ai][bj][m][0], o1 = xr[b][bj][1] + gv[bj][1] * acc[ai][bj][m][1];
                u32x4 w; w.x = pkbf(o0[0], o0[1]); w.y = pkbf(o0[2], o0[3]); w.z = pkbf(o1[0], o1[1]); w.w = pkbf(o1[2], o1[3]);
                *(GU4*)(og + off + bj * 128) = w; }
            if (b + 4 < 8) { switch (b) { case 0: MK_EO_LD(4); break; case 1: MK_EO_LD(5); break; case 2: MK_EO_LD(6); break; default: MK_EO_LD(7); break; } }
        }
#undef MK_EO_LD
    }
};
struct EpiAct {
    static constexpr bool PERM = true, AFTER_DRAIN = false;
    unsigned char* ACT;
    __device__ __forceinline__ void operator()(const f32x4 (&acc)[2][2][4][2], const Unit& u, int wr, int wc, int fr, int fq) const {
        const int row0 = u.pm * 256 + wr * 64 + fr, col0 = u.pn * 128 + wc * 32 + 8 * fq;
        unsigned char* ACT_ = ACT; asm volatile("" : "+s"(ACT_));
#pragma unroll
        for (int ai = 0; ai < 2; ++ai)
#pragma unroll
            for (int m = 0; m < 4; ++m) { f32x4 o[2];
#pragma unroll
                for (int n = 0; n < 2; ++n) { const f32x4 gt = acc[ai][0][m][n], up = acc[ai][1][m][n];
#pragma unroll
                    for (int j = 0; j < 4; ++j) o[n][j] = silu_f(gt[j] * (1.f / FP8_W_UP)) * (up[j] * (1.f / FP8_W_UP)); }
                u32x2 w; w.x = pk4_fp8(o[0][0], o[0][1], o[0][2], o[0][3]); w.y = pk4_fp8(o[1][0], o[1][1], o[1][2], o[1][3]);
                *(u32x2*)(ACT_ + (size_t)(row0 + ai * 128 + m * 16) * FF + col0) = w; asm volatile("" ::: "memory"); }
    }
};
struct EpiDown {
    static constexpr bool PERM = true, AFTER_DRAIN = false;
    unsigned char* Y; const LAS float* gate; float SC;
    __device__ __forceinline__ void operator()(const f32x4 (&acc)[2][2][4][2], const Unit& u, int wr, int wc, int fr, int fq) const {
        const int row0 = u.pm * 256 + wr * 64 + fr, col0 = u.pn * 256 + wc * 32 + 8 * fq;
        unsigned char* Y_ = Y; const LAS float* gate_ = gate; asm volatile("" : "+s"(Y_));
        typedef unsigned v2u_t __attribute__((__vector_size__(8)));
        const __amdgpu_buffer_rsrc_t rs = __builtin_amdgcn_make_buffer_rsrc((void*)Y_, 0, -1, 0x00020000);
#pragma unroll
        for (int ai = 0; ai < 2; ++ai)
#pragma unroll
            for (int m = 0; m < 4; ++m) { const int row = row0 + ai * 128 + m * 16; const float gt = gate_[row] * SC;
#pragma unroll
                for (int bj = 0; bj < 2; ++bj) { f32x4 v0 = acc[ai][bj][m][0] * gt, v1 = acc[ai][bj][m][1] * gt;
                    u32x2 w; w.x = pk4_fp8(v0[0], v0[1], v0[2], v0[3]); w.y = pk4_fp8(v1[0], v1[1], v1[2], v1[3]);
                    __builtin_amdgcn_raw_buffer_store_b64(__builtin_bit_cast(v2u_t, w), rs, row * D + col0 + bj * 128, 0, 0); } asm volatile("" ::: "memory"); }
    }
};

__device__ __forceinline__ void conv_rows(const Args& a) {
    const int tid = threadIdx.x, lane = tid & 63, wave = tid >> 6;
    const bf16_t* MQ = (const bf16_t*)(a.ws + WS_M4); const bf16_t* MK = MQ + (size_t)MA * 512;
    bf16_t* CQ = (bf16_t*)(a.ws + WS_CQ); bf16_t* CK = (bf16_t*)(a.ws + WS_CK);
    const float* conv = a.in[10];
    f32x4 wq[3][2], wk[3][2];
#pragma unroll
    for (int j = 0; j < 3; ++j) { wq[j][0] = *(const f32x4*)(conv + j * 1024 + 8 * lane); wq[j][1] = *(const f32x4*)(conv + j * 1024 + 8 * lane + 4);
        wk[j][0] = *(const f32x4*)(conv + j * 1024 + 512 + 8 * lane); wk[j][1] = *(const f32x4*)(conv + j * 1024 + 512 + 8 * lane + 4); }
    const int gw = blockIdx.x * NWAVES + wave, NGW = gridDim.x * NWAVES;
    const int per = (MA + NGW - 1) / NGW; const int r0 = gw * per, r1 = min(MA, r0 + per);
    if (r0 >= r1) return;
    const u32x4 zero = {0u, 0u, 0u, 0u};
#define CV_POS(m) ((m) < MT ? ((m) & (NT - 1)) : (((m) - MT) & (NL - 1)))
#define CV_LEN(m) ((m) < MT ? NT : NL)
#define CV_LD(dst, buf, m) do { dst = ((m) >= 0 && (m) < MA) ? __builtin_nontemporal_load((const u32x4*)(buf + (size_t)(m) * 512 + 8 * lane)) : zero; } while (0)
#define CV_LDQ(dst, m) do { dst = ((m) >= 0 && (m) < MT) ? __builtin_nontemporal_load((const u32x4*)(MQ + (size_t)(m) * 512 + 8 * lane)) : zero; } while (0)
    u32x4 wq_[6], wk_[6], nq_[4], nk_[4];
#pragma unroll
    for (int i = 0; i < 6; ++i) { CV_LDQ(wq_[i], r0 - 1 + i); CV_LD(wk_[i], MK, r0 - 1 + i); }
#pragma unroll 1
    for (int m = r0; m < r1; m += 4) {
#pragma unroll
        for (int i = 0; i < 4; ++i) { CV_LDQ(nq_[i], m + 5 + i); CV_LD(nk_[i], MK, m + 5 + i); }
#pragma unroll
        for (int u = 0; u < 4; ++u) {
            const int mm = m + u;
            if (mm < r1) {
                const int p = CV_POS(mm), len = CV_LEN(mm); const bool first = (p == 0), last = (p == len - 1);
                const u32x4 qp = wq_[u], qc = wq_[u + 1], qn = wq_[u + 2], kp = wk_[u], kc = wk_[u + 1], kn = wk_[u + 2];
                u32x4 oq, ok;
#pragma unroll
                for (int e = 0; e < 4; ++e) {
                    const float ql0 = first ? 0.f : bflo(qp[e]), qh0 = first ? 0.f : bfhi(qp[e]), ql2 = last ? 0.f : bflo(qn[e]), qh2 = last ? 0.f : bfhi(qn[e]);
                    const float kl0 = first ? 0.f : bflo(kp[e]), kh0 = first ? 0.f : bfhi(kp[e]), kl2 = last ? 0.f : bflo(kn[e]), kh2 = last ? 0.f : bfhi(kn[e]);
                    const int h2 = e >> 1, i0 = (2 * e) & 3, i1 = (2 * e + 1) & 3;
                    const float uq0 = silu_f(ql0 * wq[0][h2][i0] + bflo(qc[e]) * wq[1][h2][i0] + ql2 * wq[2][h2][i0]) * 0.08838834764831845f;
                    const float uq1 = silu_f(qh0 * wq[0][h2][i1] + bfhi(qc[e]) * wq[1][h2][i1] + qh2 * wq[2][h2][i1]) * 0.08838834764831845f;
                    const float uk0 = silu_f(kl0 * wk[0][h2][i0] + bflo(kc[e]) * wk[1][h2][i0] + kl2 * wk[2][h2][i0]);
                    const float uk1 = silu_f(kh0 * wk[0][h2][i1] + bfhi(kc[e]) * wk[1][h2][i1] + kh2 * wk[2][h2][i1]);
                    oq[e] = pkbf(uq0, uq1); ok[e] = pkbf(uk0, uk1);
                }
                if (mm < MT) *(u32x4*)(CQ + (size_t)mm * 512 + 8 * lane) = oq;
                *(u32x4*)(CK + (size_t)mm * 512 + 8 * lane) = ok;
            }
        }
        wq_[0] = wq_[4]; wq_[1] = wq_[5]; wk_[0] = wk_[4]; wk_[1] = wk_[5];
#pragma unroll
        for (int i = 0; i < 4; ++i) { wq_[2 + i] = nq_[i]; wk_[2 + i] = nk_[i]; }
    }
#undef CV_LD
#undef CV_POS
#undef CV_LEN
}

constexpr int AT_STRIDE = 72;
constexpr int AT_K = 0, AT_V = 384 * AT_STRIDE * 2;
__device__ __forceinline__ void attn_tile(const LAS bf16_t* AK, const LAS bf16_t* AV, int kb, bool masked, int kpos_base  , int qpos0  ,
                                          const bf16x8 (&Qf)[4][2], f32x4 (&O)[4][4], float (&ls)[4], float cshift, int fr, int fq) {
    const int q4 = fr >> 2, p4 = fr & 3;
#pragma unroll
    for (int kk2 = 0; kk2 < 2; ++kk2) {
        f32x4 S[2][4];
#pragma unroll
        for (int hh = 0; hh < 2; ++hh) {
            const LAS bf16_t* kp = AK + (kb + 32 * kk2 + 16 * hh + fr) * AT_STRIDE + 8 * fq;
            const bf16x8 A0 = *(const LAS bf16x8*)kp, A1 = *(const LAS bf16x8*)(kp + 32);
#pragma unroll
            for (int qt = 0; qt < 4; ++qt) { f32x4 z = {-cshift, -cshift, -cshift, -cshift}; z = mfma16(A0, Qf[qt][0], z); S[hh][qt] = mfma16(A1, Qf[qt][1], z); }
        }
        if (masked) {
#pragma unroll
            for (int hh = 0; hh < 2; ++hh)
#pragma unroll
                for (int qt = 0; qt < 4; ++qt)
#pragma unroll
                    for (int r = 0; r < 4; ++r) {
                        float p = __builtin_amdgcn_exp2f(S[hh][qt][r]);
                        const int kpos = kpos_base + kb + 32 * kk2 + 16 * hh + 4 * fq + r, qpos = qpos0 + 16 * qt + fr; const int dd = kpos - qpos;
                        if (kpos < 0 || kpos >= NT || dd > 128 || dd < -128) p = 0.f;
                        ls[qt] += p; S[hh][qt][r] = p;
                    }
        } else {
#pragma unroll
            for (int hh = 0; hh < 2; ++hh)
#pragma unroll
                for (int qt = 0; qt < 4; ++qt)
#pragma unroll
                    for (int r = 0; r < 4; ++r) { const float p = __builtin_amdgcn_exp2f(S[hh][qt][r]); ls[qt] += p; S[hh][qt][r] = p; }
        }
        bf16x8 Bp[4];
#pragma unroll
        for (int qt = 0; qt < 4; ++qt) Bp[qt] = pack8(S[0][qt], S[1][qt]);
#pragma unroll
        for (int dt = 0; dt < 4; ++dt) {
            const LAS bf16_t* vp = AV + (kb + 32 * kk2 + 4 * fq + q4) * AT_STRIDE + 16 * dt + 4 * p4;
            const bf16x8 A = tr2(vp, vp + 16 * AT_STRIDE);
#pragma unroll
            for (int qt = 0; qt < 4; ++qt) O[dt][qt] = mfma16(A, Bp[qt], O[dt][qt]);
        }
    }
}
__device__ __forceinline__ void attn_qk(const LAS bf16_t* AK, int krow, const bf16x8 (&Qf)[4][2], float cshift, int fr, int fq, f32x4 (&S)[2][4]) {
#pragma unroll
    for (int hh = 0; hh < 2; ++hh) {
        const LAS bf16_t* kp = AK + (krow + 16 * hh + fr) * AT_STRIDE + 8 * fq;
        const bf16x8 A0 = *(const LAS bf16x8*)kp, A1 = *(const LAS bf16x8*)(kp + 32);
#pragma unroll
        for (int qt = 0; qt < 4; ++qt) { f32x4 z = {-cshift, -cshift, -cshift, -cshift}; z = mfma16(A0, Qf[qt][0], z); S[hh][qt] = mfma16(A1, Qf[qt][1], z); }
    }
}
__device__ __forceinline__ void attn_pv(const LAS bf16_t* AV, int krow, bool masked, int kpos0  , int qpos0, f32x4 (&S)[2][4], f32x4 (&O)[4][4], float (&ls)[4], int fr, int fq) {
    const int q4 = fr >> 2, p4 = fr & 3;
    if (masked) {
#pragma unroll
        for (int hh = 0; hh < 2; ++hh)
#pragma unroll
            for (int qt = 0; qt < 4; ++qt)
#pragma unroll
                for (int r = 0; r < 4; ++r) {
                    float p = __builtin_amdgcn_exp2f(S[hh][qt][r]);
                    const int kpos = kpos0 + 16 * hh + 4 * fq + r, qpos = qpos0 + 16 * qt + fr; const int dd = kpos - qpos;
                    if (kpos < 0 || kpos >= NT || dd > 128 || dd < -128) p = 0.f;
                    ls[qt] += p; S[hh][qt][r] = p;
                }
    } else {
#pragma unroll
        for (int hh = 0; hh < 2; ++hh)
#pragma unroll
            for (int qt = 0; qt < 4; ++qt)
#pragma unroll
                for (int r = 0; r < 4; ++r) { const float p = __builtin_amdgcn_exp2f(S[hh][qt][r]); ls[qt] += p; S[hh][qt][r] = p; }
    }
    bf16x8 Bp[4];
#pragma unroll
    for (int qt = 0; qt < 4; ++qt) Bp[qt] = pack8(S[0][qt], S[1][qt]);
#pragma unroll
    for (int dt = 0; dt < 4; ++dt) {
        const LAS bf16_t* vp = AV + (krow + 4 * fq + q4) * AT_STRIDE + 16 * dt + 4 * p4;
        const bf16x8 A = tr2(vp, vp + 16 * AT_STRIDE);
#pragma unroll
        for (int qt = 0; qt < 4; ++qt) O[dt][qt] = mfma16(A, Bp[qt], O[dt][qt]);
    }
}
__device__ __forceinline__ void attn_pass(const LAS bf16_t* AK, const LAS bf16_t* AV, int krow0, int nsteps, bool edge, bool local, int kpos_base, int qpos0,
                                          const bf16x8 (&Qf)[4][2], f32x4 (&O)[4][4], float (&ls)[4], float cshift, int fr, int fq) {
    f32x4 SA[2][4], SB[2][4];
    attn_qk(AK, krow0, Qf, cshift, fr, fq, SA);
#pragma unroll 1
    for (int s = 0; s < nsteps; s += 2) {
        const int jt = s >> 1; const bool msk = local && (edge || jt == 0 || jt == (nsteps >> 1) - 1);
        const int kr = krow0 + 32 * s;
        attn_qk(AK, kr + 32, Qf, cshift, fr, fq, SB);
        attn_pv(AV, kr, msk, kpos_base + kr, qpos0, SA, O, ls, fr, fq);
        if (s + 2 < nsteps) attn_qk(AK, kr + 64, Qf, cshift, fr, fq, SA);
        attn_pv(AV, kr + 32, msk, kpos_base + kr + 32, qpos0, SB, O, ls, fr, fq);
    }
}
__device__ __forceinline__ void attn_item(const Args& a, LAS unsigned char* lds, int item) {
    const int tid = threadIdx.x, lane = tid & 63, w = __builtin_amdgcn_readfirstlane(tid >> 6), fr = lane & 15, fq = lane >> 4;
    const int qblk = item & 31, kvh = (item >> 5) & 1, b = item >> 6;
    const int g = w >> 1, qh = w & 1, head = 4 * kvh + g;
    const bf16_t* Q = (const bf16_t*)(a.ws + WS_Q); const bf16_t* KK = (const bf16_t*)(a.ws + WS_KK); const bf16_t* VV = (const bf16_t*)(a.ws + WS_VV);
    bf16_t* MIX = (bf16_t*)(a.ws + WS_MIX);
    LAS bf16_t* AK = (LAS bf16_t*)(lds + AT_K); LAS bf16_t* AV = (LAS bf16_t*)(lds + AT_V);
    const float cshift = ((const float*)(a.ws + WS_MISC))[0];
    const int qpos0 = 128 * qblk + 64 * qh;
    bf16x8 Qf[4][2];
    int fq0 = fq; asm volatile("" : "+v"(fq0));
#pragma unroll
    for (int qt = 0; qt < 4; ++qt) { const bf16_t* qp = Q + (size_t)(b * NT + qpos0 + 16 * qt + fr) * 512 + head * 64 + 8 * fq0; Qf[qt][0] = *(const bf16x8*)qp; Qf[qt][1] = *(const bf16x8*)(qp + 32); }
    f32x4 O[4][4]; float ls[4];
#pragma unroll
    for (int dt = 0; dt < 4; ++dt)
#pragma unroll
        for (int qt = 0; qt < 4; ++qt) O[dt][qt] = (f32x4){0.f, 0.f, 0.f, 0.f};
#pragma unroll
    for (int qt = 0; qt < 4; ++qt) ls[qt] = 0.f;
    const int kpos_base = 128 * qblk - 128;
    int tids = tid; asm volatile("" : "+v"(tids));
    { u32x4 sk[6], sv_[6];
#pragma unroll
      for (int j = 0; j < 6; ++j) { const int i = tids + NTHREADS * j, r = i >> 3, c = i & 7; int kp = kpos_base + r; kp = kp < 0 ? 0 : (kp > NT - 1 ? NT - 1 : kp);
          const size_t src = (size_t)(b * NT + kp) * 128 + kvh * 64 + 8 * c; sk[j] = *(const u32x4*)(KK + src); sv_[j] = *(const u32x4*)(VV + src); }
#pragma unroll
      for (int j = 0; j < 6; ++j) { const int i = tid + NTHREADS * j, r = i >> 3, c = i & 7; *(LAS u32x4*)(AK + r * AT_STRIDE + 8 * c) = sk[j]; *(LAS u32x4*)(AV + r * AT_STRIDE + 8 * c) = sv_[j]; } }
    __syncthreads();
    const bool edge = (qblk == 0) || (qblk == 31);
    attn_pass(AK, AV, 64 * qh, 10, edge, true, kpos_base, qpos0, Qf, O, ls, cshift, fr, fq);
    __syncthreads();
    { u32x4 sk[4], sv_[4];
#pragma unroll
      for (int j = 0; j < 4; ++j) { const int i = tid + NTHREADS * j, r = i >> 3, c = i & 7; const size_t src = (size_t)(MT + b * NL + r) * 128 + kvh * 64 + 8 * c; sk[j] = *(const u32x4*)(KK + src); sv_[j] = *(const u32x4*)(VV + src); }
#pragma unroll
      for (int j = 0; j < 4; ++j) { const int i = tid + NTHREADS * j, r = i >> 3, c = i & 7; *(LAS u32x4*)(AK + r * AT_STRIDE + 8 * c) = sk[j]; *(LAS u32x4*)(AV + r * AT_STRIDE + 8 * c) = sv_[j]; } }
    __syncthreads();
    attn_pass(AK, AV, 0, 8, false, false, 0, qpos0, Qf, O, ls, cshift, fr, fq);
    __syncthreads();
    const float psink = __builtin_amdgcn_exp2f(a.in[13][head] * LOG2E - cshift);
    int fql = fq, frl = fr; asm volatile("" : "+v"(fql), "+v"(frl));
#pragma unroll
    for (int qt = 0; qt < 4; ++qt) {
        float l = ls[qt]; l += __shfl_xor(l, 16); l += __shfl_xor(l, 32); const float inv = 1.f / (l + psink);
        bf16_t* op = MIX + (size_t)(b * NT + qpos0 + 16 * qt + frl) * D + head * 64 + 4 * fql;
#pragma unroll
        for (int dt = 0; dt < 4; ++dt) { const f32x4 o = O[dt][qt] * inv; u32x2 wv; wv.x = pkbf(o[0], o[1]); wv.y = pkbf(o[2], o[3]); *(u32x2*)(op + 16 * dt) = wv; }
    }
}

constexpr int KS_ST = 136, VS_ST = 88;
constexpr int ML_KS = 0, ML_VN = ML_KS + 128 * KS_ST * 2, ML_VW = ML_VN + 128 * VS_ST * 2, ML_CN = ML_VW + 128 * VS_ST * 2, ML_F = ML_CN + 128 * VS_ST * 2, ML_CW = ML_F + 1024 * 4, ML_END = ML_CW + 768 * 4;
static_assert(ML_END <= LDS_BYTES, "mLSTM LDS map");
#define ML_GEOM(ci, seq0, seqlen, nbase) do { if ((ci) < 2) { seq0 = MT + b * NL; seqlen = NL; nbase = dir ? 128 * (1 - (ci)) : 128 * (ci); } \
    else { const int k_ = (ci) - 2; seq0 = b * NT; seqlen = NT; nbase = dir ? 128 * (31 - k_) : 128 * k_; } } while (0)
#define ML_POS(s) (dir ? nbase + 127 - (s) : nbase + (s))
__device__ __forceinline__ void mlstm_prep(const Args& a, LAS unsigned char* lds, int item, int w0, int nw) {
    const int tid = threadIdx.x, lane = tid & 63, w = __builtin_amdgcn_readfirstlane(tid >> 6);
    const int dir = (item >> 1) & 1, h = (item >> 2) & 3, b = item >> 4;
    LAS bf16_t* Vn = (LAS bf16_t*)(lds + ML_VN); LAS bf16_t* Vw = (LAS bf16_t*)(lds + ML_VW); LAS bf16_t* Cn = (LAS bf16_t*)(lds + ML_CN);
    LAS float* F = (LAS float*)(lds + ML_F); LAS float* blA = F + 192, *plA = F + 256;
    const float* GATES = (const float*)(a.ws + WS_GATES);
    float* TBL = (float*)(a.ws + WS_TBL) + (size_t)item * 34 * 384;
    for (int i = tid - 64 * w0; i < 128 * VS_ST / 2; i += 64 * nw) ((LAS unsigned*)Cn)[i] = 0u;
    for (int i = tid - 64 * w0; i < 128 * 12; i += 64 * nw) { const int s = i / 12, c = i % 12; ((LAS unsigned*)(Vn + s * VS_ST + 64))[c] = (c == 0) ? 0x00003f80u : 0u; ((LAS unsigned*)(Vw + s * VS_ST + 64))[c] = 0u; }
    float tli0[5], tlf0[5], tli1[5], tlf1[5];
#pragma unroll
    for (int j = 0; j < 5; ++j) { const int ci = w - w0 + nw * j;
        if (ci < 34) { int seq0, seqlen, nbase; ML_GEOM(ci, seq0, seqlen, nbase); (void)seqlen;
            const float* G0 = GATES + (size_t)(seq0 + ML_POS(2 * lane)) * 16 + h; const float* G1 = GATES + (size_t)(seq0 + ML_POS(2 * lane + 1)) * 16 + h;
            tli0[j] = G0[dir ? 8 : 0]; tlf0[j] = G0[dir ? 12 : 4]; tli1[j] = G1[dir ? 8 : 0]; tlf1[j] = G1[dir ? 12 : 4]; }
        else { tli0[j] = 0.f; tlf0[j] = 0.f; tli1[j] = 0.f; tlf1[j] = 0.f; } }
#pragma unroll
    for (int j = 0; j < 5; ++j) { const int ci = w - w0 + nw * j; if (ci >= 34) break;
        const int s0 = 2 * lane;
        const float li0 = tli0[j], lf0 = tlf0[j], li1 = tli1[j], lf1 = tlf1[j];
        float cs = lf0 + lf1;
#pragma unroll
        for (int o = 1; o < 64; o <<= 1) { const float y = __shfl_up(cs, o); if (lane >= o) cs += y; }
        const float b1 = cs, b0 = cs - lf1;
        const float g0 = li0 - b0, g1 = li1 - b1;
        float mx = fmaxf(g0, g1);
#pragma unroll
        for (int o = 1; o < 64; o <<= 1) { const float y = __shfl_up(mx, o); if (lane >= o) mx = fmaxf(mx, y); }
        float ex = __shfl_up(mx, 1); if (lane == 0) ex = -INFINITY;
        const float pm0 = fmaxf(ex, g0), pm1 = mx;
        float* T = TBL + ci * 384;
        typedef float f32x2t __attribute__((ext_vector_type(2)));
        *(f32x2t*)(T + s0) = (f32x2t){b0, b1}; *(f32x2t*)(T + 128 + s0) = (f32x2t){g0, g1}; *(f32x2t*)(T + 256 + s0) = (f32x2t){pm0, pm1};
        if (lane == 63) { blA[ci] = b1; plA[ci] = pm1; }
    }
}
__device__ __forceinline__ void mlstm_item(const Args& a, LAS unsigned char* lds, int item, bool prepped) {
    const int tid = threadIdx.x, lane = tid & 63, w = __builtin_amdgcn_readfirstlane(tid >> 6), fr = lane & 15, fq = lane >> 4, q4 = fr >> 2, p4 = fr & 3;
    const int vh = item & 1, dir = (item >> 1) & 1, h = (item >> 2) & 3, b = item >> 4;
    const int tw = w < 4 ? w : 11 - w;
    LAS bf16_t* Ks = (LAS bf16_t*)(lds + ML_KS); LAS bf16_t* Vn = (LAS bf16_t*)(lds + ML_VN); LAS bf16_t* Vw = (LAS bf16_t*)(lds + ML_VW); LAS bf16_t* Cn = (LAS bf16_t*)(lds + ML_CN);
    LAS float* F = (LAS float*)(lds + ML_F); LAS float* mstA = F, *aA = F + 64, *MlA = F + 128, *blA = F + 192, *plA = F + 256, *gA = F + 512; LAS float* cw = (LAS float*)(lds + ML_CW);
    const bf16_t* MQ = (const bf16_t*)(a.ws + WS_CQ); const bf16_t* MK = (const bf16_t*)(a.ws + WS_CK); const bf16_t* MV = (const bf16_t*)(a.ws + WS_M4) + (size_t)2 * MA * 512;
    const float* GATES = (const float*)(a.ws + WS_GATES);
    float* TBL = (float*)(a.ws + WS_TBL) + (size_t)item * 34 * 384;
    unsigned char* H = a.ws + (dir ? WS_HB : WS_HF);
    if (!prepped) mlstm_prep(a, lds, item, 0, NWAVES);
    __syncthreads();
    if (w == 0) {
        float m = 0.f;
#pragma unroll 1
        for (int ci = 0; ci < 34; ++ci) { const float bl = blA[ci], pl = plA[ci]; const float Ml = fmaxf(m, pl); if (lane == 0) { mstA[ci] = m; aA[ci] = expf(m - Ml); MlA[ci] = Ml; } m = bl + Ml; }
    }
    f32x4 accC[5];
#pragma unroll
    for (int vt = 0; vt < 5; ++vt) accC[vt] = (f32x4){0.f, 0.f, 0.f, 0.f};
    u32x4 kr[4], vr[2];
#define ML_LOAD_KV(cj) do { int seq0_, seqlen_, nbase_; { const int dir_ = dir; (void)dir_; (void)seqlen_; if ((cj) < 2) { seq0_ = MT + b * NL; seqlen_ = NL; nbase_ = dir ? 128 * (1 - (cj)) : 128 * (cj); } else { const int k_ = (cj) - 2; seq0_ = b * NT; seqlen_ = NT; nbase_ = dir ? 128 * (31 - k_) : 128 * k_; } } \
        _Pragma("unroll") for (int ps = 0; ps < 4; ++ps) { const int s_ = (tid >> 4) + 32 * ps, pos_ = dir ? nbase_ + 127 - s_ : nbase_ + s_; kr[ps] = *(const u32x4*)(MK + (size_t)(seq0_ + pos_) * 512 + h * 128 + 8 * (tid & 15)); } \
        _Pragma("unroll") for (int ps = 0; ps < 2; ++ps) { const int s_ = (tid >> 3) + 64 * ps, pos_ = dir ? nbase_ + 127 - s_ : nbase_ + s_; vr[ps] = *(const u32x4*)(MV + (size_t)(seq0_ + pos_) * 512 + h * 128 + vh * 64 + 8 * (tid & 7)); } } while (0)
    u32x4 qr[4]; float nbt = 0.f, npmt = 0.f;
#define ML_LOAD_Q(cj) do { int seq0_, seqlen_, nbase_; (void)seqlen_; if ((cj) < 2) { seq0_ = MT + b * NL; seqlen_ = NL; nbase_ = dir ? 128 * (1 - (cj)) : 128 * (cj); } else { const int k_ = (cj) - 2; seq0_ = b * NT; seqlen_ = NT; nbase_ = dir ? 128 * (31 - k_) : 128 * k_; } \
        const float* T_ = TBL + (cj) * 384; const int t_ = 16 * tw + fr, post_ = dir ? nbase_ + 127 - t_ : nbase_ + t_; \
        if ((cj) >= 2) { const bf16_t* qp = MQ + (size_t)(seq0_ + post_) * 512 + h * 128 + 8 * fq; \
            _Pragma("unroll") for (int kk = 0; kk < 4; ++kk) qr[kk] = *(const u32x4*)(qp + 32 * kk); \
            nbt = T_[t_]; npmt = T_[256 + t_]; } } while (0)
    ML_LOAD_KV(0);
    __syncthreads();
    ML_LOAD_Q(0);
#ifdef MK_TIME_PHASE
    unsigned long long tA_ = 0ull, tB_ = 0ull;
#endif
#pragma unroll 1
    for (int ci = 0; ci < 34; ++ci) {
        const bool isctx = ci < 2;
#ifdef MK_TIME_PHASE
        const unsigned long long t0_ = __builtin_amdgcn_s_memrealtime();
#endif
        int seq0, seqlen, nbase; ML_GEOM(ci, seq0, seqlen, nbase);
        const float mst = mstA[ci], Ml = MlA[ci], av = aA[ci];
        const float* T = TBL + ci * 384;
        const int t = 16 * tw + fr, post = ML_POS(t);
        const float bt = nbt, pmt = npmt;
        const float gv0 = T[128 + (tid >> 3)], gv1 = T[128 + (tid >> 3) + 64];
        const float gmine = tid < 128 ? T[128 + tid] : 0.f;
#pragma unroll
        for (int ps = 0; ps < 4; ++ps) *(LAS u32x4*)(Ks + ((tid >> 4) + 32 * ps) * KS_ST + 8 * (tid & 15)) = kr[ps];
#pragma unroll
        for (int ps = 0; ps < 2; ++ps) {
            const int s = (tid >> 3) + 64 * ps, vc = tid & 7; const float wv = __expf((ps ? gv1 : gv0) - Ml); u32x4 o;
            *(LAS u32x4*)(Vn + s * VS_ST + 8 * vc) = vr[ps];
#pragma unroll
            for (int e = 0; e < 4; ++e) o[e] = pkbf(bflo(vr[ps][e]) * wv, bfhi(vr[ps][e]) * wv);
            *(LAS u32x4*)(Vw + s * VS_ST + 8 * vc) = o;
        }
        if (tid < 128) { ((LAS unsigned*)(Vw + tid * VS_ST + 64))[0] = pkbf(__expf(gmine - Ml), 0.f); gA[tid] = gmine; }
        bf16x8 Bq[4];
#pragma unroll
        for (int kk = 0; kk < 4; ++kk) Bq[kk] = __builtin_bit_cast(bf16x8, qr[kk]);
        __syncthreads();
#ifdef MK_TIME_PHASE
        const unsigned long long t1_ = __builtin_amdgcn_s_memrealtime();
#endif
        if (!isctx) {
            const float Mt = fmaxf(mst, pmt);
            const float dect = __expf(mst - Mt), ebt = __expf(-bt - Mt);
            f32x4 num[5];
#pragma unroll
            for (int vt = 0; vt < 5; ++vt) num[vt] = (f32x4){0.f, 0.f, 0.f, 0.f};
            {
                bf16x8 fa[5], fb[5];
#define ML_LDC(dst, kk) do { _Pragma("unroll") for (int vt = 0; vt < 5; ++vt) { const LAS bf16_t* cp = Cn + (32 * (kk) + 8 * fq + q4) * VS_ST + 16 * vt + 4 * p4; dst[vt] = tr2(cp, cp + 4 * VS_ST); } } while (0)
#define ML_MMC(src, kk) do { _Pragma("unroll") for (int vt = 0; vt < 5; ++vt) num[vt] = mfma16(src[vt], Bq[kk], num[vt]); } while (0)
                ML_LDC(fa, 0); ML_LDC(fb, 1); ML_MMC(fa, 0); ML_LDC(fa, 2); ML_MMC(fb, 1); ML_LDC(fb, 3); ML_MMC(fa, 2); ML_MMC(fb, 3);
#undef ML_LDC
#undef ML_MMC
#pragma unroll
                for (int vt = 0; vt < 5; ++vt) num[vt] = num[vt] * dect;
            }
            if (ci + 1 < 34) ML_LOAD_KV(ci + 1);
#pragma unroll
            for (int kk2 = 0; kk2 < 4; ++kk2) {
                if (2 * kk2 <= tw) {
                    const bool two = (2 * kk2 + 1) <= tw;
                    bf16x8 ka[2][4], fv[5];
#pragma unroll
                    for (int hh = 0; hh < 2; ++hh)
#pragma unroll
                        for (int kk = 0; kk < 4; ++kk) ka[hh][kk] = *(const LAS bf16x8*)(Ks + (16 * (2 * kk2 + hh) + fr) * KS_ST + 32 * kk + 8 * fq);
                    const f32x4 gs0 = *(const LAS f32x4*)(gA + 32 * kk2 + 4 * fq), gs1 = *(const LAS f32x4*)(gA + 32 * kk2 + 16 + 4 * fq);
#pragma unroll
                    for (int vt = 0; vt < 5; ++vt) { const LAS bf16_t* vp = Vn + (32 * kk2 + 4 * fq + q4) * VS_ST + 16 * vt + 4 * p4; fv[vt] = tr2(vp, vp + 16 * VS_ST); }
                    f32x4 Pp[2];
                    Pp[0] = (f32x4){0.f, 0.f, 0.f, 0.f}; Pp[1] = (f32x4){0.f, 0.f, 0.f, 0.f};
#pragma unroll
                    for (int kk = 0; kk < 4; ++kk) { Pp[0] = mfma16(ka[0][kk], Bq[kk], Pp[0]); Pp[1] = mfma16(ka[1][kk], Bq[kk], Pp[1]); }
#pragma unroll
                    for (int r = 0; r < 4; ++r) {
                        const int s0 = 32 * kk2 + 4 * fq + r, s1 = s0 + 16;
                        Pp[0][r] *= (s0 <= t) ? __builtin_amdgcn_exp2f((gs0[r] - Mt) * LOG2E) : 0.f;
                        Pp[1][r] *= (two && s1 <= t) ? __builtin_amdgcn_exp2f((gs1[r] - Mt) * LOG2E) : 0.f;
                    }
                    const bf16x8 Bw = pack8(Pp[0], Pp[1]);
#pragma unroll
                    for (int vt = 0; vt < 5; ++vt) num[vt] = mfma16(fv[vt], Bw, num[vt]);
                }
            }
            const float den = __shfl(num[4][0], fr);
            const float inv = 1.f / fmaxf(fabsf(den), ebt);
            unsigned char* hp = H + (size_t)(seq0 + post) * 512 + h * 128 + vh * 64 + 4 * fq;
#pragma unroll
            for (int vt = 0; vt < 4; ++vt) { const f32x4 o = num[vt] * inv;
                *(unsigned*)(hp + 16 * vt) = pk4_fp8(__builtin_amdgcn_fmed3f(o[0], -448.f, 448.f), __builtin_amdgcn_fmed3f(o[1], -448.f, 448.f), __builtin_amdgcn_fmed3f(o[2], -448.f, 448.f), __builtin_amdgcn_fmed3f(o[3], -448.f, 448.f)); }
        }
        if (isctx) ML_LOAD_KV(ci + 1);
        if (ci + 1 < 34) ML_LOAD_Q(ci + 1);
        {
#pragma unroll
            for (int vt = 0; vt < 5; ++vt) accC[vt] = accC[vt] * av;
            bf16x8 sa[6], sb[6];
#define ML_LDS_(dst, kk2) do { _Pragma("unroll") for (int vt = 0; vt < 5; ++vt) { const LAS bf16_t* vp = Vw + (32 * (kk2) + 8 * fq + q4) * VS_ST + 16 * vt + 4 * p4; dst[vt] = tr2(vp, vp + 4 * VS_ST); } \
                { const LAS bf16_t* kp = Ks + (32 * (kk2) + 8 * fq + q4) * KS_ST + 16 * w + 4 * p4; dst[5] = tr2(kp, kp + 4 * KS_ST); } } while (0)
#define ML_MMS_(src) do { _Pragma("unroll") for (int vt = 0; vt < 5; ++vt) accC[vt] = mfma16(src[vt], src[5], accC[vt]); } while (0)
            ML_LDS_(sa, 0); ML_LDS_(sb, 1); ML_MMS_(sa); ML_LDS_(sa, 2); ML_MMS_(sb); ML_LDS_(sb, 3); ML_MMS_(sa); ML_MMS_(sb);
#undef ML_LDS_
#undef ML_MMS_
        }
        __syncthreads();
#ifdef MK_TIME_PHASE
        { const unsigned long long t2_ = __builtin_amdgcn_s_memrealtime(); tA_ += t1_ - t0_; tB_ += t2_ - t1_; }
#endif
#pragma unroll
        for (int vt = 0; vt < 5; ++vt) { u32x2 wv; wv.x = pkbf(accC[vt][0], accC[vt][1]); wv.y = pkbf(accC[vt][2], accC[vt][3]); *(LAS u32x2*)(Cn + (16 * w + fr) * VS_ST + 16 * vt + 4 * fq) = wv; }
    }
    __syncthreads();
#ifdef MK_TIME_PHASE
    if (blockIdx.x == 0 && threadIdx.x == 0) { unsigned long long* ts = (unsigned long long*)(a.ws + WS_MISC + 128); ts[12] = tA_; ts[13] = tB_; }
#endif
}
#undef ML_LOAD_KV
#undef ML_LOAD_Q
#undef ML_POS
#undef ML_GEOM

__device__ __forceinline__ void mlstm_out_rows(const Args& a, int row_lo, int nrows) {
    const int tid = threadIdx.x, lane = tid & 63, wave = tid >> 6;
    const unsigned char* HF = a.ws + WS_HF; const unsigned char* HB = a.ws + WS_HB;
    const bf16_t* MO = (const bf16_t*)(a.ws + WS_M4) + (size_t)3 * MA * 512;
    bf16_t* MIX = (bf16_t*)(a.ws + WS_MIX);
    const f32x4 nw0 = *(const f32x4*)(a.in[14] + 8 * lane), nw1 = *(const f32x4*)(a.in[14] + 8 * lane + 4);
    for (int i0 = wave; i0 < nrows; i0 += 4 * NWAVES) {
        u32x2 f[4], bb[4]; u32x4 mo[4];
#pragma unroll
        for (int u = 0; u < 4; ++u) { const size_t o = (size_t)(row_lo + i0 + u * NWAVES) * 512 + 8 * lane; f[u] = __builtin_nontemporal_load((const u32x2*)(HF + o)); bb[u] = __builtin_nontemporal_load((const u32x2*)(HB + o)); mo[u] = __builtin_nontemporal_load((const u32x4*)(MO + o)); }
#pragma unroll
        for (int u = 0; u < 4; ++u) {
            float sv[8]; float ss = 0.f;
#pragma unroll
            for (int d = 0; d < 2; ++d) { const f32x4 hf = dec4_fp8(f[u][d]), hb = dec4_fp8(bb[u][d]);
#pragma unroll
                for (int i = 0; i < 4; ++i) { sv[4 * d + i] = hf[i] + hb[i]; ss += sv[4 * d + i] * sv[4 * d + i]; } }
            ss += __shfl_xor(ss, 1); ss += __shfl_xor(ss, 2); ss += __shfl_xor(ss, 4); ss += __shfl_xor(ss, 8);
            const float r = rsqrtf(ss * (1.f / 128.f) + EPS);
            float ov[8];
#pragma unroll
            for (int e = 0; e < 4; ++e) {
                ov[2 * e] = sv[2 * e] * r * (e < 2 ? nw0[2 * e] : nw1[2 * e - 4]) * __builtin_amdgcn_rcpf(1.f + __expf(-bflo(mo[u][e])));
                ov[2 * e + 1] = sv[2 * e + 1] * r * (e < 2 ? nw0[2 * e + 1] : nw1[2 * e - 3]) * __builtin_amdgcn_rcpf(1.f + __expf(-bfhi(mo[u][e])));
            }
            u32x4 o; o.x = pkbf(ov[0], ov[1]); o.y = pkbf(ov[2], ov[3]); o.z = pkbf(ov[4], ov[5]); o.w = pkbf(ov[6], ov[7]);
            *(u32x4*)(MIX + (size_t)(row_lo + i0 + u * NWAVES) * D + 512 + 8 * lane) = o;
        }
    }
}
__device__ __forceinline__ void post_rows(const Args& a, LAS unsigned char* lds, int row_lo, int nrows) {
    const int tid = threadIdx.x, lane = tid & 63, wave = tid >> 6, fr = lane & 15, kq = lane >> 4;
    const int b = row_lo >> 12; const float* mr = (const float*)(a.ws + WS_MOD) + b * 6144; const float* n2w = a.in[7]; const float* Wr = a.in[16];
    LAS bf16_t* WB = (LAS bf16_t*)lds; LAS float* SC = (LAS float*)(lds + 32768); LAS float* SH = (LAS float*)(lds + 36864); LAS float* CP = (LAS float*)(lds + 40960);
    for (int c = tid; c < D; c += NTHREADS) {
        const float scv = n2w[c] * (1.f + mr[4 * D + c]); SC[c] = scv; SH[c] = mr[3 * D + c];
        const int s = 2 * (c >> 6) + ((c >> 3) & 1), q = (c >> 4) & 3, ee = c & 7;
#pragma unroll
        for (int j = 0; j < 4; ++j) { const f32x4 w = *(const f32x4*)(Wr + (size_t)c * 16 + 4 * j);
#pragma unroll
            for (int i = 0; i < 4; ++i) WB[((s * 64 + q * 16 + 4 * j + i) << 3) + ee] = (bf16_t)(pkbf(scv * w[i], 0.f) & 0xffffu); }
    }
    { const int e = tid & 15, part = tid >> 4; float cb = 0.f;
#pragma unroll 16
        for (int i = 0; i < 32; ++i) { const int c = part * 32 + i; cb += mr[3 * D + c] * Wr[(size_t)c * 16 + e]; }
        CP[part * 16 + e] = cb; }
    __syncthreads();
    if (tid < 16) { float t = 0.f; for (int p = 0; p < 32; ++p) t += CP[p * 16 + tid]; CP[512 + tid] = t; }
    __syncthreads();
    const float cbe = CP[512 + fr];
    unsigned char* HX2 = a.ws + WS_HX; float* AFF = (float*)(a.ws + WS_AFF);
    const bf16_t* X1 = (const bf16_t*)(a.ws + WS_X1);
#pragma unroll 1
    for (int t0 = wave * 16; t0 < nrows; t0 += NWAVES * 16) {
        int row = row_lo + t0 + fr; asm volatile("" : "+v"(row));
        const bf16_t* xp = X1 + (size_t)row * D + 16 * kq;
        u32x4 xv[32];
#pragma unroll
        for (int p = 0; p < 16; ++p) { xv[2 * p] = __builtin_nontemporal_load((const u32x4*)(xp + 64 * p)); xv[2 * p + 1] = __builtin_nontemporal_load((const u32x4*)(xp + 64 * p + 8)); }
        f32x4 acc = {0.f, 0.f, 0.f, 0.f}; float ss = 0.f;
        int boff = lane * 8, coff = 16 * kq; asm volatile("" : "+v"(boff), "+v"(coff));
#pragma unroll
        for (int g = 0; g < 8; ++g) {
            bf16x8 Bf[4];
#pragma unroll
            for (int i = 0; i < 4; ++i) Bf[i] = *(const LAS bf16x8*)(WB + boff + (4 * g + i) * 512);
#pragma unroll
            for (int i = 0; i < 4; ++i) { const u32x4 v = xv[4 * g + i]; acc = mfma16(__builtin_bit_cast(bf16x8, v), Bf[i], acc);
                ss += (bflo(v.x) * bflo(v.x) + bfhi(v.x) * bfhi(v.x)) + (bflo(v.y) * bflo(v.y) + bfhi(v.y) * bfhi(v.y)) + (bflo(v.z) * bflo(v.z) + bfhi(v.z) * bfhi(v.z)) + (bflo(v.w) * bflo(v.w) + bfhi(v.w) * bfhi(v.w)); }
            asm volatile("" : "+v"(boff), "+v"(acc));
        }
        ss += __shfl_xor(ss, 16); ss += __shfl_xor(ss, 32);
        const float rstd = rsqrtf(ss * (1.f / D) + EPS);
#pragma unroll
        for (int i = 0; i < 32; ++i) asm volatile("" : "+v"(xv[i]));
        f32x4 af;
#pragma unroll
        for (int i = 0; i < 4; ++i) {
            const float lg = acc[i] * __shfl(rstd, 4 * kq + i) + cbe;
            float mx = lg; mx = fmaxf(mx, __shfl_xor(mx, 1)); mx = fmaxf(mx, __shfl_xor(mx, 2)); mx = fmaxf(mx, __shfl_xor(mx, 4)); mx = fmaxf(mx, __shfl_xor(mx, 8));
            const float e = expf(lg - mx); float sum = e; sum += __shfl_xor(sum, 1); sum += __shfl_xor(sum, 2); sum += __shfl_xor(sum, 4); sum += __shfl_xor(sum, 8);
            af[i] = e / sum;
        }
        *(f32x4*)(AFF + ((size_t)b * NE + fr) * NT + ((row_lo + t0) & (NT - 1)) + 4 * kq) = af;
        unsigned char* hp = HX2 + (size_t)row * D + 16 * kq;
#pragma unroll
        for (int p = 0; p < 16; ++p) {
            u32x4 o;
#pragma unroll
            for (int h = 0; h < 2; ++h) { const u32x4 v = xv[2 * p + h]; const int c0 = 64 * p + coff + 8 * h;
                const f32x4 s0 = *(const LAS f32x4*)(SC + c0), s1 = *(const LAS f32x4*)(SC + c0 + 4), h0 = *(const LAS f32x4*)(SH + c0), h1 = *(const LAS f32x4*)(SH + c0 + 4);
                const unsigned lo = pk4_fp8(bflo(v.x) * (rstd * s0[0]) + h0[0], bfhi(v.x) * (rstd * s0[1]) + h0[1], bflo(v.y) * (rstd * s0[2]) + h0[2], bfhi(v.y) * (rstd * s0[3]) + h0[3]);
                const unsigned hi = pk4_fp8(bflo(v.z) * (rstd * s1[0]) + h1[0], bfhi(v.z) * (rstd * s1[1]) + h1[1], bflo(v.w) * (rstd * s1[2]) + h1[2], bfhi(v.w) * (rstd * s1[3]) + h1[3]);
                if (h == 0) { o.x = lo; o.y = hi; } else { o.z = lo; o.w = hi; } }
            *(u32x4*)(hp + 64 * p) = o;
        }
    }
    __syncthreads();
}

__device__ __forceinline__ void topk_select(const Args& a, LAS unsigned char* lds, int z) {
    const int tid = threadIdx.x, lane = tid & 63, wave = tid >> 6;
    LAS unsigned* hist = (LAS unsigned*)lds; LAS unsigned* sc = hist + 256; LAS unsigned* wsum = hist + 272;
    const float* aff = (const float*)(a.ws + WS_AFF) + (size_t)z * NT;
    int* idx = (int*)(a.ws + WS_IDX) + z * CAP; float* gate = (float*)(a.ws + WS_GATE) + z * CAP; int* slot = (int*)(a.ws + WS_SLOT) + (size_t)z * NT;
    unsigned key[8];
    { const u32x4 k0 = *(const u32x4*)(aff + 8 * tid), k1 = *(const u32x4*)(aff + 8 * tid + 4); key[0] = k0.x; key[1] = k0.y; key[2] = k0.z; key[3] = k0.w; key[4] = k1.x; key[5] = k1.y; key[6] = k1.z; key[7] = k1.w; }
    unsigned prefix = 0u, need = CAP;
#pragma unroll 1
    for (int pass = 0; pass < 4; ++pass) {
        const int shift = 24 - 8 * pass;
        if (tid < 256) hist[tid] = 0u;
        __syncthreads();
#pragma unroll
        for (int i = 0; i < 8; ++i) { const bool match = (pass == 0) || ((key[i] >> (shift + 8)) == prefix); if (match) __hip_atomic_fetch_add(&hist[(key[i] >> shift) & 255u], 1u, __ATOMIC_RELAXED, __HIP_MEMORY_SCOPE_WORKGROUP); }
        __syncthreads();
        if (wave == 0) {
            unsigned c[4]; unsigned s = 0u;
#pragma unroll
            for (int j = 0; j < 4; ++j) { c[j] = hist[255 - (4 * lane + j)]; s += c[j]; }
            unsigned incl = s;
#pragma unroll
            for (int o = 1; o < 64; o <<= 1) { const unsigned y = __shfl_up(incl, o); if (lane >= o) incl += y; }
            unsigned cb = incl - s;
#pragma unroll
            for (int j = 0; j < 4; ++j) { if (cb < need && need <= cb + c[j]) { sc[0] = (prefix << 8) | (unsigned)(255 - (4 * lane + j)); sc[1] = need - cb; } cb += c[j]; }
        }
        __syncthreads();
        prefix = sc[0]; need = sc[1];
        __syncthreads();
    }
    const unsigned T = prefix;
    unsigned cg = 0u, ce = 0u;
#pragma unroll
    for (int i = 0; i < 8; ++i) { cg += key[i] > T ? 1u : 0u; ce += key[i] == T ? 1u : 0u; }
    const unsigned mine = cg | (ce << 16);
    unsigned incl = mine;
#pragma unroll
    for (int o = 1; o < 64; o <<= 1) { const unsigned y = __shfl_up(incl, o); if (lane >= o) incl += y; }
    if (lane == 63) wsum[wave] = incl;
    __syncthreads();
    unsigned base = 0u;
    for (int q = 0; q < wave; ++q) base += wsum[q];
    const unsigned excl = base + incl - mine;
    unsigned pg = excl & 0xffffu, pe = excl >> 16;
    const unsigned total_gt = CAP - need;
#pragma unroll
    for (int i = 0; i < 8; ++i) {
        const int tok = 8 * tid + i; int sl = -1;
        if (key[i] > T) { sl = (int)pg; ++pg; }
        else if (key[i] == T) { if (pe < need) sl = (int)(total_gt + pe); ++pe; }
        if (sl >= 0) { idx[sl] = tok; gate[sl] = __builtin_bit_cast(float, key[i]); }
        slot[tok] = sl;
    }
    __syncthreads();
}

#define XB_TMO      128
#define XB_XCNT(j)  (256  + 64 * (j))
#define XB_XSUB(j)  (1280 + 64 * (j))
#define XB_XGEN(j)  (2304 + 64 * (j))
#define XB_TOP      3328
#define XB_TOPGEN   3392
#define XCD_BAR_WORDS 3456
#define XB_SPIN_CAP (1u << 18)

__device__ __forceinline__ unsigned xb_ld(unsigned* p)              { return __hip_atomic_load(p, __ATOMIC_RELAXED, __HIP_MEMORY_SCOPE_AGENT); }
__device__ __forceinline__ unsigned xb_add(unsigned* p, unsigned v) { return __hip_atomic_fetch_add(p, v, __ATOMIC_RELAXED, __HIP_MEMORY_SCOPE_AGENT); }
__device__ __forceinline__ unsigned xb_xcc_id() { return (unsigned)__builtin_amdgcn_s_getreg((3 << 11) | 20) & 0xFu; }
#define XB_SPIN(cond, bar) do { unsigned _sp = 0; while (cond) { __builtin_amdgcn_s_sleep(1); \
    if ((++_sp & 255u) == 0u) { if (xb_ld(&(bar)[XB_TMO])) break; if (_sp > XB_SPIN_CAP) { atomicAdd(&(bar)[XB_TMO], 1u); break; } } } } while (0)

struct XcdBarrier {
    unsigned* bar; unsigned x;
    volatile LAS unsigned* st;
};

__device__ __forceinline__ XcdBarrier xcd_barrier_post(unsigned* bar, volatile LAS unsigned* st) {
    XcdBarrier b; b.bar = bar; b.x = xb_xcc_id(); b.st = st;
    if (threadIdx.x == 0) (void)xb_add(&bar[XB_XCNT(b.x)], 1u);
    return b;
}
__device__ __forceinline__ void xcd_barrier_complete(unsigned* bar, unsigned x, unsigned& nloc, unsigned& nx) {
    const unsigned G = gridDim.x * gridDim.y * gridDim.z;
    unsigned sum, cnt, mine, sp = 0u;
    for (;;) {
        sum = 0u; cnt = 0u; mine = 0u;
#pragma unroll
        for (unsigned j = 0; j < 16; ++j) { const unsigned c = xb_ld(&bar[XB_XCNT(j)]); sum += c; cnt += (c > 0u) ? 1u : 0u; mine = (j == x) ? c : mine; }
        if (sum == G) break;
        __builtin_amdgcn_s_sleep(1);
        if ((++sp & 255u) == 0u) { if (xb_ld(&bar[XB_TMO])) break; if (sp > XB_SPIN_CAP) { atomicAdd(&bar[XB_TMO], 1u); break; } }
    }
    nloc = mine > 0u ? mine : 1u; nx = cnt > 0u ? cnt : 1u;
}

__device__ __forceinline__ void xcd_barrier(const XcdBarrier& b) {
    asm volatile("s_waitcnt vmcnt(0)" ::: "memory");
    __syncthreads();
    if (threadIdx.x == 0) {
        unsigned* bar = b.bar;
        __builtin_amdgcn_s_waitcnt(0);
        unsigned nloc = b.st[0], nx = b.st[1];
        if (nloc == 0u) { xcd_barrier_complete(bar, b.x, nloc, nx); b.st[0] = nloc; b.st[1] = nx; }
        const unsigned old = xb_add(&bar[XB_XSUB(b.x)], 1u);
        const unsigned gen = old / nloc;
        if (old + 1u == (gen + 1u) * nloc) {
            __builtin_amdgcn_fence(__ATOMIC_RELEASE, "agent");
            asm volatile("s_waitcnt vmcnt(0)" ::: "memory");
            const unsigned og = xb_add(&bar[XB_TOP], 1u);
            const unsigned tg = og / nx;
            if (og + 1u == (tg + 1u) * nx) xb_add(&bar[XB_TOPGEN], 1u);
            else XB_SPIN(xb_ld(&bar[XB_TOPGEN]) == tg, bar);
            __builtin_amdgcn_fence(__ATOMIC_ACQUIRE, "agent");
            xb_add(&bar[XB_XGEN(b.x)], 1u);
            asm volatile("s_waitcnt vmcnt(0)" ::: "memory");
        } else {
            XB_SPIN(xb_ld(&bar[XB_XGEN(b.x)]) == gen, bar);
            __builtin_amdgcn_fence(__ATOMIC_ACQUIRE, "agent");
            asm volatile("s_waitcnt vmcnt(0)" ::: "memory");
        }
    }
    __syncthreads();
}

template <class F> __device__ __forceinline__ void xcd_barrier_w(const XcdBarrier& b, const F& side) {
    asm volatile("s_waitcnt vmcnt(0)" ::: "memory");
    __syncthreads();
    if (threadIdx.x == 0) {
        unsigned* bar = b.bar;
        __builtin_amdgcn_s_waitcnt(0);
        unsigned nloc = b.st[0], nx = b.st[1];
        if (nloc == 0u) { xcd_barrier_complete(bar, b.x, nloc, nx); b.st[0] = nloc; b.st[1] = nx; }
        const unsigned old = xb_add(&bar[XB_XSUB(b.x)], 1u);
        const unsigned gen = old / nloc;
        if (old + 1u == (gen + 1u) * nloc) {
            __builtin_amdgcn_fence(__ATOMIC_RELEASE, "agent");
            asm volatile("s_waitcnt vmcnt(0)" ::: "memory");
            const unsigned og = xb_add(&bar[XB_TOP], 1u);
            const unsigned tg = og / nx;
            if (og + 1u == (tg + 1u) * nx) xb_add(&bar[XB_TOPGEN], 1u);
            else XB_SPIN(xb_ld(&bar[XB_TOPGEN]) == tg, bar);
            __builtin_amdgcn_fence(__ATOMIC_ACQUIRE, "agent");
            xb_add(&bar[XB_XGEN(b.x)], 1u);
            asm volatile("s_waitcnt vmcnt(0)" ::: "memory");
        } else {
            XB_SPIN(xb_ld(&bar[XB_XGEN(b.x)]) == gen, bar);
            __builtin_amdgcn_fence(__ATOMIC_ACQUIRE, "agent");
            asm volatile("s_waitcnt vmcnt(0)" ::: "memory");
        }
    } else if (threadIdx.x >= 64) side();
    __syncthreads();
}

__device__ __forceinline__ Args load_args() {
    typedef const volatile Args __attribute__((address_space(4))) KA;
    KA* p = (KA*)__builtin_amdgcn_kernarg_segment_ptr();
    Args r;
#pragma unroll
    for (int i = 0; i < 20; ++i) r.in[i] = (const float*)p->in[i];
    r.out = (float*)p->out; r.ws = (unsigned char*)p->ws; r.ph_lo = p->ph_lo; r.ph_hi = p->ph_hi; r.sub = p->sub; r.pad = 0;
    return r;
}
__device__ __forceinline__ void stagger_wait(unsigned ticks) {
    const unsigned long long t0 = __builtin_amdgcn_s_memrealtime();
    while ((unsigned)(__builtin_amdgcn_s_memrealtime() - t0) < ticks) __builtin_amdgcn_s_sleep(16);
}
#ifndef MK_STAG2
#define MK_STAG2 0
#endif
#ifndef MK_STAG6
#define MK_STAG6 0
#endif
#ifndef MK_STAG8
#define MK_STAG8 0
#endif
struct MlPrepSide { const unsigned char* unused; LAS unsigned char* lds; int item; __device__ __forceinline__ void operator()() const { const Args a = load_args(); mlstm_prep(a, lds, item, 1, NWAVES - 1); } };
template <int MASK> __global__ void __launch_bounds__(NTHREADS, 2) mk_fwd_t(Args a_unused_) {
    extern __shared__ __attribute__((aligned(16))) unsigned char lds_raw[];
    LAS unsigned char* lds = (LAS unsigned char*)lds_raw;
    __builtin_assume(__builtin_amdgcn_workitem_id_y() == 0); __builtin_assume(__builtin_amdgcn_workitem_id_z() == 0);
    cg::grid_group grid = cg::this_grid();
    if (threadIdx.x < 2) ((LAS unsigned*)(lds + LDS_BAR_OFF))[threadIdx.x] = 0u;
    __syncthreads();
    int lo, hi; unsigned char* ws0; { const Args a = load_args(); lo = a.ph_lo; hi = a.ph_hi; ws0 = a.ws; }
#ifdef MK_NO_MEMSET
    if (blockIdx.x == 0) for (int i = threadIdx.x; i < 4096; i += NTHREADS) ((unsigned*)(ws0 + WS_BAR))[i] = 0u;
    XcdBarrier xbar; xbar.bar = (unsigned*)(ws0 + WS_BAR); xbar.x = 0; xbar.st = (volatile LAS unsigned*)(lds + LDS_BAR_OFF);
#else
    XcdBarrier xbar = xcd_barrier_post((unsigned*)(ws0 + WS_BAR), (volatile LAS unsigned*)(lds + LDS_BAR_OFF));
#endif
    const int c = blockIdx.x, G = gridDim.x;
#define IN(k) ((((MASK) >> (k)) & 1) && lo <= (k) && (k) < hi)
#ifdef MK_TIME_PHASE
#define MK_STAMP(k) do { if (blockIdx.x == 0 && threadIdx.x == 0) ((unsigned long long*)(load_args().ws + WS_MISC + 128))[(k)] = __builtin_amdgcn_s_memrealtime(); } while (0)
#else
#define MK_STAMP(k) do { } while (0)
#endif
#ifdef MK_NO_MEMSET
#define SEAM(k) do { if (IN(k) && IN((k) + 1)) { if ((k) == 0) { grid.sync(); xbar = xcd_barrier_post(xbar.bar, xbar.st); } else xcd_barrier(xbar); MK_STAMP((k) + 1); } } while (0)
#else
#define SEAM(k) do { if (IN(k) && IN((k) + 1)) { xcd_barrier(xbar); MK_STAMP((k) + 1); } } while (0)
#endif
    if (lo < 0) grid.sync();

    MK_STAMP(0);
    if (IN(0)) { const Args a = load_args(); phase0(a, lds); }
    SEAM(0);
    if (IN(1)) { const Args a = load_args(); phase1(a, lds); }
    SEAM(1);
    if (IN(2)) {
        const Args a = load_args(); unsigned char* const ws = a.ws; (void)ws;
        Gemm g{(const bf16_t*)(ws + WS_HX), (const bf16_t*)(ws + WS_WIN), MA, NPROJ, D};
        P2TwoPass S{G, c};
        EpiProj E{(bf16_t*)(ws + WS_Q), (bf16_t*)(ws + WS_KK), (bf16_t*)(ws + WS_VV), (bf16_t*)(ws + WS_M4), a.in[11], a.in[12], (const float*)(ws + WS_ROPE), 0.125f * LOG2E};
        pg8::gemm_phase<EpiProj, P2TwoPass, true, true>(lds, g, S, E);
        __syncthreads();
    }
    SEAM(2);
    if (IN(3)) {
        const Args a = load_args(); unsigned char* const ws = a.ws; (void)ws;
        if (c & 1) { conv_rows(a); transpose_late(a, lds, 0, 512); __syncthreads(); }
#ifndef MK_NO_ATTN
        if (G == 256) { const int x = c & 7, k = c >> 3; for (int i = 0; i < 4; ++i) attn_item(a, lds, ((4 * x + i) << 5) | k); }
        else for (int it = c; it < 1024; it += G) attn_item(a, lds, it);
#endif
        if (!(c & 1)) { __syncthreads(); conv_rows(a); transpose_late(a, lds, 0, 512); }
    }
    bool ml_prepped = false;
    if (IN(3) && IN(4)) {
        if (G == 256) { const int x = c & 7, k = c >> 3; MlPrepSide side{nullptr, lds, 4 * (8 * x + (k >> 2)) + (k & 3)}; xcd_barrier_w(xbar, side); ml_prepped = true; }
        else xcd_barrier(xbar);
        MK_STAMP(4);
    }
    if (IN(4)) {
        const Args a = load_args(); unsigned char* const ws = a.ws; (void)ws;
#ifndef MK_NO_ML
        if (G == 256) { const int x = c & 7, k = c >> 3; mlstm_item(a, lds, 4 * (8 * x + (k >> 2)) + (k & 3), ml_prepped); }
        else for (int it = c; it < 256; it += G) mlstm_item(a, lds, it, false);
#endif
    }
    SEAM(4);
    if (IN(5)) {
        const Args a = load_args(); unsigned char* const ws = a.ws; (void)ws;
        if (c < 256) mlstm_out_rows(a, c * 256, 256);
    }
    __syncthreads(); MK_STAMP(6);
    if (IN(6)) {
        const Args a = load_args(); unsigned char* const ws = a.ws; (void)ws;
        Gemm g{(const bf16_t*)(ws + WS_MIX), (const bf16_t*)(ws + WS_WOUT), MT, D, D};
        SeqOrder S{c, 4, 4};
        EpiOut E{a.in[0], (const float*)(ws + WS_MOD), (bf16_t*)(ws + WS_X1)};
        if (c < 256) pg8::gemm_phase<EpiOut, SeqOrder, true, true>(lds, g, S, E);
        __syncthreads();
    }
    __syncthreads(); MK_STAMP(7);
    if (IN(7)) {
        const Args a = load_args(); unsigned char* const ws = a.ws; (void)ws;
        if (c < 256) post_rows(a, lds, c * 256, 256);
        transpose_late(a, lds, 512, 512 + NE * 768);
        __syncthreads();
    }
    SEAM(7);
    if (IN(8)) {
        const Args a = load_args(); unsigned char* const ws = a.ws; (void)ws;
        if (c < 256) { const int z = c;
            const int b = z >> 4, e = z & 15;
            topk_select(a, lds, z);
            MK_STAMP(16);
            const bf16_t* HX2 = (const bf16_t*)(ws + WS_HX + (size_t)b * NT * D); const int* idx = (const int*)(ws + WS_IDX) + z * CAP;
            unsigned char* ACT = ws + WS_ACT + (size_t)z * CAP * FF;
            ((LAS float*)(lds + LDS_GATE_OFF))[threadIdx.x] = ((const float*)(ws + WS_GATE) + z * CAP)[threadIdx.x];
            __syncthreads();
            MK_STAMP(17);
#pragma unroll 1
            for (int half = 0; half < 2; ++half) { Gemm g{HX2, (const bf16_t*)(ws + WS_WGU + (size_t)e * 1024 * D), 256, 1024, D / 2, idx + 256 * half}; SeqOrder S{0, 4, 4}; EpiAct E{ACT + (size_t)half * 256 * FF};
              pg8::gemm_phase<EpiAct, SeqOrder, true, true, 1, FP8_W_SCALE>(lds, g, S, E); __syncthreads(); }
            MK_STAMP(18);
            { Gemm g{(const bf16_t*)ACT, (const bf16_t*)(ws + WS_WD + (size_t)e * D * FF), CAP, D, FF / 2}; SeqOrder S{0, 4, 8}; EpiDown E{ws + WS_MIX + (size_t)z * CAP * D, (const LAS float*)(lds + LDS_GATE_OFF), Y_FP8_UP / FP8_W_UP};
              pg8::gemm_phase<EpiDown, SeqOrder, false, true, 1, FP8_W_SCALE>(lds, g, S, E); }
            __syncthreads();
        }
    }
    SEAM(8);
    if (IN(9)) {
        const Args a = load_args(); unsigned char* const ws = a.ws; (void)ws;
        const int tid = threadIdx.x, lane = tid & 63, wave = tid >> 6;
        const int gw = c * NWAVES + wave, NGW = G * NWAVES;
        const int* SL = (const int*)(ws + WS_SLOT); const unsigned char* Y = ws + WS_MIX; const float* mod = (const float*)(ws + WS_MOD);
        const bf16_t* X1 = (const bf16_t*)(ws + WS_X1);
        for (int grp = gw; grp < MT / 4; grp += NGW) {
            const int mbase = 4 * grp, b = mbase >> 12, n0 = mbase & (NT - 1);
            const int sv = SL[((size_t)b * NE + (lane & 15)) * NT + n0 + (lane >> 4)];
            const unsigned long long ball = __ballot(sv >= 0);
            const float* g2 = mod + b * 6144 + 5 * D + 4 * lane;
            f32x4 gv[4];
#pragma unroll
            for (int j = 0; j < 4; ++j) gv[j] = *(const f32x4*)(g2 + 256 * j) * (1.f / Y_FP8_UP);
#pragma unroll 1
            for (int u = 0; u < 4; u += 2) {
                unsigned mA = (unsigned)(ball >> (16 * u)) & 0xffffu, mB = (unsigned)(ball >> (16 * u + 16)) & 0xffffu;
                float* orow = a.out + (size_t)(mbase + u) * D + 4 * lane; const bf16_t* xrow = X1 + (size_t)(mbase + u) * D + 4 * lane;
                u32x2 xa[4], xb[4];
#pragma unroll
                for (int j = 0; j < 4; ++j) { xa[j] = __builtin_nontemporal_load((const u32x2*)(xrow + 256 * j)); xb[j] = __builtin_nontemporal_load((const u32x2*)(xrow + D + 256 * j)); }
                float accA[16], accB[16];
#pragma unroll
                for (int i = 0; i < 16; ++i) { accA[i] = 0.f; accB[i] = 0.f; }
                while (mA | mB) {
                    const float wa0 = mA ? 1.f : 0.f; const int ea0 = mA ? __builtin_ctz(mA) : 0; mA &= mA - 1u; const float wa1 = mA ? 1.f : 0.f; const int ea1 = mA ? __builtin_ctz(mA) : ea0; mA &= mA - 1u;
                    const float wb0 = mB ? 1.f : 0.f; const int eb0 = mB ? __builtin_ctz(mB) : 0; mB &= mB - 1u; const float wb1 = mB ? 1.f : 0.f; const int eb1 = mB ? __builtin_ctz(mB) : eb0; mB &= mB - 1u;
                    const int sa0 = max(__shfl(sv, 16 * u + ea0), 0), sa1 = max(__shfl(sv, 16 * u + ea1), 0), sb0 = max(__shfl(sv, 16 * u + 16 + eb0), 0), sb1 = max(__shfl(sv, 16 * u + 16 + eb1), 0);
                    const unsigned char* pa0 = Y + ((size_t)(b * NE + ea0) * CAP + sa0) * D + 4 * lane; const unsigned char* pa1 = Y + ((size_t)(b * NE + ea1) * CAP + sa1) * D + 4 * lane;
                    const unsigned char* pb0 = Y + ((size_t)(b * NE + eb0) * CAP + sb0) * D + 4 * lane; const unsigned char* pb1 = Y + ((size_t)(b * NE + eb1) * CAP + sb1) * D + 4 * lane;
                    unsigned ya0[4], ya1[4], yb0[4], yb1[4];
#pragma unroll
                    for (int j = 0; j < 4; ++j) { ya0[j] = __builtin_nontemporal_load((const unsigned*)(pa0 + 256 * j)); ya1[j] = __builtin_nontemporal_load((const unsigned*)(pa1 + 256 * j));
                        yb0[j] = __builtin_nontemporal_load((const unsigned*)(pb0 + 256 * j)); yb1[j] = __builtin_nontemporal_load((const unsigned*)(pb1 + 256 * j)); }
#pragma unroll
                    for (int j = 0; j < 4; ++j) { const f32x4 a0 = dec4_fp8(ya0[j]), a1 = dec4_fp8(ya1[j]), b0 = dec4_fp8(yb0[j]), b1 = dec4_fp8(yb1[j]);
#pragma unroll
                        for (int i = 0; i < 4; ++i) { accA[4 * j + i] += wa0 * a0[i] + wa1 * a1[i]; accB[4 * j + i] += wb0 * b0[i] + wb1 * b1[i]; } }
                }
#pragma unroll
                for (int j = 0; j < 4; ++j) { f32x4 o; o[0] = bflo(xa[j].x) + gv[j][0] * accA[4 * j]; o[1] = bfhi(xa[j].x) + gv[j][1] * accA[4 * j + 1]; o[2] = bflo(xa[j].y) + gv[j][2] * accA[4 * j + 2]; o[3] = bfhi(xa[j].y) + gv[j][3] * accA[4 * j + 3];
                    *(f32x4*)(orow + 256 * j) = o; }
#pragma unroll
                for (int j = 0; j < 4; ++j) { f32x4 o; o[0] = bflo(xb[j].x) + gv[j][0] * accB[4 * j]; o[1] = bfhi(xb[j].x) + gv[j][1] * accB[4 * j + 1]; o[2] = bflo(xb[j].y) + gv[j][2] * accB[4 * j + 2]; o[3] = bfhi(xb[j].y) + gv[j][3] * accB[4 * j + 3];
                    *(f32x4*)(orow + D + 256 * j) = o; }
            }
        }
    }
#ifdef MK_TIME_PHASE
    xcd_barrier(xbar); MK_STAMP(10);
    xcd_barrier(xbar);
    { const Args a = load_args(); const unsigned long long* ts = (const unsigned long long*)(a.ws + WS_MISC + 128); const int k = MK_TIME_PHASE;
      const float delta = k < 0 ? 0.1f : (k == 30 ? (float)(ts[15] - ts[4]) : k == 31 ? (float)(ts[5] - ts[15]) : k == 99 ? (float)(ts[10] - ts[0]) : k == 70 ? (float)(ts[16] - ts[8]) : k == 71 ? (float)(ts[17] - ts[16]) : k == 72 ? (float)(ts[18] - ts[17]) : k == 73 ? (float)(ts[9] - ts[18]) : k == 32 ? (float)ts[12] : k == 33 ? (float)ts[13] : (float)(ts[k + 1] - ts[k])) * (float)MK_TIME_SCALE * 1e-2f;
      for (size_t i = (size_t)blockIdx.x * NTHREADS + threadIdx.x; i < (size_t)MT * D; i += (size_t)gridDim.x * NTHREADS) a.out[i] += delta; }
#endif
#undef IN
#undef SEAM
}
}

#ifndef MK_N_LAUNCHES
#define MK_N_LAUNCHES 1
#endif
extern "C" void kernel_launch(void* const* d_in, const int* in_sizes, int n_in, void* d_out, int out_size, void* d_ws, size_t ws_size, hipStream_t stream) {
    using namespace mk;
    static int grid = 0;
    if (grid == 0) {
        if (n_in != 20 || out_size != MT * D || ws_size < WS_END) { fprintf(stderr, "kernel_launch: unexpected problem (n_in %d out %d ws %zu need %zu)\n", n_in, out_size, ws_size, (size_t)WS_END); grid = -1; return; }
        int dev = 0, cus = 0, per_cu = 0;
        hipGetDevice(&dev); hipDeviceGetAttribute(&cus, hipDeviceAttributeMultiprocessorCount, dev);
#if MK_N_LAUNCHES == 1
        if (hipFuncSetAttribute((const void*)mk_fwd_t<0x3ff>, hipFuncAttributeMaxDynamicSharedMemorySize, LDS_BYTES) != hipSuccess) { fprintf(stderr, "kernel_launch: hipFuncSetAttribute failed\n"); grid = -1; return; }
        hipOccupancyMaxActiveBlocksPerMultiprocessor(&per_cu, (const void*)mk_fwd_t<0x3ff>, NTHREADS, LDS_BYTES);
#else
        per_cu = 1;
#endif
        (void)hipGetLastError();
        if (per_cu < 1) { fprintf(stderr, "kernel_launch: occupancy query says %d blocks per CU\n", per_cu); per_cu = 1; }
        grid = cus;
        if (grid > 256) grid = 256;
    }
    if (grid < 0) return;
#ifndef MK_NO_MEMSET
    if (hipMemsetAsync((char*)d_ws + WS_BAR, 0, 16384, stream) != hipSuccess) { fprintf(stderr, "kernel_launch: hipMemsetAsync failed\n"); return; }
#endif
    Args a{};
    for (int i = 0; i < 20; ++i) a.in[i] = (const float*)d_in[i];
    a.out = (float*)d_out; a.ws = (unsigned char*)d_ws; a.sub = 7;
#if MK_N_LAUNCHES == 1
    a.ph_lo = 0; a.ph_hi = 10;
    void* args[] = {&a};
#ifdef MK_PLAIN_LAUNCH
    hipLaunchKernelGGL(mk_fwd_t<0x3ff>, dim3(grid), dim3(NTHREADS), LDS_BYTES, stream, a); hipError_t e = hipGetLastError(); (void)args;
#else
    hipError_t e = hipLaunchCooperativeKernel((const void*)mk_fwd_t<0x3ff>, dim3(grid), dim3(NTHREADS), args, LDS_BYTES, stream);
#endif
    if (e != hipSuccess) fprintf(stderr, "cooperative launch failed: %s (grid %d)\n", hipGetErrorString(e), grid);
#else
#define MK_LAUNCH_P(p) do { hipFuncSetAttribute((const void*)mk_fwd_t<(1 << (p))>, hipFuncAttributeMaxDynamicSharedMemorySize, LDS_BYTES); a.ph_lo = (p); a.ph_hi = (p) + 1; hipLaunchKernelGGL(mk_fwd_t<(1 << (p))>, dim3(grid), dim3(NTHREADS), LDS_BYTES, stream, a); } while (0)
#ifndef MK_DUP
#define MK_DUP -1
#endif
#ifndef MK_DUP_SUB
#define MK_DUP_SUB 7
#endif
#define MK_LAUNCH_D(p) do { MK_LAUNCH_P(p); if (MK_DUP == (p)) { a.sub = MK_DUP_SUB; MK_LAUNCH_P(p); a.sub = 7; } } while (0)
    MK_LAUNCH_D(0); MK_LAUNCH_D(1); MK_LAUNCH_D(2); MK_LAUNCH_D(3); MK_LAUNCH_D(4); MK_LAUNCH_D(5); MK_LAUNCH_D(6); MK_LAUNCH_D(7); MK_LAUNCH_D(8); MK_LAUNCH_D(9);
#endif
}
```
